# Optimizing an MI355X kernel written in HIP

```python
import jax, jax.numpy as jnp
from jax import lax
import numpy as np

D_MODEL = 1024
BATCH = 32
SEQ = 2048
DEPTH = 1

HEAD_DIM = 64
FOX_HEADS = 8
NSA_HEADS = 8
NSA_KV_GROUPS = 2
NSA_HEADS_PER_GROUP = NSA_HEADS // NSA_KV_GROUPS
FOX_WIDTH = FOX_HEADS * HEAD_DIM
NSA_WIDTH = NSA_HEADS * HEAD_DIM
NSA_KV_WIDTH = NSA_KV_GROUPS * HEAD_DIM
D_FF = 4 * D_MODEL
ROPE_THETA = 10000.0
Q_BLOCK = 128
CMP_BLOCK = 32
CMP_STRIDE = 16
SEL_BLOCK = 64
SEL_TOPN = 8
SEL_Q_BLOCK = 64
WINDOW = 512
RMS_EPS = 1e-6
NEG_INF = -1e30
FORCED_BONUS = 1e4
FORGET_BIAS_INIT = 2.0
ATTN_SCALE = HEAD_DIM ** -0.5
IN_SPLITS = (FOX_WIDTH, FOX_WIDTH, FOX_WIDTH, FOX_HEADS,
             NSA_WIDTH, NSA_KV_WIDTH, NSA_KV_WIDTH, NSA_KV_WIDTH, NSA_KV_WIDTH, NSA_KV_WIDTH, NSA_KV_WIDTH,
             3 * NSA_HEADS, D_MODEL, D_MODEL)
IN_COLS = 3 * FOX_WIDTH + FOX_HEADS + NSA_WIDTH + 6 * NSA_KV_WIDTH + 3 * NSA_HEADS + 2 * D_MODEL

kernel_name = 'fox_nsa_gated_hybrid_block'


def _rms_norm(x, g):
    xf = x.astype(jnp.float32)
    y = xf * lax.rsqrt(jnp.mean(xf * xf, axis=-1, keepdims=True) + RMS_EPS)
    return (y * g.astype(jnp.float32)).astype(x.dtype)


def _heads(t, n):
    b, s, _ = t.shape
    return t.reshape(b, s, n, HEAD_DIM).transpose(0, 2, 1, 3)


def _rope(t):
    s, d = t.shape[2], t.shape[3]
    inv = jnp.power(jnp.float32(ROPE_THETA), -jnp.arange(0, d, 2, dtype=jnp.float32) / d)
    ang = jnp.arange(s, dtype=jnp.float32)[:, None] * inv[None, :]
    cos, sin = jnp.cos(ang), jnp.sin(ang)
    tf = t.astype(jnp.float32)
    t1, t2 = tf[..., : d // 2], tf[..., d // 2:]
    return jnp.concatenate([t1 * cos - t2 * sin, t2 * cos + t1 * sin], axis=-1).astype(t.dtype)


def _masked_softmax(s, mask):
    s = jnp.where(mask, s, NEG_INF)
    m = jnp.max(s, axis=-1, keepdims=True)
    p = jnp.where(mask, jnp.exp(s - m), 0.0)
    return p / jnp.maximum(jnp.sum(p, axis=-1, keepdims=True), 1e-30)


def _forgetting_attention(q, k, v, f_logit):
    b, h, s, d = q.shape
    nb = s // Q_BLOCK
    c = jnp.cumsum(jax.nn.log_sigmoid(f_logit.astype(jnp.float32)), axis=1).transpose(0, 2, 1)
    kf, vf = k.astype(jnp.float32), v.astype(jnp.float32)
    qb = q.astype(jnp.float32).reshape(b, h, nb, Q_BLOCK, d).transpose(2, 0, 1, 3, 4)
    cb = c.reshape(b, h, nb, Q_BLOCK).transpose(2, 0, 1, 3)
    k_pos = jnp.arange(s)

    def one_block(args):
        i, q_i, c_i = args
        sc = jnp.einsum('bhqd,bhkd->bhqk', q_i, kf) * ATTN_SCALE + c_i[..., None] - c[:, :, None, :]
        q_pos = i * Q_BLOCK + jnp.arange(Q_BLOCK)
        mask = k_pos[None, :] <= q_pos[:, None]
        p = _masked_softmax(sc, mask)
        return jnp.einsum('bhqk,bhkd->bhqd', p, vf)

    out = lax.map(one_block, (jnp.arange(nb), qb, cb))
    out = out.transpose(1, 0, 3, 2, 4).reshape(b, s, h * d)
    return out.astype(q.dtype)


def _compress(t, pos, w1, w2):
    s = t.shape[2]
    n_cmp = (s - CMP_BLOCK) // CMP_STRIDE + 1
    idx = jnp.arange(n_cmp)[:, None] * CMP_STRIDE + jnp.arange(CMP_BLOCK)[None, :]
    blocks = t[:, :, idx, :] + pos
    flat = blocks.reshape(blocks.shape[0], blocks.shape[1], n_cmp, CMP_BLOCK * HEAD_DIM)
    return jax.nn.silu(flat @ w1) @ w2


def _selected_attention(qg, k, v, idx):
    b, g, hg, s, d = qg.shape
    n_sel = s // SEL_BLOCK
    n_top = idx.shape[-1]
    nqb = s // SEL_Q_BLOCK
    ksb = k.reshape(b, g, n_sel, SEL_BLOCK, d)
    vsb = v.reshape(b, g, n_sel, SEL_BLOCK, d)
    qb = qg.reshape(b, g, hg, nqb, SEL_Q_BLOCK, d).transpose(3, 0, 1, 2, 4, 5)
    ib = idx.reshape(b, g, nqb, SEL_Q_BLOCK, n_top).transpose(2, 0, 1, 3, 4)
    bi = jnp.arange(b)[:, None, None, None]
    gi = jnp.arange(g)[None, :, None, None]

    def one_block(args):
        i, q_i, idx_i = args
        kg = ksb[bi, gi, idx_i]
        vg = vsb[bi, gi, idx_i]
        sc = jnp.einsum('bghqd,bgqnld->bghqnl', q_i, kg) * ATTN_SCALE
        key_pos = idx_i[..., None] * SEL_BLOCK + jnp.arange(SEL_BLOCK)
        q_pos = i * SEL_Q_BLOCK + jnp.arange(SEL_Q_BLOCK)
        mask = key_pos <= q_pos[None, None, :, None, None]
        m = n_top * SEL_BLOCK
        p = _masked_softmax(sc.reshape(b, g, hg, SEL_Q_BLOCK, m),
                            mask.reshape(b, g, 1, SEL_Q_BLOCK, m))
        return jnp.einsum('bghqm,bgqmd->bghqd', p, vg.reshape(b, g, SEL_Q_BLOCK, m, d))

    out = lax.map(one_block, (jnp.arange(nqb), qb, ib))
    return out.transpose(1, 2, 3, 0, 4, 5).reshape(b, g, hg, s, d)


def _window_attention(qg, k, v):
    b, g, hg, s, d = qg.shape
    nb = s // Q_BLOCK
    span = WINDOW + Q_BLOCK
    kp = jnp.pad(k, ((0, 0), (0, 0), (WINDOW, 0), (0, 0)))
    vp = jnp.pad(v, ((0, 0), (0, 0), (WINDOW, 0), (0, 0)))
    qb = qg.reshape(b, g, hg, nb, Q_BLOCK, d).transpose(3, 0, 1, 2, 4, 5)

    def one_block(args):
        i, q_i = args
        start = i * Q_BLOCK
        k_i = lax.dynamic_slice_in_dim(kp, start, span, axis=2)
        v_i = lax.dynamic_slice_in_dim(vp, start, span, axis=2)
        q_pos = start + jnp.arange(Q_BLOCK)
        k_pos = start - WINDOW + jnp.arange(span)
        mask = ((k_pos[None, :] <= q_pos[:, None]) & (k_pos[None, :] > q_pos[:, None] - WINDOW)
                & (k_pos[None, :] >= 0))
        sc = jnp.einsum('bghqd,bgkd->bghqk', q_i, k_i) * ATTN_SCALE
        p = _masked_softmax(sc, mask)
        return jnp.einsum('bghqk,bgkd->bghqd', p, v_i)

    out = lax.map(one_block, (jnp.arange(nb), qb))
    return out.transpose(1, 2, 3, 0, 4, 5).reshape(b, g, hg, s, d)


def _native_sparse_attention(nq, kc, vc, ks, vs, kw, vw, gate_logits,
                             pos_k, w1_k, w2_k, pos_v, w1_v, w2_v):
    b, s, _ = nq.shape
    g, hg = NSA_KV_GROUPS, NSA_HEADS_PER_GROUP
    f32 = jnp.float32
    q = _rope(_heads(nq, NSA_HEADS)).astype(f32)
    qg = q.reshape(b, g, hg, s, HEAD_DIM)
    k_cmp = _compress(_rope(_heads(kc, g)).astype(f32), pos_k, w1_k, w2_k)
    v_cmp = _compress(_heads(vc, g).astype(f32), pos_v, w1_v, w2_v)
    n_cmp = k_cmp.shape[2]
    t_pos = jnp.arange(s)
    cmp_end = jnp.arange(n_cmp) * CMP_STRIDE + CMP_BLOCK - 1
    cmp_mask = cmp_end[None, :] <= t_pos[:, None]
    sc = jnp.einsum('bghtd,bgnd->bghtn', qg, k_cmp) * ATTN_SCALE
    p_cmp = _masked_softmax(sc, cmp_mask)
    o_cmp = jnp.einsum('bghtn,bgnd->bghtd', p_cmp, v_cmp)
    n_sel = s // SEL_BLOCK
    ci = jnp.arange(n_cmp)[:, None] * CMP_STRIDE
    sj = jnp.arange(n_sel)[None, :] * SEL_BLOCK
    overlap = ((ci < sj + SEL_BLOCK) & (ci + CMP_BLOCK > sj)).astype(f32)
    p_slc = jnp.einsum('bgtn,ns->bgts', jnp.sum(p_cmp, axis=2), overlap)
    cur = t_pos // SEL_BLOCK
    jj = jnp.arange(n_sel)
    forced = (jj[None, :] == 0) | (jj[None, :] == cur[:, None]) | (jj[None, :] == cur[:, None] - 1)
    valid = jj[None, :] <= cur[:, None]
    score = jnp.where(valid, p_slc + FORCED_BONUS * forced.astype(f32), NEG_INF)
    n_top = min(SEL_TOPN, n_sel)
    _, idx = lax.top_k(score, n_top)
    k_sel = _rope(_heads(ks, g)).astype(f32)
    v_sel = _heads(vs, g).astype(f32)
    o_sel = _selected_attention(qg, k_sel, v_sel, idx)
    k_win = _rope(_heads(kw, g)).astype(f32)
    v_win = _heads(vw, g).astype(f32)
    o_win = _window_attention(qg, k_win, v_win)
    gates = jax.nn.sigmoid(gate_logits.astype(f32)).reshape(b, s, NSA_HEADS, 3).transpose(0, 2, 1, 3)
    gates = gates.reshape(b, g, hg, s, 3)
    o = gates[..., 0:1] * o_cmp + gates[..., 1:2] * o_sel + gates[..., 2:3] * o_win
    o = o.reshape(b, NSA_HEADS, s, HEAD_DIM).transpose(0, 2, 1, 3).reshape(b, s, NSA_WIDTH)
    return o.astype(nq.dtype)


def setup_inputs(seed: int = 0) -> dict:
    key = jax.random.key(seed)
    ks = jax.random.split(key, 20)
    f32 = jnp.float32

    def nrm(k, shape, scale):
        return jax.random.normal(k, shape, f32) * scale

    return {
        'x': nrm(ks[0], (BATCH, SEQ, D_MODEL), 1.0),
        'norm_mix_pre': 1.0 + nrm(ks[1], (DEPTH, D_MODEL), 0.05),
        'norm_mix_post': 1.0 + nrm(ks[2], (DEPTH, D_MODEL), 0.05),
        'norm_mlp_pre': 1.0 + nrm(ks[3], (DEPTH, D_MODEL), 0.05),
        'norm_mlp_post': 1.0 + nrm(ks[4], (DEPTH, D_MODEL), 0.05),
        'w_in': nrm(ks[5], (DEPTH, D_MODEL, IN_COLS), D_MODEL ** -0.5),
        'b_forget': FORGET_BIAS_INIT + nrm(ks[6], (DEPTH, FOX_HEADS), 0.1),
        'cmp_pos_k': nrm(ks[7], (DEPTH, CMP_BLOCK, HEAD_DIM), 0.1),
        'cmp_w1_k': nrm(ks[8], (DEPTH, CMP_BLOCK * HEAD_DIM, HEAD_DIM), (CMP_BLOCK * HEAD_DIM) ** -0.5),
        'cmp_w2_k': nrm(ks[9], (DEPTH, HEAD_DIM, HEAD_DIM), HEAD_DIM ** -0.5),
        'cmp_pos_v': nrm(ks[10], (DEPTH, CMP_BLOCK, HEAD_DIM), 0.1),
        'cmp_w1_v': nrm(ks[11], (DEPTH, CMP_BLOCK * HEAD_DIM, HEAD_DIM), (CMP_BLOCK * HEAD_DIM) ** -0.5),
        'cmp_w2_v': nrm(ks[12], (DEPTH, HEAD_DIM, HEAD_DIM), HEAD_DIM ** -0.5),
        'w_fox_out': nrm(ks[13], (DEPTH, FOX_WIDTH, D_MODEL), FOX_WIDTH ** -0.5),
        'w_nsa_out': nrm(ks[14], (DEPTH, NSA_WIDTH, D_MODEL), NSA_WIDTH ** -0.5),
        'w_o': nrm(ks[15], (DEPTH, D_MODEL, D_MODEL), D_MODEL ** -0.5),
        'w_up': nrm(ks[16], (DEPTH, D_MODEL, D_FF), D_MODEL ** -0.5),
        'w_down': nrm(ks[17], (DEPTH, D_FF, D_MODEL), D_FF ** -0.5),
    }


def reference(x, norm_mix_pre, norm_mix_post, norm_mlp_pre, norm_mlp_post, w_in, b_forget,
              cmp_pos_k, cmp_w1_k, cmp_w2_k, cmp_pos_v, cmp_w1_v, cmp_w2_v,
              w_fox_out, w_nsa_out, w_o, w_up, w_down):
    split_points = [int(p) for p in np.cumsum(IN_SPLITS)[:-1]]
    for layer in range(DEPTH):
        h = _rms_norm(x, norm_mix_pre[layer])
        proj = h @ w_in[layer]
        (fq, fk, fv, ff, nq, kc, vc, ksl, vsl, kwn, vwn, ng, ga, gb) = jnp.split(proj, split_points, axis=-1)
        fox = _forgetting_attention(_heads(fq, FOX_HEADS), _heads(fk, FOX_HEADS), _heads(fv, FOX_HEADS),
                                    ff + b_forget[layer])
        nsa = _native_sparse_attention(nq, kc, vc, ksl, vsl, kwn, vwn, ng,
                                       cmp_pos_k[layer], cmp_w1_k[layer], cmp_w2_k[layer],
                                       cmp_pos_v[layer], cmp_w1_v[layer], cmp_w2_v[layer])
        mix = jax.nn.sigmoid(ga) * (fox @ w_fox_out[layer]) + jax.nn.sigmoid(gb) * (nsa @ w_nsa_out[layer])
        x = x + _rms_norm(mix @ w_o[layer], norm_mix_post[layer])
        h = _rms_norm(x, norm_mlp_pre[layer])
        u = jnp.square(jax.nn.relu(h @ w_up[layer]))
        x = x + _rms_norm(u @ w_down[layer], norm_mlp_post[layer])
    return x
```

```cpp
#include <hip/hip_runtime.h>
#include <cstdio>
#include <cstdint>
#include <cmath>
namespace pg8 {
#define PG8_LAS __attribute__((address_space(3)))
typedef unsigned short bf16_t;
typedef short bf16x8 __attribute__((ext_vector_type(8)));
typedef float f32x4 __attribute__((ext_vector_type(4)));
typedef unsigned u32x4 __attribute__((ext_vector_type(4)));
constexpr int BM = 256, BK = 64, HALF = 128, HTB = HALF * BK * 2  , STAGE_BYTES = 8 * HTB, NXCD = 8, WGM = 8;

__host__ __device__ __forceinline__ int lds_byte(int r, int c) { const int st = (r >> 4) * 2 + (c >> 5), rr = r & 15, cc = c & 31, ob = rr * 64 + cc * 2; return st * 1024 + (ob ^ (((ob >> 9) & 1) << 5)); }
__host__ __device__ __forceinline__ void stage_rc(int b, int& R, int& C) { const int st = b / 1024, sb = b % 1024, swz = sb ^ (((sb >> 9) & 1) << 5); R = (st >> 1) * 16 + swz / 64; C = (st & 1) * 32 + (swz % 64) / 2; }
__host__ __device__ __forceinline__ int perm32(int rho) { const int n = rho >> 4, i = rho & 15; return 8 * (i >> 2) + 4 * n + (i & 3); }

struct Unit { int pm, pn; };
struct Gemm { const bf16_t* A; const bf16_t* Bt; int M, N, K; };

struct StaticOrder {
    int nM, nN, nwg, G, c;
    __host__ __device__ void init(int M, int N, int G_, int c_) { nM = M / BM; nN = N / BM; nwg = nM * nN; G = G_; c = c_; }
    __host__ __device__ bool next(int i, Unit& u) const {
        const long L = (long)i * G + c; if (L >= nwg) return false;
        int wgid = (int)L; { const int q = nwg / NXCD, r = nwg % NXCD, xcd = wgid % NXCD, off = wgid / NXCD; wgid = (xcd < r ? xcd * (q + 1) : r * (q + 1) + (xcd - r) * q) + off; }
        const int nig = WGM * nN, gid = wgid / nig, fm = gid * WGM, gsz = (nM - fm) < WGM ? (nM - fm) : WGM;
        u.pm = fm + ((wgid % nig) % gsz); u.pn = (wgid % nig) / gsz; return true;
    }
    __device__ __forceinline__ void a_ready(const Unit&) const {}
    __device__ __forceinline__ void done(const Unit&) const {}
};

__device__ __forceinline__ unsigned cvt_pk_bf16(float lo, float hi) { unsigned r; asm volatile("v_cvt_pk_bf16_f32 %0, %1, %2" : "=v"(r) : "v"(lo), "v"(hi)); return r; }
typedef float f32x2 __attribute__((ext_vector_type(2)));
__device__ __forceinline__ float bf_lo(unsigned w) { return __uint_as_float(w << 16); }
__device__ __forceinline__ float bf_hi(unsigned w) { return __uint_as_float(w & 0xffff0000u); }
__device__ __forceinline__ float sigmoid_f(float x) { return __builtin_amdgcn_rcpf(1.0f + __expf(-x)); }
typedef unsigned u32x2 __attribute__((ext_vector_type(2)));
__device__ __forceinline__ u32x4 pack8(const f32x4& a, const f32x4& b) { u32x4 w; w.x = cvt_pk_bf16(a[0], a[1]); w.y = cvt_pk_bf16(a[2], a[3]); w.z = cvt_pk_bf16(b[0], b[1]); w.w = cvt_pk_bf16(b[2], b[3]); return w; }
__device__ __forceinline__ u32x2 pack4(const f32x4& a) { u32x2 w; w.x = cvt_pk_bf16(a[0], a[1]); w.y = cvt_pk_bf16(a[2], a[3]); return w; }

struct EpiInProj {
    static constexpr bool PERM = true, AFTER_DRAIN = false;
    bf16_t *QKV, *NQ, *KVB, *SG;
    float *LF, *GATE; const float* bforget; const float *ROPEC, *ROPES; size_t qkvs, kvs, sgs; float qscale;
    __device__ __forceinline__ void operator()(const f32x4 (&acc)[2][2][4][2], const Unit& u, int wr, int wc, int fr, int fq) const {
        const int pn = u.pn;
#pragma unroll
        for (int ai = 0; ai < 2; ++ai)
#pragma unroll
            for (int m = 0; m < 4; ++m) {
                const int row = u.pm * BM + ai * HALF + wr * 64 + m * 16 + fr; const int t = row & 2047, b = row >> 11;
#pragma unroll
                for (int bj = 0; bj < 2; ++bj) {
                    const int tc = bj * HALF + wc * 32 + 8 * fq;
                    f32x4 v0 = acc[ai][bj][m][0], v1 = acc[ai][bj][m][1];
                    if (pn < 6) {
                        bf16_t* base = QKV + (size_t)(pn >> 1) * qkvs; const float sc = pn < 2 ? qscale : 1.0f;
                        *(u32x4*)(base + (size_t)row * 512 + (pn & 1) * 256 + tc) = pack8(v0 * sc, v1 * sc);
                    } else if (pn < 8) {
                        const int head = (pn - 6) * 4 + (tc >> 6), i4 = ((tc & 63) >> 3) * 4;
                        const f32x4 cs = *(const f32x4*)(ROPEC + t * 32 + i4), sn = *(const f32x4*)(ROPES + t * 32 + i4);
                        const f32x4 lo = (v0 * cs - v1 * sn) * qscale, hi = (v1 * cs + v0 * sn) * qscale;
                        bf16_t* d = NQ + (size_t)row * 512 + head * 64 + i4;
                        *(u32x2*)d = pack4(lo); *(u32x2*)(d + 32) = pack4(hi);
                    } else if (pn < 11) {
                        const int sel = pn - 8;
                        if (bj == 0) {
                            const int g = tc >> 6, i4 = ((tc & 63) >> 3) * 4;
                            const f32x4 cs = *(const f32x4*)(ROPEC + t * 32 + i4), sn = *(const f32x4*)(ROPES + t * 32 + i4);
                            const f32x4 lo = v0 * cs - v1 * sn, hi = v1 * cs + v0 * sn;
                            bf16_t* d = KVB + (size_t)(2 * sel) * kvs + ((size_t)((b * 2 + g) * 2048 + t)) * 64 + i4;
                            *(u32x2*)d = pack4(lo); *(u32x2*)(d + 32) = pack4(hi);
                        } else {
                            const int tv = tc - HALF, g = tv >> 6, dd = tv & 63;
                            bf16_t* d = KVB + (size_t)(2 * sel + 1) * kvs + ((size_t)((b * 2 + g) * 2048 + t)) * 64 + dd;
                            *(u32x4*)d = pack8(v0, v1);
                        }
                    } else if (pn < 19) {
                        bf16_t* base = SG + (size_t)(pn >= 15 ? 1 : 0) * sgs; const int ct = (pn < 15 ? pn - 11 : pn - 15) * 256 + tc;
                        f32x4 a, c;
#pragma unroll
                        for (int k = 0; k < 4; ++k) { a[k] = sigmoid_f(v0[k]); c[k] = sigmoid_f(v1[k]); }
                        *(u32x4*)(base + (size_t)row * 1024 + ct) = pack8(a, c);
                    } else {
                        if (bj == 0 && wc == 0) {
                            if (fq == 0) {
                                f32x4 a, c;
#pragma unroll
                                for (int k = 0; k < 4; ++k) { const float x0 = v0[k] + bforget[k], x1 = v1[k] + bforget[4 + k];
                                    a[k] = fminf(x0, 0.f) - log1pf(__expf(-fabsf(x0))); c[k] = fminf(x1, 0.f) - log1pf(__expf(-fabsf(x1))); }
                                *(f32x4*)(LF + (size_t)row * 8) = a; *(f32x4*)(LF + (size_t)row * 8 + 4) = c;
                            } else {
                                f32x4 a, c;
#pragma unroll
                                for (int k = 0; k < 4; ++k) { a[k] = sigmoid_f(v0[k]); c[k] = sigmoid_f(v1[k]); }
                                *(f32x4*)(GATE + (size_t)row * 24 + 8 * (fq - 1)) = a; *(f32x4*)(GATE + (size_t)row * 24 + 8 * (fq - 1) + 4) = c;
                            }
                        }
                    }
                }
            }
    }
};
struct EpiGate {
    static constexpr bool PERM = true, AFTER_DRAIN = false;
    bf16_t* O; const bf16_t* gate; const bf16_t* addend; int ldc;
    __device__ __forceinline__ void operator()(const f32x4 (&acc)[2][2][4][2], const Unit& u, int wr, int wc, int fr, int fq) const {
#pragma unroll
        for (int ai = 0; ai < 2; ++ai)
#pragma unroll
            for (int m = 0; m < 4; ++m) {
                const size_t rowo = (size_t)(u.pm * BM + ai * HALF + wr * 64 + m * 16 + fr) * ldc + u.pn * BM + wc * 32 + 8 * fq;
#pragma unroll
                for (int bj = 0; bj < 2; ++bj) {
                    const size_t off = rowo + bj * HALF;
                    const u32x4 gw = *(const u32x4*)(gate + off);
                    f32x4 v0 = acc[ai][bj][m][0], v1 = acc[ai][bj][m][1];
                    v0[0] *= bf_lo(gw.x); v0[1] *= bf_hi(gw.x); v0[2] *= bf_lo(gw.y); v0[3] *= bf_hi(gw.y);
                    v1[0] *= bf_lo(gw.z); v1[1] *= bf_hi(gw.z); v1[2] *= bf_lo(gw.w); v1[3] *= bf_hi(gw.w);
                    if (addend) { const u32x4 aw = *(const u32x4*)(addend + off);
                        v0[0] += bf_lo(aw.x); v0[1] += bf_hi(aw.x); v0[2] += bf_lo(aw.y); v0[3] += bf_hi(aw.y);
                        v1[0] += bf_lo(aw.z); v1[1] += bf_hi(aw.z); v1[2] += bf_lo(aw.w); v1[3] += bf_hi(aw.w); }
                    *(u32x4*)(O + off) = pack8(v0, v1);
                }
            }
    }
};
template <int ACT> struct EpiPlain {
    static constexpr bool PERM = true, AFTER_DRAIN = false;
    bf16_t* O; int ldc;
    __device__ __forceinline__ void operator()(const f32x4 (&acc)[2][2][4][2], const Unit& u, int wr, int wc, int fr, int fq) const {
#pragma unroll
        for (int ai = 0; ai < 2; ++ai)
#pragma unroll
            for (int m = 0; m < 4; ++m) {
                const size_t rowo = (size_t)(u.pm * BM + ai * HALF + wr * 64 + m * 16 + fr) * ldc + u.pn * BM + wc * 32 + 8 * fq;
#pragma unroll
                for (int bj = 0; bj < 2; ++bj) {
                    f32x4 v0 = acc[ai][bj][m][0], v1 = acc[ai][bj][m][1];
                    if (ACT == 1) {
#pragma unroll
                        for (int k = 0; k < 4; ++k) { const float a = fmaxf(v0[k], 0.f), c = fmaxf(v1[k], 0.f); v0[k] = a * a; v1[k] = c * c; }
                    }
                    *(u32x4*)(O + rowo + bj * HALF) = pack8(v0, v1);
                }
            }
    }
};

template <class Epi, class Sched, bool ALIGN_EPI = false, bool SP2 = false>
__device__ __forceinline__ void gemm_phase(PG8_LAS unsigned char* lds, const Gemm g, const Sched& S, const Epi& E) {
    const int tid = threadIdx.x, wid = __builtin_amdgcn_readfirstlane(tid >> 6), lane = tid & 63, wr = wid >> 2, wc = wid & 3, fr = lane & 15, fq = lane >> 4;
    const int K = g.K, nt = K / BK;
    unsigned voffA[2], voffB[2];
#pragma unroll
    for (int i = 0; i < 2; ++i) { int R, C; stage_rc(tid * 16 + i * 8192, R, C); const int Rb = Epi::PERM ? ((R & ~31) + perm32(R & 31)) : R;
        voffA[i] = (unsigned)(R * K + C) * 2u; voffB[i] = (unsigned)(Rb * K + C) * 2u; }
    const size_t kstep = (size_t)(BK * 2);
    const size_t hstep = (size_t)HALF * K * 2;
    const size_t tstep = 2 * hstep;
    const unsigned ldsw = (unsigned)wid * 1024u;
    const int aoff = lds_byte(wr * 64 + fr, fq * 8), boff = lds_byte(wc * 32 + fr, fq * 8);
#define PG8_SA(b, h) (((b) * 2 + (h)) * HTB)
#define PG8_SB(b, h) ((4 + (b) * 2 + (h)) * HTB)
#define PG8_STAGE(bufoff, gbase, voff) do { _Pragma("unroll") for (int _i = 0; _i < 2; ++_i) \
        __builtin_amdgcn_global_load_lds((const unsigned*)((const char*)(gbase) + (voff)[_i]), (PG8_LAS unsigned*)(lds + (bufoff) + ldsw + _i * 8192), 16, 0, 0); } while (0)
#define PG8_LDA(dst, b, h) do { _Pragma("unroll") for (int m = 0; m < 4; ++m) _Pragma("unroll") for (int k = 0; k < 2; ++k) dst[m][k] = *(const PG8_LAS bf16x8*)(lds + PG8_SA(b, h) + aoff + m * 2048 + k * 1024); } while (0)
#define PG8_LDB(dst, b, h) do { _Pragma("unroll") for (int n = 0; n < 2; ++n) _Pragma("unroll") for (int k = 0; k < 2; ++k) dst[n][k] = *(const PG8_LAS bf16x8*)(lds + PG8_SB(b, h) + boff + n * 2048 + k * 1024); } while (0)
#define PG8_MMA(ai, bj, At, Bt) do { __builtin_amdgcn_s_setprio(1); _Pragma("unroll") for (int m = 0; m < 4; ++m) _Pragma("unroll") for (int n = 0; n < 2; ++n) _Pragma("unroll") for (int k = 0; k < 2; ++k) \
        acc[ai][bj][m][n] = __builtin_amdgcn_mfma_f32_16x16x32_bf16(Bt[n][k], At[m][k], acc[ai][bj][m][n], 0, 0, 0); __builtin_amdgcn_s_setprio(0); } while (0)
#define PG8_WAIT_V(n) asm volatile("s_waitcnt vmcnt(" #n ")" ::: "memory")
#define PG8_WAIT_L(n) asm volatile("s_waitcnt lgkmcnt(" #n ")" ::: "memory")
#define PG8_BAR __builtin_amdgcn_s_barrier()
#define PG8_SCHED __builtin_amdgcn_sched_barrier(0)
    Unit cur, nxt; int ui = 0;
    if (!S.next(0, cur)) return;
    f32x4 acc[2][2][4][2];
#pragma unroll
    for (int a = 0; a < 2; ++a)
#pragma unroll
        for (int b = 0; b < 2; ++b)
#pragma unroll
            for (int m = 0; m < 4; ++m)
#pragma unroll
                for (int n = 0; n < 2; ++n) acc[a][b][m][n] = (f32x4){0.f, 0.f, 0.f, 0.f};
    bf16x8 At[4][2], B0[2][2], B1[2][2];
    const char* cA = (const char*)g.A + (size_t)cur.pm * tstep; const char* cB = (const char*)g.Bt + (size_t)cur.pn * tstep;
    S.a_ready(cur);
    if constexpr (SP2) {
        PG8_STAGE(PG8_SB(0, 0), cB, voffB); PG8_STAGE(PG8_SB(0, 1), cB + hstep, voffB); PG8_STAGE(PG8_SA(0, 0), cA, voffA); PG8_STAGE(PG8_SA(0, 1), cA + hstep, voffA);
        if (wr == 1) PG8_BAR;
        PG8_WAIT_V(2); PG8_BAR;
        PG8_STAGE(PG8_SB(1, 0), cB + kstep, voffB); PG8_STAGE(PG8_SA(1, 0), cA + kstep, voffA); PG8_STAGE(PG8_SB(1, 1), cB + hstep + kstep, voffB);
        PG8_WAIT_V(6); PG8_BAR;
    } else {
        PG8_STAGE(PG8_SB(0, 0), cB, voffB); PG8_STAGE(PG8_SA(0, 0), cA, voffA); PG8_STAGE(PG8_SB(0, 1), cB + hstep, voffB); PG8_STAGE(PG8_SA(0, 1), cA + hstep, voffA);
        if (wr == 1) PG8_BAR;
        PG8_WAIT_V(4); PG8_BAR;
        PG8_STAGE(PG8_SB(1, 0), cB + kstep, voffB); PG8_STAGE(PG8_SA(1, 0), cA + kstep, voffA); PG8_STAGE(PG8_SB(1, 1), cB + hstep + kstep, voffB);
        PG8_WAIT_V(6); PG8_BAR;
    }
    for (;;) {
        const bool has_next = S.next(ui + 1, nxt);
        const char* nA = has_next ? (const char*)g.A + (size_t)nxt.pm * tstep : cA; const char* nB = has_next ? (const char*)g.Bt + (size_t)nxt.pn * tstep : cB;
        for (int t = 0; t < nt; t += 2) {
            const bool last = (t == nt - 2);
            const char* a1 = cA + (size_t)(t + 1) * kstep;
            const char* a2 = last ? nA : cA + (size_t)(t + 2) * kstep; const char* b2 = last ? nB : cB + (size_t)(t + 2) * kstep;
            const char* a3 = a2 + kstep; const char* b3 = b2 + kstep;
            if (last && has_next) S.a_ready(nxt);
            if constexpr (SP2) {
            PG8_LDB(B0, 0, 0); PG8_LDB(B1, 0, 1); PG8_SCHED; PG8_LDA(At, 0, 0); PG8_STAGE(PG8_SA(1, 1), a1 + hstep, voffA);
            PG8_WAIT_V(8); PG8_WAIT_L(0); PG8_BAR; PG8_MMA(0, 0, At, B0); PG8_MMA(0, 1, At, B1); PG8_BAR; PG8_SCHED;
            PG8_LDA(At, 0, 1); PG8_STAGE(PG8_SB(0, 0), b2, voffB); PG8_STAGE(PG8_SB(0, 1), b2 + hstep, voffB); PG8_STAGE(PG8_SA(0, 0), a2, voffA);
            PG8_WAIT_V(8); PG8_WAIT_L(0); PG8_BAR; PG8_MMA(1, 0, At, B0); PG8_MMA(1, 1, At, B1); PG8_BAR; PG8_SCHED;
            PG8_LDB(B0, 1, 0); PG8_LDB(B1, 1, 1); PG8_SCHED; PG8_LDA(At, 1, 0); PG8_STAGE(PG8_SA(0, 1), a2 + hstep, voffA);
            PG8_WAIT_V(8); PG8_WAIT_L(0); PG8_BAR; PG8_MMA(0, 0, At, B0); PG8_MMA(0, 1, At, B1); PG8_BAR; PG8_SCHED;
            PG8_LDA(At, 1, 1); PG8_STAGE(PG8_SB(1, 0), b3, voffB); PG8_STAGE(PG8_SB(1, 1), b3 + hstep, voffB); PG8_STAGE(PG8_SA(1, 0), a3, voffA);
            PG8_WAIT_V(8); PG8_WAIT_L(0); PG8_BAR; PG8_MMA(1, 0, At, B0); PG8_MMA(1, 1, At, B1); PG8_BAR; PG8_SCHED;
            } else {
            PG8_LDB(B0, 0, 0); PG8_SCHED; PG8_LDA(At, 0, 0); PG8_STAGE(PG8_SA(1, 1), a1 + hstep, voffA);
            PG8_WAIT_L(8); PG8_BAR; PG8_WAIT_L(0); PG8_MMA(0, 0, At, B0); PG8_BAR; PG8_SCHED;
            PG8_LDB(B1, 0, 1); PG8_STAGE(PG8_SB(0, 0), b2, voffB);
            PG8_BAR; PG8_WAIT_L(0); PG8_MMA(0, 1, At, B1); PG8_BAR;
            PG8_LDA(At, 0, 1); PG8_STAGE(PG8_SA(0, 0), a2, voffA);
            PG8_BAR; PG8_WAIT_L(0); PG8_MMA(1, 0, At, B0); PG8_BAR; PG8_SCHED;
            PG8_STAGE(PG8_SB(0, 1), b2 + hstep, voffB);
            PG8_WAIT_V(6); PG8_BAR; PG8_MMA(1, 1, At, B1); PG8_BAR;
            PG8_LDB(B0, 1, 0); PG8_SCHED; PG8_LDA(At, 1, 0); PG8_STAGE(PG8_SA(0, 1), a2 + hstep, voffA);
            PG8_WAIT_L(8); PG8_BAR; PG8_WAIT_L(0); PG8_MMA(0, 0, At, B0); PG8_BAR; PG8_SCHED;
            PG8_LDB(B1, 1, 1); PG8_STAGE(PG8_SB(1, 0), b3, voffB);
            PG8_BAR; PG8_WAIT_L(0); PG8_MMA(0, 1, At, B1); PG8_BAR;
            PG8_LDA(At, 1, 1); PG8_STAGE(PG8_SA(1, 0), a3, voffA);
            PG8_BAR; PG8_WAIT_L(0); PG8_MMA(1, 0, At, B0); PG8_BAR; PG8_SCHED;
            PG8_STAGE(PG8_SB(1, 1), b3 + hstep, voffB);
            PG8_WAIT_V(6); PG8_BAR; PG8_MMA(1, 1, At, B1); PG8_BAR;
            }
        }
        if constexpr (ALIGN_EPI) { if (wr == 0) PG8_BAR; }
        if constexpr (!Epi::AFTER_DRAIN) { E(acc, cur, wr, wc, fr, fq); S.done(cur); }
        if (!has_next) break;
#pragma unroll
        for (int a = 0; a < 2; ++a)
#pragma unroll
            for (int b = 0; b < 2; ++b)
#pragma unroll
                for (int m = 0; m < 4; ++m)
#pragma unroll
                    for (int n = 0; n < 2; ++n) acc[a][b][m][n] = (f32x4){0.f, 0.f, 0.f, 0.f};
        cur = nxt; cA = nA; cB = nB; ++ui;
        if constexpr (ALIGN_EPI) { if (wr == 1) PG8_BAR; }
    }
    PG8_WAIT_V(0);
    if constexpr (!ALIGN_EPI) { if (wr == 0) PG8_BAR; }
    PG8_BAR;
    if constexpr (Epi::AFTER_DRAIN) { E.fused(acc, cur, wr, wc, fr, fq, lds, wid, lane); S.done(cur); }
#undef PG8_SA
#undef PG8_SB
#undef PG8_STAGE
#undef PG8_LDA
#undef PG8_LDB
#undef PG8_MMA
#undef PG8_WAIT_V
#undef PG8_WAIT_L
#undef PG8_BAR
#undef PG8_SCHED
}
}
#define GAS __attribute__((address_space(1)))
#define LAS __attribute__((address_space(3)))
typedef unsigned short bf16;
typedef unsigned v4u __attribute__((ext_vector_type(4)));
typedef float f32x4 __attribute__((ext_vector_type(4)));
typedef short bf16x8 __attribute__((ext_vector_type(8)));
typedef GAS unsigned gu32;
typedef GAS unsigned long long gu64;
#define RLX_AGENT __ATOMIC_RELAXED, __HIP_MEMORY_SCOPE_AGENT
#define LDS_WAIT() asm volatile("s_waitcnt lgkmcnt(0)" ::: "memory")
#define VM_WAIT() asm volatile("s_waitcnt vmcnt(0)" ::: "memory")
__device__ __forceinline__ unsigned long long rt() { return __builtin_amdgcn_s_memrealtime(); }
__device__ __forceinline__ unsigned f2bf(float f) { unsigned u = __builtin_bit_cast(unsigned, f); return (u + 0x7fffu + ((u >> 16) & 1u)) >> 16; }
__device__ __forceinline__ unsigned pk2(float lo, float hi) { return f2bf(lo) | (f2bf(hi) << 16); }

#define XB_TMO      128
#define XB_XCNT(j)  (256  + 64 * (j))
#define XB_XSUB(j)  (1280 + 64 * (j))
#define XB_XGEN(j)  (2304 + 64 * (j))
#define XB_TOP      3328
#define XB_TOPGEN   3392
#define XCD_BAR_WORDS 3456
#define XB_SPIN_CAP (1u << 18)

__device__ __forceinline__ unsigned xb_ld(unsigned* p)              { return __hip_atomic_load(p, __ATOMIC_RELAXED, __HIP_MEMORY_SCOPE_AGENT); }
__device__ __forceinline__ unsigned xb_add(unsigned* p, unsigned v) { return __hip_atomic_fetch_add(p, v, __ATOMIC_RELAXED, __HIP_MEMORY_SCOPE_AGENT); }
__device__ __forceinline__ unsigned xb_xcc_id() { return (unsigned)__builtin_amdgcn_s_getreg((3 << 11) | 20) & 0xFu; }
#define XB_SPIN(cond, bar) do { unsigned _sp = 0; while (cond) { __builtin_amdgcn_s_sleep(1); \
    if ((++_sp & 255u) == 0u) { if (xb_ld(&(bar)[XB_TMO])) break; if (_sp > XB_SPIN_CAP) { atomicAdd(&(bar)[XB_TMO], 1u); break; } } } } while (0)

struct XcdBarrier {
    unsigned* bar; unsigned x;
    volatile LAS unsigned* st;
};

__device__ __forceinline__ XcdBarrier xcd_barrier_post(unsigned* bar, volatile LAS unsigned* st) {
    XcdBarrier b; b.bar = bar; b.x = xb_xcc_id(); b.st = st;
    if (threadIdx.x == 0) (void)xb_add(&bar[XB_XCNT(b.x)], 1u);
    return b;
}
__device__ __forceinline__ void xcd_barrier_complete(unsigned* bar, unsigned x, unsigned& nloc, unsigned& nx) {
    const unsigned G = gridDim.x * gridDim.y * gridDim.z;
    unsigned sum, cnt, mine, sp = 0u;
    for (;;) {
        sum = 0u; cnt = 0u; mine = 0u;
#pragma unroll
        for (unsigned j = 0; j < 16; ++j) { const unsigned c = xb_ld(&bar[XB_XCNT(j)]); sum += c; cnt += (c > 0u) ? 1u : 0u; mine = (j == x) ? c : mine; }
        if (sum == G) break;
        __builtin_amdgcn_s_sleep(1);
        if ((++sp & 255u) == 0u) { if (xb_ld(&bar[XB_TMO])) break; if (sp > XB_SPIN_CAP) { atomicAdd(&bar[XB_TMO], 1u); break; } }
    }
    nloc = mine > 0u ? mine : 1u; nx = cnt > 0u ? cnt : 1u;
}

__device__ __forceinline__ void xcd_barrier(const XcdBarrier& b) {
    asm volatile("s_waitcnt vmcnt(0)" ::: "memory");
    __syncthreads();
    if (threadIdx.x == 0) {
        unsigned* bar = b.bar;
        __builtin_amdgcn_s_waitcnt(0);
        unsigned nloc = b.st[0], nx = b.st[1];
        if (nloc == 0u) { xcd_barrier_complete(bar, b.x, nloc, nx); b.st[0] = nloc; b.st[1] = nx; }
        const unsigned old = xb_add(&bar[XB_XSUB(b.x)], 1u);
        const unsigned gen = old / nloc;
        if (old + 1u == (gen + 1u) * nloc) {
            __builtin_amdgcn_fence(__ATOMIC_RELEASE, "agent");
            asm volatile("s_waitcnt vmcnt(0)" ::: "memory");
            const unsigned og = xb_add(&bar[XB_TOP], 1u);
            const unsigned tg = og / nx;
            if (og + 1u == (tg + 1u) * nx) xb_add(&bar[XB_TOPGEN], 1u);
            else XB_SPIN(xb_ld(&bar[XB_TOPGEN]) == tg, bar);
            __builtin_amdgcn_fence(__ATOMIC_ACQUIRE, "agent");
            xb_add(&bar[XB_XGEN(b.x)], 1u);
            asm volatile("s_waitcnt vmcnt(0)" ::: "memory");
        } else {
            XB_SPIN(xb_ld(&bar[XB_XGEN(b.x)]) == gen, bar);
            __builtin_amdgcn_fence(__ATOMIC_ACQUIRE, "agent");
            asm volatile("s_waitcnt vmcnt(0)" ::: "memory");
        }
    }
    __syncthreads();
}

constexpr int NWAVES = 8;
constexpr int BATCH = 32, SEQ = 2048, DMODEL = 1024, MTOK = BATCH * SEQ, DFF = 4096, NPROJ = 5120, INCOLS = 4896;
constexpr float RMS_EPS = 1e-6f;
constexpr float QSCALE = 0.125f * 1.4426950408889634f;
constexpr float LOG2E = 1.4426950408889634f;
#ifndef MK_N_LAUNCHES
#define MK_N_LAUNCHES 10
#endif
constexpr int N_PHASES = 10;
constexpr int N_LAUNCHES = MK_N_LAUNCHES;
constexpr size_t MiB = 1u << 20, KiB = 1u << 10;
constexpr size_t WS_CTL = 0, CTL_ZERO_BYTES = 1 * MiB;
constexpr size_t WS_WIN = 2 * MiB, WS_WF = 12 * MiB, WS_WN = 13 * MiB, WS_WO = 14 * MiB, WS_WUP = 16 * MiB, WS_WDN = 24 * MiB;
constexpr size_t WS_W1K = 32 * MiB, WS_W1V = WS_W1K + 256 * KiB, WS_W2K = WS_W1V + 256 * KiB, WS_W2V = WS_W2K + 8 * KiB, WS_PBK = WS_W2V + 8 * KiB, WS_PBV = WS_PBK + 256;
constexpr size_t WS_ROPEC = 33 * MiB, WS_ROPES = WS_ROPEC + 256 * KiB;
constexpr size_t WS_KCMP = 34 * MiB, WS_VCMP = 35 * MiB, WS_C = 36 * MiB, WS_LF = 38 * MiB, WS_GATE = 40 * MiB;
constexpr size_t WS_HB = 48 * MiB;
constexpr size_t WS_FQ = 176 * MiB, WS_FK = 240 * MiB, WS_FV = 304 * MiB, WS_NQ = 368 * MiB;
constexpr size_t WS_KV = 432 * MiB, KV_STRIDE = 16 * MiB;
constexpr size_t WS_SGA = 528 * MiB, WS_SGB = 656 * MiB;
constexpr size_t WS_Y = 784 * MiB;
constexpr size_t WS_U = 176 * MiB;
constexpr size_t WS_END = 1024 * MiB;
static_assert(WS_FV - WS_FK == WS_FK - WS_FQ && WS_U + (size_t)MTOK * DFF * 2 <= WS_Y && WS_Y + (size_t)MTOK * 512 * 4 <= WS_END && WS_GATE + (size_t)MTOK * 24 * 4 <= WS_HB, "d_ws map");
constexpr int CW_TMO = 0, CW_CODE = 1, CW_BAR = 4096, CW_QUEUE = 16384;
constexpr int RING_OFF = 0, RING_BYTES = 131072;
constexpr int LDSCTL_OFF = RING_BYTES, MISC_OFF = LDSCTL_OFF + 320;
constexpr int LDS_BYTES = 147456;
static_assert(MISC_OFF + 128 <= LDS_BYTES, "LDS map");


typedef float f32x16 __attribute__((ext_vector_type(16)));
struct Frame {
    LAS unsigned char* lds;
    volatile LAS unsigned* MISC;
    gu32* ctl;
    int tid, lane, wave;
    int vcu, G;
    unsigned char* ws;
    const float* x; float* out;
    const float *g_mix_pre, *g_mix_post, *g_mlp_pre, *g_mlp_post, *w_in, *b_forget, *pos_k, *w1_k, *w2_k, *pos_v, *w1_v, *w2_v, *w_fox, *w_nsa, *w_o, *w_up, *w_down;
};
template <class T> __device__ __forceinline__ T* wsp(const Frame& F, size_t off) { return (T*)(F.ws + off); }

__device__ __forceinline__ float wave_sum(float v) {
#pragma unroll
    for (int o = 1; o < 64; o <<= 1) v += __shfl_xor(v, o);
    return v;
}
__device__ __forceinline__ float bfl(unsigned w) { return __uint_as_float(w << 16); }
__device__ __forceinline__ float bfh(unsigned w) { return __uint_as_float(w & 0xffff0000u); }

__device__ __forceinline__ int rope_d(int w) { const int i = w >> 3, j = w & 7; return j < 4 ? 4 * i + j : 32 + 4 * i + (j - 4); }
__device__ __forceinline__ int in_src_col(int n) {
    if (n < 1536) return n;
    if (n < 2048) { const int l = n - 1536; return 1544 + (l & ~63) + rope_d(l & 63); }
    if (n < 2816) { const int s = (n - 2048) >> 8, l = (n - 2048) & 255; const int kb = 2056 + s * 256;
        return l < 128 ? kb + (l & ~63) + rope_d(l & 63) : kb + 128 + (l - 128); }
    if (n < 3840) return 2848 + (n - 2816);
    if (n < 4864) return 3872 + (n - 3840);
    const int l = n - 4864; if (l < 8) return 1536 + l; if (l < 32) return 2824 + (l - 8); return -1;
}
template <class SrcCol>
__device__ __forceinline__ void p0_transpose_item(const float* W, int K, int Nsrc, bf16* WT, int nblk, LAS float* scr, int item, int lane, SrcCol srccol) {
    const int kb = item / nblk, nb = item % nblk, k0 = 64 * kb, n0 = 32 * nb;
    const int sc = srccol(n0 + (lane & 31));
#pragma unroll 8
    for (int i = 0; i < 32; ++i) { const int kk = 2 * i + (lane >> 5); scr[kk * 33 + (lane & 31)] = sc >= 0 ? W[(size_t)(k0 + kk) * Nsrc + sc] : 0.f; }
    LDS_WAIT(); asm volatile("" ::: "memory");
    const int c = lane & 7;
#pragma unroll
    for (int j = 0; j < 4; ++j) { const int n = (lane >> 3) + 8 * j; const LAS float* s = scr + (8 * c) * 33 + n;
        v4u o; o.x = pk2(s[0 * 33], s[1 * 33]); o.y = pk2(s[2 * 33], s[3 * 33]); o.z = pk2(s[4 * 33], s[5 * 33]); o.w = pk2(s[6 * 33], s[7 * 33]);
        *(GAS v4u*)(WT + (size_t)(n0 + n) * K + k0 + 8 * c) = o; }
    LDS_WAIT(); asm volatile("" ::: "memory");
}
__device__ __forceinline__ void rms_row_to_bf16(int lane, const float* xrow, const float* g, bf16* orow) {
    const GAS f32x4* xr = (const GAS f32x4*)xrow + lane; const GAS f32x4* gr = (const GAS f32x4*)g + lane;
    f32x4 v[4]; float s = 0.f;
#pragma unroll
    for (int j = 0; j < 4; ++j) { v[j] = xr[64 * j]; s += (v[j].x * v[j].x + v[j].y * v[j].y) + (v[j].z * v[j].z + v[j].w * v[j].w); }
    const float r = 1.0f / sqrtf(wave_sum(s) * (1.f / DMODEL) + RMS_EPS);
    GAS unsigned long long* o8 = (GAS unsigned long long*)orow + lane;
#pragma unroll
    for (int j = 0; j < 4; ++j) { const f32x4 gg = gr[64 * j];
        o8[64 * j] = (unsigned long long)pk2(v[j].x * r * gg.x, v[j].y * r * gg.y) | ((unsigned long long)pk2(v[j].z * r * gg.z, v[j].w * r * gg.w) << 32); }
}
__device__ __forceinline__ void p0_prologue(Frame& F) {
    LAS float* scr = (LAS float*)(F.lds + RING_OFF + F.wave * 16384);
    const int gw = F.vcu * NWAVES + F.wave, NGW = F.G * NWAVES, lane = F.lane;
    constexpr int I_IN = 16 * (NPROJ / 32), I_F = 8 * 32, I_O = 16 * 32, I_UP = 16 * 128, I_DN = 64 * 32, I_W1 = 32 * 2, I_W2 = 1 * 2;
    constexpr int NITEMS = I_IN + 2 * I_F + I_O + I_UP + I_DN + 2 * I_W1 + 2 * I_W2;
    auto ident = [](int n) { return n; };
    for (int it = gw; it < NITEMS; it += NGW) {
        int r = it;
        if (r < I_IN) { p0_transpose_item(F.w_in, 1024, INCOLS, wsp<bf16>(F, WS_WIN), NPROJ / 32, scr, r, lane, [](int n) { return in_src_col(n); }); continue; } r -= I_IN;
        if (r < I_F) { p0_transpose_item(F.w_fox, 512, 1024, wsp<bf16>(F, WS_WF), 32, scr, r, lane, ident); continue; } r -= I_F;
        if (r < I_F) { p0_transpose_item(F.w_nsa, 512, 1024, wsp<bf16>(F, WS_WN), 32, scr, r, lane, ident); continue; } r -= I_F;
        if (r < I_O) { p0_transpose_item(F.w_o, 1024, 1024, wsp<bf16>(F, WS_WO), 32, scr, r, lane, ident); continue; } r -= I_O;
        if (r < I_UP) { p0_transpose_item(F.w_up, 1024, 4096, wsp<bf16>(F, WS_WUP), 128, scr, r, lane, ident); continue; } r -= I_UP;
        if (r < I_DN) { p0_transpose_item(F.w_down, 4096, 1024, wsp<bf16>(F, WS_WDN), 32, scr, r, lane, ident); continue; } r -= I_DN;
        if (r < I_W1) { p0_transpose_item(F.w1_k, 2048, 64, wsp<bf16>(F, WS_W1K), 2, scr, r, lane, ident); continue; } r -= I_W1;
        if (r < I_W1) { p0_transpose_item(F.w1_v, 2048, 64, wsp<bf16>(F, WS_W1V), 2, scr, r, lane, ident); continue; } r -= I_W1;
        if (r < I_W2) { p0_transpose_item(F.w2_k, 64, 64, wsp<bf16>(F, WS_W2K), 2, scr, r, lane, ident); continue; } r -= I_W2;
        p0_transpose_item(F.w2_v, 64, 64, wsp<bf16>(F, WS_W2V), 2, scr, r, lane, ident);
    }
    { float* RC = wsp<float>(F, WS_ROPEC); float* RS = wsp<float>(F, WS_ROPES);
      for (int e = (F.vcu * NWAVES * 64 + F.tid); e < SEQ * 32; e += F.G * NWAVES * 64) { const int t = e >> 5, i = e & 31;
          const float inv = powf(10000.0f, -(float)(2 * i) / 64.0f); const float ang = (float)t * inv; RC[e] = cosf(ang); RS[e] = sinf(ang); } }
    for (int it = gw; it < 128; it += NGW) { const int kv = it >> 6, c = it & 63; const float* pos = kv ? F.pos_v : F.pos_k; const float* w1 = kv ? F.w1_v : F.w1_k; float s = 0.f;
        for (int k = lane; k < 2048; k += 64) s += pos[k] * w1[(size_t)k * 64 + c];
        s = wave_sum(s); if (lane == 0) wsp<float>(F, kv ? WS_PBV : WS_PBK)[c] = s; }
    for (int m = gw; m < MTOK; m += NGW) rms_row_to_bf16(lane, F.x + (size_t)m * DMODEL, F.g_mix_pre, wsp<bf16>(F, WS_HB) + (size_t)m * DMODEL);
}

__device__ __forceinline__ int crow(int r, int hi) { return (r & 3) + 8 * (r >> 2) + 4 * hi; }
__device__ __forceinline__ void p2_compress_unit(Frame& F, int unit) {
    const int bg = unit >> 2, kv = (unit >> 1) & 1, half = unit & 1, lane = F.lane, w = F.wave;
    const bf16* X = wsp<bf16>(F, WS_KV + (size_t)kv * KV_STRIDE) + (size_t)bg * SEQ * 64;
    const bf16* W1t = wsp<bf16>(F, kv ? WS_W1V : WS_W1K); const bf16* W2t = wsp<bf16>(F, kv ? WS_W2V : WS_W2K); const float* PB = wsp<float>(F, kv ? WS_PBV : WS_PBK);
    bf16* OUT = wsp<bf16>(F, kv ? WS_VCMP : WS_KCMP) + (size_t)bg * 128 * 64;
    const int rt = w & 1, ct = (w >> 1) & 1, kh = w >> 2, r = lane & 31, h = lane >> 5;
    const int irow = 64 * half + 32 * rt + r, ild = irow < 126 ? irow : 126;
    const bf16* arow = X + (size_t)ild * 1024 + kh * 1024 + 8 * h; const bf16* brow = W1t + (size_t)(32 * ct + r) * 2048 + kh * 1024 + 8 * h;
    f32x16 acc = {};
#pragma unroll 8
    for (int s = 0; s < 64; ++s) { const bf16x8 a = *(const GAS bf16x8*)(arow + 16 * s), b = *(const GAS bf16x8*)(brow + 16 * s); acc = __builtin_amdgcn_mfma_f32_32x32x16_bf16(a, b, acc, 0, 0, 0); }
    LAS float* red = (LAS float*)(F.lds + RING_OFF);
    LAS bf16* Hs = (LAS bf16*)(F.lds + RING_OFF + 16384);
    if (kh == 1) {
#pragma unroll
        for (int i = 0; i < 16; ++i) red[((w & 3) * 16 + i) * 64 + lane] = acc[i];
    }
    __syncthreads();
    if (kh == 0) { const float pb = PB[32 * ct + r];
#pragma unroll
        for (int i = 0; i < 16; ++i) { float v = acc[i] + red[((w & 3) * 16 + i) * 64 + lane] + pb; v = v / (1.0f + __expf(-v)); Hs[(32 * rt + crow(i, h)) * 72 + 32 * ct + r] = (bf16)f2bf(v); }
    }
    __syncthreads();
    if (kh == 0) { f32x16 o = {};
#pragma unroll
        for (int s = 0; s < 4; ++s) { const bf16x8 a = *(const LAS bf16x8*)(Hs + (32 * rt + r) * 72 + 16 * s + 8 * h), b = *(const GAS bf16x8*)(W2t + (size_t)(32 * ct + r) * 64 + 16 * s + 8 * h);
            o = __builtin_amdgcn_mfma_f32_32x32x16_bf16(a, b, o, 0, 0, 0); }
#pragma unroll
        for (int i = 0; i < 16; ++i) { const int row = 64 * half + 32 * rt + crow(i, h); OUT[(size_t)row * 64 + 32 * ct + r] = (bf16)(row == 127 ? 0u : f2bf(o[i])); }
    }
    __syncthreads();
}
__device__ __forceinline__ void p2_phase(Frame& F) {
    for (int u = F.vcu; u < 256; u += F.G) p2_compress_unit(F, u);
    const int gw = F.vcu * NWAVES + F.wave, NGW = F.G * NWAVES, lane = F.lane;
    for (int id = gw; id < BATCH * 8; id += NGW) { const int b = id >> 3, h = id & 7;
        const float* lf = wsp<float>(F, WS_LF) + ((size_t)b * SEQ + 32 * lane) * 8 + h; float* c = wsp<float>(F, WS_C) + (size_t)id * SEQ + 32 * lane;
        float tot = 0.f;
        for (int i = 0; i < 32; ++i) tot += lf[i * 8];
        float incl = tot;
#pragma unroll
        for (int o = 1; o < 64; o <<= 1) { const float n = __shfl_up(incl, o); if (lane >= o) incl += n; }
        float run = incl - tot;
        for (int i = 0; i < 32; ++i) { run += lf[i * 8]; c[i] = run; } }
}

constexpr int NV_WAVE_LDS = 16384;
__device__ __forceinline__ void nv_stage(const bf16* Kg, int kp, const bf16* Vg, int vp, int nk, LAS unsigned char* scr, int lane) {
    const int r = lane >> 1, hf = lane & 1, rr = r < nk ? r : 0;
    const GAS v4u* ks = (const GAS v4u*)(Kg + (size_t)rr * kp + hf * 32); LAS v4u* kd = (LAS v4u*)(scr + r * 128 + hf * 64);
#pragma unroll
    for (int i = 0; i < 4; ++i) kd[i] = ks[i];
    if (Vg) { const GAS v4u* vs = (const GAS v4u*)(Vg + (size_t)rr * vp + hf * 32); LAS v4u* vd = (LAS v4u*)(scr + 4096 + r * 128 + hf * 64);
#pragma unroll
        for (int i = 0; i < 4; ++i) vd[i] = vs[i]; }
    asm volatile("s_waitcnt vmcnt(0) lgkmcnt(0)" ::: "memory");
}
__device__ __forceinline__ float nv_dot(const float (&q)[64], const LAS unsigned char* krow) {
    float s = 0.f;
#pragma unroll
    for (int c = 0; c < 8; ++c) { const v4u w = *(const LAS v4u*)(krow + c * 16);
        s += q[8 * c + 0] * bfl(w.x) + q[8 * c + 1] * bfh(w.x) + q[8 * c + 2] * bfl(w.y) + q[8 * c + 3] * bfh(w.y) + q[8 * c + 4] * bfl(w.z) + q[8 * c + 5] * bfh(w.z) + q[8 * c + 6] * bfl(w.w) + q[8 * c + 7] * bfh(w.w); }
    return s;
}
__device__ __forceinline__ void nv_axpy(float (&o)[64], float p, const LAS unsigned char* vrow) {
#pragma unroll
    for (int c = 0; c < 8; ++c) { const v4u w = *(const LAS v4u*)(vrow + c * 16);
        o[8 * c + 0] += p * bfl(w.x); o[8 * c + 1] += p * bfh(w.x); o[8 * c + 2] += p * bfl(w.y); o[8 * c + 3] += p * bfh(w.y);
        o[8 * c + 4] += p * bfl(w.z); o[8 * c + 5] += p * bfh(w.z); o[8 * c + 6] += p * bfl(w.w); o[8 * c + 7] += p * bfh(w.w); }
}
__device__ __forceinline__ void nv_loadq(float (&q)[64], const bf16* src) {
#pragma unroll
    for (int c = 0; c < 8; ++c) { const v4u w = *(const GAS v4u*)(src + c * 8);
        q[8 * c + 0] = bfl(w.x); q[8 * c + 1] = bfh(w.x); q[8 * c + 2] = bfl(w.y); q[8 * c + 3] = bfh(w.y); q[8 * c + 4] = bfl(w.z); q[8 * c + 5] = bfh(w.z); q[8 * c + 6] = bfl(w.w); q[8 * c + 7] = bfh(w.w); }
}
template <class VF, class BF>
__device__ __forceinline__ void nv_attend(const bf16* Kg, int kp, const bf16* Vg, int vp, int k0, int k1, LAS unsigned char* scr, int lane, const float (&q)[64], float (&o)[64], float& m, float& l, VF valid, BF bias) {
    for (int kb = k0; kb < k1; kb += 32) { const int nk = (k1 - kb) < 32 ? (k1 - kb) : 32;
        nv_stage(Kg + (size_t)kb * kp, kp, Vg + (size_t)kb * vp, vp, nk, scr, lane);
        for (int kk = 0; kk < nk; ++kk) { const int key = kb + kk;
            const float s = nv_dot(q, scr + kk * 128) + bias(key); const bool v = valid(key);
            if (__any(v && s > m)) { const float mn = (v && s > m) ? s : m; const float f = exp2f(m - mn); l *= f;
#pragma unroll
                for (int d = 0; d < 64; ++d) o[d] *= f;
                m = mn; }
            const float p = v ? exp2f(s - m) : 0.f; l += p; nv_axpy(o, p, scr + 4096 + kk * 128); }
        asm volatile("s_waitcnt lgkmcnt(0)" ::: "memory"); }
}
__device__ __forceinline__ void nv_fox_unit(Frame& F, int id, LAS unsigned char* scr) {
    const int lane = F.lane; const int j = 31 - (id >> 8), bh = id & 255, b = bh >> 3, h = bh & 7; const int t = 64 * j + lane; const size_t row = (size_t)b * SEQ + t;
    float q[64], o[64]; nv_loadq(q, wsp<bf16>(F, WS_FQ) + row * 512 + h * 64);
#pragma unroll
    for (int d = 0; d < 64; ++d) o[d] = 0.f;
    float m = -1e30f, l = 0.f; const float* C = wsp<float>(F, WS_C) + (size_t)bh * SEQ; const float ct = C[t];
    nv_attend(wsp<bf16>(F, WS_FK) + (size_t)b * SEQ * 512 + h * 64, 512, wsp<bf16>(F, WS_FV) + (size_t)b * SEQ * 512 + h * 64, 512, 0, 64 * j + 64, scr, lane, q, o, m, l,
              [=](int key) { return key <= t; }, [=](int key) { return (ct - C[key]) * LOG2E; });
    const float rl = 1.0f / fmaxf(l, 1e-30f); bf16* dst = wsp<bf16>(F, WS_FQ) + row * 512 + h * 64;
#pragma unroll
    for (int c = 0; c < 8; ++c) { v4u w; w.x = pk2(o[8 * c] * rl, o[8 * c + 1] * rl); w.y = pk2(o[8 * c + 2] * rl, o[8 * c + 3] * rl); w.z = pk2(o[8 * c + 4] * rl, o[8 * c + 5] * rl); w.w = pk2(o[8 * c + 6] * rl, o[8 * c + 7] * rl);
        *(GAS v4u*)(dst + c * 8) = w; }
}
__device__ __forceinline__ void nv_nsa_unit(Frame& F, int id, LAS unsigned char* scr) {
    const int lane = F.lane; const int j = 31 - (id >> 6), bg = id & 63, b = bg >> 1, g = bg & 1; const int t = 64 * j + lane; const size_t row = (size_t)b * SEQ + t;
    LAS float* psl = (LAS float*)(scr + 8192);
    const bf16* KC = wsp<bf16>(F, WS_KCMP) + (size_t)bg * 128 * 64; const bf16* VC = wsp<bf16>(F, WS_VCMP) + (size_t)bg * 128 * 64;
    const bf16* KS = wsp<bf16>(F, WS_KV + 2 * KV_STRIDE) + (size_t)bg * SEQ * 64; const bf16* VS = wsp<bf16>(F, WS_KV + 3 * KV_STRIDE) + (size_t)bg * SEQ * 64;
    const bf16* KW = wsp<bf16>(F, WS_KV + 4 * KV_STRIDE) + (size_t)bg * SEQ * 64; const bf16* VW = wsp<bf16>(F, WS_KV + 5 * KV_STRIDE) + (size_t)bg * SEQ * 64;
    float q[64], o[64]; LAS float* mlv = (LAS float*)(scr + 4096);
    for (int jj = 0; jj < 32; ++jj) psl[jj * 64 + lane] = 0.f;
#pragma unroll 1
    for (int hh = 0; hh < 4; ++hh) { const int head = 4 * g + hh; nv_loadq(q, wsp<bf16>(F, WS_NQ) + row * 512 + head * 64);
        float m = -1e30f, l = 0.f;
        for (int kb = 0; kb < 128; kb += 32) { nv_stage(KC + (size_t)kb * 64, 64, nullptr, 0, 32, scr, lane);
            for (int kk = 0; kk < 32; ++kk) { const int n = kb + kk; const float s = nv_dot(q, scr + kk * 128); const bool v = (n < 127) && (16 * n + 31 <= t);
                if (v) { const float mn = fmaxf(m, s); l = l * exp2f(m - mn) + exp2f(s - mn); m = mn; } }
            asm volatile("s_waitcnt lgkmcnt(0)" ::: "memory"); }
        mlv[(2 * hh) * 64 + lane] = m; mlv[(2 * hh + 1) * 64 + lane] = l; const float rl = 1.0f / fmaxf(l, 1e-30f);
        for (int kb = 0; kb < 128; kb += 32) { nv_stage(KC + (size_t)kb * 64, 64, nullptr, 0, 32, scr, lane);
            for (int kk = 0; kk < 32; ++kk) { const int n = kb + kk; const float s = nv_dot(q, scr + kk * 128); const bool v = (n < 127) && (16 * n + 31 <= t);
                const float p = v ? exp2f(s - m) * rl : 0.f;
                psl[(n >> 2) * 64 + lane] += p; if ((n & 3) == 3 && n < 127) psl[((n + 1) >> 2) * 64 + lane] += p; }
            asm volatile("s_waitcnt lgkmcnt(0)" ::: "memory"); } }
    unsigned selmask = 0u; const int cur = t >> 6;
    for (int jj = 0; jj < 32; ++jj) { const bool forced = (jj == 0) || (jj == cur) || (jj == cur - 1); const float sc = jj <= cur ? psl[jj * 64 + lane] + (forced ? 1e4f : 0.f) : -1e30f; psl[jj * 64 + lane] = sc; }
    for (int rnd = 0; rnd < 8; ++rnd) { float best = -3.0e38f; int bi = 0;
        for (int jj = 0; jj < 32; ++jj) { const float sc = psl[jj * 64 + lane]; if (sc > best) { best = sc; bi = jj; } }
        selmask |= 1u << bi; psl[bi * 64 + lane] = -3.4e38f; }
    for (int i = 0; i < 8; ++i) psl[i * 64 + lane] = mlv[i * 64 + lane];
    asm volatile("s_waitcnt lgkmcnt(0)" ::: "memory");
    float* TMP = wsp<float>(F, WS_Y);
#pragma unroll 1
    for (int hh = 0; hh < 4; ++hh) { const int head = 4 * g + hh; nv_loadq(q, wsp<bf16>(F, WS_NQ) + row * 512 + head * 64);
        const float* gt = wsp<float>(F, WS_GATE) + row * 24 + head * 3; const float g0 = gt[0], g1 = gt[1], g2 = gt[2];
        float* tmp = TMP + row * 512 + head * 64;
#pragma unroll
        for (int d = 0; d < 64; ++d) o[d] = 0.f;
        { const float m = psl[(2 * hh) * 64 + lane], rl = 1.0f / fmaxf(psl[(2 * hh + 1) * 64 + lane], 1e-30f);
          for (int kb = 0; kb < 128; kb += 32) { nv_stage(KC + (size_t)kb * 64, 64, VC + (size_t)kb * 64, 64, 32, scr, lane);
              for (int kk = 0; kk < 32; ++kk) { const int n = kb + kk; const float s = nv_dot(q, scr + kk * 128); const bool v = (n < 127) && (16 * n + 31 <= t);
                  const float p = v ? exp2f(s - m) * rl : 0.f; nv_axpy(o, p, scr + 4096 + kk * 128); }
              asm volatile("s_waitcnt lgkmcnt(0)" ::: "memory"); } }
#pragma unroll
        for (int c = 0; c < 16; ++c) *(GAS f32x4*)(tmp + 4 * c) = (f32x4){g0 * o[4 * c], g0 * o[4 * c + 1], g0 * o[4 * c + 2], g0 * o[4 * c + 3]};
#pragma unroll
        for (int d = 0; d < 64; ++d) o[d] = 0.f;
        { float m = -1e30f, l = 0.f;
          nv_attend(KS, 64, VS, 64, 0, 64 * j + 64, scr, lane, q, o, m, l, [=](int key) { return ((selmask >> (key >> 6)) & 1u) != 0u && key <= t; }, [=](int) { return 0.f; });
          const float rl = g1 / fmaxf(l, 1e-30f);
#pragma unroll
          for (int c = 0; c < 16; ++c) { f32x4 a = *(GAS f32x4*)(tmp + 4 * c); a[0] += rl * o[4 * c]; a[1] += rl * o[4 * c + 1]; a[2] += rl * o[4 * c + 2]; a[3] += rl * o[4 * c + 3]; *(GAS f32x4*)(tmp + 4 * c) = a; } }
#pragma unroll
        for (int d = 0; d < 64; ++d) o[d] = 0.f;
        { float m = -1e30f, l = 0.f; const int kb0 = j >= 8 ? 64 * (j - 8) : 0;
          nv_attend(KW, 64, VW, 64, kb0, 64 * j + 64, scr, lane, q, o, m, l, [=](int key) { return key <= t && key > t - 512; }, [=](int) { return 0.f; });
          const float rl = g2 / fmaxf(l, 1e-30f); bf16* dst = wsp<bf16>(F, WS_NQ) + row * 512 + head * 64;
#pragma unroll
          for (int c = 0; c < 8; ++c) { const f32x4 a = *(GAS f32x4*)(tmp + 8 * c), e = *(GAS f32x4*)(tmp + 8 * c + 4); v4u w;
              w.x = pk2(a[0] + rl * o[8 * c], a[1] + rl * o[8 * c + 1]); w.y = pk2(a[2] + rl * o[8 * c + 2], a[3] + rl * o[8 * c + 3]);
              w.z = pk2(e[0] + rl * o[8 * c + 4], e[1] + rl * o[8 * c + 5]); w.w = pk2(e[2] + rl * o[8 * c + 6], e[3] + rl * o[8 * c + 7]);
              *(GAS v4u*)(dst + c * 8) = w; } }
    }
}
__device__ __forceinline__ void p3_attention_ref(Frame& F) {
    LAS unsigned char* scr = F.lds + RING_OFF + F.wave * NV_WAVE_LDS;
    const int gw = F.vcu * NWAVES + F.wave, NGW = F.G * NWAVES;
    for (int id = gw; id < 8192; id += NGW) nv_fox_unit(F, id, scr);
    for (int id = gw; id < 2048; id += NGW) nv_nsa_unit(F, id, scr);
}

__device__ __forceinline__ void row_pass(Frame& F, const float* xin, const bf16* Y, const float* gpost, float* xout, const float* gpre2, bf16* H2) {
    const int gw = F.vcu * NWAVES + F.wave, NGW = F.G * NWAVES, lane = F.lane;
    const GAS f32x4* gp = (const GAS f32x4*)gpost + lane;
    for (int m = gw; m < MTOK; m += NGW) {
        const GAS f32x4* xr = (const GAS f32x4*)(xin + (size_t)m * DMODEL) + lane; const GAS unsigned long long* yr = (const GAS unsigned long long*)(Y + (size_t)m * DMODEL) + lane;
        f32x4 xv[4], yv[4]; float s = 0.f;
#pragma unroll
        for (int j = 0; j < 4; ++j) { xv[j] = xr[64 * j]; const unsigned long long w = yr[64 * j]; const unsigned lo = (unsigned)w, hi = (unsigned)(w >> 32);
            yv[j] = (f32x4){bfl(lo), bfh(lo), bfl(hi), bfh(hi)}; s += (yv[j].x * yv[j].x + yv[j].y * yv[j].y) + (yv[j].z * yv[j].z + yv[j].w * yv[j].w); }
        const float r = 1.0f / sqrtf(wave_sum(s) * (1.f / DMODEL) + RMS_EPS); float s2 = 0.f;
        GAS f32x4* xo = (GAS f32x4*)(xout + (size_t)m * DMODEL) + lane;
#pragma unroll
        for (int j = 0; j < 4; ++j) { xv[j] = xv[j] + yv[j] * r * gp[64 * j]; xo[64 * j] = xv[j]; s2 += (xv[j].x * xv[j].x + xv[j].y * xv[j].y) + (xv[j].z * xv[j].z + xv[j].w * xv[j].w); }
        if (H2) { const float r2 = 1.0f / sqrtf(wave_sum(s2) * (1.f / DMODEL) + RMS_EPS); const GAS f32x4* g2 = (const GAS f32x4*)gpre2 + lane;
            GAS unsigned long long* o8 = (GAS unsigned long long*)(H2 + (size_t)m * DMODEL) + lane;
#pragma unroll
            for (int j = 0; j < 4; ++j) { const f32x4 gg = g2[64 * j];
                o8[64 * j] = (unsigned long long)pk2(xv[j].x * r2 * gg.x, xv[j].y * r2 * gg.y) | ((unsigned long long)pk2(xv[j].z * r2 * gg.z, xv[j].w * r2 * gg.w) << 32); } }
    }
}

struct Args { const float* in[18]; float* out; unsigned char* ws; int ph_lo, ph_hi, li, pad; };
__global__ void __launch_bounds__(NWAVES * 64, 2) fwd_kernel(Args args) {
    extern __shared__ __attribute__((aligned(16))) unsigned char lds[];
    Frame F;
    F.lds = (LAS unsigned char*)lds;
    F.MISC = (volatile LAS unsigned*)(F.lds + MISC_OFF);
    F.tid = threadIdx.x; F.lane = F.tid & 63; F.wave = __builtin_amdgcn_readfirstlane(F.tid >> 6);
    F.G = gridDim.x; { const int bx = blockIdx.x; F.vcu = (F.G % 8 == 0) ? (bx % 8) * (F.G / 8) + bx / 8 : bx; }
    F.ws = args.ws; F.ctl = (gu32*)(args.ws + WS_CTL);
    F.x = args.in[0]; F.g_mix_pre = args.in[1]; F.g_mix_post = args.in[2]; F.g_mlp_pre = args.in[3]; F.g_mlp_post = args.in[4]; F.w_in = args.in[5]; F.b_forget = args.in[6];
    F.pos_k = args.in[7]; F.w1_k = args.in[8]; F.w2_k = args.in[9]; F.pos_v = args.in[10]; F.w1_v = args.in[11]; F.w2_v = args.in[12];
    F.w_fox = args.in[13]; F.w_nsa = args.in[14]; F.w_o = args.in[15]; F.w_up = args.in[16]; F.w_down = args.in[17]; F.out = args.out;
    for (int u = F.tid; u < (LDS_BYTES - LDSCTL_OFF) / 4; u += NWAVES * 64) ((LAS unsigned*)(F.lds + LDSCTL_OFF))[u] = 0u;
    __syncthreads();
    XcdBarrier bar; bar.bar = (unsigned*)(F.ctl + CW_BAR); bar.x = 0; bar.st = nullptr;
    if (N_LAUNCHES == 1) bar = xcd_barrier_post((unsigned*)(F.ctl + CW_BAR), F.MISC + 8);
#define GRID_BAR() do { if (N_LAUNCHES == 1) xcd_barrier(bar); } while (0)
    const int lo = args.ph_lo, hi = args.ph_hi;
#define IN(k) (lo <= (k) && (k) < hi)
#define BOTH(k) (IN(k) && IN((k) + 1))

    if (IN(0)) { p0_prologue(F); if (BOTH(0)) GRID_BAR(); }

    if (IN(1)) {
        pg8::Gemm g{wsp<bf16>(F, WS_HB), wsp<bf16>(F, WS_WIN), MTOK, NPROJ, DMODEL}; pg8::StaticOrder S; S.init(MTOK, NPROJ, F.G, (int)blockIdx.x);
        pg8::EpiInProj E{wsp<bf16>(F, WS_FQ), wsp<bf16>(F, WS_NQ), wsp<bf16>(F, WS_KV), wsp<bf16>(F, WS_SGA),
                         wsp<float>(F, WS_LF), wsp<float>(F, WS_GATE), F.b_forget, wsp<float>(F, WS_ROPEC), wsp<float>(F, WS_ROPES), (WS_FK - WS_FQ) / 2, KV_STRIDE / 2, (WS_SGB - WS_SGA) / 2, QSCALE};
        pg8::gemm_phase<pg8::EpiInProj, pg8::StaticOrder, true, true>(F.lds + RING_OFF, g, S, E);
        if (BOTH(1)) GRID_BAR();
    }
    if (IN(2)) { p2_phase(F); if (BOTH(2)) GRID_BAR(); }
    if (IN(3)) { p3_attention_ref(F); if (BOTH(3)) GRID_BAR(); }
    if (IN(4)) {
        { pg8::Gemm g{wsp<bf16>(F, WS_NQ), wsp<bf16>(F, WS_WN), MTOK, DMODEL, 512}; pg8::StaticOrder S; S.init(MTOK, DMODEL, F.G, (int)blockIdx.x);
          pg8::EpiGate E{wsp<bf16>(F, WS_HB), wsp<bf16>(F, WS_SGB), nullptr, DMODEL};
          pg8::gemm_phase<pg8::EpiGate, pg8::StaticOrder, true, true>(F.lds + RING_OFF, g, S, E); }
        VM_WAIT(); __syncthreads();
        { pg8::Gemm g{wsp<bf16>(F, WS_FQ), wsp<bf16>(F, WS_WF), MTOK, DMODEL, 512}; pg8::StaticOrder S; S.init(MTOK, DMODEL, F.G, (int)blockIdx.x);
          pg8::EpiGate E{wsp<bf16>(F, WS_HB), wsp<bf16>(F, WS_SGA), wsp<bf16>(F, WS_HB), DMODEL};
          pg8::gemm_phase<pg8::EpiGate, pg8::StaticOrder, true, true>(F.lds + RING_OFF, g, S, E); }
        if (BOTH(4)) GRID_BAR();
    }
    if (IN(5)) {
        pg8::Gemm g{wsp<bf16>(F, WS_HB), wsp<bf16>(F, WS_WO), MTOK, DMODEL, DMODEL}; pg8::StaticOrder S; S.init(MTOK, DMODEL, F.G, (int)blockIdx.x);
        pg8::EpiPlain<0> E{wsp<bf16>(F, WS_Y), DMODEL};
        pg8::gemm_phase<pg8::EpiPlain<0>, pg8::StaticOrder, true, true>(F.lds + RING_OFF, g, S, E);
        if (BOTH(5)) GRID_BAR();
    }
    if (IN(6)) { row_pass(F, F.x, wsp<bf16>(F, WS_Y), F.g_mix_post, F.out, F.g_mlp_pre, wsp<bf16>(F, WS_HB)); if (BOTH(6)) GRID_BAR(); }
    if (IN(7)) {
        pg8::Gemm g{wsp<bf16>(F, WS_HB), wsp<bf16>(F, WS_WUP), MTOK, DFF, DMODEL}; pg8::StaticOrder S; S.init(MTOK, DFF, F.G, (int)blockIdx.x);
        pg8::EpiPlain<1> E{wsp<bf16>(F, WS_U), DFF};
        pg8::gemm_phase<pg8::EpiPlain<1>, pg8::StaticOrder, true, true>(F.lds + RING_OFF, g, S, E);
        if (BOTH(7)) GRID_BAR();
    }
    if (IN(8)) {
        pg8::Gemm g{wsp<bf16>(F, WS_U), wsp<bf16>(F, WS_WDN), MTOK, DMODEL, DFF}; pg8::StaticOrder S; S.init(MTOK, DMODEL, F.G, (int)blockIdx.x);
        pg8::EpiPlain<0> E{wsp<bf16>(F, WS_Y), DMODEL};
        pg8::gemm_phase<pg8::EpiPlain<0>, pg8::StaticOrder, true, true>(F.lds + RING_OFF, g, S, E);
        if (BOTH(8)) GRID_BAR();
    }
    if (IN(9)) { row_pass(F, F.out, wsp<bf16>(F, WS_Y), F.g_mlp_post, F.out, nullptr, nullptr); }
#undef IN
#undef BOTH
#undef GRID_BAR
}

extern "C" void kernel_launch(void* const* d_in, const int* in_sizes, int n_in, void* d_out, int out_size, void* d_ws, size_t ws_size, hipStream_t stream) {
    static int grid = 0;
    if (grid == 0) {
        if (n_in != 18 || in_sizes[0] != MTOK * DMODEL || out_size != MTOK * DMODEL || ws_size < WS_END) {
            fprintf(stderr, "kernel_launch: built for 18 inputs, x/out of %d floats, >= %zu bytes of workspace; got n_in %d, in0 %d, out %d, ws %zu; nothing launched\n", MTOK * DMODEL, (size_t)WS_END, n_in, n_in > 0 ? in_sizes[0] : -1, out_size, ws_size); grid = -1; return; }
        int dev = 0, cus = 0, per_cu = 0;
        if (hipGetDevice(&dev) != hipSuccess || hipDeviceGetAttribute(&cus, hipDeviceAttributeMultiprocessorCount, dev) != hipSuccess) { fprintf(stderr, "kernel_launch: device query failed\n"); grid = -1; return; }
        if (hipFuncSetAttribute((const void*)fwd_kernel, hipFuncAttributeMaxDynamicSharedMemorySize, LDS_BYTES) != hipSuccess) { fprintf(stderr, "kernel_launch: hipFuncSetAttribute failed\n"); grid = -1; return; }
        if (hipOccupancyMaxActiveBlocksPerMultiprocessor(&per_cu, (const void*)fwd_kernel, NWAVES * 64, LDS_BYTES) != hipSuccess || per_cu < 1)
            fprintf(stderr, "kernel_launch: note: occupancy query reports %d workgroups per CU\n", per_cu);
        (void)hipGetLastError();
        grid = cus;
    }
    if (grid < 0) return;
    if (hipMemsetAsync((char*)d_ws + WS_CTL, 0, CTL_ZERO_BYTES, stream) != hipSuccess) { fprintf(stderr, "kernel_launch: hipMemsetAsync failed\n"); return; }
    Args a{};
    for (int i = 0; i < 18; ++i) a.in[i] = (const float*)d_in[i];
    a.out = (float*)d_out; a.ws = (unsigned char*)d_ws;
    for (int li = 0; li < N_LAUNCHES; ++li) {
        a.ph_lo = (N_LAUNCHES == 1) ? 0 : li; a.ph_hi = (N_LAUNCHES == 1) ? N_PHASES : li + 1; a.li = li; a.pad = 0;
        hipLaunchKernelGGL(fwd_kernel, dim3(grid), dim3(NWAVES * 64), LDS_BYTES, stream, a);
        const hipError_t le = hipPeekAtLastError();
        if (le != hipSuccess) { fprintf(stderr, "kernel_launch: launch %d failed: %s\n", li, hipGetErrorName(le)); break; }
    }
}
```

```cpp
#include <hip/hip_runtime.h>
#include <cstdio>
#include <cstdint>
#include <cmath>
namespace pg8 {
#define PG8_LAS __attribute__((address_space(3)))
typedef unsigned short bf16_t;
typedef short bf16x8 __attribute__((ext_vector_type(8)));
typedef float f32x4 __attribute__((ext_vector_type(4)));
typedef unsigned u32x4 __attribute__((ext_vector_type(4)));
constexpr int BM = 256, BK = 64, HALF = 128, HTB = HALF * BK * 2  , STAGE_BYTES = 8 * HTB, NXCD = 8, WGM = 8;

__host__ __device__ __forceinline__ int lds_byte(int r, int c) { const int st = (r >> 4) * 2 + (c >> 5), rr = r & 15, cc = c & 31, ob = rr * 64 + cc * 2; return st * 1024 + (ob ^ (((ob >> 9) & 1) << 5)); }
__host__ __device__ __forceinline__ void stage_rc(int b, int& R, int& C) { const int st = b / 1024, sb = b % 1024, swz = sb ^ (((sb >> 9) & 1) << 5); R = (st >> 1) * 16 + swz / 64; C = (st & 1) * 32 + (swz % 64) / 2; }
__host__ __device__ __forceinline__ int perm32(int rho) { const int n = rho >> 4, i = rho & 15; return 8 * (i >> 2) + 4 * n + (i & 3); }

struct Unit { int pm, pn; };
struct Gemm { const bf16_t* A; const bf16_t* Bt; int M, N, K; };

struct StaticOrder {
    int nM, nN, nwg, G, c;
    __host__ __device__ void init(int M, int N, int G_, int c_) { nM = M / BM; nN = N / BM; nwg = nM * nN; G = G_; c = c_; }
    __host__ __device__ bool next(int i, Unit& u) const {
        const long L = (long)i * G + c; if (L >= nwg) return false;
        int wgid = (int)L; { const int q = nwg / NXCD, r = nwg % NXCD, xcd = wgid % NXCD, off = wgid / NXCD; wgid = (xcd < r ? xcd * (q + 1) : r * (q + 1) + (xcd - r) * q) + off; }
        const int nig = WGM * nN, gid = wgid / nig, fm = gid * WGM, gsz = (nM - fm) < WGM ? (nM - fm) : WGM;
        u.pm = fm + ((wgid % nig) % gsz); u.pn = (wgid % nig) / gsz; return true;
    }
    __device__ __forceinline__ void a_ready(const Unit&) const {}
    __device__ __forceinline__ void done(const Unit&) const {}
};

__device__ __forceinline__ unsigned cvt_pk_bf16(float lo, float hi) { unsigned r; asm volatile("v_cvt_pk_bf16_f32 %0, %1, %2" : "=v"(r) : "v"(lo), "v"(hi)); return r; }
typedef float f32x2 __attribute__((ext_vector_type(2)));
__device__ __forceinline__ float bf_lo(unsigned w) { return __uint_as_float(w << 16); }
__device__ __forceinline__ float bf_hi(unsigned w) { return __uint_as_float(w & 0xffff0000u); }
__device__ __forceinline__ float sigmoid_f(float x) { return __builtin_amdgcn_rcpf(1.0f + __expf(-x)); }
typedef unsigned u32x2 __attribute__((ext_vector_type(2)));
__device__ __forceinline__ u32x4 pack8(const f32x4& a, const f32x4& b) { u32x4 w; w.x = cvt_pk_bf16(a[0], a[1]); w.y = cvt_pk_bf16(a[2], a[3]); w.z = cvt_pk_bf16(b[0], b[1]); w.w = cvt_pk_bf16(b[2], b[3]); return w; }
__device__ __forceinline__ u32x2 pack4(const f32x4& a) { u32x2 w; w.x = cvt_pk_bf16(a[0], a[1]); w.y = cvt_pk_bf16(a[2], a[3]); return w; }

struct EpiInProj {
    static constexpr bool PERM = true, AFTER_DRAIN = false, MIDK = false;
    bf16_t *QKV, *NQ, *KVB, *SG;
    float *LF, *GATE; const float* bforget; const float *ROPEC, *ROPES; size_t qkvs, kvs, sgs; float qscale;
    __device__ __forceinline__ void operator()(const f32x4 (&acc)[2][2][4][2], const Unit& u, int wr, int wc, int fr, int fq) const {
        const int pn = u.pn; const bool roped = pn >= 6 && pn < 11; const int i4 = (4 * (wc & 1) + fq) * 4;
#pragma unroll
        for (int ai = 0; ai < 2; ++ai) {
#pragma unroll
          for (int mp = 0; mp < 2; ++mp) {
            f32x4 csv[8];
            if (roped) {
#pragma unroll
                for (int mm = 0; mm < 2; ++mm) { const int t_ = (u.pm * BM + ai * HALF + wr * 64 + (2 * mp + mm) * 16 + fr) & 2047; csv[mm] = *(const f32x4*)(ROPEC + t_ * 32 + i4); csv[4 + mm] = *(const f32x4*)(ROPES + t_ * 32 + i4); }
                asm volatile("" : "+v"(csv[0]), "+v"(csv[1]), "+v"(csv[4]), "+v"(csv[5])); }
#pragma unroll
            for (int mm = 0; mm < 2; ++mm) { const int m = 2 * mp + mm;
                const int row = u.pm * BM + ai * HALF + wr * 64 + m * 16 + fr; const int t = row & 2047, b = row >> 11; (void)t;
#pragma unroll
                for (int bj = 0; bj < 2; ++bj) {
                    const int tc = bj * HALF + wc * 32 + 8 * fq;
                    f32x4 v0 = acc[ai][bj][m][0], v1 = acc[ai][bj][m][1];
                    if (pn < 6) {
                        bf16_t* base = QKV + (size_t)(pn >> 1) * qkvs; const float sc = pn < 2 ? qscale : 1.0f;
                        *(u32x4*)(base + (size_t)row * 512 + (pn & 1) * 256 + tc) = pack8(v0 * sc, v1 * sc);
                    } else if (pn < 8) {
                        const int head = (pn - 6) * 4 + (tc >> 6);
                        const f32x4 cs = csv[mm], sn = csv[4 + mm];
                        const f32x4 lo = (v0 * cs - v1 * sn) * qscale, hi = (v1 * cs + v0 * sn) * qscale;
                        bf16_t* d = NQ + (size_t)row * 512 + head * 64 + i4;
                        *(u32x2*)d = pack4(lo); *(u32x2*)(d + 32) = pack4(hi);
                    } else if (pn < 11) {
                        const int sel = pn - 8;
                        if (bj == 0) {
                            const int g = tc >> 6;
                            const f32x4 cs = csv[mm], sn = csv[4 + mm];
                            const f32x4 lo = v0 * cs - v1 * sn, hi = v1 * cs + v0 * sn;
                            bf16_t* d = KVB + (size_t)(2 * sel) * kvs + ((size_t)((b * 2 + g) * 2048 + t)) * 64 + i4;
                            *(u32x2*)d = pack4(lo); *(u32x2*)(d + 32) = pack4(hi);
                        } else {
                            const int tv = tc - HALF, g = tv >> 6, dd = tv & 63;
                            bf16_t* d = KVB + (size_t)(2 * sel + 1) * kvs + ((size_t)((b * 2 + g) * 2048 + t)) * 64 + dd;
                            *(u32x4*)d = pack8(v0, v1);
                        }
                    } else if (pn < 19) {
                        if (bj == 0) { const int ct = (pn - 11) * 128 + wc * 32 + 8 * fq; const f32x4 w0 = acc[ai][1][m][0], w1 = acc[ai][1][m][1];
                            f32x4 a, c, ra, rc;
#pragma unroll
                            for (int k = 0; k < 4; ++k) { const float ea = __expf(-v0[k]), ec = __expf(-v1[k]), fa = __expf(-w0[k]), fc = __expf(-w1[k]);
                                a[k] = __builtin_amdgcn_rcpf(1.0f + ea); c[k] = __builtin_amdgcn_rcpf(1.0f + ec); ra[k] = (1.0f + ea) * __builtin_amdgcn_rcpf(1.0f + fa); rc[k] = (1.0f + ec) * __builtin_amdgcn_rcpf(1.0f + fc); }
                            *(u32x4*)(SG + (size_t)row * 1024 + ct) = pack8(a, c); *(u32x4*)(SG + sgs + (size_t)row * 1024 + ct) = pack8(ra, rc); }
                    } else {
                        if (bj == 0 && wc == 0) {
                            if (fq == 0) {
                                f32x4 a, c;
#pragma unroll
                                for (int k = 0; k < 4; ++k) { const float x0 = v0[k] + bforget[k], x1 = v1[k] + bforget[4 + k];
                                    a[k] = fminf(x0, 0.f) - log1pf(__expf(-fabsf(x0))); c[k] = fminf(x1, 0.f) - log1pf(__expf(-fabsf(x1))); }
                                *(f32x4*)(LF + (size_t)row * 8) = a; *(f32x4*)(LF + (size_t)row * 8 + 4) = c;
                            } else {
                                f32x4 a, c;
#pragma unroll
                                for (int k = 0; k < 4; ++k) { a[k] = sigmoid_f(v0[k]); c[k] = sigmoid_f(v1[k]); }
                                *(f32x4*)(GATE + (size_t)row * 24 + 8 * (fq - 1)) = a; *(f32x4*)(GATE + (size_t)row * 24 + 8 * (fq - 1) + 4) = c;
                            }
                        }
                    }
                }
            }
          }
        }
    }
};
#define PIN8(a) asm volatile("" : "+v"(a[0]), "+v"(a[1]), "+v"(a[2]), "+v"(a[3]), "+v"(a[4]), "+v"(a[5]), "+v"(a[6]), "+v"(a[7]))
struct EpiGate {
    static constexpr bool PERM = true, AFTER_DRAIN = false, MIDK = false;
    bf16_t* O; const bf16_t* gate; const bf16_t* addend; int ldc;
    __device__ __forceinline__ void operator()(const f32x4 (&acc)[2][2][4][2], const Unit& u, int wr, int wc, int fr, int fq) const {
#pragma unroll
        for (int ai = 0; ai < 2; ++ai) {
            const size_t base = (size_t)(u.pm * BM + ai * HALF + wr * 64 + fr) * ldc + u.pn * BM + wc * 32 + 8 * fq;
            u32x4 gw[8], aw[8];
#pragma unroll
            for (int k = 0; k < 8; ++k) gw[k] = *(const u32x4*)(gate + base + (size_t)((k >> 1) * 16) * ldc + (k & 1) * HALF);
            PIN8(gw);
            if (addend) {
#pragma unroll
                for (int k = 0; k < 8; ++k) aw[k] = *(const u32x4*)(addend + base + (size_t)((k >> 1) * 16) * ldc + (k & 1) * HALF);
                PIN8(aw); }
#pragma unroll
            for (int k = 0; k < 8; ++k) { const int m = k >> 1, bj = k & 1; const u32x4 g = gw[k];
                f32x4 v0 = acc[ai][bj][m][0], v1 = acc[ai][bj][m][1];
                v0[0] *= bf_lo(g.x); v0[1] *= bf_hi(g.x); v0[2] *= bf_lo(g.y); v0[3] *= bf_hi(g.y);
                v1[0] *= bf_lo(g.z); v1[1] *= bf_hi(g.z); v1[2] *= bf_lo(g.w); v1[3] *= bf_hi(g.w);
                if (addend) { const u32x4 a = aw[k];
                    v0[0] += bf_lo(a.x); v0[1] += bf_hi(a.x); v0[2] += bf_lo(a.y); v0[3] += bf_hi(a.y);
                    v1[0] += bf_lo(a.z); v1[1] += bf_hi(a.z); v1[2] += bf_lo(a.w); v1[3] += bf_hi(a.w); }
                *(u32x4*)(O + base + (size_t)(m * 16) * ldc + bj * HALF) = pack8(v0, v1); }
        }
    }
};
struct EpiGateMid {
    static constexpr bool PERM = true, AFTER_DRAIN = false, MIDK = true;
    bf16_t* O; const bf16_t* sga; const bf16_t* rr; int ldc;
    __device__ __forceinline__ void scale(f32x4 (&acc)[2][2][4][2], const bf16_t* g, const Unit& u, int wr, int wc, int fr, int fq, bf16_t* out) const {
#pragma unroll
        for (int ai = 0; ai < 2; ++ai) {
            const size_t base = (size_t)(u.pm * BM + ai * HALF + wr * 64 + fr) * ldc + u.pn * BM + wc * 32 + 8 * fq;
            u32x4 gw[8];
#pragma unroll
            for (int k = 0; k < 8; ++k) gw[k] = *(const u32x4*)(g + base + (size_t)((k >> 1) * 16) * ldc + (k & 1) * HALF);
            PIN8(gw);
#pragma unroll
            for (int k = 0; k < 8; ++k) { const int m = k >> 1, bj = k & 1; const u32x4 w = gw[k];
                f32x4& v0 = acc[ai][bj][m][0]; f32x4& v1 = acc[ai][bj][m][1];
                v0[0] *= bf_lo(w.x); v0[1] *= bf_hi(w.x); v0[2] *= bf_lo(w.y); v0[3] *= bf_hi(w.y);
                v1[0] *= bf_lo(w.z); v1[1] *= bf_hi(w.z); v1[2] *= bf_lo(w.w); v1[3] *= bf_hi(w.w);
                if (out) *(u32x4*)(out + base + (size_t)(m * 16) * ldc + bj * HALF) = pack8(v0, v1); }
        }
    }
    __device__ __forceinline__ void mid(f32x4 (&acc)[2][2][4][2], const Unit& u, int wr, int wc, int fr, int fq) const { int fr_ = fr; asm volatile("" : "+v"(fr_));
        scale(acc, rr, u, wr, wc, fr_, fq, nullptr); }
    __device__ __forceinline__ void operator()(const f32x4 (&acc)[2][2][4][2], const Unit& u, int wr, int wc, int fr, int fq) const {
#pragma unroll
        for (int ai = 0; ai < 2; ++ai) {
            const size_t base = (size_t)(u.pm * BM + ai * HALF + wr * 64 + fr) * ldc + u.pn * BM + wc * 32 + 8 * fq;
            u32x4 gw[8];
#pragma unroll
            for (int k = 0; k < 8; ++k) gw[k] = *(const u32x4*)(sga + base + (size_t)((k >> 1) * 16) * ldc + (k & 1) * HALF);
            PIN8(gw);
#pragma unroll
            for (int k = 0; k < 8; ++k) { const int m = k >> 1, bj = k & 1; const u32x4 w = gw[k];
                f32x4 v0 = acc[ai][bj][m][0], v1 = acc[ai][bj][m][1];
                v0[0] *= bf_lo(w.x); v0[1] *= bf_hi(w.x); v0[2] *= bf_lo(w.y); v0[3] *= bf_hi(w.y);
                v1[0] *= bf_lo(w.z); v1[1] *= bf_hi(w.z); v1[2] *= bf_lo(w.w); v1[3] *= bf_hi(w.w);
                *(u32x4*)(O + base + (size_t)(m * 16) * ldc + bj * HALF) = pack8(v0, v1); }
        }
    }
};
template <int ACT> struct EpiPlain {
    static constexpr bool PERM = true, AFTER_DRAIN = false, MIDK = false;
    bf16_t* O; int ldc;
    __device__ __forceinline__ void operator()(const f32x4 (&acc)[2][2][4][2], const Unit& u, int wr, int wc, int fr, int fq) const {
#pragma unroll
        for (int ai = 0; ai < 2; ++ai)
#pragma unroll
            for (int m = 0; m < 4; ++m) {
                const size_t rowo = (size_t)(u.pm * BM + ai * HALF + wr * 64 + m * 16 + fr) * ldc + u.pn * BM + wc * 32 + 8 * fq;
#pragma unroll
                for (int bj = 0; bj < 2; ++bj) {
                    f32x4 v0 = acc[ai][bj][m][0], v1 = acc[ai][bj][m][1];
                    if (ACT == 1) {
#pragma unroll
                        for (int k = 0; k < 4; ++k) { const float a = fmaxf(v0[k], 0.f), c = fmaxf(v1[k], 0.f); v0[k] = a * a; v1[k] = c * c; }
                    }
                    *(u32x4*)(O + rowo + bj * HALF) = pack8(v0, v1);
                }
            }
    }
};

struct EpiRelu2Rs {
    static constexpr bool PERM = true, AFTER_DRAIN = false, MIDK = false;
    bf16_t* O; const float* rs; int ldc;
    __device__ __forceinline__ void operator()(const f32x4 (&acc)[2][2][4][2], const Unit& u, int wr, int wc, int fr, int fq) const {
        float rv[8];
#pragma unroll
        for (int k = 0; k < 8; ++k) rv[k] = rs[u.pm * BM + (k >> 2) * HALF + wr * 64 + (k & 3) * 16 + fr];
        PIN8(rv);
#pragma unroll
        for (int ai = 0; ai < 2; ++ai)
#pragma unroll
            for (int m = 0; m < 4; ++m) { const float r = rv[ai * 4 + m];
                const size_t rowo = (size_t)(u.pm * BM + ai * HALF + wr * 64 + m * 16 + fr) * ldc + u.pn * BM + wc * 32 + 8 * fq;
#pragma unroll
                for (int bj = 0; bj < 2; ++bj) { f32x4 v0 = acc[ai][bj][m][0], v1 = acc[ai][bj][m][1];
#pragma unroll
                    for (int k = 0; k < 4; ++k) { const float a = fmaxf(v0[k] * r, 0.f), c = fmaxf(v1[k] * r, 0.f); v0[k] = a * a; v1[k] = c * c; }
                    __builtin_nontemporal_store(pack8(v0, v1), (u32x4*)(O + rowo + bj * HALF)); } }
    }
};
template <class Epi, class Sched, bool ALIGN_EPI = false, bool SP2 = false>
__device__ __forceinline__ void gemm_phase(PG8_LAS unsigned char* lds, const Gemm g, const Sched& S, const Epi& E, const int wave_id  ) {
    int tid_ = wave_id * 64 + (int)__builtin_amdgcn_mbcnt_hi(~0u, __builtin_amdgcn_mbcnt_lo(~0u, 0u)); asm volatile("" : "+v"(tid_));
    const int tid = tid_, wid = __builtin_amdgcn_readfirstlane(tid >> 6), lane = tid & 63, wr = wid >> 2, wc = wid & 3, fr = lane & 15, fq = lane >> 4;
    const int K = g.K, nt = K / BK;
    unsigned voffA[2], voffB[2];
#pragma unroll
    for (int i = 0; i < 2; ++i) { int R, C; stage_rc(tid * 16 + i * 8192, R, C); const int Rb = Epi::PERM ? ((R & ~31) + perm32(R & 31)) : R;
        voffA[i] = (unsigned)(R * K + C) * 2u; voffB[i] = (unsigned)(Rb * K + C) * 2u; }
    const size_t kstep = (size_t)(BK * 2);
    const size_t hstep = (size_t)HALF * K * 2;
    const size_t tstep = 2 * hstep;
    const unsigned ldsw = (unsigned)wid * 1024u;
    const int aoff = lds_byte(wr * 64 + fr, fq * 8), boff = lds_byte(wc * 32 + fr, fq * 8);
#define PG8_SA(b, h) (((b) * 2 + (h)) * HTB)
#define PG8_SB(b, h) ((4 + (b) * 2 + (h)) * HTB)
#define PG8_STAGE(bufoff, gbase, voff) do { _Pragma("unroll") for (int _i = 0; _i < 2; ++_i) \
        __builtin_amdgcn_global_load_lds((const unsigned*)((const char*)(gbase) + (voff)[_i]), (PG8_LAS unsigned*)(lds + (bufoff) + ldsw + _i * 8192), 16, 0, 0); } while (0)
#define PG8_LDA(dst, b, h) do { _Pragma("unroll") for (int m = 0; m < 4; ++m) _Pragma("unroll") for (int k = 0; k < 2; ++k) dst[m][k] = *(const PG8_LAS bf16x8*)(lds + PG8_SA(b, h) + aoff + m * 2048 + k * 1024); } while (0)
#define PG8_LDB(dst, b, h) do { _Pragma("unroll") for (int n = 0; n < 2; ++n) _Pragma("unroll") for (int k = 0; k < 2; ++k) dst[n][k] = *(const PG8_LAS bf16x8*)(lds + PG8_SB(b, h) + boff + n * 2048 + k * 1024); } while (0)
#define PG8_MMA(ai, bj, At, Bt) do { __builtin_amdgcn_s_setprio(1); _Pragma("unroll") for (int m = 0; m < 4; ++m) _Pragma("unroll") for (int n = 0; n < 2; ++n) _Pragma("unroll") for (int k = 0; k < 2; ++k) \
        acc[ai][bj][m][n] = __builtin_amdgcn_mfma_f32_16x16x32_bf16(Bt[n][k], At[m][k], acc[ai][bj][m][n], 0, 0, 0); __builtin_amdgcn_s_setprio(0); } while (0)
#define PG8_WAIT_V(n) asm volatile("s_waitcnt vmcnt(" #n ")" ::: "memory")
#define PG8_WAIT_L(n) asm volatile("s_waitcnt lgkmcnt(" #n ")" ::: "memory")
#define PG8_BAR __builtin_amdgcn_s_barrier()
#define PG8_SCHED __builtin_amdgcn_sched_barrier(0)
    Unit cur, nxt; int ui = 0;
    if (!S.next(0, cur)) return;
    f32x4 acc[2][2][4][2];
#pragma unroll
    for (int a = 0; a < 2; ++a)
#pragma unroll
        for (int b = 0; b < 2; ++b)
#pragma unroll
            for (int m = 0; m < 4; ++m)
#pragma unroll
                for (int n = 0; n < 2; ++n) acc[a][b][m][n] = (f32x4){0.f, 0.f, 0.f, 0.f};
    bf16x8 At[4][2], B0[2][2], B1[2][2];
    const char* cA = (const char*)g.A + (size_t)cur.pm * tstep; const char* cB = (const char*)g.Bt + (size_t)cur.pn * tstep;
    S.a_ready(cur);
    if constexpr (SP2) {
        PG8_STAGE(PG8_SB(0, 0), cB, voffB); PG8_STAGE(PG8_SB(0, 1), cB + hstep, voffB); PG8_STAGE(PG8_SA(0, 0), cA, voffA); PG8_STAGE(PG8_SA(0, 1), cA + hstep, voffA);
        if (wr == 1) PG8_BAR;
        PG8_WAIT_V(2); PG8_BAR;
        PG8_STAGE(PG8_SB(1, 0), cB + kstep, voffB); PG8_STAGE(PG8_SA(1, 0), cA + kstep, voffA); PG8_STAGE(PG8_SB(1, 1), cB + hstep + kstep, voffB);
        PG8_WAIT_V(6); PG8_BAR;
    } else {
        PG8_STAGE(PG8_SB(0, 0), cB, voffB); PG8_STAGE(PG8_SA(0, 0), cA, voffA); PG8_STAGE(PG8_SB(0, 1), cB + hstep, voffB); PG8_STAGE(PG8_SA(0, 1), cA + hstep, voffA);
        if (wr == 1) PG8_BAR;
        PG8_WAIT_V(4); PG8_BAR;
        PG8_STAGE(PG8_SB(1, 0), cB + kstep, voffB); PG8_STAGE(PG8_SA(1, 0), cA + kstep, voffA); PG8_STAGE(PG8_SB(1, 1), cB + hstep + kstep, voffB);
        PG8_WAIT_V(6); PG8_BAR;
    }
    for (;;) {
        const bool has_next = S.next(ui + 1, nxt);
        const char* nA = has_next ? (const char*)g.A + (size_t)nxt.pm * tstep : cA; const char* nB = has_next ? (const char*)g.Bt + (size_t)nxt.pn * tstep : cB;
        for (int t = 0; t < nt; t += 2) {
            if constexpr (Epi::MIDK) { if (t == nt / 2) E.mid(acc, cur, wr, wc, fr, fq); }
            const bool last = (t == nt - 2);
            const char* a1 = cA + (size_t)(t + 1) * kstep;
            const char* a2 = last ? nA : cA + (size_t)(t + 2) * kstep; const char* b2 = last ? nB : cB + (size_t)(t + 2) * kstep;
            const char* a3 = a2 + kstep; const char* b3 = b2 + kstep;
            if (last && has_next) S.a_ready(nxt);
            if constexpr (SP2) {
            PG8_LDB(B0, 0, 0); PG8_LDB(B1, 0, 1); PG8_SCHED; PG8_LDA(At, 0, 0); PG8_STAGE(PG8_SA(1, 1), a1 + hstep, voffA);
            PG8_WAIT_V(8); PG8_WAIT_L(0); PG8_BAR; PG8_MMA(0, 0, At, B0); PG8_MMA(0, 1, At, B1); PG8_BAR; PG8_SCHED;
            PG8_LDA(At, 0, 1); PG8_STAGE(PG8_SB(0, 0), b2, voffB); PG8_STAGE(PG8_SB(0, 1), b2 + hstep, voffB); PG8_STAGE(PG8_SA(0, 0), a2, voffA);
            PG8_WAIT_V(8); PG8_WAIT_L(0); PG8_BAR; PG8_MMA(1, 0, At, B0); PG8_MMA(1, 1, At, B1); PG8_BAR; PG8_SCHED;
            PG8_LDB(B0, 1, 0); PG8_LDB(B1, 1, 1); PG8_SCHED; PG8_LDA(At, 1, 0); PG8_STAGE(PG8_SA(0, 1), a2 + hstep, voffA);
            PG8_WAIT_V(8); PG8_WAIT_L(0); PG8_BAR; PG8_MMA(0, 0, At, B0); PG8_MMA(0, 1, At, B1); PG8_BAR; PG8_SCHED;
            PG8_LDA(At, 1, 1); PG8_STAGE(PG8_SB(1, 0), b3, voffB); PG8_STAGE(PG8_SB(1, 1), b3 + hstep, voffB); PG8_STAGE(PG8_SA(1, 0), a3, voffA);
            PG8_WAIT_V(8); PG8_WAIT_L(0); PG8_BAR; PG8_MMA(1, 0, At, B0); PG8_MMA(1, 1, At, B1); PG8_BAR; PG8_SCHED;
            } else {
            PG8_LDB(B0, 0, 0); PG8_SCHED; PG8_LDA(At, 0, 0); PG8_STAGE(PG8_SA(1, 1), a1 + hstep, voffA);
            PG8_WAIT_L(8); PG8_BAR; PG8_WAIT_L(0); PG8_MMA(0, 0, At, B0); PG8_BAR; PG8_SCHED;
            PG8_LDB(B1, 0, 1); PG8_STAGE(PG8_SB(0, 0), b2, voffB);
            PG8_BAR; PG8_WAIT_L(0); PG8_MMA(0, 1, At, B1); PG8_BAR;
            PG8_LDA(At, 0, 1); PG8_STAGE(PG8_SA(0, 0), a2, voffA);
            PG8_BAR; PG8_WAIT_L(0); PG8_MMA(1, 0, At, B0); PG8_BAR; PG8_SCHED;
            PG8_STAGE(PG8_SB(0, 1), b2 + hstep, voffB);
            PG8_WAIT_V(6); PG8_BAR; PG8_MMA(1, 1, At, B1); PG8_BAR;
            PG8_LDB(B0, 1, 0); PG8_SCHED; PG8_LDA(At, 1, 0); PG8_STAGE(PG8_SA(0, 1), a2 + hstep, voffA);
            PG8_WAIT_L(8); PG8_BAR; PG8_WAIT_L(0); PG8_MMA(0, 0, At, B0); PG8_BAR; PG8_SCHED;
            PG8_LDB(B1, 1, 1); PG8_STAGE(PG8_SB(1, 0), b3, voffB);
            PG8_BAR; PG8_WAIT_L(0); PG8_MMA(0, 1, At, B1); PG8_BAR;
            PG8_LDA(At, 1, 1); PG8_STAGE(PG8_SA(1, 0), a3, voffA);
            PG8_BAR; PG8_WAIT_L(0); PG8_MMA(1, 0, At, B0); PG8_BAR; PG8_SCHED;
            PG8_STAGE(PG8_SB(1, 1), b3 + hstep, voffB);
            PG8_WAIT_V(6); PG8_BAR; PG8_MMA(1, 1, At, B1); PG8_BAR;
            }
        }
        if constexpr (ALIGN_EPI) { if (wr == 0) PG8_BAR; }
        if constexpr (!Epi::AFTER_DRAIN) { E(acc, cur, wr, wc, fr, fq); S.done(cur); }
        if (!has_next) break;
#pragma unroll
        for (int a = 0; a < 2; ++a)
#pragma unroll
            for (int b = 0; b < 2; ++b)
#pragma unroll
                for (int m = 0; m < 4; ++m)
#pragma unroll
                    for (int n = 0; n < 2; ++n) acc[a][b][m][n] = (f32x4){0.f, 0.f, 0.f, 0.f};
        cur = nxt; cA = nA; cB = nB; ++ui;
        if constexpr (ALIGN_EPI) { if (wr == 1) PG8_BAR; }
    }
    PG8_WAIT_V(0);
    if constexpr (!ALIGN_EPI) { if (wr == 0) PG8_BAR; }
    PG8_BAR;
    if constexpr (Epi::AFTER_DRAIN) { E.fused(acc, cur, wr, wc, fr, fq, lds, wid, lane); S.done(cur); }
#undef PG8_SA
#undef PG8_SB
#undef PG8_STAGE
#undef PG8_LDA
#undef PG8_LDB
#undef PG8_MMA
#undef PG8_WAIT_V
#undef PG8_WAIT_L
#undef PG8_BAR
#undef PG8_SCHED
}
}
#define GAS __attribute__((address_space(1)))
#define LAS __attribute__((address_space(3)))
typedef unsigned short bf16;
typedef unsigned v4u __attribute__((ext_vector_type(4)));
typedef float f32x4 __attribute__((ext_vector_type(4)));
typedef short bf16x8 __attribute__((ext_vector_type(8)));
typedef GAS unsigned gu32;
typedef GAS unsigned long long gu64;
#define RLX_AGENT __ATOMIC_RELAXED, __HIP_MEMORY_SCOPE_AGENT
#define LDS_WAIT() asm volatile("s_waitcnt lgkmcnt(0)" ::: "memory")
#define VM_WAIT() asm volatile("s_waitcnt vmcnt(0)" ::: "memory")
__device__ __forceinline__ unsigned long long rt() { return __builtin_amdgcn_s_memrealtime(); }
__device__ __forceinline__ unsigned f2bf(float f) { unsigned u = __builtin_bit_cast(unsigned, f); return (u + 0x7fffu + ((u >> 16) & 1u)) >> 16; }
__device__ __forceinline__ unsigned pk2(float lo, float hi) { return f2bf(lo) | (f2bf(hi) << 16); }

#define XB_TMO      128
#define XB_XCNT(j)  (256  + 64 * (j))
#define XB_XSUB(j)  (1280 + 64 * (j))
#define XB_XGEN(j)  (2304 + 64 * (j))
#define XB_TOP      3328
#define XB_TOPGEN   3392
#define XCD_BAR_WORDS 3456
#define XB_SPIN_CAP (1u << 18)

__device__ __forceinline__ unsigned xb_ld(unsigned* p)              { return __hip_atomic_load(p, __ATOMIC_RELAXED, __HIP_MEMORY_SCOPE_AGENT); }
__device__ __forceinline__ unsigned xb_add(unsigned* p, unsigned v) { return __hip_atomic_fetch_add(p, v, __ATOMIC_RELAXED, __HIP_MEMORY_SCOPE_AGENT); }
__device__ __forceinline__ unsigned xb_xcc_id() { return (unsigned)__builtin_amdgcn_s_getreg((3 << 11) | 20) & 0xFu; }
#define XB_SPIN(cond, bar) do { unsigned _sp = 0; while (cond) { __builtin_amdgcn_s_sleep(1); \
    if ((++_sp & 255u) == 0u) { if (xb_ld(&(bar)[XB_TMO])) break; if (_sp > XB_SPIN_CAP) { atomicAdd(&(bar)[XB_TMO], 1u); break; } } } } while (0)

struct XcdBarrier {
    unsigned* bar; unsigned x;
    volatile LAS unsigned* st;
};

__device__ __forceinline__ XcdBarrier xcd_barrier_post(unsigned* bar, volatile LAS unsigned* st) {
    XcdBarrier b; b.bar = bar; b.x = xb_xcc_id(); b.st = st;
    if (threadIdx.x == 0) (void)xb_add(&bar[XB_XCNT(b.x)], 1u);
    return b;
}
__device__ __forceinline__ void xcd_barrier_complete(unsigned* bar, unsigned x, unsigned& nloc, unsigned& nx) {
    const unsigned G = gridDim.x * gridDim.y * gridDim.z;
    unsigned sum, cnt, mine, sp = 0u;
    for (;;) {
        sum = 0u; cnt = 0u; mine = 0u;
#pragma unroll
        for (unsigned j = 0; j < 16; ++j) { const unsigned c = xb_ld(&bar[XB_XCNT(j)]); sum += c; cnt += (c > 0u) ? 1u : 0u; mine = (j == x) ? c : mine; }
        if (sum == G) break;
        __builtin_amdgcn_s_sleep(1);
        if ((++sp & 255u) == 0u) { if (xb_ld(&bar[XB_TMO])) break; if (sp > XB_SPIN_CAP) { atomicAdd(&bar[XB_TMO], 1u); break; } }
    }
    nloc = mine > 0u ? mine : 1u; nx = cnt > 0u ? cnt : 1u;
}

__device__ __forceinline__ void xcd_barrier(const XcdBarrier& b) {
    asm volatile("s_waitcnt vmcnt(0)" ::: "memory");
    __syncthreads();
    if (threadIdx.x == 0) {
        unsigned* bar = b.bar;
        __builtin_amdgcn_s_waitcnt(0);
        unsigned nloc = b.st[0], nx = b.st[1];
        if (nloc == 0u) { xcd_barrier_complete(bar, b.x, nloc, nx); b.st[0] = nloc; b.st[1] = nx; }
        const unsigned old = xb_add(&bar[XB_XSUB(b.x)], 1u);
        const unsigned gen = old / nloc;
        if (old + 1u == (gen + 1u) * nloc) {
            __builtin_amdgcn_fence(__ATOMIC_RELEASE, "agent");
            asm volatile("s_waitcnt vmcnt(0)" ::: "memory");
            const unsigned og = xb_add(&bar[XB_TOP], 1u);
            const unsigned tg = og / nx;
            if (og + 1u == (tg + 1u) * nx) xb_add(&bar[XB_TOPGEN], 1u);
            else XB_SPIN(xb_ld(&bar[XB_TOPGEN]) == tg, bar);
            __builtin_amdgcn_fence(__ATOMIC_ACQUIRE, "agent");
            xb_add(&bar[XB_XGEN(b.x)], 1u);
            asm volatile("s_waitcnt vmcnt(0)" ::: "memory");
        } else {
            XB_SPIN(xb_ld(&bar[XB_XGEN(b.x)]) == gen, bar);
            __builtin_amdgcn_fence(__ATOMIC_ACQUIRE, "agent");
            asm volatile("s_waitcnt vmcnt(0)" ::: "memory");
        }
    }
    __syncthreads();
}

constexpr int NWAVES = 8;
constexpr int BATCH = 32, SEQ = 2048, DMODEL = 1024, MTOK = BATCH * SEQ, DFF = 4096, NPROJ = 5120, INCOLS = 4896;
constexpr float RMS_EPS = 1e-6f;
constexpr float QSCALE = 0.125f * 1.4426950408889634f;
constexpr float LOG2E = 1.4426950408889634f;
#ifndef MK_N_LAUNCHES
#define MK_N_LAUNCHES 1
#endif
constexpr int N_PHASES = 10;
constexpr int N_LAUNCHES = MK_N_LAUNCHES;
constexpr size_t MiB = 1u << 20, KiB = 1u << 10;
constexpr size_t WS_CTL = 0, CTL_ZERO_BYTES = 1 * MiB;
constexpr size_t WS_WIN = 2 * MiB, WS_WF = 12 * MiB, WS_WN = 13 * MiB, WS_WO = 14 * MiB, WS_WUP = 16 * MiB, WS_WDN = 24 * MiB;
constexpr size_t WS_W1K = 32 * MiB, WS_W1V = WS_W1K + 256 * KiB, WS_W2K = WS_W1V + 256 * KiB, WS_W2V = WS_W2K + 8 * KiB, WS_PBK = WS_W2V + 8 * KiB, WS_PBV = WS_PBK + 256;
constexpr size_t WS_KT0 = WS_PBV + 256;
constexpr size_t WS_RSTD2 = 46 * MiB;
constexpr size_t WS_ROPEC = 33 * MiB, WS_ROPES = WS_ROPEC + 256 * KiB;
constexpr size_t WS_KCMP = 34 * MiB, WS_VCMP = 35 * MiB, WS_C = 36 * MiB, WS_LF = 38 * MiB, WS_GATE = 40 * MiB;
constexpr size_t WS_HB = 48 * MiB;
constexpr size_t WS_FKX = 48 * MiB;
constexpr size_t WS_PROBE_O = 64 * MiB;
constexpr size_t WS_FQ = 176 * MiB, WS_FK = 240 * MiB, WS_FV = 304 * MiB, WS_NQ = 368 * MiB;
constexpr size_t WS_KV = 432 * MiB, KV_STRIDE = 16 * MiB;
constexpr size_t WS_SGA = 528 * MiB, WS_SGB = 656 * MiB;
constexpr size_t WS_Y = 784 * MiB;
constexpr size_t WS_ATT = WS_Y;
constexpr size_t WS_FOXO_UNUSED = WS_Y, WS_NSAO_UNUSED = WS_Y + 64 * MiB;
constexpr size_t WS_U = 176 * MiB;
constexpr size_t WS_END = 1024 * MiB;
static_assert(WS_FV - WS_FK == WS_FK - WS_FQ && WS_U + (size_t)MTOK * DFF * 2 <= WS_Y && WS_Y + (size_t)MTOK * 512 * 4 <= WS_END && WS_GATE + (size_t)MTOK * 24 * 4 <= WS_HB, "d_ws map");
constexpr int CW_TMO = 0, CW_CODE = 1, CW_BAR = 4096, CW_QUEUE = 16384;
constexpr int RING_OFF = 0, RING_BYTES = 131072;
constexpr int LDSCTL_OFF = RING_BYTES, MISC_OFF = LDSCTL_OFF + 320;
constexpr int LDS_BYTES = 147456;
static_assert(MISC_OFF + 128 <= LDS_BYTES, "LDS map");


typedef float f32x16 __attribute__((ext_vector_type(16)));
struct Frame {
    LAS unsigned char* lds;
    volatile LAS unsigned* MISC;
    gu32* ctl;
    int wave;
    int vcu, G;
    unsigned char* ws;
    const float* x; float* out;
    const float *g_mix_pre, *g_mix_post, *g_mlp_pre, *g_mlp_post, *w_in, *b_forget, *pos_k, *w1_k, *w2_k, *pos_v, *w1_v, *w2_v, *w_fox, *w_nsa, *w_o, *w_up, *w_down;
};
template <class T> __device__ __forceinline__ T* wsp(const Frame& F, size_t off) { return (T*)(F.ws + off); }
__device__ __forceinline__ int cur_lane() { return (int)__builtin_amdgcn_mbcnt_hi(~0u, __builtin_amdgcn_mbcnt_lo(~0u, 0u)); }
__device__ __forceinline__ int cur_tid(const Frame& F) { return F.wave * 64 + cur_lane(); }

__device__ __forceinline__ float wave_sum(float v) {
#pragma unroll
    for (int o = 1; o < 64; o <<= 1) v += __shfl_xor(v, o);
    return v;
}
__device__ __forceinline__ float bfl(unsigned w) { return __uint_as_float(w << 16); }
__device__ __forceinline__ float bfh(unsigned w) { return __uint_as_float(w & 0xffff0000u); }

__device__ __forceinline__ int rope_d(int w) { const int i = w >> 3, j = w & 7; return j < 4 ? 4 * i + j : 32 + 4 * i + (j - 4); }
__device__ __forceinline__ int in_src_col(int n) {
    if (n < 1536) return n;
    if (n < 2048) { const int l = n - 1536; return 1544 + (l & ~63) + rope_d(l & 63); }
    if (n < 2816) { const int s = (n - 2048) >> 8, l = (n - 2048) & 255; const int kb = 2056 + s * 256;
        return l < 128 ? kb + (l & ~63) + rope_d(l & 63) : kb + 128 + (l - 128); }
    if (n < 4864) { const int q = (n - 2816) >> 8, l = (n - 2816) & 255; return l < 128 ? 2848 + 128 * q + l : 3872 + 128 * q + (l - 128); }
    const int l = n - 4864; if (l < 8) return 1536 + l; if (l < 32) return 2824 + (l - 8); return -1;
}
template <class SrcCol>
__device__ __forceinline__ void p0_transpose_item(const float* W, int K, int Nsrc, bf16* WT, int nblk, LAS float* scr, int item, int lane, SrcCol srccol, const float* kgain = nullptr, int ldk = 0, int koff = 0) {
    const int kb = item / nblk, nb = item % nblk, k0 = 64 * kb, n0 = 32 * nb;
    const int sc = srccol(n0 + (lane & 31));
#pragma unroll 8
    for (int i = 0; i < 32; ++i) { const int kk = 2 * i + (lane >> 5); float w = sc >= 0 ? W[(size_t)(k0 + kk) * Nsrc + sc] : 0.f; if (kgain) w *= kgain[k0 + kk]; scr[kk * 33 + (lane & 31)] = w; }
    LDS_WAIT(); asm volatile("" ::: "memory");
    const int c = lane & 7;
#pragma unroll
    for (int j = 0; j < 4; ++j) { const int n = (lane >> 3) + 8 * j; const LAS float* s = scr + (8 * c) * 33 + n;
        v4u o; o.x = pk2(s[0 * 33], s[1 * 33]); o.y = pk2(s[2 * 33], s[3 * 33]); o.z = pk2(s[4 * 33], s[5 * 33]); o.w = pk2(s[6 * 33], s[7 * 33]);
        *(GAS v4u*)(WT + (size_t)(n0 + n) * (ldk ? ldk : K) + koff + k0 + 8 * c) = o; }
    LDS_WAIT(); asm volatile("" ::: "memory");
}
__device__ __forceinline__ void rms_rows_to_bf16(int lane, int gw, int NGW, const float* X, const float* g, bf16* O) {
    constexpr int RP = 4;
    const GAS f32x4* gr = (const GAS f32x4*)g + lane; f32x4 gv[4];
#pragma unroll
    for (int j = 0; j < 4; ++j) gv[j] = gr[64 * j];
    for (int m0 = gw; m0 < MTOK; m0 += NGW * RP) {
        f32x4 v[RP][4];
#pragma unroll
        for (int r = 0; r < RP; ++r) { const GAS f32x4* xr = (const GAS f32x4*)(X + (size_t)(m0 + r * NGW) * DMODEL) + lane;
#pragma unroll
            for (int j = 0; j < 4; ++j) v[r][j] = __builtin_nontemporal_load(xr + 64 * j); }
#pragma unroll
        for (int r = 0; r < RP; ++r) { float s = 0.f;
#pragma unroll
            for (int j = 0; j < 4; ++j) s += (v[r][j].x * v[r][j].x + v[r][j].y * v[r][j].y) + (v[r][j].z * v[r][j].z + v[r][j].w * v[r][j].w);
            const float rr = 1.0f / sqrtf(wave_sum(s) * (1.f / DMODEL) + RMS_EPS);
            GAS unsigned long long* o8 = (GAS unsigned long long*)(O + (size_t)(m0 + r * NGW) * DMODEL) + lane;
#pragma unroll
            for (int j = 0; j < 4; ++j) { const f32x4 a = v[r][j], gg = gv[j];
                o8[64 * j] = (unsigned long long)pk2(a.x * rr * gg.x, a.y * rr * gg.y) | ((unsigned long long)pk2(a.z * rr * gg.z, a.w * rr * gg.w) << 32); } }
    }
}
__device__ __forceinline__ void p0_prologue(Frame& F) {
    LAS float* scr = (LAS float*)(F.lds + RING_OFF + F.wave * 16384);
    const int gw = F.vcu * NWAVES + F.wave, NGW = F.G * NWAVES, lane = cur_lane();
    constexpr int I_IN = 16 * (NPROJ / 32), I_F = 8 * 32, I_O = 16 * 32, I_UP = 16 * 128, I_DN = 64 * 32, I_W1 = 32 * 2, I_W2 = 1 * 2;
    constexpr int NITEMS = I_IN + 2 * I_F + I_O + I_UP + I_DN + 2 * I_W1 + 2 * I_W2;
    auto ident = [](int n) { return n; };
    for (int it = gw; it < NITEMS; it += NGW) {
        int r = it;
        if (r < I_IN) { p0_transpose_item(F.w_in, 1024, INCOLS, wsp<bf16>(F, WS_WIN), NPROJ / 32, scr, r, lane, [](int n) { return in_src_col(n); }); continue; } r -= I_IN;
        if (r < I_F) { p0_transpose_item(F.w_fox, 512, 1024, wsp<bf16>(F, WS_WF), 32, scr, r, lane, ident, nullptr, 1024, 512); continue; } r -= I_F;
        if (r < I_F) { p0_transpose_item(F.w_nsa, 512, 1024, wsp<bf16>(F, WS_WF), 32, scr, r, lane, ident, nullptr, 1024, 0); continue; } r -= I_F;
        if (r < I_O) { p0_transpose_item(F.w_o, 1024, 1024, wsp<bf16>(F, WS_WO), 32, scr, r, lane, ident); continue; } r -= I_O;
        if (r < I_UP) { p0_transpose_item(F.w_up, 1024, 4096, wsp<bf16>(F, WS_WUP), 128, scr, r, lane, ident, F.g_mlp_pre); continue; }     r -= I_UP;
        if (r < I_DN) { p0_transpose_item(F.w_down, 4096, 1024, wsp<bf16>(F, WS_WDN), 32, scr, r, lane, ident); continue; } r -= I_DN;
        if (r < I_W1) { p0_transpose_item(F.w1_k, 2048, 64, wsp<bf16>(F, WS_W1K), 2, scr, r, lane, ident); continue; } r -= I_W1;
        if (r < I_W1) { p0_transpose_item(F.w1_v, 2048, 64, wsp<bf16>(F, WS_W1V), 2, scr, r, lane, ident); continue; } r -= I_W1;
        if (r < I_W2) { p0_transpose_item(F.w2_k, 64, 64, wsp<bf16>(F, WS_W2K), 2, scr, r, lane, ident); continue; } r -= I_W2;
        p0_transpose_item(F.w2_v, 64, 64, wsp<bf16>(F, WS_W2V), 2, scr, r, lane, ident);
    }
    { float* RC = wsp<float>(F, WS_ROPEC); float* RS = wsp<float>(F, WS_ROPES);
      for (int e = (F.vcu * NWAVES * 64 + cur_tid(F)); e < SEQ * 32; e += F.G * NWAVES * 64) { const int t = e >> 5, i = e & 31;
          const float inv = powf(10000.0f, -(float)(2 * i) / 64.0f); const float ang = (float)t * inv; RC[e] = cosf(ang); RS[e] = sinf(ang); } }
    if (F.wave == 0) for (int it = F.vcu; it < 128; it += F.G) { const int kv = it >> 6, c = it & 63; const float* pos = kv ? F.pos_v : F.pos_k; const float* w1 = kv ? F.w1_v : F.w1_k; float s = 0.f;
        for (int k = lane; k < 2048; k += 64) s += pos[k] * w1[(size_t)k * 64 + c];
        s = wave_sum(s); if (lane == 0) wsp<float>(F, kv ? WS_PBV : WS_PBK)[c] = s; }
    rms_rows_to_bf16(lane, gw, NGW, F.x, F.g_mix_pre, wsp<bf16>(F, WS_HB));
}

__device__ __forceinline__ int crow(int r, int hi) { return (r & 3) + 8 * (r >> 2) + 4 * hi; }
#define P2_PIN8(a) asm volatile("" : "+v"(a[0]), "+v"(a[1]), "+v"(a[2]), "+v"(a[3]), "+v"(a[4]), "+v"(a[5]), "+v"(a[6]), "+v"(a[7]))
__device__ __forceinline__ void p2_compress_unit(Frame& F, int unit) {
    const int bg = unit >> 2, kv = (unit >> 1) & 1, half = unit & 1, lane = cur_lane(), w = F.wave;
    const bf16* X = wsp<bf16>(F, WS_KV + (size_t)kv * KV_STRIDE) + (size_t)bg * SEQ * 64;
    const bf16* W1t = wsp<bf16>(F, kv ? WS_W1V : WS_W1K); const bf16* W2t = wsp<bf16>(F, kv ? WS_W2V : WS_W2K); const float* PB = wsp<float>(F, kv ? WS_PBV : WS_PBK);
    bf16* OUT = wsp<bf16>(F, kv ? WS_VCMP : WS_KCMP) + (size_t)bg * 128 * 64;
    const int rt = w & 1, ct = (w >> 1) & 1, kh = w >> 2, r = lane & 31, h = lane >> 5;
    const int irow = 64 * half + 32 * rt + r, ild = irow < 126 ? irow : 126;
    const GAS bf16x8* arow = (const GAS bf16x8*)(X + (size_t)ild * 1024 + kh * 1024 + 8 * h); const GAS bf16x8* brow = (const GAS bf16x8*)(W1t + (size_t)(32 * ct + r) * 2048 + kh * 1024 + 8 * h);
    f32x16 acc = {};
    bf16x8 a0[8], b0[8], a1[8], b1[8];
#pragma unroll
    for (int s = 0; s < 8; ++s) { a0[s] = arow[2 * s]; b0[s] = brow[2 * s]; }
#pragma unroll 1
    for (int bt = 0; bt < 8; bt += 2) {
#pragma unroll
        for (int s = 0; s < 8; ++s) { a1[s] = arow[2 * (8 * (bt + 1) + s)]; b1[s] = brow[2 * (8 * (bt + 1) + s)]; }
        P2_PIN8(a0); P2_PIN8(b0);
#pragma unroll
        for (int s = 0; s < 8; ++s) acc = __builtin_amdgcn_mfma_f32_32x32x16_bf16(a0[s], b0[s], acc, 0, 0, 0);
        if (bt + 2 < 8) {
#pragma unroll
            for (int s = 0; s < 8; ++s) { a0[s] = arow[2 * (8 * (bt + 2) + s)]; b0[s] = brow[2 * (8 * (bt + 2) + s)]; } }
        P2_PIN8(a1); P2_PIN8(b1);
#pragma unroll
        for (int s = 0; s < 8; ++s) acc = __builtin_amdgcn_mfma_f32_32x32x16_bf16(a1[s], b1[s], acc, 0, 0, 0);
    }
    LAS float* red = (LAS float*)(F.lds + RING_OFF);
    LAS bf16* Hs = (LAS bf16*)(F.lds + RING_OFF + 16384);
    if (kh == 1) {
#pragma unroll
        for (int i = 0; i < 16; ++i) red[((w & 3) * 16 + i) * 64 + lane] = acc[i];
    }
    __syncthreads();
    if (kh == 0) { const float pb = PB[32 * ct + r];
#pragma unroll
        for (int i = 0; i < 16; ++i) { float v = acc[i] + red[((w & 3) * 16 + i) * 64 + lane] + pb; v = v / (1.0f + __expf(-v)); Hs[(32 * rt + crow(i, h)) * 72 + 32 * ct + r] = (bf16)f2bf(v); }
    }
    __syncthreads();
    if (kh == 0) { f32x16 o = {};
#pragma unroll
        for (int s = 0; s < 4; ++s) { const bf16x8 a = *(const LAS bf16x8*)(Hs + (32 * rt + r) * 72 + 16 * s + 8 * h), b = *(const GAS bf16x8*)(W2t + (size_t)(32 * ct + r) * 64 + 16 * s + 8 * h);
            o = __builtin_amdgcn_mfma_f32_32x32x16_bf16(a, b, o, 0, 0, 0); }
#pragma unroll
        for (int i = 0; i < 16; ++i) { const int row = 64 * half + 32 * rt + crow(i, h); OUT[(size_t)row * 64 + 32 * ct + r] = (bf16)(row == 127 ? 0u : f2bf(o[i])); }
    }
    __syncthreads();
}
__device__ __forceinline__ void p2_phase(Frame& F) {
    for (int id = F.vcu; id < BATCH * 8; id += F.G) { const int b = id >> 3, h = id & 7, tid = cur_tid(F), lane = cur_lane(), w = F.wave;
        LAS float* wt = (LAS float*)(F.lds + RING_OFF + 32768);
        const float* lf = wsp<float>(F, WS_LF) + ((size_t)b * SEQ + 4 * tid) * 8 + h; float v[4];
#pragma unroll
        for (int i = 0; i < 4; ++i) v[i] = lf[i * 8];
        const float tot = (v[0] + v[1]) + (v[2] + v[3]); float incl = tot;
#pragma unroll
        for (int o = 1; o < 64; o <<= 1) { const float n = __shfl_up(incl, o); if (lane >= o) incl += n; }
        if (lane == 63) wt[w] = incl;
        __syncthreads();
        float run = incl - tot;
        for (int k = 0; k < w; ++k) run += wt[k];
        float* c = wsp<float>(F, WS_C) + (size_t)id * SEQ + 4 * tid; GAS v4u* kx = (GAS v4u*)(wsp<bf16>(F, WS_FKX) + ((size_t)id * SEQ + 4 * tid) * 16);
        float cv[4];
#pragma unroll
        for (int i = 0; i < 4; ++i) { run += v[i]; cv[i] = run;
            const float x = -run * LOG2E; const unsigned h1 = f2bf(x); const float r1 = x - __uint_as_float(h1 << 16); const unsigned h2 = f2bf(r1); const float r2 = r1 - __uint_as_float(h2 << 16); const unsigned h3 = f2bf(r2);
            kx[2 * i] = (v4u){h1 | (h2 << 16), h3, 0u, 0u}; kx[2 * i + 1] = (v4u){0u, 0u, 0u, 0u}; }
        *(GAS f32x4*)c = (f32x4){cv[0], cv[1], cv[2], cv[3]};
        { LAS float* cl = (LAS float*)(F.lds + RING_OFF + 36864); LAS float* wk = cl + 2048; LAS float* wq = wk + 256;
          *(LAS f32x4*)(cl + 4 * tid) = (f32x4){cv[0], cv[1], cv[2], cv[3]};
          const GAS v4u* kr = (const GAS v4u*)(wsp<bf16>(F, WS_FK) + ((size_t)b * SEQ + (tid >> 3)) * 512 + h * 64 + (tid & 7) * 8);
          const GAS v4u* qrw = (const GAS v4u*)(wsp<bf16>(F, WS_FQ) + ((size_t)b * SEQ + (tid >> 3)) * 512 + h * 64 + (tid & 7) * 8);
#pragma unroll 1
          for (int i0 = 0; i0 < 32; i0 += 8) { v4u ka[8], qa[8];
#pragma unroll
              for (int i = 0; i < 8; ++i) { ka[i] = kr[(size_t)(i0 + i) * 64 * 64]; qa[i] = qrw[(size_t)(i0 + i) * 64 * 64]; }
              P2_PIN8(ka); P2_PIN8(qa);
#pragma unroll
              for (int i = 0; i < 8; ++i) { const v4u a = ka[i], e = qa[i];
                  float sk = (bfl(a.x) * bfl(a.x) + bfh(a.x) * bfh(a.x)) + (bfl(a.y) * bfl(a.y) + bfh(a.y) * bfh(a.y)) + (bfl(a.z) * bfl(a.z) + bfh(a.z) * bfh(a.z)) + (bfl(a.w) * bfl(a.w) + bfh(a.w) * bfh(a.w));
                  float sq = (bfl(e.x) * bfl(e.x) + bfh(e.x) * bfh(e.x)) + (bfl(e.y) * bfl(e.y) + bfh(e.y) * bfh(e.y)) + (bfl(e.z) * bfl(e.z) + bfh(e.z) * bfh(e.z)) + (bfl(e.w) * bfl(e.w) + bfh(e.w) * bfh(e.w));
                  sk += __shfl_xor(sk, 1); sq += __shfl_xor(sq, 1); sk += __shfl_xor(sk, 2); sq += __shfl_xor(sq, 2); sk += __shfl_xor(sk, 4); sq += __shfl_xor(sq, 4);
                  sk = fmaxf(sk, __shfl_xor(sk, 8)); sq = fmaxf(sq, __shfl_xor(sq, 8)); sk = fmaxf(sk, __shfl_xor(sk, 16)); sq = fmaxf(sq, __shfl_xor(sq, 16)); sk = fmaxf(sk, __shfl_xor(sk, 32)); sq = fmaxf(sq, __shfl_xor(sq, 32));
                  if (lane == 0) { wk[w * 32 + i0 + i] = sk; wq[w * 32 + i0 + i] = sq; } } }
          __syncthreads();
          if (tid < 8) { const int qb = tid; float Qm = 0.f, Kband = 0.f;
              for (int t4 = 0; t4 < 4; ++t4) for (int ww = 0; ww < 8; ++ww) { Qm = fmaxf(Qm, wq[ww * 32 + 4 * qb + t4]); Kband = fmaxf(Kband, wk[ww * 32 + 4 * qb + t4]); }
              Qm = sqrtf(Qm) * 1.001f; Kband = sqrtf(Kband) * 1.001f;
              const float cq0 = cl[256 * qb]; int kt0 = 4 * qb;
              for (int kt = 4 * qb - 1; kt >= 0; --kt) { float kk = 0.f; for (int ww = 0; ww < 8; ++ww) kk = fmaxf(kk, wk[ww * 32 + kt]); kk = sqrtf(kk) * 1.001f;
                  const float bound = Qm * (kk + Kband) + (cq0 - cl[64 * kt + 63]) * LOG2E; if (bound >= -40.0f) kt0 = kt; }
              wsp<int>(F, WS_KT0)[id * 8 + qb] = kt0; } }
        __syncthreads(); }
    for (int u = F.vcu; u < 256; u += F.G) p2_compress_unit(F, u);
}

template <bool FINAL>
__device__ __forceinline__ void row_pass(Frame& F, const float* xin_f32, const bf16* xin_b16, const bf16* Y, const float* gpost, float* out_f32, bf16* X1B, float* RSTD2) {
    constexpr int RP = 4;
    const int gw = F.vcu * NWAVES + F.wave, NGW = F.G * NWAVES, lane = cur_lane();
    const GAS f32x4* gp = (const GAS f32x4*)gpost + lane;
    f32x4 gpv[4];
#pragma unroll
    for (int j = 0; j < 4; ++j) gpv[j] = gp[64 * j];
    for (int m0 = gw; m0 < MTOK; m0 += NGW * RP) {
        f32x4 xv[RP][4]; unsigned long long yw[RP][4];
#pragma unroll
        for (int r = 0; r < RP; ++r) { const size_t m = (size_t)(m0 + r * NGW);
            const GAS unsigned long long* yr = (const GAS unsigned long long*)(Y + m * DMODEL) + lane;
            if (FINAL) { const GAS unsigned long long* xr = (const GAS unsigned long long*)(xin_b16 + m * DMODEL) + lane;
#pragma unroll
                for (int j = 0; j < 4; ++j) { const unsigned long long w = __builtin_nontemporal_load(xr + 64 * j); const unsigned lo = (unsigned)w, hi = (unsigned)(w >> 32); xv[r][j] = (f32x4){bfl(lo), bfh(lo), bfl(hi), bfh(hi)}; yw[r][j] = __builtin_nontemporal_load(yr + 64 * j); }
            } else { const GAS f32x4* xr = (const GAS f32x4*)(xin_f32 + m * DMODEL) + lane;
#pragma unroll
                for (int j = 0; j < 4; ++j) { xv[r][j] = __builtin_nontemporal_load(xr + 64 * j); yw[r][j] = __builtin_nontemporal_load(yr + 64 * j); } } }
#pragma unroll
        for (int r = 0; r < RP; ++r) { const size_t m = (size_t)(m0 + r * NGW);
            f32x4 yv[4]; float s = 0.f;
#pragma unroll
            for (int j = 0; j < 4; ++j) { const unsigned lo = (unsigned)yw[r][j], hi = (unsigned)(yw[r][j] >> 32);
                yv[j] = (f32x4){bfl(lo), bfh(lo), bfl(hi), bfh(hi)}; s += (yv[j].x * yv[j].x + yv[j].y * yv[j].y) + (yv[j].z * yv[j].z + yv[j].w * yv[j].w); }
            const float rr = 1.0f / sqrtf(wave_sum(s) * (1.f / DMODEL) + RMS_EPS); float s2 = 0.f;
            if (FINAL) { GAS f32x4* xo = (GAS f32x4*)(out_f32 + m * DMODEL) + lane;
#pragma unroll
                for (int j = 0; j < 4; ++j) __builtin_nontemporal_store(xv[r][j] + yv[j] * rr * gpv[j], xo + 64 * j);
            } else { GAS unsigned long long* o8 = (GAS unsigned long long*)(X1B + m * DMODEL) + lane;
#pragma unroll
                for (int j = 0; j < 4; ++j) { const f32x4 v = xv[r][j] + yv[j] * rr * gpv[j]; s2 += (v.x * v.x + v.y * v.y) + (v.z * v.z + v.w * v.w);
                    o8[64 * j] = (unsigned long long)pk2(v.x, v.y) | ((unsigned long long)pk2(v.z, v.w) << 32); }
                const float r2 = 1.0f / sqrtf(wave_sum(s2) * (1.f / DMODEL) + RMS_EPS); if (lane == 0) RSTD2[m] = r2; }
        }
    }
}

namespace at {
constexpr int KSLOT = 10240, VSLOT = 8192, NSLOT = 3;
constexpr int L_K = 0, L_V = NSLOT * KSLOT, L_WS = L_V + NSLOT * VSLOT, L_PARK = L_WS + 8 * 512, L_PSL = L_PARK, L_CMP = L_PARK + 4 * 64 * 33 * 4, L_SELM = L_CMP + 4 * 8192, L_NEXT = L_SELM + 256, L_END = L_NEXT + 16;
static_assert(L_SELM >= L_PARK + 8 * 8192, "park region");
static_assert(L_END <= RING_BYTES, "attention LDS map");
constexpr float THR = 8.0f;
typedef short s16x4 __attribute__((ext_vector_type(4)));
typedef short v4i16_t __attribute__((ext_vector_type(4)));
#define AT_NEG (-INFINITY)
__device__ __forceinline__ void glds16(const void* sbase, unsigned voff, unsigned lds_dst) { unsigned keep;
    asm volatile("s_mov_b32 %0, m0\n\ts_mov_b32 m0, %3\n\ts_nop 2\n\tglobal_load_lds_dwordx4 %1, %2\n\ts_mov_b32 m0, %0" : "=&s"(keep) : "v"(voff), "s"(sbase), "s"(lds_dst) : "memory"); }
__device__ __forceinline__ void glds4(const void* sbase, unsigned voff, unsigned lds_dst) { unsigned keep;
    asm volatile("s_mov_b32 %0, m0\n\ts_mov_b32 m0, %3\n\ts_nop 2\n\tglobal_load_lds_dword %1, %2\n\ts_mov_b32 m0, %0" : "=&s"(keep) : "v"(voff), "s"(sbase), "s"(lds_dst) : "memory"); }
#define AT_WAIT_BAR(N) asm volatile("s_waitcnt vmcnt(" #N ") lgkmcnt(0)\n\ts_barrier" ::: "memory")
#define AT_BAR() asm volatile("s_waitcnt lgkmcnt(0)\n\ts_barrier" ::: "memory")
__device__ __forceinline__ unsigned cvtpk(float lo, float hi) { typedef float f2 __attribute__((ext_vector_type(2))); typedef __bf16 b2 __attribute__((ext_vector_type(2))); f2 v = {lo, hi}; b2 b = __builtin_convertvector(v, b2); return __builtin_bit_cast(unsigned, b); }
__device__ __forceinline__ float swap_half(float x, int hi) { auto rr = __builtin_amdgcn_permlane32_swap(__float_as_uint(x), __float_as_uint(x), false, false); return hi ? __uint_as_float(rr[0]) : __uint_as_float(rr[1]); }
__device__ __forceinline__ float max_half(float x) { auto rr = __builtin_amdgcn_permlane32_swap(__float_as_uint(x), __float_as_uint(x), false, false); return fmaxf(__uint_as_float(rr[0]), __uint_as_float(rr[1])); }
__device__ __forceinline__ float sum_half(float x) { auto rr = __builtin_amdgcn_permlane32_swap(__float_as_uint(x), __float_as_uint(x), false, false); return __uint_as_float(rr[0]) + __uint_as_float(rr[1]); }
template <int KS>
__device__ __forceinline__ void qk(f32x16& p0, f32x16& p1, const LAS unsigned char* Kslot, const bf16x8 (&qr)[5], const f32x16& cinit, int r32, int hi) {
    const LAS unsigned char* kb = Kslot + hi * 1024 + r32 * 16;
#pragma unroll
    for (int d0 = 0; d0 < KS; ++d0) { const bf16x8 b0 = *(const LAS bf16x8*)(kb + d0 * 2048), b1 = *(const LAS bf16x8*)(kb + d0 * 2048 + 512);
        if (d0 == 0) { p0 = __builtin_amdgcn_mfma_f32_32x32x16_bf16(b0, qr[0], cinit, 0, 0, 0); p1 = __builtin_amdgcn_mfma_f32_32x32x16_bf16(b1, qr[0], cinit, 0, 0, 0); }
        else { p0 = __builtin_amdgcn_mfma_f32_32x32x16_bf16(b0, qr[d0], p0, 0, 0, 0); p1 = __builtin_amdgcn_mfma_f32_32x32x16_bf16(b1, qr[d0], p1, 0, 0, 0); } }
}
__device__ __forceinline__ s16x4 vtr(const LAS unsigned char* p) { return __builtin_bit_cast(s16x4, __builtin_amdgcn_ds_read_tr16_b64_v4i16((LAS v4i16_t*)p)); }
__device__ __forceinline__ void pv(f32x16 (&o)[2], const LAS unsigned char* vb, const f32x16& p0, const f32x16& p1) {
    v4u pw[4];
#pragma unroll
    for (int k = 0; k < 2; ++k) { pw[k] = (v4u){cvtpk(p0[8 * k], p0[8 * k + 1]), cvtpk(p0[8 * k + 2], p0[8 * k + 3]), cvtpk(p0[8 * k + 4], p0[8 * k + 5]), cvtpk(p0[8 * k + 6], p0[8 * k + 7])};
        pw[2 + k] = (v4u){cvtpk(p1[8 * k], p1[8 * k + 1]), cvtpk(p1[8 * k + 2], p1[8 * k + 3]), cvtpk(p1[8 * k + 4], p1[8 * k + 5]), cvtpk(p1[8 * k + 6], p1[8 * k + 7])}; }
#pragma unroll
    for (int d0 = 0; d0 < 2; ++d0)
#pragma unroll
        for (int ks = 0; ks < 4; ++ks) { const s16x4 lo = vtr(vb + d0 * 4096 + ks * 1024), hi = vtr(vb + d0 * 4096 + ks * 1024 + 512);
            const bf16x8 vf = (bf16x8){lo[0], lo[1], lo[2], lo[3], hi[0], hi[1], hi[2], hi[3]};
            o[d0] = __builtin_amdgcn_mfma_f32_32x32x16_bf16(__builtin_bit_cast(bf16x8, pw[ks]), vf, o[d0], 0, 0, 0); }
}
template <int KS>
__device__ __forceinline__ void load_kf(bf16x8 (&kf)[10], const LAS unsigned char* Kslot, int r32, int hi) {
    const LAS unsigned char* kb = Kslot + hi * 1024 + r32 * 16;
#pragma unroll
    for (int d0 = 0; d0 < KS; ++d0) { kf[2 * d0] = *(const LAS bf16x8*)(kb + d0 * 2048); kf[2 * d0 + 1] = *(const LAS bf16x8*)(kb + d0 * 2048 + 512); }
}
__device__ __forceinline__ void v_load(bf16x8 (&vf)[8], const LAS unsigned char* vb) {
#pragma unroll
    for (int d0 = 0; d0 < 2; ++d0)
#pragma unroll
        for (int ks = 0; ks < 4; ++ks) { const s16x4 lo = vtr(vb + d0 * 4096 + ks * 1024), hi = vtr(vb + d0 * 4096 + ks * 1024 + 512);
            vf[d0 * 4 + ks] = (bf16x8){lo[0], lo[1], lo[2], lo[3], hi[0], hi[1], hi[2], hi[3]}; }
}
template <int KS, bool LOADK>
__device__ __forceinline__ void pv_regs(f32x16 (&o)[2], const bf16x8 (&vf)[8], const f32x16& p0, const f32x16& p1, bf16x8 (&kf)[10], const LAS unsigned char* Knext, int r32, int hi) {
    v4u pw[4];
#pragma unroll
    for (int k = 0; k < 2; ++k) { pw[k] = (v4u){cvtpk(p0[8 * k], p0[8 * k + 1]), cvtpk(p0[8 * k + 2], p0[8 * k + 3]), cvtpk(p0[8 * k + 4], p0[8 * k + 5]), cvtpk(p0[8 * k + 6], p0[8 * k + 7])};
        pw[2 + k] = (v4u){cvtpk(p1[8 * k], p1[8 * k + 1]), cvtpk(p1[8 * k + 2], p1[8 * k + 3]), cvtpk(p1[8 * k + 4], p1[8 * k + 5]), cvtpk(p1[8 * k + 6], p1[8 * k + 7])}; }
#pragma unroll
    for (int ks = 0; ks < 2; ++ks)
#pragma unroll
        for (int d0 = 0; d0 < 2; ++d0) o[d0] = __builtin_amdgcn_mfma_f32_32x32x16_bf16(__builtin_bit_cast(bf16x8, pw[ks]), vf[d0 * 4 + ks], o[d0], 0, 0, 0);
    if (LOADK) { __builtin_amdgcn_sched_barrier(0); load_kf<KS>(kf, Knext, r32, hi); __builtin_amdgcn_sched_barrier(0); }
#pragma unroll
    for (int ks = 2; ks < 4; ++ks)
#pragma unroll
        for (int d0 = 0; d0 < 2; ++d0) o[d0] = __builtin_amdgcn_mfma_f32_32x32x16_bf16(__builtin_bit_cast(bf16x8, pw[ks]), vf[d0 * 4 + ks], o[d0], 0, 0, 0);
}
__device__ __forceinline__ float max3f(float a, float b, float c) { float r; asm("v_max3_f32 %0, %1, %2, %3" : "=v"(r) : "v"(a), "v"(b), "v"(c)); return r; }
__device__ __forceinline__ float rowmax32(const f32x16& p0, const f32x16& p1) {
    float a = max3f(p0[0], p0[1], p1[0]), b = max3f(p0[2], p0[3], p1[1]); a = max3f(a, p1[2], p1[3]);
#pragma unroll
    for (int r = 4; r < 16; r += 4) { a = max3f(a, p0[r], p0[r + 1]); b = max3f(b, p0[r + 2], p0[r + 3]); a = max3f(a, p1[r], p1[r + 1]); b = max3f(b, p1[r + 2], p1[r + 3]); }
    return max_half(__builtin_fmaxf(a, b));
}
template <bool FIRST>
__device__ __forceinline__ void softmax_tile(f32x16& p0, f32x16& p1, f32x16& cinit, float& l, f32x16 (&o)[2], LAS float* wsf, int r32, int hi) {
    const float rm = rowmax32(p0, p1);
    bool resc = false;
    if (FIRST) { const float dl = rm;
#pragma unroll
        for (int r = 0; r < 16; ++r) { p0[r] -= dl; p1[r] -= dl; cinit[r] -= dl; } }
    else if (__any(rm > THR)) { const float dl = fmaxf(rm, 0.f);
#pragma unroll
        for (int r = 0; r < 16; ++r) { p0[r] -= dl; p1[r] -= dl; cinit[r] -= dl; }
        const float f = __builtin_amdgcn_exp2f(-dl); l *= f; if (hi == 0) wsf[r32] = f; resc = true; }
    float s = 0.f;
#pragma unroll
    for (int r = 0; r < 16; ++r) { p0[r] = __builtin_amdgcn_exp2f(p0[r]); p1[r] = __builtin_amdgcn_exp2f(p1[r]); s += p0[r] + p1[r]; }
    l += s;
    if (resc) {
#pragma unroll
        for (int i = 0; i < 4; ++i) { const f32x4 f4 = *(const LAS f32x4*)(wsf + 8 * i + 4 * hi);
#pragma unroll
            for (int k = 0; k < 4; ++k) { o[0][4 * i + k] *= f4[k]; o[1][4 * i + k] *= f4[k]; } } }
}
__device__ __forceinline__ void row_bcast(float v, float (&out)[16], LAS float* wsf, int r32, int hi) {
    asm volatile("s_waitcnt lgkmcnt(0)" ::: "memory");
    if (hi == 0) wsf[32 + r32] = v;
#pragma unroll
    for (int i = 0; i < 4; ++i) { const f32x4 f4 = *(const LAS f32x4*)(wsf + 32 + 8 * i + 4 * hi);
#pragma unroll
        for (int k = 0; k < 4; ++k) out[4 * i + k] = f4[k]; }
    asm volatile("s_waitcnt lgkmcnt(0)" ::: "memory");
}
__device__ __forceinline__ void store_rows(const f32x16 (&v)[2], LAS unsigned char* stg_, bf16* Ow, int pitch, int lane, int r32, int hi) {
    LAS bf16* stg = (LAS bf16*)stg_;
#pragma unroll
    for (int r = 0; r < 16; ++r) { const int orow = crow(r, hi);
#pragma unroll
        for (int d0 = 0; d0 < 2; ++d0) stg[orow * 64 + d0 * 32 + r32] = (bf16)f2bf(v[d0][r]); }
    asm volatile("s_waitcnt lgkmcnt(0)" ::: "memory");
#pragma unroll
    for (int i = 0; i < 4; ++i) { const int row = i * 8 + (lane >> 3), ch = lane & 7; const v4u w = *(const LAS v4u*)(stg + row * 64 + ch * 8); *(GAS v4u*)(Ow + (size_t)row * pitch + ch * 8) = w; }
    asm volatile("s_waitcnt lgkmcnt(0)" ::: "memory");
}


template <int KS>
__device__ __forceinline__ void qk_regs(f32x16& p0, f32x16& p1, const bf16x8 (&kf)[10], const bf16x8 (&qr)[5], const f32x16& cinit) {
    p0 = __builtin_amdgcn_mfma_f32_32x32x16_bf16(kf[0], qr[0], cinit, 0, 0, 0); p1 = __builtin_amdgcn_mfma_f32_32x32x16_bf16(kf[1], qr[0], cinit, 0, 0, 0);
#pragma unroll
    for (int d0 = 1; d0 < KS; ++d0) { p0 = __builtin_amdgcn_mfma_f32_32x32x16_bf16(kf[2 * d0], qr[d0], p0, 0, 0, 0); p1 = __builtin_amdgcn_mfma_f32_32x32x16_bf16(kf[2 * d0 + 1], qr[d0], p1, 0, 0, 0); }
}
__device__ __forceinline__ void softmax_first(f32x16& p0, f32x16& p1, f32x16& cinit, float& l) {
    const float dl = rowmax32(p0, p1); float s = 0.f;
#pragma unroll
    for (int r = 0; r < 16; ++r) { cinit[r] -= dl; p0[r] = __builtin_amdgcn_exp2f(p0[r] - dl); p1[r] = __builtin_amdgcn_exp2f(p1[r] - dl); s += p0[r] + p1[r]; }
    l = s;
}
__device__ __forceinline__ void softmax_next(f32x16& p0, f32x16& p1, f32x16& cinit, float& l, f32x16 (&o)[2], LAS float* wsf, int r32, int hi) {
    const float rm = rowmax32(p0, p1);
    if (__builtin_expect(__any(rm > THR), 0)) { const float dl = __builtin_fmaxf(rm, 0.f);
#pragma unroll
        for (int r = 0; r < 16; ++r) { p0[r] -= dl; p1[r] -= dl; cinit[r] -= dl; }
        const float f = __builtin_amdgcn_exp2f(-dl); l *= f; if (hi == 0) wsf[r32] = f;
#pragma unroll
        for (int i = 0; i < 4; ++i) { const f32x4 f4 = *(const LAS f32x4*)(wsf + 8 * i + 4 * hi);
#pragma unroll
            for (int k = 0; k < 4; ++k) { o[0][4 * i + k] *= f4[k]; o[1][4 * i + k] *= f4[k]; } } }
    float s = 0.f;
#pragma unroll
    for (int r = 0; r < 16; ++r) { p0[r] = __builtin_amdgcn_exp2f(p0[r]); p1[r] = __builtin_amdgcn_exp2f(p1[r]); s += p0[r] + p1[r]; }
    l += s;
}

#define AT_CONSUME4(a, b, c, d) asm volatile("" :: "v"(a), "v"(b), "v"(c), "v"(d))

__device__ __forceinline__ void fox_unit(Frame& F, int bh, int qb, int kt0, const int ABL) {
    int tid_ = cur_tid(F); asm volatile("" : "+v"(tid_));
    const int lane = tid_ & 63, r32 = lane & 31, hi = lane >> 5, wid = F.wave; const int b = bh >> 3, h = bh & 7;
    LAS unsigned char* shm = F.lds + RING_OFF; const unsigned lds0 = (unsigned)(uintptr_t)shm;
    LAS float* wsf = (LAS float*)(shm + L_WS + wid * 512);
    const size_t rowbase = (size_t)b * SEQ; const int q0 = qb * 256;
    const bf16* Q = wsp<bf16>(F, WS_FQ); const bf16* K = wsp<bf16>(F, WS_FK) + (rowbase + (size_t)kt0 * 64) * 512 + h * 64; const bf16* V = wsp<bf16>(F, WS_FV) + (rowbase + (size_t)kt0 * 64) * 512 + h * 64;
    const bf16* KX = wsp<bf16>(F, WS_FKX) + ((size_t)bh * SEQ + (size_t)kt0 * 64) * 16;
    const unsigned koff = (unsigned)(lane * 512 + wid * 8) * 2u, voff = (unsigned)((16 * (wid & 3) + (lane >> 2)) * 512 + (wid >> 2) * 32 + (lane & 3) * 8) * 2u;
    const unsigned xoff = (unsigned)((16 * (wid & 3) + (lane >> 2)) * 16 + (wid >> 2) * 8 + (lane & 3) * 2) * 2u;
    const unsigned kdst = lds0 + L_K + wid * 1024, vdst = lds0 + L_V + wid * 1024, xdst = lds0 + L_K + (8 + (wid >> 2)) * 1024 + (wid & 3) * 256;
#define FX_DMA_K(t, slot) do { glds16(K + (size_t)(t) * 64 * 512, koff, (unsigned)__builtin_amdgcn_readfirstlane(kdst + (slot) * KSLOT)); \
        glds4(KX + (size_t)(t) * 64 * 16, xoff, (unsigned)__builtin_amdgcn_readfirstlane(xdst + (slot) * KSLOT)); } while (0)
#define FX_DMA_V(t, slot) glds16(V + (size_t)(t) * 64 * 512, voff, (unsigned)__builtin_amdgcn_readfirstlane(vdst + (slot) * VSLOT))
    const int NT = 4 * qb + 4 - kt0;
    bf16x8 qr[5];
    { const bf16* Qw = Q + (rowbase + q0 + wid * 32 + r32) * 512 + h * 64;
#pragma unroll
      for (int d0 = 0; d0 < 4; ++d0) qr[d0] = *(const GAS bf16x8*)(Qw + d0 * 16 + hi * 8);
      const short one = (short)0x3F80; qr[4] = hi == 0 ? (bf16x8){one, one, one, 0, 0, 0, 0, 0} : (bf16x8){0, 0, 0, 0, 0, 0, 0, 0}; }
    const float ct = wsp<float>(F, WS_C)[(size_t)bh * SEQ + q0 + wid * 32 + r32] * LOG2E;
    asm volatile("" ::: "memory");
    FX_DMA_K(0, 0); FX_DMA_V(0, 0); FX_DMA_K(1, 1); FX_DMA_K(2, 2); FX_DMA_V(1, 1);
    f32x16 cinit;
    f32x16 o[2]; o[0] = f32x16{}; o[1] = f32x16{}; float l = 0.f;
    const int qrel = wid * 32 + r32;
    const LAS unsigned char* vtb = shm + L_V + ((lane >> 4) & 1) * 32 + (lane & 3) * 8 + (4 * hi + ((lane & 15) >> 2)) * 64;
    bf16x8 kf[10], vf[8];
    AT_WAIT_BAR(3);
    AT_CONSUME4(qr[0], qr[1], qr[2], qr[3]); asm volatile("" :: "v"(ct));
#pragma unroll
    for (int r = 0; r < 16; ++r) cinit[r] = ct;
    load_kf<5>(kf, shm + L_K, r32, hi);
    int s0 = 0, s1 = 1, s2 = 2;
#define FX_MASK(n) do { const int jb_ = (n) - (NT - 4); if (jb_ >= 0) { const int kb_ = 64 * jb_ + 4 * hi; \
        _Pragma("unroll") for (int r = 0; r < 16; ++r) { const int kv = kb_ + (r & 3) + 8 * (r >> 2); if (kv > qrel) p0[r] = AT_NEG; if (kv + 32 > qrel) p1[r] = AT_NEG; } } } while (0)
#define FX_ROT() do { const int t_ = s0; s0 = s1; s1 = s2; s2 = t_; } while (0)
    if (ABL != 7) {
    {
      AT_WAIT_BAR(3); FX_DMA_K(3, 0); FX_DMA_V(2, 2);
      f32x16 p0, p1; qk_regs<5>(p0, p1, kf, qr, cinit); v_load(vf, vtb); __builtin_amdgcn_sched_barrier(0);
      FX_MASK(0); softmax_first(p0, p1, cinit, l); pv_regs<5, true>(o, vf, p0, p1, kf, shm + L_K + KSLOT, r32, hi); FX_ROT(); }
    int n = 1;
    for (; n + 3 < NT; ++n) {
        if (ABL == 4) asm volatile("s_waitcnt vmcnt(3) lgkmcnt(0)" ::: "memory"); else AT_WAIT_BAR(3);
        if (ABL != 5) { FX_DMA_K(n + 3, s0); FX_DMA_V(n + 2, s2); }
        f32x16 p0, p1; if (ABL == 3) { p0 = cinit; p1 = cinit; asm volatile("" : "+v"(p0), "+v"(p1)); } else qk_regs<5>(p0, p1, kf, qr, cinit);
        v_load(vf, vtb + s0 * VSLOT); __builtin_amdgcn_sched_barrier(0);
        FX_MASK(n);
        if (ABL == 6) { asm volatile("" : "+v"(p0), "+v"(p1)); }
        else if (ABL == 1) { const float rm = rowmax32(p0, p1); l += rm; asm volatile("" : "+v"(p0), "+v"(p1)); }
        else softmax_next(p0, p1, cinit, l, o, wsf, r32, hi);
        if (ABL == 2) { asm volatile("" :: "v"(p0), "v"(p1), "v"(vf[0]), "v"(vf[1]), "v"(vf[2]), "v"(vf[3]), "v"(vf[4]), "v"(vf[5]), "v"(vf[6]), "v"(vf[7])); load_kf<5>(kf, shm + L_K + s1 * KSLOT, r32, hi); }
        else pv_regs<5, true>(o, vf, p0, p1, kf, shm + L_K + s1 * KSLOT, r32, hi);
        FX_ROT(); }
    {
      AT_WAIT_BAR(3); FX_DMA_V(n + 2, s2);
      f32x16 p0, p1; qk_regs<5>(p0, p1, kf, qr, cinit); v_load(vf, vtb + s0 * VSLOT); __builtin_amdgcn_sched_barrier(0);
      FX_MASK(n); softmax_next(p0, p1, cinit, l, o, wsf, r32, hi); pv_regs<5, true>(o, vf, p0, p1, kf, shm + L_K + s1 * KSLOT, r32, hi); FX_ROT(); ++n; }
    {
      AT_WAIT_BAR(1);
      f32x16 p0, p1; qk_regs<5>(p0, p1, kf, qr, cinit); v_load(vf, vtb + s0 * VSLOT); __builtin_amdgcn_sched_barrier(0);
      FX_MASK(n); softmax_next(p0, p1, cinit, l, o, wsf, r32, hi); pv_regs<5, true>(o, vf, p0, p1, kf, shm + L_K + s1 * KSLOT, r32, hi); FX_ROT(); ++n; }
    {
      AT_WAIT_BAR(0);
      f32x16 p0, p1; qk_regs<5>(p0, p1, kf, qr, cinit); v_load(vf, vtb + s0 * VSLOT); __builtin_amdgcn_sched_barrier(0);
      FX_MASK(n); softmax_next(p0, p1, cinit, l, o, wsf, r32, hi); pv_regs<5, false>(o, vf, p0, p1, kf, shm, r32, hi); }
    } else { asm volatile("s_waitcnt vmcnt(0)" ::: "memory"); l = 1.f; }
#undef FX_DMA_K
#undef FX_DMA_V
#undef FX_MASK
#undef FX_ROT
    l = sum_half(l); float rl[16]; row_bcast(1.0f / l, rl, wsf, r32, hi);
#pragma unroll
    for (int r = 0; r < 16; ++r) { o[0][r] *= rl[r]; o[1][r] *= rl[r]; }
    store_rows(o, shm + L_PARK + wid * 8192, wsp<bf16>(F, ABL ? WS_PROBE_O : WS_ATT) + (rowbase + q0 + wid * 32) * 1024 + 512 + h * 64, 1024, lane, r32, hi);
    AT_BAR();
}

__device__ __forceinline__ void nsa_unit(Frame& F, int bg, int j) {
    int tid_ = cur_tid(F); asm volatile("" : "+v"(tid_));
    const int tid = tid_, lane = tid & 63, r32 = lane & 31, hi = lane >> 5, wid = F.wave; const int b = bg >> 1, g = bg & 1, hh = wid >> 1, head = 4 * g + hh;
    LAS unsigned char* shm = F.lds + RING_OFF; const unsigned lds0 = (unsigned)(uintptr_t)shm;
    LAS float* wsf = (LAS float*)(shm + L_WS + wid * 512);
    LAS float* PSL = (LAS float*)(shm + L_PSL); LAS unsigned* SELM = (LAS unsigned*)(shm + L_SELM);
    const int qrel = 32 * (wid & 1) + r32, t = 64 * j + qrel; const size_t row = (size_t)b * SEQ + t;
    const bf16* KC = wsp<bf16>(F, WS_KCMP) + (size_t)bg * 128 * 64; const bf16* VC = wsp<bf16>(F, WS_VCMP) + (size_t)bg * 128 * 64;
    const bf16* KS = wsp<bf16>(F, WS_KV + 2 * KV_STRIDE) + (size_t)bg * SEQ * 64; const bf16* VS = wsp<bf16>(F, WS_KV + 3 * KV_STRIDE) + (size_t)bg * SEQ * 64;
    const bf16* KW = wsp<bf16>(F, WS_KV + 4 * KV_STRIDE) + (size_t)bg * SEQ * 64; const bf16* VW = wsp<bf16>(F, WS_KV + 5 * KV_STRIDE) + (size_t)bg * SEQ * 64;
    const unsigned koff = (unsigned)(lane * 64 + wid * 8) * 2u, voff = (unsigned)((16 * (wid & 3) + (lane >> 2)) * 64 + (wid >> 2) * 32 + (lane & 3) * 8) * 2u;
    const unsigned kdst = lds0 + L_K + wid * 1024, vdst = lds0 + L_V + wid * 1024, cdst = lds0 + L_CMP + wid * 1024;
    const int nsel = j + 1, nwin = j >= 8 ? 9 : j + 1, NR = nsel + nwin;
#define NS_TILE(m) ({ int m_ = (m); m_ = m_ < NR ? m_ : NR - 1; (m_ < nsel) ? m_ : (j - (m_ - nsel)) + 64; })
#define NS_DMA_K(m, slot) do { const int e_ = NS_TILE(m); const bf16* kp_ = (e_ < 64) ? KS + e_ * 4096 : KW + (e_ - 64) * 4096; glds16(kp_, koff, (unsigned)__builtin_amdgcn_readfirstlane(kdst + (slot) * KSLOT)); } while (0)
#define NS_DMA_V(m, slot) do { const int e_ = NS_TILE(m); const bf16* vp_ = (e_ < 64) ? VS + e_ * 4096 : VW + (e_ - 64) * 4096; glds16(vp_, voff, (unsigned)__builtin_amdgcn_readfirstlane(vdst + (slot) * VSLOT)); } while (0)
    bf16x8 qr[5];
    { const bf16* Qw = wsp<bf16>(F, WS_NQ) + row * 512 + head * 64;
#pragma unroll
      for (int d0 = 0; d0 < 4; ++d0) qr[d0] = *(const GAS bf16x8*)(Qw + d0 * 16 + hi * 8);
      qr[4] = (bf16x8){0, 0, 0, 0, 0, 0, 0, 0}; }
    const float* gt = wsp<float>(F, WS_GATE) + row * 24 + head * 3; const float g0 = gt[0], g1 = gt[1], g2 = gt[2];
    asm volatile("" ::: "memory");
    glds16(KC, koff, (unsigned)__builtin_amdgcn_readfirstlane(cdst)); glds16(KC + 4096, koff, (unsigned)__builtin_amdgcn_readfirstlane(cdst + 8192));
    glds16(VC, voff, (unsigned)__builtin_amdgcn_readfirstlane(cdst + 16384)); glds16(VC + 4096, voff, (unsigned)__builtin_amdgcn_readfirstlane(cdst + 24576));
    NS_DMA_K(0, 0); NS_DMA_V(0, 0); NS_DMA_K(1, 1); NS_DMA_K(2, 2); NS_DMA_V(1, 1);
    const LAS unsigned char* vlane = shm + ((lane >> 4) & 1) * 32 + (lane & 3) * 8 + (4 * hi + ((lane & 15) >> 2)) * 64;
    const LAS unsigned char* vtb = vlane + L_V;
    f32x16 o[2]; float rs[16]; bf16x8 kf[10], vf[8];
    LAS float* park = (LAS float*)(shm + L_PARK + wid * 8192) + lane;
    AT_WAIT_BAR(5);
    AT_CONSUME4(qr[0], qr[1], qr[2], qr[3]); asm volatile("" :: "v"(g0), "v"(g1), "v"(g2));
    { f32x16 zero = f32x16{}; f32x16 a0, a1, b0, b1;
      load_kf<4>(kf, shm + L_CMP, r32, hi); qk_regs<4>(a0, a1, kf, qr, zero); load_kf<4>(kf, shm + L_CMP + 8192, r32, hi); qk_regs<4>(b0, b1, kf, qr, zero);
      const int nmax = (t - 31) >> 4;
#pragma unroll
      for (int r = 0; r < 16; ++r) { const int n = (r & 3) + 8 * (r >> 2) + 4 * hi; if (n > nmax) a0[r] = AT_NEG; if (n + 32 > nmax) a1[r] = AT_NEG; if (n + 64 > nmax) b0[r] = AT_NEG; if (n + 96 > nmax) b1[r] = AT_NEG; }
      float m = __builtin_fmaxf(rowmax32(a0, a1), rowmax32(b0, b1)); m = (m == AT_NEG) ? 0.f : m;
      float s = 0.f;
#pragma unroll
      for (int r = 0; r < 16; ++r) { a0[r] = __builtin_amdgcn_exp2f(a0[r] - m); a1[r] = __builtin_amdgcn_exp2f(a1[r] - m); b0[r] = __builtin_amdgcn_exp2f(b0[r] - m); b1[r] = __builtin_amdgcn_exp2f(b1[r] - m); s += (a0[r] + a1[r]) + (b0[r] + b1[r]); }
      s = sum_half(s); const float inv = 1.0f / fmaxf(s, 1e-30f);
#pragma unroll
      for (int r = 0; r < 16; ++r) { a0[r] *= inv; a1[r] *= inv; b0[r] *= inv; b1[r] *= inv; }
      if (j >= 8) {
          float G[16], Lp[16];
#pragma unroll
          for (int i = 0; i < 4; ++i) { G[i] = (a0[4 * i] + a0[4 * i + 1]) + (a0[4 * i + 2] + a0[4 * i + 3]); G[4 + i] = (a1[4 * i] + a1[4 * i + 1]) + (a1[4 * i + 2] + a1[4 * i + 3]);
              G[8 + i] = (b0[4 * i] + b0[4 * i + 1]) + (b0[4 * i + 2] + b0[4 * i + 3]); G[12 + i] = (b1[4 * i] + b1[4 * i + 1]) + (b1[4 * i + 2] + b1[4 * i + 3]);
              Lp[i] = swap_half(a0[4 * i + 3], hi); Lp[4 + i] = swap_half(a1[4 * i + 3], hi); Lp[8 + i] = swap_half(b0[4 * i + 3], hi); Lp[12 + i] = swap_half(b1[4 * i + 3], hi); }
          LAS float* dst = PSL + (hh * 64 + qrel) * 33 + hi;
#pragma unroll
          for (int I = 0; I < 16; ++I) { const float prev = hi ? Lp[I] : (I > 0 ? Lp[I > 0 ? I - 1 : 0] : 0.f); dst[2 * I] = G[I] + prev; }
      }
      o[0] = f32x16{}; o[1] = f32x16{};
      pv(o, vlane + L_CMP + 16384, a0, a1); pv(o, vlane + L_CMP + 24576, b0, b1);
    }
    AT_BAR();
    if (j >= 8) { const int q = tid >> 3, sub = tid & 7;
        float v[4]; unsigned bits = 1u | (1u << j) | (1u << (j - 1));
#pragma unroll
        for (int c4 = 0; c4 < 4; ++c4) { const int k = 4 * sub + c4;
            const float ps = (PSL[(0 * 64 + q) * 33 + k] + PSL[(1 * 64 + q) * 33 + k]) + (PSL[(2 * 64 + q) * 33 + k] + PSL[(3 * 64 + q) * 33 + k]);
            v[c4] = (k > j - 2 || k == 0) ? -1e30f : ps; }
#pragma unroll 1
        for (int rnd = 0; rnd < 5; ++rnd) {
            float bv = v[0]; int bi = 4 * sub;
#pragma unroll
            for (int c4 = 1; c4 < 4; ++c4) if (v[c4] > bv) { bv = v[c4]; bi = 4 * sub + c4; }
#pragma unroll
            for (int o = 1; o < 8; o <<= 1) { const float ov = __shfl_xor(bv, o); const int oi = __shfl_xor(bi, o); if (ov > bv || (ov == bv && oi < bi)) { bv = ov; bi = oi; } }
            bits |= 1u << bi;
#pragma unroll
            for (int c4 = 0; c4 < 4; ++c4) if (bi == 4 * sub + c4) v[c4] = -3.0e38f; }
        if (sub == 0) SELM[q] = bits;
    } else { if (tid < 64) SELM[tid] = (2u << j) - 1u; }
    AT_BAR();
    const unsigned selm = SELM[qrel];
    row_bcast(g0, rs, wsf, r32, hi);
#pragma unroll
    for (int r = 0; r < 16; ++r) { park[r * 64] = o[0][r] * rs[r]; park[(16 + r) * 64] = o[1][r] * rs[r]; }
    f32x16 cinit; float l;
    AT_WAIT_BAR(2);
    load_kf<4>(kf, shm + L_K, r32, hi);
    int s0 = 0, s1 = 1, s2 = 2, m = 0;
#define NS_ROT() do { const int t_ = s0; s0 = s1; s1 = s2; s2 = t_; ++m; } while (0)
#define NS_HEAD() AT_WAIT_BAR(2); NS_DMA_K(m + 3, s0); NS_DMA_V(m + 2, s2); f32x16 p0, p1; qk_regs<4>(p0, p1, kf, qr, cinit); v_load(vf, vtb + s0 * VSLOT); __builtin_amdgcn_sched_barrier(0)
#define NS_MASK_SEL() do { const float keep_ = ((selm >> m) & 1u) ? 0.f : AT_NEG;        \
        _Pragma("unroll") for (int r = 0; r < 16; ++r) { p0[r] += keep_; p1[r] += keep_; } \
        if (m == j) {   \
        _Pragma("unroll") for (int r = 0; r < 16; ++r) { const int kk = (r & 3) + 8 * (r >> 2) + 4 * hi; if (kk > qrel) p0[r] = AT_NEG; if (kk + 32 > qrel) p1[r] = AT_NEG; } } } while (0)
#define NS_MASK_WIN() do { const int tt = j - (m - nsel); if (tt == j) { \
        _Pragma("unroll") for (int r = 0; r < 16; ++r) { const int kk = (r & 3) + 8 * (r >> 2) + 4 * hi; if (kk > qrel) p0[r] = AT_NEG; if (kk + 32 > qrel) p1[r] = AT_NEG; } } \
      else if (tt == j - 8) {   \
        _Pragma("unroll") for (int r = 0; r < 16; ++r) { const int kk = (r & 3) + 8 * (r >> 2) + 4 * hi; if (kk <= qrel) p0[r] = AT_NEG; if (kk + 32 <= qrel) p1[r] = AT_NEG; } } } while (0)
    cinit = f32x16{}; o[0] = f32x16{}; o[1] = f32x16{};
    { NS_HEAD(); NS_MASK_SEL(); softmax_first(p0, p1, cinit, l); pv_regs<4, true>(o, vf, p0, p1, kf, shm + L_K + s1 * KSLOT, r32, hi); NS_ROT(); }
    for (; m < nsel;) { NS_HEAD(); NS_MASK_SEL(); softmax_next(p0, p1, cinit, l, o, wsf, r32, hi); pv_regs<4, true>(o, vf, p0, p1, kf, shm + L_K + s1 * KSLOT, r32, hi); NS_ROT(); }
    l = sum_half(l); row_bcast(g1 / l, rs, wsf, r32, hi);
#pragma unroll
    for (int r = 0; r < 16; ++r) { park[r * 64] += o[0][r] * rs[r]; park[(16 + r) * 64] += o[1][r] * rs[r]; }
    cinit = f32x16{}; o[0] = f32x16{}; o[1] = f32x16{};
    { NS_HEAD(); NS_MASK_WIN(); softmax_first(p0, p1, cinit, l); pv_regs<4, true>(o, vf, p0, p1, kf, shm + L_K + s1 * KSLOT, r32, hi); NS_ROT(); }
    for (; m < NR;) { NS_HEAD(); NS_MASK_WIN(); softmax_next(p0, p1, cinit, l, o, wsf, r32, hi); pv_regs<4, true>(o, vf, p0, p1, kf, shm + L_K + s1 * KSLOT, r32, hi); NS_ROT(); }
#undef NS_HEAD
#undef NS_TILE
#undef NS_DMA_K
#undef NS_DMA_V
#undef NS_ROT
#undef NS_MASK_SEL
#undef NS_MASK_WIN
    l = sum_half(l); row_bcast(g2 / l, rs, wsf, r32, hi);
#pragma unroll
    for (int r = 0; r < 16; ++r) { o[0][r] = park[r * 64] + o[0][r] * rs[r]; o[1][r] = park[(16 + r) * 64] + o[1][r] * rs[r]; }
    asm volatile("s_waitcnt vmcnt(0) lgkmcnt(0)" ::: "memory");
    store_rows(o, shm + L_PARK + wid * 8192, wsp<bf16>(F, WS_ATT) + ((size_t)b * SEQ + 64 * j + 32 * (wid & 1)) * 1024 + head * 64, 1024, lane, r32, hi);
    AT_BAR();
}
constexpr int NUNITS = 4096;
__device__ const unsigned short BLK_TAB[64] = {64512, 63489, 62466, 61443, 60420, 59397, 58374, 57351, 56328, 55305, 54282, 53259, 52236, 51213, 50190, 49167, 48144, 47121, 46098, 45075, 44052, 43029, 42006, 40983, 39960, 38937, 37914, 36891, 35868, 2077, 2077, 2077, 2077, 3105, 3105, 3105, 3105, 4133, 4133, 4133, 4133, 5161, 5161, 5161, 5161, 6189, 6189, 6189, 6189, 7217, 7217, 7217, 7217, 34869, 1078, 1078, 1078, 1078, 33850, 32827, 60, 60, 60, 60};
}
__device__ __forceinline__ void p3_attention(Frame& F, const int MODE) {
    const int G = F.G, c = F.vcu, nrounds = (at::NUNITS + G - 1) / G;
    const gu32* KT0 = (const gu32*)wsp<unsigned>(F, WS_KT0);
#define P3_UNIT(i) ((i) * G + (((i) & 1) ? G - 1 - c : c))
#define P3_KT0_IDX(u) ({ const unsigned tb_ = at::BLK_TAB[(u) >> 6]; const int ix_ = (u) - (int)(tb_ & 1023u) * 64; (tb_ >> 15) ? 0 : ix_ * 8 + (int)((tb_ >> 10) & 31u); })
    unsigned kt_next = 0u;
    { const int u0 = P3_UNIT(0); if (u0 < at::NUNITS) kt_next = __hip_atomic_load(KT0 + P3_KT0_IDX(u0), RLX_AGENT); }
    for (int i = 0; i < nrounds; ++i) {
        const int u = P3_UNIT(i); if (u >= at::NUNITS) continue;
        const int kt0 = __builtin_amdgcn_readfirstlane((int)kt_next);
        { const int un = P3_UNIT(i + 1); if (i + 1 < nrounds && un < at::NUNITS) kt_next = __hip_atomic_load(KT0 + P3_KT0_IDX(un), RLX_AGENT); }
        const unsigned tab = at::BLK_TAB[u >> 6]; const int idx = u - (int)(tab & 1023u) * 64; const int par = (tab >> 10) & 31;
#ifndef PROBE_ABL
#define PROBE_ABL 0
#endif
        if (tab >> 15) { if (MODE != 1) at::nsa_unit(F, idx, par); } else { if (MODE != 2) at::fox_unit(F, idx, par, kt0, MODE == 1 ? PROBE_ABL : 0); }
    }
#undef P3_UNIT
#undef P3_KT0_IDX
    asm volatile("s_waitcnt vmcnt(0) lgkmcnt(0)" ::: "memory");
    __syncthreads();
}

struct Args { const float* in[18]; float* out; unsigned char* ws; int ph_lo, ph_hi, li, pad; };
__global__ void __launch_bounds__(NWAVES * 64, 2) fwd_kernel(Args args) {
    extern __shared__ __attribute__((aligned(16))) unsigned char lds[];
    Frame F;
    F.lds = (LAS unsigned char*)lds;
    F.MISC = (volatile LAS unsigned*)(F.lds + MISC_OFF);
    F.wave = __builtin_amdgcn_readfirstlane((int)threadIdx.x >> 6);
    F.G = gridDim.x; { const int bx = blockIdx.x; F.vcu = (F.G % 8 == 0) ? (bx % 8) * (F.G / 8) + bx / 8 : bx; }
    F.ws = args.ws; F.ctl = (gu32*)(args.ws + WS_CTL);
    F.x = args.in[0]; F.g_mix_pre = args.in[1]; F.g_mix_post = args.in[2]; F.g_mlp_pre = args.in[3]; F.g_mlp_post = args.in[4]; F.w_in = args.in[5]; F.b_forget = args.in[6];
    F.pos_k = args.in[7]; F.w1_k = args.in[8]; F.w2_k = args.in[9]; F.pos_v = args.in[10]; F.w1_v = args.in[11]; F.w2_v = args.in[12];
    F.w_fox = args.in[13]; F.w_nsa = args.in[14]; F.w_o = args.in[15]; F.w_up = args.in[16]; F.w_down = args.in[17]; F.out = args.out;
    for (int u = (int)threadIdx.x; u < (LDS_BYTES - LDSCTL_OFF) / 4; u += NWAVES * 64) ((LAS unsigned*)(F.lds + LDSCTL_OFF))[u] = 0u;
    __syncthreads();
    XcdBarrier bar; bar.bar = (unsigned*)(F.ctl + CW_BAR); bar.x = 0; bar.st = nullptr;
    if (N_LAUNCHES == 1) bar = xcd_barrier_post((unsigned*)(F.ctl + CW_BAR), F.MISC + 8);
#define GRID_BAR() do { if (N_LAUNCHES == 1) xcd_barrier(bar); } while (0)
    const int lo = args.ph_lo, hi = args.ph_hi;
#define IN(k) (lo <= (k) && (k) < hi)
#define BOTH(k) (IN(k) && IN((k) + 1))
#ifndef STAGGER_P7
#define STAGGER_P7 0
#endif
#ifndef STAGGER_P1
#define STAGGER_P1 0
#endif
#define XCD_STAGGER(ticks) do { if ((ticks) > 0) { const unsigned long long t0_ = rt(); const unsigned long long d_ = (unsigned long long)(xb_xcc_id() & 7u) * (unsigned)(ticks) / 8u; while (rt() - t0_ < d_) __builtin_amdgcn_s_sleep(8); } } while (0)
#ifndef PROBE_REPEAT
#define PROBE_REPEAT (-1)
#endif
#define REPS(k) for (int rep_ = 0; rep_ < ((PROBE_REPEAT == (k)) ? 2 : 1); ++rep_)
#define REP_BAR(k) do { if (PROBE_REPEAT == (k) && rep_ == 0) { VM_WAIT(); __syncthreads(); GRID_BAR(); } } while (0)

    if (IN(0)) { REPS(0) { p0_prologue(F); REP_BAR(0); } if (BOTH(0)) GRID_BAR(); }

    if (IN(1)) { XCD_STAGGER(STAGGER_P1);
        pg8::Gemm g{wsp<bf16>(F, WS_HB), wsp<bf16>(F, WS_WIN), MTOK, NPROJ, DMODEL}; pg8::StaticOrder S; S.init(MTOK, NPROJ, F.G, (int)blockIdx.x);
        pg8::EpiInProj E{wsp<bf16>(F, WS_FQ), wsp<bf16>(F, WS_NQ), wsp<bf16>(F, WS_KV), wsp<bf16>(F, WS_SGA),
                         wsp<float>(F, WS_LF), wsp<float>(F, WS_GATE), F.b_forget, wsp<float>(F, WS_ROPEC), wsp<float>(F, WS_ROPES), (WS_FK - WS_FQ) / 2, KV_STRIDE / 2, (WS_SGB - WS_SGA) / 2, QSCALE};
        REPS(1) { pg8::gemm_phase<pg8::EpiInProj, pg8::StaticOrder, true, true>(F.lds + RING_OFF, g, S, E, F.wave); REP_BAR(1); }
        if (BOTH(1)) GRID_BAR();
    }
    if (IN(2)) { REPS(2) { p2_phase(F); REP_BAR(2); } if (BOTH(2)) GRID_BAR(); }
#ifndef PROBE_P3_MODE
#define PROBE_P3_MODE 3
#endif
    if (IN(3)) {
#if PROBE_REPEAT == 3
        for (int rep_ = 0; rep_ < 2; ++rep_) { p3_attention(F, rep_ ? PROBE_P3_MODE : 0); if (rep_ == 0) { VM_WAIT(); __syncthreads(); GRID_BAR(); } }
#else
        p3_attention(F, 0);
#endif
        if (BOTH(3)) GRID_BAR(); }
    if (IN(4)) { REPS(4) {
        pg8::Gemm g{wsp<bf16>(F, WS_ATT), wsp<bf16>(F, WS_WF), MTOK, DMODEL, DMODEL}; pg8::StaticOrder S; S.init(MTOK, DMODEL, F.G, (int)blockIdx.x);
        pg8::EpiGateMid E{wsp<bf16>(F, WS_HB), wsp<bf16>(F, WS_SGA), wsp<bf16>(F, WS_SGB), DMODEL};
        pg8::gemm_phase<pg8::EpiGateMid, pg8::StaticOrder, true, true>(F.lds + RING_OFF, g, S, E, F.wave);
        REP_BAR(4); }
        if (BOTH(4)) GRID_BAR();
    }
    if (IN(5)) {
        pg8::Gemm g{wsp<bf16>(F, WS_HB), wsp<bf16>(F, WS_WO), MTOK, DMODEL, DMODEL}; pg8::StaticOrder S; S.init(MTOK, DMODEL, F.G, (int)blockIdx.x);
        pg8::EpiPlain<0> E{wsp<bf16>(F, WS_Y), DMODEL};
        REPS(5) { pg8::gemm_phase<pg8::EpiPlain<0>, pg8::StaticOrder, true, true>(F.lds + RING_OFF, g, S, E, F.wave); REP_BAR(5); }
        if (BOTH(5)) GRID_BAR();
    }
    if (IN(6)) { REPS(6) { row_pass<false>(F, F.x, nullptr, wsp<bf16>(F, WS_Y), F.g_mix_post, nullptr, wsp<bf16>(F, WS_HB), wsp<float>(F, WS_RSTD2)); REP_BAR(6); } if (BOTH(6)) GRID_BAR(); }
#ifndef MLP_CHUNKS
#define MLP_CHUNKS 1
#endif
    if (IN(7) || IN(8)) {
        constexpr int CH = MLP_CHUNKS, MC = MTOK / CH;
#pragma unroll
        for (int ch = 0; ch < CH; ++ch) {
            if (IN(7)) { XCD_STAGGER(STAGGER_P7);
                pg8::Gemm g{wsp<bf16>(F, WS_HB) + (size_t)ch * MC * DMODEL, wsp<bf16>(F, WS_WUP), MC, DFF, DMODEL}; pg8::StaticOrder S; S.init(MC, DFF, F.G, (int)blockIdx.x);
                pg8::EpiRelu2Rs E{wsp<bf16>(F, WS_U) + (size_t)ch * MC * DFF, wsp<float>(F, WS_RSTD2) + (size_t)ch * MC, DFF};
                pg8::gemm_phase<pg8::EpiRelu2Rs, pg8::StaticOrder, true, true>(F.lds + RING_OFF, g, S, E, F.wave);
                if (IN(8)) GRID_BAR(); }
            if (IN(8)) {
                pg8::Gemm g{wsp<bf16>(F, WS_U) + (size_t)ch * MC * DFF, wsp<bf16>(F, WS_WDN), MC, DMODEL, DFF}; pg8::StaticOrder S; S.init(MC, DMODEL, F.G, (int)blockIdx.x);
                pg8::EpiPlain<0> E{wsp<bf16>(F, WS_Y) + (size_t)ch * MC * DMODEL, DMODEL};
                pg8::gemm_phase<pg8::EpiPlain<0>, pg8::StaticOrder, true, true>(F.lds + RING_OFF, g, S, E, F.wave);
                if (ch + 1 == CH && BOTH(8)) GRID_BAR(); }
        }
    }
    if (IN(9)) { row_pass<true>(F, nullptr, wsp<bf16>(F, WS_HB), wsp<bf16>(F, WS_Y), F.g_mlp_post, F.out, nullptr, nullptr); }
#undef IN
#undef BOTH
#undef GRID_BAR
}

extern "C" void kernel_launch(void* const* d_in, const int* in_sizes, int n_in, void* d_out, int out_size, void* d_ws, size_t ws_size, hipStream_t stream) {
    static int grid = 0;
    if (grid == 0) {
        if (n_in != 18 || in_sizes[0] != MTOK * DMODEL || out_size != MTOK * DMODEL || ws_size < WS_END) {
            fprintf(stderr, "kernel_launch: built for 18 inputs, x/out of %d floats, >= %zu bytes of workspace; got n_in %d, in0 %d, out %d, ws %zu; nothing launched\n", MTOK * DMODEL, (size_t)WS_END, n_in, n_in > 0 ? in_sizes[0] : -1, out_size, ws_size); grid = -1; return; }
        int dev = 0, cus = 0, per_cu = 0;
        if (hipGetDevice(&dev) != hipSuccess || hipDeviceGetAttribute(&cus, hipDeviceAttributeMultiprocessorCount, dev) != hipSuccess) { fprintf(stderr, "kernel_launch: device query failed\n"); grid = -1; return; }
        if (hipFuncSetAttribute((const void*)fwd_kernel, hipFuncAttributeMaxDynamicSharedMemorySize, LDS_BYTES) != hipSuccess) { fprintf(stderr, "kernel_launch: hipFuncSetAttribute failed\n"); grid = -1; return; }
        if (hipOccupancyMaxActiveBlocksPerMultiprocessor(&per_cu, (const void*)fwd_kernel, NWAVES * 64, LDS_BYTES) != hipSuccess || per_cu < 1)
            fprintf(stderr, "kernel_launch: note: occupancy query reports %d workgroups per CU\n", per_cu);
        (void)hipGetLastError();
        grid = 256;
        if (cus < grid) fprintf(stderr, "kernel_launch: this device reports %d CUs; the 256-workgroup grid cannot be resident: the grid barrier will time out (bounded) and the output will be wrong\n", cus);
    }
    if (grid < 0) return;
    if (hipMemsetAsync((char*)d_ws + WS_CTL, 0, CTL_ZERO_BYTES, stream) != hipSuccess) { fprintf(stderr, "kernel_launch: hipMemsetAsync failed\n"); return; }
    Args a{};
    for (int i = 0; i < 18; ++i) a.in[i] = (const float*)d_in[i];
    a.out = (float*)d_out; a.ws = (unsigned char*)d_ws;
    for (int li = 0; li < N_LAUNCHES; ++li) {
        a.ph_lo = (N_LAUNCHES == 1) ? 0 : li; a.ph_hi = (N_LAUNCHES == 1) ? N_PHASES : li + 1; a.li = li; a.pad = 0;
        hipLaunchKernelGGL(fwd_kernel, dim3(grid), dim3(NWAVES * 64), LDS_BYTES, stream, a);
        const hipError_t le = hipPeekAtLastError();
        if (le != hipSuccess) { fprintf(stderr, "kernel_launch: launch %d failed: %s\n", li, hipGetErrorName(le)); break; }
    }
}
```

```cpp
#include <hip/hip_runtime.h>
#include <cstdio>
#include <cstdint>
#include <cmath>
namespace pg8 {
#define PG8_LAS __attribute__((address_space(3)))
typedef unsigned short bf16_t;
typedef short bf16x8 __attribute__((ext_vector_type(8)));
typedef float f32x4 __attribute__((ext_vector_type(4)));
typedef unsigned u32x4 __attribute__((ext_vector_type(4)));
constexpr int BM = 256, BK = 64, HALF = 128, HTB = HALF * BK * 2  , STAGE_BYTES = 8 * HTB, NXCD = 8, WGM = 8;

__host__ __device__ __forceinline__ int lds_byte(int r, int c) { const int st = (r >> 4) * 2 + (c >> 5), rr = r & 15, cc = c & 31, ob = rr * 64 + cc * 2; return st * 1024 + (ob ^ (((ob >> 9) & 1) << 5)); }
__host__ __device__ __forceinline__ void stage_rc(int b, int& R, int& C) { const int st = b / 1024, sb = b % 1024, swz = sb ^ (((sb >> 9) & 1) << 5); R = (st >> 1) * 16 + swz / 64; C = (st & 1) * 32 + (swz % 64) / 2; }
__host__ __device__ __forceinline__ int perm32(int rho) { const int n = rho >> 4, i = rho & 15; return 8 * (i >> 2) + 4 * n + (i & 3); }

struct Unit { int pm, pn; };
struct Gemm { const bf16_t* A; const bf16_t* Bt; int M, N, K; };

struct StaticOrder {
    int nM, nN, nwg, G, c;
    __host__ __device__ void init(int M, int N, int G_, int c_) { nM = M / BM; nN = N / BM; nwg = nM * nN; G = G_; c = c_; }
    __host__ __device__ bool next(int i, Unit& u) const {
        const long L = (long)i * G + c; if (L >= nwg) return false;
        int wgid = (int)L; { const int q = nwg / NXCD, r = nwg % NXCD, xcd = wgid % NXCD, off = wgid / NXCD; wgid = (xcd < r ? xcd * (q + 1) : r * (q + 1) + (xcd - r) * q) + off; }
        const int nig = WGM * nN, gid = wgid / nig, fm = gid * WGM, gsz = (nM - fm) < WGM ? (nM - fm) : WGM;
        u.pm = fm + ((wgid % nig) % gsz); u.pn = (wgid % nig) / gsz; return true;
    }
    __device__ __forceinline__ void a_ready(const Unit&) const {}
    __device__ __forceinline__ void done(const Unit&) const {}
};

__device__ __forceinline__ unsigned cvt_pk_bf16(float lo, float hi) { unsigned r; asm volatile("v_cvt_pk_bf16_f32 %0, %1, %2" : "=v"(r) : "v"(lo), "v"(hi)); return r; }
typedef float f32x2 __attribute__((ext_vector_type(2)));
__device__ __forceinline__ float bf_lo(unsigned w) { return __uint_as_float(w << 16); }
__device__ __forceinline__ float bf_hi(unsigned w) { return __uint_as_float(w & 0xffff0000u); }
__device__ __forceinline__ float sigmoid_f(float x) { return __builtin_amdgcn_rcpf(1.0f + __expf(-x)); }
typedef unsigned u32x2 __attribute__((ext_vector_type(2)));
__device__ __forceinline__ u32x4 pack8(const f32x4& a, const f32x4& b) { u32x4 w; w.x = cvt_pk_bf16(a[0], a[1]); w.y = cvt_pk_bf16(a[2], a[3]); w.z = cvt_pk_bf16(b[0], b[1]); w.w = cvt_pk_bf16(b[2], b[3]); return w; }
__device__ __forceinline__ u32x2 pack4(const f32x4& a) { u32x2 w; w.x = cvt_pk_bf16(a[0], a[1]); w.y = cvt_pk_bf16(a[2], a[3]); return w; }

struct EpiInProj {
    static constexpr bool PERM = true, AFTER_DRAIN = false, MIDK = false;
    bf16_t *QKV, *NQ, *KVB, *SG;
    float *LF, *GATE; const float* bforget; const float *ROPEC, *ROPES; size_t qkvs, kvs, sgs; float qscale;
    __device__ __forceinline__ void operator()(const f32x4 (&acc)[2][2][4][2], const Unit& u, int wr, int wc, int fr, int fq) const {
        const int pn = u.pn; const bool roped = pn >= 6 && pn < 11; const int i4 = (4 * (wc & 1) + fq) * 4;
#pragma unroll
        for (int ai = 0; ai < 2; ++ai) {
#pragma unroll
          for (int mp = 0; mp < 2; ++mp) {
            f32x4 csv[8];
            if (roped) {
#pragma unroll
                for (int mm = 0; mm < 2; ++mm) { const int t_ = (u.pm * BM + ai * HALF + wr * 64 + (2 * mp + mm) * 16 + fr) & 2047; csv[mm] = *(const f32x4*)(ROPEC + t_ * 32 + i4); csv[4 + mm] = *(const f32x4*)(ROPES + t_ * 32 + i4); }
                asm volatile("" : "+v"(csv[0]), "+v"(csv[1]), "+v"(csv[4]), "+v"(csv[5])); }
#pragma unroll
            for (int mm = 0; mm < 2; ++mm) { const int m = 2 * mp + mm;
                const int row = u.pm * BM + ai * HALF + wr * 64 + m * 16 + fr; const int t = row & 2047, b = row >> 11; (void)t;
#pragma unroll
                for (int bj = 0; bj < 2; ++bj) {
                    const int tc = bj * HALF + wc * 32 + 8 * fq;
                    f32x4 v0 = acc[ai][bj][m][0], v1 = acc[ai][bj][m][1];
                    if (pn < 6) {
                        bf16_t* base = QKV + (size_t)(pn >> 1) * qkvs; const float sc = pn < 2 ? qscale : 1.0f;
                        *(u32x4*)(base + (size_t)row * 512 + (pn & 1) * 256 + tc) = pack8(v0 * sc, v1 * sc);
                    } else if (pn < 8) {
                        const int head = (pn - 6) * 4 + (tc >> 6);
                        const f32x4 cs = csv[mm], sn = csv[4 + mm];
                        const f32x4 lo = (v0 * cs - v1 * sn) * qscale, hi = (v1 * cs + v0 * sn) * qscale;
                        bf16_t* d = NQ + (size_t)row * 512 + head * 64 + i4;
                        *(u32x2*)d = pack4(lo); *(u32x2*)(d + 32) = pack4(hi);
                    } else if (pn < 11) {
                        const int sel = pn - 8;
                        if (bj == 0) {
                            const int g = tc >> 6;
                            const f32x4 cs = csv[mm], sn = csv[4 + mm];
                            const f32x4 lo = v0 * cs - v1 * sn, hi = v1 * cs + v0 * sn;
                            bf16_t* d = KVB + (size_t)(2 * sel) * kvs + ((size_t)((b * 2 + g) * 2048 + t)) * 64 + i4;
                            *(u32x2*)d = pack4(lo); *(u32x2*)(d + 32) = pack4(hi);
                        } else {
                            const int tv = tc - HALF, g = tv >> 6, dd = tv & 63;
                            bf16_t* d = KVB + (size_t)(2 * sel + 1) * kvs + ((size_t)((b * 2 + g) * 2048 + t)) * 64 + dd;
                            *(u32x4*)d = pack8(v0, v1);
                        }
                    } else if (pn < 19) {
                        if (bj == 0) { const int ct = (pn - 11) * 128 + wc * 32 + 8 * fq; const f32x4 w0 = acc[ai][1][m][0], w1 = acc[ai][1][m][1];
                            f32x4 a, c, ra, rc;
#pragma unroll
                            for (int k = 0; k < 4; ++k) { const float ea = __expf(-v0[k]), ec = __expf(-v1[k]), fa = __expf(-w0[k]), fc = __expf(-w1[k]);
                                a[k] = __builtin_amdgcn_rcpf(1.0f + ea); c[k] = __builtin_amdgcn_rcpf(1.0f + ec); ra[k] = (1.0f + ea) * __builtin_amdgcn_rcpf(1.0f + fa); rc[k] = (1.0f + ec) * __builtin_amdgcn_rcpf(1.0f + fc); }
                            __builtin_nontemporal_store(pack8(a, c), (u32x4*)(SG + (size_t)row * 1024 + ct)); __builtin_nontemporal_store(pack8(ra, rc), (u32x4*)(SG + sgs + (size_t)row * 1024 + ct)); }
                    } else {
                        if (bj == 0 && wc == 0) {
                            if (fq == 0) {
                                f32x4 a, c;
#pragma unroll
                                for (int k = 0; k < 4; ++k) { const float x0 = v0[k] + bforget[k], x1 = v1[k] + bforget[4 + k];
                                    a[k] = fminf(x0, 0.f) - log1pf(__expf(-fabsf(x0))); c[k] = fminf(x1, 0.f) - log1pf(__expf(-fabsf(x1))); }
                                *(f32x4*)(LF + (size_t)row * 8) = a; *(f32x4*)(LF + (size_t)row * 8 + 4) = c;
                            } else {
                                f32x4 a, c;
#pragma unroll
                                for (int k = 0; k < 4; ++k) { a[k] = sigmoid_f(v0[k]); c[k] = sigmoid_f(v1[k]); }
                                *(f32x4*)(GATE + (size_t)row * 24 + 8 * (fq - 1)) = a; *(f32x4*)(GATE + (size_t)row * 24 + 8 * (fq - 1) + 4) = c;
                            }
                        }
                    }
                }
            }
          }
        }
    }
};
#define PIN8(a) asm volatile("" : "+v"(a[0]), "+v"(a[1]), "+v"(a[2]), "+v"(a[3]), "+v"(a[4]), "+v"(a[5]), "+v"(a[6]), "+v"(a[7]))
struct EpiGate {
    static constexpr bool PERM = true, AFTER_DRAIN = false, MIDK = false;
    bf16_t* O; const bf16_t* gate; const bf16_t* addend; int ldc;
    __device__ __forceinline__ void operator()(const f32x4 (&acc)[2][2][4][2], const Unit& u, int wr, int wc, int fr, int fq) const {
#pragma unroll
        for (int ai = 0; ai < 2; ++ai) {
            const size_t base = (size_t)(u.pm * BM + ai * HALF + wr * 64 + fr) * ldc + u.pn * BM + wc * 32 + 8 * fq;
            u32x4 gw[8], aw[8];
#pragma unroll
            for (int k = 0; k < 8; ++k) gw[k] = *(const u32x4*)(gate + base + (size_t)((k >> 1) * 16) * ldc + (k & 1) * HALF);
            PIN8(gw);
            if (addend) {
#pragma unroll
                for (int k = 0; k < 8; ++k) aw[k] = *(const u32x4*)(addend + base + (size_t)((k >> 1) * 16) * ldc + (k & 1) * HALF);
                PIN8(aw); }
#pragma unroll
            for (int k = 0; k < 8; ++k) { const int m = k >> 1, bj = k & 1; const u32x4 g = gw[k];
                f32x4 v0 = acc[ai][bj][m][0], v1 = acc[ai][bj][m][1];
                v0[0] *= bf_lo(g.x); v0[1] *= bf_hi(g.x); v0[2] *= bf_lo(g.y); v0[3] *= bf_hi(g.y);
                v1[0] *= bf_lo(g.z); v1[1] *= bf_hi(g.z); v1[2] *= bf_lo(g.w); v1[3] *= bf_hi(g.w);
                if (addend) { const u32x4 a = aw[k];
                    v0[0] += bf_lo(a.x); v0[1] += bf_hi(a.x); v0[2] += bf_lo(a.y); v0[3] += bf_hi(a.y);
                    v1[0] += bf_lo(a.z); v1[1] += bf_hi(a.z); v1[2] += bf_lo(a.w); v1[3] += bf_hi(a.w); }
                *(u32x4*)(O + base + (size_t)(m * 16) * ldc + bj * HALF) = pack8(v0, v1); }
        }
    }
};
struct EpiGateMid {
    static constexpr bool PERM = true, AFTER_DRAIN = false, MIDK = true;
    bf16_t* O; const bf16_t* sga; const bf16_t* rr; int ldc;
    __device__ __forceinline__ void scale(f32x4 (&acc)[2][2][4][2], const bf16_t* g, const Unit& u, int wr, int wc, int fr, int fq, bf16_t* out) const {
#pragma unroll
        for (int ai = 0; ai < 2; ++ai) {
            const size_t base = (size_t)(u.pm * BM + ai * HALF + wr * 64 + fr) * ldc + u.pn * BM + wc * 32 + 8 * fq;
            u32x4 gw[8];
#pragma unroll
            for (int k = 0; k < 8; ++k) gw[k] = *(const u32x4*)(g + base + (size_t)((k >> 1) * 16) * ldc + (k & 1) * HALF);
            PIN8(gw);
#pragma unroll
            for (int k = 0; k < 8; ++k) { const int m = k >> 1, bj = k & 1; const u32x4 w = gw[k];
                f32x4& v0 = acc[ai][bj][m][0]; f32x4& v1 = acc[ai][bj][m][1];
                v0[0] *= bf_lo(w.x); v0[1] *= bf_hi(w.x); v0[2] *= bf_lo(w.y); v0[3] *= bf_hi(w.y);
                v1[0] *= bf_lo(w.z); v1[1] *= bf_hi(w.z); v1[2] *= bf_lo(w.w); v1[3] *= bf_hi(w.w);
                if (out) *(u32x4*)(out + base + (size_t)(m * 16) * ldc + bj * HALF) = pack8(v0, v1); }
        }
    }
    __device__ __forceinline__ void mid(f32x4 (&acc)[2][2][4][2], const Unit& u, int wr, int wc, int fr, int fq) const { int fr_ = fr; asm volatile("" : "+v"(fr_));
        scale(acc, rr, u, wr, wc, fr_, fq, nullptr); }
    __device__ __forceinline__ void operator()(const f32x4 (&acc)[2][2][4][2], const Unit& u, int wr, int wc, int fr, int fq) const {
#pragma unroll
        for (int ai = 0; ai < 2; ++ai) {
            const size_t base = (size_t)(u.pm * BM + ai * HALF + wr * 64 + fr) * ldc + u.pn * BM + wc * 32 + 8 * fq;
            u32x4 gw[8];
#pragma unroll
            for (int k = 0; k < 8; ++k) gw[k] = *(const u32x4*)(sga + base + (size_t)((k >> 1) * 16) * ldc + (k & 1) * HALF);
            PIN8(gw);
#pragma unroll
            for (int k = 0; k < 8; ++k) { const int m = k >> 1, bj = k & 1; const u32x4 w = gw[k];
                f32x4 v0 = acc[ai][bj][m][0], v1 = acc[ai][bj][m][1];
                v0[0] *= bf_lo(w.x); v0[1] *= bf_hi(w.x); v0[2] *= bf_lo(w.y); v0[3] *= bf_hi(w.y);
                v1[0] *= bf_lo(w.z); v1[1] *= bf_hi(w.z); v1[2] *= bf_lo(w.w); v1[3] *= bf_hi(w.w);
                *(u32x4*)(O + base + (size_t)(m * 16) * ldc + bj * HALF) = pack8(v0, v1); }
        }
    }
};
template <int ACT> struct EpiPlain {
    static constexpr bool PERM = true, AFTER_DRAIN = false, MIDK = false;
    bf16_t* O; int ldc;
    __device__ __forceinline__ void operator()(const f32x4 (&acc)[2][2][4][2], const Unit& u, int wr, int wc, int fr, int fq) const {
#pragma unroll
        for (int ai = 0; ai < 2; ++ai)
#pragma unroll
            for (int m = 0; m < 4; ++m) {
                const size_t rowo = (size_t)(u.pm * BM + ai * HALF + wr * 64 + m * 16 + fr) * ldc + u.pn * BM + wc * 32 + 8 * fq;
#pragma unroll
                for (int bj = 0; bj < 2; ++bj) {
                    f32x4 v0 = acc[ai][bj][m][0], v1 = acc[ai][bj][m][1];
                    if (ACT == 1) {
#pragma unroll
                        for (int k = 0; k < 4; ++k) { const float a = fmaxf(v0[k], 0.f), c = fmaxf(v1[k], 0.f); v0[k] = a * a; v1[k] = c * c; }
                    }
                    *(u32x4*)(O + rowo + bj * HALF) = pack8(v0, v1);
                }
            }
    }
};

struct EpiRelu2Rs {
    static constexpr bool PERM = true, AFTER_DRAIN = false, MIDK = false;
    bf16_t* O; const float* rs; int ldc;
    __device__ __forceinline__ void operator()(const f32x4 (&acc)[2][2][4][2], const Unit& u, int wr, int wc, int fr, int fq) const {
        float rv[8];
#pragma unroll
        for (int k = 0; k < 8; ++k) rv[k] = rs[u.pm * BM + (k >> 2) * HALF + wr * 64 + (k & 3) * 16 + fr];
        PIN8(rv);
#pragma unroll
        for (int ai = 0; ai < 2; ++ai)
#pragma unroll
            for (int m = 0; m < 4; ++m) { const float r = rv[ai * 4 + m];
                const size_t rowo = (size_t)(u.pm * BM + ai * HALF + wr * 64 + m * 16 + fr) * ldc + u.pn * BM + wc * 32 + 8 * fq;
#pragma unroll
                for (int bj = 0; bj < 2; ++bj) { f32x4 v0 = acc[ai][bj][m][0], v1 = acc[ai][bj][m][1];
#pragma unroll
                    for (int k = 0; k < 4; ++k) { const float a = fmaxf(v0[k] * r, 0.f), c = fmaxf(v1[k] * r, 0.f); v0[k] = a * a; v1[k] = c * c; }
                    __builtin_nontemporal_store(pack8(v0, v1), (u32x4*)(O + rowo + bj * HALF)); } }
    }
};
template <class Epi, class Sched, bool ALIGN_EPI = false, bool SP2 = false>
__device__ __forceinline__ void gemm_phase(PG8_LAS unsigned char* lds, const Gemm g, const Sched& S, const Epi& E, const int wave_id  ) {
    int tid_ = wave_id * 64 + (int)__builtin_amdgcn_mbcnt_hi(~0u, __builtin_amdgcn_mbcnt_lo(~0u, 0u)); asm volatile("" : "+v"(tid_));
    const int tid = tid_, wid = __builtin_amdgcn_readfirstlane(tid >> 6), lane = tid & 63, wr = wid >> 2, wc = wid & 3, fr = lane & 15, fq = lane >> 4;
    const int K = g.K, nt = K / BK;
    unsigned voffA[2], voffB[2];
#pragma unroll
    for (int i = 0; i < 2; ++i) { int R, C; stage_rc(tid * 16 + i * 8192, R, C); const int Rb = Epi::PERM ? ((R & ~31) + perm32(R & 31)) : R;
        voffA[i] = (unsigned)(R * K + C) * 2u; voffB[i] = (unsigned)(Rb * K + C) * 2u; }
    const size_t kstep = (size_t)(BK * 2);
    const size_t hstep = (size_t)HALF * K * 2;
    const size_t tstep = 2 * hstep;
    const unsigned ldsw = (unsigned)wid * 1024u;
    const int aoff = lds_byte(wr * 64 + fr, fq * 8), boff = lds_byte(wc * 32 + fr, fq * 8);
#define PG8_SA(b, h) (((b) * 2 + (h)) * HTB)
#define PG8_SB(b, h) ((4 + (b) * 2 + (h)) * HTB)
#define PG8_STAGE(bufoff, gbase, voff) do { _Pragma("unroll") for (int _i = 0; _i < 2; ++_i) \
        __builtin_amdgcn_global_load_lds((const unsigned*)((const char*)(gbase) + (voff)[_i]), (PG8_LAS unsigned*)(lds + (bufoff) + ldsw + _i * 8192), 16, 0, 0); } while (0)
#define PG8_LDA(dst, b, h) do { _Pragma("unroll") for (int m = 0; m < 4; ++m) _Pragma("unroll") for (int k = 0; k < 2; ++k) dst[m][k] = *(const PG8_LAS bf16x8*)(lds + PG8_SA(b, h) + aoff + m * 2048 + k * 1024); } while (0)
#define PG8_LDB(dst, b, h) do { _Pragma("unroll") for (int n = 0; n < 2; ++n) _Pragma("unroll") for (int k = 0; k < 2; ++k) dst[n][k] = *(const PG8_LAS bf16x8*)(lds + PG8_SB(b, h) + boff + n * 2048 + k * 1024); } while (0)
#define PG8_MMA(ai, bj, At, Bt) do { __builtin_amdgcn_s_setprio(1); _Pragma("unroll") for (int m = 0; m < 4; ++m) _Pragma("unroll") for (int n = 0; n < 2; ++n) _Pragma("unroll") for (int k = 0; k < 2; ++k) \
        acc[ai][bj][m][n] = __builtin_amdgcn_mfma_f32_16x16x32_bf16(Bt[n][k], At[m][k], acc[ai][bj][m][n], 0, 0, 0); __builtin_amdgcn_s_setprio(0); } while (0)
#define PG8_WAIT_V(n) asm volatile("s_waitcnt vmcnt(" #n ")" ::: "memory")
#define PG8_WAIT_L(n) asm volatile("s_waitcnt lgkmcnt(" #n ")" ::: "memory")
#define PG8_BAR __builtin_amdgcn_s_barrier()
#define PG8_SCHED __builtin_amdgcn_sched_barrier(0)
    Unit cur, nxt; int ui = 0;
    if (!S.next(0, cur)) return;
    f32x4 acc[2][2][4][2];
#pragma unroll
    for (int a = 0; a < 2; ++a)
#pragma unroll
        for (int b = 0; b < 2; ++b)
#pragma unroll
            for (int m = 0; m < 4; ++m)
#pragma unroll
                for (int n = 0; n < 2; ++n) acc[a][b][m][n] = (f32x4){0.f, 0.f, 0.f, 0.f};
    bf16x8 At[4][2], B0[2][2], B1[2][2];
    const char* cA = (const char*)g.A + (size_t)cur.pm * tstep; const char* cB = (const char*)g.Bt + (size_t)cur.pn * tstep;
    S.a_ready(cur);
    if constexpr (SP2) {
        PG8_STAGE(PG8_SB(0, 0), cB, voffB); PG8_STAGE(PG8_SB(0, 1), cB + hstep, voffB); PG8_STAGE(PG8_SA(0, 0), cA, voffA); PG8_STAGE(PG8_SA(0, 1), cA + hstep, voffA);
        if (wr == 1) PG8_BAR;
        PG8_WAIT_V(2); PG8_BAR;
        PG8_STAGE(PG8_SB(1, 0), cB + kstep, voffB); PG8_STAGE(PG8_SA(1, 0), cA + kstep, voffA); PG8_STAGE(PG8_SB(1, 1), cB + hstep + kstep, voffB);
        PG8_WAIT_V(6); PG8_BAR;
    } else {
        PG8_STAGE(PG8_SB(0, 0), cB, voffB); PG8_STAGE(PG8_SA(0, 0), cA, voffA); PG8_STAGE(PG8_SB(0, 1), cB + hstep, voffB); PG8_STAGE(PG8_SA(0, 1), cA + hstep, voffA);
        if (wr == 1) PG8_BAR;
        PG8_WAIT_V(4); PG8_BAR;
        PG8_STAGE(PG8_SB(1, 0), cB + kstep, voffB); PG8_STAGE(PG8_SA(1, 0), cA + kstep, voffA); PG8_STAGE(PG8_SB(1, 1), cB + hstep + kstep, voffB);
        PG8_WAIT_V(6); PG8_BAR;
    }
    for (;;) {
        const bool has_next = S.next(ui + 1, nxt);
        const char* nA = has_next ? (const char*)g.A + (size_t)nxt.pm * tstep : cA; const char* nB = has_next ? (const char*)g.Bt + (size_t)nxt.pn * tstep : cB;
        for (int t = 0; t < nt; t += 2) {
            if constexpr (Epi::MIDK) { if (t == nt / 2) E.mid(acc, cur, wr, wc, fr, fq); }
            const bool last = (t == nt - 2);
            const char* a1 = cA + (size_t)(t + 1) * kstep;
            const char* a2 = last ? nA : cA + (size_t)(t + 2) * kstep; const char* b2 = last ? nB : cB + (size_t)(t + 2) * kstep;
            const char* a3 = a2 + kstep; const char* b3 = b2 + kstep;
            if (last && has_next) S.a_ready(nxt);
            if constexpr (SP2) {
            PG8_LDB(B0, 0, 0); PG8_LDB(B1, 0, 1); PG8_SCHED; PG8_LDA(At, 0, 0); PG8_STAGE(PG8_SA(1, 1), a1 + hstep, voffA);
            PG8_WAIT_V(8); PG8_WAIT_L(0); PG8_BAR; PG8_MMA(0, 0, At, B0); PG8_MMA(0, 1, At, B1); PG8_BAR; PG8_SCHED;
            PG8_LDA(At, 0, 1); PG8_STAGE(PG8_SB(0, 0), b2, voffB); PG8_STAGE(PG8_SB(0, 1), b2 + hstep, voffB); PG8_STAGE(PG8_SA(0, 0), a2, voffA);
            PG8_WAIT_V(8); PG8_WAIT_L(0); PG8_BAR; PG8_MMA(1, 0, At, B0); PG8_MMA(1, 1, At, B1); PG8_BAR; PG8_SCHED;
            PG8_LDB(B0, 1, 0); PG8_LDB(B1, 1, 1); PG8_SCHED; PG8_LDA(At, 1, 0); PG8_STAGE(PG8_SA(0, 1), a2 + hstep, voffA);
            PG8_WAIT_V(8); PG8_WAIT_L(0); PG8_BAR; PG8_MMA(0, 0, At, B0); PG8_MMA(0, 1, At, B1); PG8_BAR; PG8_SCHED;
            PG8_LDA(At, 1, 1); PG8_STAGE(PG8_SB(1, 0), b3, voffB); PG8_STAGE(PG8_SB(1, 1), b3 + hstep, voffB); PG8_STAGE(PG8_SA(1, 0), a3, voffA);
            PG8_WAIT_V(8); PG8_WAIT_L(0); PG8_BAR; PG8_MMA(1, 0, At, B0); PG8_MMA(1, 1, At, B1); PG8_BAR; PG8_SCHED;
            } else {
            PG8_LDB(B0, 0, 0); PG8_SCHED; PG8_LDA(At, 0, 0); PG8_STAGE(PG8_SA(1, 1), a1 + hstep, voffA);
            PG8_WAIT_L(8); PG8_BAR; PG8_WAIT_L(0); PG8_MMA(0, 0, At, B0); PG8_BAR; PG8_SCHED;
            PG8_LDB(B1, 0, 1); PG8_STAGE(PG8_SB(0, 0), b2, voffB);
            PG8_BAR; PG8_WAIT_L(0); PG8_MMA(0, 1, At, B1); PG8_BAR;
            PG8_LDA(At, 0, 1); PG8_STAGE(PG8_SA(0, 0), a2, voffA);
            PG8_BAR; PG8_WAIT_L(0); PG8_MMA(1, 0, At, B0); PG8_BAR; PG8_SCHED;
            PG8_STAGE(PG8_SB(0, 1), b2 + hstep, voffB);
            PG8_WAIT_V(6); PG8_BAR; PG8_MMA(1, 1, At, B1); PG8_BAR;
            PG8_LDB(B0, 1, 0); PG8_SCHED; PG8_LDA(At, 1, 0); PG8_STAGE(PG8_SA(0, 1), a2 + hstep, voffA);
            PG8_WAIT_L(8); PG8_BAR; PG8_WAIT_L(0); PG8_MMA(0, 0, At, B0); PG8_BAR; PG8_SCHED;
            PG8_LDB(B1, 1, 1); PG8_STAGE(PG8_SB(1, 0), b3, voffB);
            PG8_BAR; PG8_WAIT_L(0); PG8_MMA(0, 1, At, B1); PG8_BAR;
            PG8_LDA(At, 1, 1); PG8_STAGE(PG8_SA(1, 0), a3, voffA);
            PG8_BAR; PG8_WAIT_L(0); PG8_MMA(1, 0, At, B0); PG8_BAR; PG8_SCHED;
            PG8_STAGE(PG8_SB(1, 1), b3 + hstep, voffB);
            PG8_WAIT_V(6); PG8_BAR; PG8_MMA(1, 1, At, B1); PG8_BAR;
            }
        }
        if constexpr (ALIGN_EPI) { if (wr == 0) PG8_BAR; }
        if constexpr (!Epi::AFTER_DRAIN) { E(acc, cur, wr, wc, fr, fq); S.done(cur); }
        if (!has_next) break;
#pragma unroll
        for (int a = 0; a < 2; ++a)
#pragma unroll
            for (int b = 0; b < 2; ++b)
#pragma unroll
                for (int m = 0; m < 4; ++m)
#pragma unroll
                    for (int n = 0; n < 2; ++n) acc[a][b][m][n] = (f32x4){0.f, 0.f, 0.f, 0.f};
        cur = nxt; cA = nA; cB = nB; ++ui;
        if constexpr (ALIGN_EPI) { if (wr == 1) PG8_BAR; }
    }
    PG8_WAIT_V(0);
    if constexpr (!ALIGN_EPI) { if (wr == 0) PG8_BAR; }
    PG8_BAR;
    if constexpr (Epi::AFTER_DRAIN) { E.fused(acc, cur, wr, wc, fr, fq, lds, wid, lane); S.done(cur); }
#undef PG8_SA
#undef PG8_SB
#undef PG8_STAGE
#undef PG8_LDA
#undef PG8_LDB
#undef PG8_MMA
#undef PG8_WAIT_V
#undef PG8_WAIT_L
#undef PG8_BAR
#undef PG8_SCHED
}
}
#define GAS __attribute__((address_space(1)))
#define LAS __attribute__((address_space(3)))
typedef unsigned short bf16;
typedef unsigned v4u __attribute__((ext_vector_type(4)));
typedef float f32x4 __attribute__((ext_vector_type(4)));
typedef short bf16x8 __attribute__((ext_vector_type(8)));
typedef GAS unsigned gu32;
typedef GAS unsigned long long gu64;
#define RLX_AGENT __ATOMIC_RELAXED, __HIP_MEMORY_SCOPE_AGENT
#define LDS_WAIT() asm volatile("s_waitcnt lgkmcnt(0)" ::: "memory")
#define VM_WAIT() asm volatile("s_waitcnt vmcnt(0)" ::: "memory")
__device__ __forceinline__ unsigned long long rt() { return __builtin_amdgcn_s_memrealtime(); }
__device__ __forceinline__ unsigned f2bf(float f) { unsigned u = __builtin_bit_cast(unsigned, f); return (u + 0x7fffu + ((u >> 16) & 1u)) >> 16; }
__device__ __forceinline__ unsigned pk2(float lo, float hi) { return f2bf(lo) | (f2bf(hi) << 16); }

#define XB_TMO      128
#define XB_XCNT(j)  (256  + 64 * (j))
#define XB_XSUB(j)  (1280 + 64 * (j))
#define XB_XGEN(j)  (2304 + 64 * (j))
#define XB_TOP      3328
#define XB_TOPGEN   3392
#define XCD_BAR_WORDS 3456
#define XB_SPIN_CAP (1u << 18)

__device__ __forceinline__ unsigned xb_ld(unsigned* p)              { return __hip_atomic_load(p, __ATOMIC_RELAXED, __HIP_MEMORY_SCOPE_AGENT); }
__device__ __forceinline__ unsigned xb_add(unsigned* p, unsigned v) { return __hip_atomic_fetch_add(p, v, __ATOMIC_RELAXED, __HIP_MEMORY_SCOPE_AGENT); }
__device__ __forceinline__ unsigned xb_xcc_id() { return (unsigned)__builtin_amdgcn_s_getreg((3 << 11) | 20) & 0xFu; }
#define XB_SPIN(cond, bar) do { unsigned _sp = 0; while (cond) { __builtin_amdgcn_s_sleep(1); \
    if ((++_sp & 255u) == 0u) { if (xb_ld(&(bar)[XB_TMO])) break; if (_sp > XB_SPIN_CAP) { atomicAdd(&(bar)[XB_TMO], 1u); break; } } } } while (0)

struct XcdBarrier {
    unsigned* bar; unsigned x;
    volatile LAS unsigned* st;
};

__device__ __forceinline__ XcdBarrier xcd_barrier_post(unsigned* bar, volatile LAS unsigned* st) {
    XcdBarrier b; b.bar = bar; b.x = xb_xcc_id(); b.st = st;
    if (threadIdx.x == 0) (void)xb_add(&bar[XB_XCNT(b.x)], 1u);
    return b;
}
__device__ __forceinline__ void xcd_barrier_complete(unsigned* bar, unsigned x, unsigned& nloc, unsigned& nx) {
    const unsigned G = gridDim.x * gridDim.y * gridDim.z;
    unsigned sum, cnt, mine, sp = 0u;
    for (;;) {
        sum = 0u; cnt = 0u; mine = 0u;
#pragma unroll
        for (unsigned j = 0; j < 16; ++j) { const unsigned c = xb_ld(&bar[XB_XCNT(j)]); sum += c; cnt += (c > 0u) ? 1u : 0u; mine = (j == x) ? c : mine; }
        if (sum == G) break;
        __builtin_amdgcn_s_sleep(1);
        if ((++sp & 255u) == 0u) { if (xb_ld(&bar[XB_TMO])) break; if (sp > XB_SPIN_CAP) { atomicAdd(&bar[XB_TMO], 1u); break; } }
    }
    nloc = mine > 0u ? mine : 1u; nx = cnt > 0u ? cnt : 1u;
}

__device__ __forceinline__ void xcd_barrier(const XcdBarrier& b) {
    asm volatile("s_waitcnt vmcnt(0)" ::: "memory");
    __syncthreads();
    if (threadIdx.x == 0) {
        unsigned* bar = b.bar;
        __builtin_amdgcn_s_waitcnt(0);
        unsigned nloc = b.st[0], nx = b.st[1];
        if (nloc == 0u) { xcd_barrier_complete(bar, b.x, nloc, nx); b.st[0] = nloc; b.st[1] = nx; }
        const unsigned old = xb_add(&bar[XB_XSUB(b.x)], 1u);
        const unsigned gen = old / nloc;
        if (old + 1u == (gen + 1u) * nloc) {
            __builtin_amdgcn_fence(__ATOMIC_RELEASE, "agent");
            asm volatile("s_waitcnt vmcnt(0)" ::: "memory");
            const unsigned og = xb_add(&bar[XB_TOP], 1u);
            const unsigned tg = og / nx;
            if (og + 1u == (tg + 1u) * nx) xb_add(&bar[XB_TOPGEN], 1u);
            else XB_SPIN(xb_ld(&bar[XB_TOPGEN]) == tg, bar);
            __builtin_amdgcn_fence(__ATOMIC_ACQUIRE, "agent");
            xb_add(&bar[XB_XGEN(b.x)], 1u);
            asm volatile("s_waitcnt vmcnt(0)" ::: "memory");
        } else {
            XB_SPIN(xb_ld(&bar[XB_XGEN(b.x)]) == gen, bar);
            __builtin_amdgcn_fence(__ATOMIC_ACQUIRE, "agent");
            asm volatile("s_waitcnt vmcnt(0)" ::: "memory");
        }
    }
    __syncthreads();
}

constexpr int NWAVES = 8;
constexpr int BATCH = 32, SEQ = 2048, DMODEL = 1024, MTOK = BATCH * SEQ, DFF = 4096, NPROJ = 5120, INCOLS = 4896;
constexpr float RMS_EPS = 1e-6f;
constexpr float QSCALE = 0.125f * 1.4426950408889634f;
constexpr float LOG2E = 1.4426950408889634f;
#ifndef MK_N_LAUNCHES
#define MK_N_LAUNCHES 1
#endif
constexpr int N_PHASES = 10;
constexpr int N_LAUNCHES = MK_N_LAUNCHES;
constexpr size_t MiB = 1u << 20, KiB = 1u << 10;
constexpr size_t WS_CTL = 0, CTL_ZERO_BYTES = 1 * MiB;
constexpr size_t WS_WIN = 2 * MiB, WS_WF = 12 * MiB, WS_WN = 13 * MiB, WS_WO = 14 * MiB, WS_WUP = 16 * MiB, WS_WDN = 24 * MiB;
constexpr size_t WS_W1K = 32 * MiB, WS_W1V = WS_W1K + 256 * KiB, WS_W2K = WS_W1V + 256 * KiB, WS_W2V = WS_W2K + 8 * KiB, WS_PBK = WS_W2V + 8 * KiB, WS_PBV = WS_PBK + 256;
constexpr size_t WS_KT0 = WS_PBV + 256;
constexpr size_t WS_RSTD2 = 46 * MiB;
constexpr size_t WS_ROPEC = 33 * MiB, WS_ROPES = WS_ROPEC + 256 * KiB;
constexpr size_t WS_KCMP = 34 * MiB, WS_VCMP = 35 * MiB, WS_C = 36 * MiB, WS_LF = 38 * MiB, WS_GATE = 40 * MiB;
constexpr size_t WS_HB = 48 * MiB;
constexpr size_t WS_FKX = 48 * MiB;
constexpr size_t WS_PROBE_O = 64 * MiB;
constexpr size_t WS_FQ = 176 * MiB, WS_FK = 240 * MiB, WS_FV = 304 * MiB, WS_NQ = 368 * MiB;
constexpr size_t WS_KV = 432 * MiB, KV_STRIDE = 16 * MiB;
constexpr size_t WS_SGA = 528 * MiB, WS_SGB = 656 * MiB;
constexpr size_t WS_Y = 784 * MiB;
constexpr size_t WS_ATT = WS_Y;
constexpr size_t WS_FOXO_UNUSED = WS_Y, WS_NSAO_UNUSED = WS_Y + 64 * MiB;
constexpr size_t WS_U = 176 * MiB;
constexpr size_t WS_END = 1024 * MiB;
static_assert(WS_FV - WS_FK == WS_FK - WS_FQ && WS_U + (size_t)MTOK * DFF * 2 <= WS_Y && WS_Y + (size_t)MTOK * 512 * 4 <= WS_END && WS_GATE + (size_t)MTOK * 24 * 4 <= WS_HB, "d_ws map");
constexpr int CW_TMO = 0, CW_CODE = 1, CW_BAR = 4096, CW_QUEUE = 16384;
constexpr int RING_OFF = 0, RING_BYTES = 131072;
constexpr int LDSCTL_OFF = RING_BYTES, MISC_OFF = LDSCTL_OFF + 320;
constexpr int LDS_BYTES = 147456;
static_assert(MISC_OFF + 128 <= LDS_BYTES, "LDS map");


typedef float f32x16 __attribute__((ext_vector_type(16)));
struct Frame {
    LAS unsigned char* lds;
    volatile LAS unsigned* MISC;
    gu32* ctl;
    int wave;
    int vcu, G;
    unsigned char* ws;
    const float* x; float* out;
    const float *g_mix_pre, *g_mix_post, *g_mlp_pre, *g_mlp_post, *w_in, *b_forget, *pos_k, *w1_k, *w2_k, *pos_v, *w1_v, *w2_v, *w_fox, *w_nsa, *w_o, *w_up, *w_down;
};
template <class T> __device__ __forceinline__ T* wsp(const Frame& F, size_t off) { return (T*)(F.ws + off); }
__device__ __forceinline__ int cur_lane() { return (int)__builtin_amdgcn_mbcnt_hi(~0u, __builtin_amdgcn_mbcnt_lo(~0u, 0u)); }
__device__ __forceinline__ int cur_tid(const Frame& F) { return F.wave * 64 + cur_lane(); }

__device__ __forceinline__ float wave_sum(float v) {
#pragma unroll
    for (int o = 1; o < 64; o <<= 1) v += __shfl_xor(v, o);
    return v;
}
__device__ __forceinline__ float bfl(unsigned w) { return __uint_as_float(w << 16); }
__device__ __forceinline__ float bfh(unsigned w) { return __uint_as_float(w & 0xffff0000u); }

__device__ __forceinline__ int rope_d(int w) { const int i = w >> 3, j = w & 7; return j < 4 ? 4 * i + j : 32 + 4 * i + (j - 4); }
__device__ __forceinline__ int in_src_col(int n) {
    if (n < 1536) return n;
    if (n < 2048) { const int l = n - 1536; return 1544 + (l & ~63) + rope_d(l & 63); }
    if (n < 2816) { const int s = (n - 2048) >> 8, l = (n - 2048) & 255; const int kb = 2056 + s * 256;
        return l < 128 ? kb + (l & ~63) + rope_d(l & 63) : kb + 128 + (l - 128); }
    if (n < 4864) { const int q = (n - 2816) >> 8, l = (n - 2816) & 255; return l < 128 ? 2848 + 128 * q + l : 3872 + 128 * q + (l - 128); }
    const int l = n - 4864; if (l < 8) return 1536 + l; if (l < 32) return 2824 + (l - 8); return -1;
}
template <class SrcCol>
__device__ __forceinline__ void p0_transpose_item(const float* W, int K, int Nsrc, bf16* WT, int nblk, LAS float* scr, int item, int lane, SrcCol srccol, const float* kgain = nullptr, int ldk = 0, int koff = 0) {
    const int kb = item / nblk, nb = item % nblk, k0 = 64 * kb, n0 = 32 * nb;
    const int sc = srccol(n0 + (lane & 31));
#pragma unroll 8
    for (int i = 0; i < 32; ++i) { const int kk = 2 * i + (lane >> 5); float w = sc >= 0 ? W[(size_t)(k0 + kk) * Nsrc + sc] : 0.f; if (kgain) w *= kgain[k0 + kk]; scr[kk * 33 + (lane & 31)] = w; }
    LDS_WAIT(); asm volatile("" ::: "memory");
    const int c = lane & 7;
#pragma unroll
    for (int j = 0; j < 4; ++j) { const int n = (lane >> 3) + 8 * j; const LAS float* s = scr + (8 * c) * 33 + n;
        v4u o; o.x = pk2(s[0 * 33], s[1 * 33]); o.y = pk2(s[2 * 33], s[3 * 33]); o.z = pk2(s[4 * 33], s[5 * 33]); o.w = pk2(s[6 * 33], s[7 * 33]);
        *(GAS v4u*)(WT + (size_t)(n0 + n) * (ldk ? ldk : K) + koff + k0 + 8 * c) = o; }
    LDS_WAIT(); asm volatile("" ::: "memory");
}
__device__ __forceinline__ void rms_rows_to_bf16(int lane, int gw, int NGW, const float* X, const float* g, bf16* O) {
    constexpr int RP = 4;
    const GAS f32x4* gr = (const GAS f32x4*)g + lane; f32x4 gv[4];
#pragma unroll
    for (int j = 0; j < 4; ++j) gv[j] = gr[64 * j];
    for (int m0 = gw; m0 < MTOK; m0 += NGW * RP) {
        f32x4 v[RP][4];
#pragma unroll
        for (int r = 0; r < RP; ++r) { const GAS f32x4* xr = (const GAS f32x4*)(X + (size_t)(m0 + r * NGW) * DMODEL) + lane;
#pragma unroll
            for (int j = 0; j < 4; ++j) v[r][j] = __builtin_nontemporal_load(xr + 64 * j); }
#pragma unroll
        for (int r = 0; r < RP; ++r) { float s = 0.f;
#pragma unroll
            for (int j = 0; j < 4; ++j) s += (v[r][j].x * v[r][j].x + v[r][j].y * v[r][j].y) + (v[r][j].z * v[r][j].z + v[r][j].w * v[r][j].w);
            const float rr = 1.0f / sqrtf(wave_sum(s) * (1.f / DMODEL) + RMS_EPS);
            GAS unsigned long long* o8 = (GAS unsigned long long*)(O + (size_t)(m0 + r * NGW) * DMODEL) + lane;
#pragma unroll
            for (int j = 0; j < 4; ++j) { const f32x4 a = v[r][j], gg = gv[j];
                o8[64 * j] = (unsigned long long)pk2(a.x * rr * gg.x, a.y * rr * gg.y) | ((unsigned long long)pk2(a.z * rr * gg.z, a.w * rr * gg.w) << 32); } }
    }
}
__device__ __forceinline__ void p0_prologue(Frame& F) {
    LAS float* scr = (LAS float*)(F.lds + RING_OFF + F.wave * 16384);
    const int gw = F.vcu * NWAVES + F.wave, NGW = F.G * NWAVES, lane = cur_lane();
    constexpr int I_IN = 16 * (NPROJ / 32), I_F = 8 * 32, I_O = 16 * 32, I_UP = 16 * 128, I_DN = 64 * 32, I_W1 = 32 * 2, I_W2 = 1 * 2;
    constexpr int NITEMS = I_IN + 2 * I_F + I_O + I_UP + I_DN + 2 * I_W1 + 2 * I_W2;
    auto ident = [](int n) { return n; };
    for (int it = gw; it < NITEMS; it += NGW) {
        int r = it;
        if (r < I_IN) { p0_transpose_item(F.w_in, 1024, INCOLS, wsp<bf16>(F, WS_WIN), NPROJ / 32, scr, r, lane, [](int n) { return in_src_col(n); }); continue; } r -= I_IN;
        if (r < I_F) { p0_transpose_item(F.w_fox, 512, 1024, wsp<bf16>(F, WS_WF), 32, scr, r, lane, ident, nullptr, 1024, 512); continue; } r -= I_F;
        if (r < I_F) { p0_transpose_item(F.w_nsa, 512, 1024, wsp<bf16>(F, WS_WF), 32, scr, r, lane, ident, nullptr, 1024, 0); continue; } r -= I_F;
        if (r < I_O) { p0_transpose_item(F.w_o, 1024, 1024, wsp<bf16>(F, WS_WO), 32, scr, r, lane, ident); continue; } r -= I_O;
        if (r < I_UP) { p0_transpose_item(F.w_up, 1024, 4096, wsp<bf16>(F, WS_WUP), 128, scr, r, lane, ident, F.g_mlp_pre); continue; }     r -= I_UP;
        if (r < I_DN) { p0_transpose_item(F.w_down, 4096, 1024, wsp<bf16>(F, WS_WDN), 32, scr, r, lane, ident); continue; } r -= I_DN;
        if (r < I_W1) { p0_transpose_item(F.w1_k, 2048, 64, wsp<bf16>(F, WS_W1K), 2, scr, r, lane, ident); continue; } r -= I_W1;
        if (r < I_W1) { p0_transpose_item(F.w1_v, 2048, 64, wsp<bf16>(F, WS_W1V), 2, scr, r, lane, ident); continue; } r -= I_W1;
        if (r < I_W2) { p0_transpose_item(F.w2_k, 64, 64, wsp<bf16>(F, WS_W2K), 2, scr, r, lane, ident); continue; } r -= I_W2;
        p0_transpose_item(F.w2_v, 64, 64, wsp<bf16>(F, WS_W2V), 2, scr, r, lane, ident);
    }
    { float* RC = wsp<float>(F, WS_ROPEC); float* RS = wsp<float>(F, WS_ROPES);
      for (int e = (F.vcu * NWAVES * 64 + cur_tid(F)); e < SEQ * 32; e += F.G * NWAVES * 64) { const int t = e >> 5, i = e & 31;
          const float inv = powf(10000.0f, -(float)(2 * i) / 64.0f); const float ang = (float)t * inv; RC[e] = cosf(ang); RS[e] = sinf(ang); } }
    if (F.wave == 0) for (int it = F.vcu; it < 128; it += F.G) { const int kv = it >> 6, c = it & 63; const float* pos = kv ? F.pos_v : F.pos_k; const float* w1 = kv ? F.w1_v : F.w1_k; float s = 0.f;
        for (int k = lane; k < 2048; k += 64) s += pos[k] * w1[(size_t)k * 64 + c];
        s = wave_sum(s); if (lane == 0) wsp<float>(F, kv ? WS_PBV : WS_PBK)[c] = s; }
    rms_rows_to_bf16(lane, gw, NGW, F.x, F.g_mix_pre, wsp<bf16>(F, WS_HB));
}

__device__ __forceinline__ int crow(int r, int hi) { return (r & 3) + 8 * (r >> 2) + 4 * hi; }
#define P2_PIN8(a) asm volatile("" : "+v"(a[0]), "+v"(a[1]), "+v"(a[2]), "+v"(a[3]), "+v"(a[4]), "+v"(a[5]), "+v"(a[6]), "+v"(a[7]))
__device__ __forceinline__ void p2_compress_unit(Frame& F, int unit) {
    const int bg = unit >> 2, kv = (unit >> 1) & 1, half = unit & 1, lane = cur_lane(), w = F.wave;
    const bf16* X = wsp<bf16>(F, WS_KV + (size_t)kv * KV_STRIDE) + (size_t)bg * SEQ * 64;
    const bf16* W1t = wsp<bf16>(F, kv ? WS_W1V : WS_W1K); const bf16* W2t = wsp<bf16>(F, kv ? WS_W2V : WS_W2K); const float* PB = wsp<float>(F, kv ? WS_PBV : WS_PBK);
    bf16* OUT = wsp<bf16>(F, kv ? WS_VCMP : WS_KCMP) + (size_t)bg * 128 * 64;
    const int rt = w & 1, ct = (w >> 1) & 1, kh = w >> 2, r = lane & 31, h = lane >> 5;
    const int irow = 64 * half + 32 * rt + r, ild = irow < 126 ? irow : 126;
    const GAS bf16x8* arow = (const GAS bf16x8*)(X + (size_t)ild * 1024 + kh * 1024); const GAS bf16x8* brow = (const GAS bf16x8*)(W1t + (size_t)(32 * ct + r) * 2048 + kh * 1024);
#define P2_KIDX(S) (8 * ((S) >> 2) + 4 * h + ((S) & 3))
    f32x16 acc = {};
    bf16x8 a0[8], b0[8], a1[8], b1[8];
#pragma unroll
    for (int s = 0; s < 8; ++s) { a0[s] = arow[P2_KIDX(s)]; b0[s] = brow[P2_KIDX(s)]; }
#pragma unroll 1
    for (int bt = 0; bt < 8; bt += 2) {
#pragma unroll
        for (int s = 0; s < 8; ++s) { a1[s] = arow[P2_KIDX(8 * (bt + 1) + s)]; b1[s] = brow[P2_KIDX(8 * (bt + 1) + s)]; }
        P2_PIN8(a0); P2_PIN8(b0);
#pragma unroll
        for (int s = 0; s < 8; ++s) acc = __builtin_amdgcn_mfma_f32_32x32x16_bf16(a0[s], b0[s], acc, 0, 0, 0);
        if (bt + 2 < 8) {
#pragma unroll
            for (int s = 0; s < 8; ++s) { a0[s] = arow[P2_KIDX(8 * (bt + 2) + s)]; b0[s] = brow[P2_KIDX(8 * (bt + 2) + s)]; } }
#undef P2_KIDX_DONE
        P2_PIN8(a1); P2_PIN8(b1);
#pragma unroll
        for (int s = 0; s < 8; ++s) acc = __builtin_amdgcn_mfma_f32_32x32x16_bf16(a1[s], b1[s], acc, 0, 0, 0);
    }
    LAS float* red = (LAS float*)(F.lds + RING_OFF);
    LAS bf16* Hs = (LAS bf16*)(F.lds + RING_OFF + 16384);
    if (kh == 1) {
#pragma unroll
        for (int i = 0; i < 16; ++i) red[((w & 3) * 16 + i) * 64 + lane] = acc[i];
    }
    __syncthreads();
    if (kh == 0) { const float pb = PB[32 * ct + r];
#pragma unroll
        for (int i = 0; i < 16; ++i) { float v = acc[i] + red[((w & 3) * 16 + i) * 64 + lane] + pb; v = v / (1.0f + __expf(-v)); Hs[(32 * rt + crow(i, h)) * 72 + 32 * ct + r] = (bf16)f2bf(v); }
    }
    __syncthreads();
    if (kh == 0) { f32x16 o = {};
#pragma unroll
        for (int s = 0; s < 4; ++s) { const bf16x8 a = *(const LAS bf16x8*)(Hs + (32 * rt + r) * 72 + 16 * s + 8 * h), b = *(const GAS bf16x8*)(W2t + (size_t)(32 * ct + r) * 64 + 16 * s + 8 * h);
            o = __builtin_amdgcn_mfma_f32_32x32x16_bf16(a, b, o, 0, 0, 0); }
#pragma unroll
        for (int i = 0; i < 16; ++i) { const int row = 64 * half + 32 * rt + crow(i, h); OUT[(size_t)row * 64 + 32 * ct + r] = (bf16)(row == 127 ? 0u : f2bf(o[i])); }
    }
    __syncthreads();
}
__device__ __forceinline__ void p2_phase(Frame& F) {
    for (int id = F.vcu; id < BATCH * 8; id += F.G) { const int b = id >> 3, h = id & 7, tid = cur_tid(F), lane = cur_lane(), w = F.wave;
        LAS float* wt = (LAS float*)(F.lds + RING_OFF + 32768);
        const float* lf = wsp<float>(F, WS_LF) + ((size_t)b * SEQ + 4 * tid) * 8 + h; float v[4];
#pragma unroll
        for (int i = 0; i < 4; ++i) v[i] = lf[i * 8];
        const float tot = (v[0] + v[1]) + (v[2] + v[3]); float incl = tot;
#pragma unroll
        for (int o = 1; o < 64; o <<= 1) { const float n = __shfl_up(incl, o); if (lane >= o) incl += n; }
        if (lane == 63) wt[w] = incl;
        __syncthreads();
        float run = incl - tot;
        for (int k = 0; k < w; ++k) run += wt[k];
        float* c = wsp<float>(F, WS_C) + (size_t)id * SEQ + 4 * tid; GAS v4u* kx = (GAS v4u*)(wsp<bf16>(F, WS_FKX) + ((size_t)id * SEQ + 4 * tid) * 16);
        float cv[4];
#pragma unroll
        for (int i = 0; i < 4; ++i) { run += v[i]; cv[i] = run;
            const float x = -run * LOG2E; const unsigned h1 = f2bf(x); const float r1 = x - __uint_as_float(h1 << 16); const unsigned h2 = f2bf(r1); const float r2 = r1 - __uint_as_float(h2 << 16); const unsigned h3 = f2bf(r2);
            kx[2 * i] = (v4u){h1 | (h2 << 16), h3, 0u, 0u}; kx[2 * i + 1] = (v4u){0u, 0u, 0u, 0u}; }
        *(GAS f32x4*)c = (f32x4){cv[0], cv[1], cv[2], cv[3]};
        { LAS float* cl = (LAS float*)(F.lds + RING_OFF + 36864); LAS float* wk = cl + 2048; LAS float* wq = wk + 256;
          *(LAS f32x4*)(cl + 4 * tid) = (f32x4){cv[0], cv[1], cv[2], cv[3]};
          const GAS v4u* kr = (const GAS v4u*)(wsp<bf16>(F, WS_FK) + ((size_t)b * SEQ + (tid >> 3)) * 512 + h * 64 + (tid & 7) * 8);
          const GAS v4u* qrw = (const GAS v4u*)(wsp<bf16>(F, WS_FQ) + ((size_t)b * SEQ + (tid >> 3)) * 512 + h * 64 + (tid & 7) * 8);
#pragma unroll 1
          for (int i0 = 0; i0 < 32; i0 += 16) { v4u ka[16], qa[16];
#pragma unroll
              for (int i = 0; i < 16; ++i) { ka[i] = kr[(size_t)(i0 + i) * 64 * 64]; qa[i] = qrw[(size_t)(i0 + i) * 64 * 64]; }
              asm volatile("" : "+v"(ka[0]), "+v"(ka[1]), "+v"(ka[2]), "+v"(ka[3]), "+v"(ka[4]), "+v"(ka[5]), "+v"(ka[6]), "+v"(ka[7]), "+v"(ka[8]), "+v"(ka[9]), "+v"(ka[10]), "+v"(ka[11]), "+v"(ka[12]), "+v"(ka[13]), "+v"(ka[14]), "+v"(ka[15]));
              asm volatile("" : "+v"(qa[0]), "+v"(qa[1]), "+v"(qa[2]), "+v"(qa[3]), "+v"(qa[4]), "+v"(qa[5]), "+v"(qa[6]), "+v"(qa[7]), "+v"(qa[8]), "+v"(qa[9]), "+v"(qa[10]), "+v"(qa[11]), "+v"(qa[12]), "+v"(qa[13]), "+v"(qa[14]), "+v"(qa[15]));
#pragma unroll
              for (int i = 0; i < 16; ++i) { const v4u a = ka[i], e = qa[i];
                  float sk = (bfl(a.x) * bfl(a.x) + bfh(a.x) * bfh(a.x)) + (bfl(a.y) * bfl(a.y) + bfh(a.y) * bfh(a.y)) + (bfl(a.z) * bfl(a.z) + bfh(a.z) * bfh(a.z)) + (bfl(a.w) * bfl(a.w) + bfh(a.w) * bfh(a.w));
                  float sq = (bfl(e.x) * bfl(e.x) + bfh(e.x) * bfh(e.x)) + (bfl(e.y) * bfl(e.y) + bfh(e.y) * bfh(e.y)) + (bfl(e.z) * bfl(e.z) + bfh(e.z) * bfh(e.z)) + (bfl(e.w) * bfl(e.w) + bfh(e.w) * bfh(e.w));
                  sk += __shfl_xor(sk, 1); sq += __shfl_xor(sq, 1); sk += __shfl_xor(sk, 2); sq += __shfl_xor(sq, 2); sk += __shfl_xor(sk, 4); sq += __shfl_xor(sq, 4);
                  sk = fmaxf(sk, __shfl_xor(sk, 8)); sq = fmaxf(sq, __shfl_xor(sq, 8)); sk = fmaxf(sk, __shfl_xor(sk, 16)); sq = fmaxf(sq, __shfl_xor(sq, 16)); sk = fmaxf(sk, __shfl_xor(sk, 32)); sq = fmaxf(sq, __shfl_xor(sq, 32));
                  if (lane == 0) { wk[w * 32 + i0 + i] = sk; wq[w * 32 + i0 + i] = sq; } } }
          __syncthreads();
          if (tid < 8) { const int qb = tid; float Qm = 0.f, Kband = 0.f;
              for (int t4 = 0; t4 < 4; ++t4) for (int ww = 0; ww < 8; ++ww) { Qm = fmaxf(Qm, wq[ww * 32 + 4 * qb + t4]); Kband = fmaxf(Kband, wk[ww * 32 + 4 * qb + t4]); }
              Qm = sqrtf(Qm) * 1.001f; Kband = sqrtf(Kband) * 1.001f;
              const float cq0 = cl[256 * qb]; int kt0 = 4 * qb;
              for (int kt = 4 * qb - 1; kt >= 0; --kt) { float kk = 0.f; for (int ww = 0; ww < 8; ++ww) kk = fmaxf(kk, wk[ww * 32 + kt]); kk = sqrtf(kk) * 1.001f;
                  const float bound = Qm * (kk + Kband) + (cq0 - cl[64 * kt + 63]) * LOG2E; if (bound >= -40.0f) kt0 = kt; }
              wsp<int>(F, WS_KT0)[id * 8 + qb] = kt0; } }
        __syncthreads(); }
    for (int u = F.vcu; u < 256; u += F.G) p2_compress_unit(F, u);
}

template <bool FINAL>
__device__ __forceinline__ void row_pass(Frame& F, const float* xin_f32, const bf16* xin_b16, const bf16* Y, const float* gpost, float* out_f32, bf16* X1B, float* RSTD2) {
    constexpr int RP = 4;
    const int gw = F.vcu * NWAVES + F.wave, NGW = F.G * NWAVES, lane = cur_lane();
    const GAS f32x4* gp = (const GAS f32x4*)gpost + lane;
    f32x4 gpv[4];
#pragma unroll
    for (int j = 0; j < 4; ++j) gpv[j] = gp[64 * j];
    for (int m0 = gw; m0 < MTOK; m0 += NGW * RP) {
        f32x4 xv[RP][4]; unsigned long long yw[RP][4];
#pragma unroll
        for (int r = 0; r < RP; ++r) { const size_t m = (size_t)(m0 + r * NGW);
            const GAS unsigned long long* yr = (const GAS unsigned long long*)(Y + m * DMODEL) + lane;
            if (FINAL) { const GAS unsigned long long* xr = (const GAS unsigned long long*)(xin_b16 + m * DMODEL) + lane;
#pragma unroll
                for (int j = 0; j < 4; ++j) { const unsigned long long w = __builtin_nontemporal_load(xr + 64 * j); const unsigned lo = (unsigned)w, hi = (unsigned)(w >> 32); xv[r][j] = (f32x4){bfl(lo), bfh(lo), bfl(hi), bfh(hi)}; yw[r][j] = __builtin_nontemporal_load(yr + 64 * j); }
            } else { const GAS f32x4* xr = (const GAS f32x4*)(xin_f32 + m * DMODEL) + lane;
#pragma unroll
                for (int j = 0; j < 4; ++j) { xv[r][j] = __builtin_nontemporal_load(xr + 64 * j); yw[r][j] = __builtin_nontemporal_load(yr + 64 * j); } } }
#pragma unroll
        for (int r = 0; r < RP; ++r) { const size_t m = (size_t)(m0 + r * NGW);
            f32x4 yv[4]; float s = 0.f;
#pragma unroll
            for (int j = 0; j < 4; ++j) { const unsigned lo = (unsigned)yw[r][j], hi = (unsigned)(yw[r][j] >> 32);
                yv[j] = (f32x4){bfl(lo), bfh(lo), bfl(hi), bfh(hi)}; s += (yv[j].x * yv[j].x + yv[j].y * yv[j].y) + (yv[j].z * yv[j].z + yv[j].w * yv[j].w); }
            const float rr = 1.0f / sqrtf(wave_sum(s) * (1.f / DMODEL) + RMS_EPS); float s2 = 0.f;
            if (FINAL) { GAS f32x4* xo = (GAS f32x4*)(out_f32 + m * DMODEL) + lane;
#pragma unroll
                for (int j = 0; j < 4; ++j) __builtin_nontemporal_store(xv[r][j] + yv[j] * rr * gpv[j], xo + 64 * j);
            } else { GAS unsigned long long* o8 = (GAS unsigned long long*)(X1B + m * DMODEL) + lane;
#pragma unroll
                for (int j = 0; j < 4; ++j) { const f32x4 v = xv[r][j] + yv[j] * rr * gpv[j]; s2 += (v.x * v.x + v.y * v.y) + (v.z * v.z + v.w * v.w);
                    o8[64 * j] = (unsigned long long)pk2(v.x, v.y) | ((unsigned long long)pk2(v.z, v.w) << 32); }
                const float r2 = 1.0f / sqrtf(wave_sum(s2) * (1.f / DMODEL) + RMS_EPS); if (lane == 0) RSTD2[m] = r2; }
        }
    }
}

namespace at {
constexpr int KSLOT = 10240, VSLOT = 8192, NSLOT = 3;
constexpr int L_K = 0, L_V = NSLOT * KSLOT, L_WS = L_V + NSLOT * VSLOT, L_PARK = L_WS + 8 * 512, L_PSL = L_PARK, L_CMP = L_PARK + 4 * 64 * 33 * 4, L_SELM = L_CMP + 4 * 8192, L_NEXT = L_SELM + 256, L_END = L_NEXT + 16;
static_assert(L_SELM >= L_PARK + 8 * 8192, "park region");
static_assert(L_END <= RING_BYTES, "attention LDS map");
constexpr float THR = 8.0f;
typedef short s16x4 __attribute__((ext_vector_type(4)));
typedef short v4i16_t __attribute__((ext_vector_type(4)));
#define AT_NEG (-INFINITY)
__device__ __forceinline__ void glds16(const void* sbase, unsigned voff, unsigned lds_dst) { unsigned keep;
    asm volatile("s_mov_b32 %0, m0\n\ts_mov_b32 m0, %3\n\ts_nop 2\n\tglobal_load_lds_dwordx4 %1, %2\n\ts_mov_b32 m0, %0" : "=&s"(keep) : "v"(voff), "s"(sbase), "s"(lds_dst) : "memory"); }
__device__ __forceinline__ void glds4(const void* sbase, unsigned voff, unsigned lds_dst) { unsigned keep;
    asm volatile("s_mov_b32 %0, m0\n\ts_mov_b32 m0, %3\n\ts_nop 2\n\tglobal_load_lds_dword %1, %2\n\ts_mov_b32 m0, %0" : "=&s"(keep) : "v"(voff), "s"(sbase), "s"(lds_dst) : "memory"); }
#define AT_WAIT_BAR(N) asm volatile("s_waitcnt vmcnt(" #N ") lgkmcnt(0)\n\ts_barrier" ::: "memory")
#define AT_BAR() asm volatile("s_waitcnt lgkmcnt(0)\n\ts_barrier" ::: "memory")
__device__ __forceinline__ unsigned cvtpk(float lo, float hi) { typedef float f2 __attribute__((ext_vector_type(2))); typedef __bf16 b2 __attribute__((ext_vector_type(2))); f2 v = {lo, hi}; b2 b = __builtin_convertvector(v, b2); return __builtin_bit_cast(unsigned, b); }
__device__ __forceinline__ float swap_half(float x, int hi) { auto rr = __builtin_amdgcn_permlane32_swap(__float_as_uint(x), __float_as_uint(x), false, false); return hi ? __uint_as_float(rr[0]) : __uint_as_float(rr[1]); }
__device__ __forceinline__ float max_half(float x) { auto rr = __builtin_amdgcn_permlane32_swap(__float_as_uint(x), __float_as_uint(x), false, false); return fmaxf(__uint_as_float(rr[0]), __uint_as_float(rr[1])); }
__device__ __forceinline__ float sum_half(float x) { auto rr = __builtin_amdgcn_permlane32_swap(__float_as_uint(x), __float_as_uint(x), false, false); return __uint_as_float(rr[0]) + __uint_as_float(rr[1]); }
template <int KS>
__device__ __forceinline__ void qk(f32x16& p0, f32x16& p1, const LAS unsigned char* Kslot, const bf16x8 (&qr)[5], const f32x16& cinit, int r32, int hi) {
    const LAS unsigned char* kb = Kslot + hi * 1024 + r32 * 16;
#pragma unroll
    for (int d0 = 0; d0 < KS; ++d0) { const bf16x8 b0 = *(const LAS bf16x8*)(kb + d0 * 2048), b1 = *(const LAS bf16x8*)(kb + d0 * 2048 + 512);
        if (d0 == 0) { p0 = __builtin_amdgcn_mfma_f32_32x32x16_bf16(b0, qr[0], cinit, 0, 0, 0); p1 = __builtin_amdgcn_mfma_f32_32x32x16_bf16(b1, qr[0], cinit, 0, 0, 0); }
        else { p0 = __builtin_amdgcn_mfma_f32_32x32x16_bf16(b0, qr[d0], p0, 0, 0, 0); p1 = __builtin_amdgcn_mfma_f32_32x32x16_bf16(b1, qr[d0], p1, 0, 0, 0); } }
}
__device__ __forceinline__ s16x4 vtr(const LAS unsigned char* p) { return __builtin_bit_cast(s16x4, __builtin_amdgcn_ds_read_tr16_b64_v4i16((LAS v4i16_t*)p)); }
__device__ __forceinline__ void pv(f32x16 (&o)[2], const LAS unsigned char* vb, const f32x16& p0, const f32x16& p1) {
    v4u pw[4];
#pragma unroll
    for (int k = 0; k < 2; ++k) { pw[k] = (v4u){cvtpk(p0[8 * k], p0[8 * k + 1]), cvtpk(p0[8 * k + 2], p0[8 * k + 3]), cvtpk(p0[8 * k + 4], p0[8 * k + 5]), cvtpk(p0[8 * k + 6], p0[8 * k + 7])};
        pw[2 + k] = (v4u){cvtpk(p1[8 * k], p1[8 * k + 1]), cvtpk(p1[8 * k + 2], p1[8 * k + 3]), cvtpk(p1[8 * k + 4], p1[8 * k + 5]), cvtpk(p1[8 * k + 6], p1[8 * k + 7])}; }
#pragma unroll
    for (int d0 = 0; d0 < 2; ++d0)
#pragma unroll
        for (int ks = 0; ks < 4; ++ks) { const s16x4 lo = vtr(vb + d0 * 4096 + ks * 1024), hi = vtr(vb + d0 * 4096 + ks * 1024 + 512);
            const bf16x8 vf = (bf16x8){lo[0], lo[1], lo[2], lo[3], hi[0], hi[1], hi[2], hi[3]};
            o[d0] = __builtin_amdgcn_mfma_f32_32x32x16_bf16(__builtin_bit_cast(bf16x8, pw[ks]), vf, o[d0], 0, 0, 0); }
}
template <int KS>
__device__ __forceinline__ void load_kf(bf16x8 (&kf)[10], const LAS unsigned char* Kslot, int r32, int hi) {
    const LAS unsigned char* kb = Kslot + hi * 1024 + r32 * 16;
#pragma unroll
    for (int d0 = 0; d0 < KS; ++d0) { kf[2 * d0] = *(const LAS bf16x8*)(kb + d0 * 2048); kf[2 * d0 + 1] = *(const LAS bf16x8*)(kb + d0 * 2048 + 512); }
}
__device__ __forceinline__ void v_load(bf16x8 (&vf)[8], const LAS unsigned char* vb) {
#pragma unroll
    for (int d0 = 0; d0 < 2; ++d0)
#pragma unroll
        for (int ks = 0; ks < 4; ++ks) { const s16x4 lo = vtr(vb + d0 * 4096 + ks * 1024), hi = vtr(vb + d0 * 4096 + ks * 1024 + 512);
            vf[d0 * 4 + ks] = (bf16x8){lo[0], lo[1], lo[2], lo[3], hi[0], hi[1], hi[2], hi[3]}; }
}
template <int KS, bool LOADK>
__device__ __forceinline__ void pv_regs(f32x16 (&o)[2], const bf16x8 (&vf)[8], const f32x16& p0, const f32x16& p1, bf16x8 (&kf)[10], const LAS unsigned char* Knext, int r32, int hi) {
    v4u pw[4];
#pragma unroll
    for (int k = 0; k < 2; ++k) { pw[k] = (v4u){cvtpk(p0[8 * k], p0[8 * k + 1]), cvtpk(p0[8 * k + 2], p0[8 * k + 3]), cvtpk(p0[8 * k + 4], p0[8 * k + 5]), cvtpk(p0[8 * k + 6], p0[8 * k + 7])};
        pw[2 + k] = (v4u){cvtpk(p1[8 * k], p1[8 * k + 1]), cvtpk(p1[8 * k + 2], p1[8 * k + 3]), cvtpk(p1[8 * k + 4], p1[8 * k + 5]), cvtpk(p1[8 * k + 6], p1[8 * k + 7])}; }
#pragma unroll
    for (int ks = 0; ks < 2; ++ks)
#pragma unroll
        for (int d0 = 0; d0 < 2; ++d0) o[d0] = __builtin_amdgcn_mfma_f32_32x32x16_bf16(__builtin_bit_cast(bf16x8, pw[ks]), vf[d0 * 4 + ks], o[d0], 0, 0, 0);
    if (LOADK) { __builtin_amdgcn_sched_barrier(0); load_kf<KS>(kf, Knext, r32, hi); __builtin_amdgcn_sched_barrier(0); }
#pragma unroll
    for (int ks = 2; ks < 4; ++ks)
#pragma unroll
        for (int d0 = 0; d0 < 2; ++d0) o[d0] = __builtin_amdgcn_mfma_f32_32x32x16_bf16(__builtin_bit_cast(bf16x8, pw[ks]), vf[d0 * 4 + ks], o[d0], 0, 0, 0);
}
__device__ __forceinline__ float max3f(float a, float b, float c) { float r; asm("v_max3_f32 %0, %1, %2, %3" : "=v"(r) : "v"(a), "v"(b), "v"(c)); return r; }
__device__ __forceinline__ float rowmax32(const f32x16& p0, const f32x16& p1) {
    float a = max3f(p0[0], p0[1], p1[0]), b = max3f(p0[2], p0[3], p1[1]); a = max3f(a, p1[2], p1[3]);
#pragma unroll
    for (int r = 4; r < 16; r += 4) { a = max3f(a, p0[r], p0[r + 1]); b = max3f(b, p0[r + 2], p0[r + 3]); a = max3f(a, p1[r], p1[r + 1]); b = max3f(b, p1[r + 2], p1[r + 3]); }
    return max_half(__builtin_fmaxf(a, b));
}
template <bool FIRST>
__device__ __forceinline__ void softmax_tile(f32x16& p0, f32x16& p1, f32x16& cinit, float& l, f32x16 (&o)[2], LAS float* wsf, int r32, int hi) {
    const float rm = rowmax32(p0, p1);
    bool resc = false;
    if (FIRST) { const float dl = rm;
#pragma unroll
        for (int r = 0; r < 16; ++r) { p0[r] -= dl; p1[r] -= dl; cinit[r] -= dl; } }
    else if (__any(rm > THR)) { const float dl = fmaxf(rm, 0.f);
#pragma unroll
        for (int r = 0; r < 16; ++r) { p0[r] -= dl; p1[r] -= dl; cinit[r] -= dl; }
        const float f = __builtin_amdgcn_exp2f(-dl); l *= f; if (hi == 0) wsf[r32] = f; resc = true; }
    float s = 0.f;
#pragma unroll
    for (int r = 0; r < 16; ++r) { p0[r] = __builtin_amdgcn_exp2f(p0[r]); p1[r] = __builtin_amdgcn_exp2f(p1[r]); s += p0[r] + p1[r]; }
    l += s;
    if (resc) {
#pragma unroll
        for (int i = 0; i < 4; ++i) { const f32x4 f4 = *(const LAS f32x4*)(wsf + 8 * i + 4 * hi);
#pragma unroll
            for (int k = 0; k < 4; ++k) { o[0][4 * i + k] *= f4[k]; o[1][4 * i + k] *= f4[k]; } } }
}
__device__ __forceinline__ void row_bcast(float v, float (&out)[16], LAS float* wsf, int r32, int hi) {
    asm volatile("s_waitcnt lgkmcnt(0)" ::: "memory");
    if (hi == 0) wsf[32 + r32] = v;
#pragma unroll
    for (int i = 0; i < 4; ++i) { const f32x4 f4 = *(const LAS f32x4*)(wsf + 32 + 8 * i + 4 * hi);
#pragma unroll
        for (int k = 0; k < 4; ++k) out[4 * i + k] = f4[k]; }
    asm volatile("s_waitcnt lgkmcnt(0)" ::: "memory");
}
__device__ __forceinline__ void store_rows(const f32x16 (&v)[2], LAS unsigned char* stg_, bf16* Ow, int pitch, int lane, int r32, int hi) {
    LAS bf16* stg = (LAS bf16*)stg_;
#pragma unroll
    for (int r = 0; r < 16; ++r) { const int orow = crow(r, hi);
#pragma unroll
        for (int d0 = 0; d0 < 2; ++d0) stg[orow * 64 + d0 * 32 + r32] = (bf16)f2bf(v[d0][r]); }
    asm volatile("s_waitcnt lgkmcnt(0)" ::: "memory");
#pragma unroll
    for (int i = 0; i < 4; ++i) { const int row = i * 8 + (lane >> 3), ch = lane & 7; const v4u w = *(const LAS v4u*)(stg + row * 64 + ch * 8); *(GAS v4u*)(Ow + (size_t)row * pitch + ch * 8) = w; }
    asm volatile("s_waitcnt lgkmcnt(0)" ::: "memory");
}


template <int KS>
__device__ __forceinline__ void qk_regs(f32x16& p0, f32x16& p1, const bf16x8 (&kf)[10], const bf16x8 (&qr)[5], const f32x16& cinit) {
    p0 = __builtin_amdgcn_mfma_f32_32x32x16_bf16(kf[0], qr[0], cinit, 0, 0, 0); p1 = __builtin_amdgcn_mfma_f32_32x32x16_bf16(kf[1], qr[0], cinit, 0, 0, 0);
#pragma unroll
    for (int d0 = 1; d0 < KS; ++d0) { p0 = __builtin_amdgcn_mfma_f32_32x32x16_bf16(kf[2 * d0], qr[d0], p0, 0, 0, 0); p1 = __builtin_amdgcn_mfma_f32_32x32x16_bf16(kf[2 * d0 + 1], qr[d0], p1, 0, 0, 0); }
}
__device__ __forceinline__ void softmax_first(f32x16& p0, f32x16& p1, f32x16& cinit, float& l) {
    const float dl = rowmax32(p0, p1); float s = 0.f;
#pragma unroll
    for (int r = 0; r < 16; ++r) { cinit[r] -= dl; p0[r] = __builtin_amdgcn_exp2f(p0[r] - dl); p1[r] = __builtin_amdgcn_exp2f(p1[r] - dl); s += p0[r] + p1[r]; }
    l = s;
}
__device__ __forceinline__ void softmax_next(f32x16& p0, f32x16& p1, f32x16& cinit, float& l, f32x16 (&o)[2], LAS float* wsf, int r32, int hi) {
    const float rm = rowmax32(p0, p1);
    if (__builtin_expect(__any(rm > THR), 0)) { const float dl = __builtin_fmaxf(rm, 0.f);
#pragma unroll
        for (int r = 0; r < 16; ++r) { p0[r] -= dl; p1[r] -= dl; cinit[r] -= dl; }
        const float f = __builtin_amdgcn_exp2f(-dl); l *= f; if (hi == 0) wsf[r32] = f;
#pragma unroll
        for (int i = 0; i < 4; ++i) { const f32x4 f4 = *(const LAS f32x4*)(wsf + 8 * i + 4 * hi);
#pragma unroll
            for (int k = 0; k < 4; ++k) { o[0][4 * i + k] *= f4[k]; o[1][4 * i + k] *= f4[k]; } } }
    float s = 0.f;
#pragma unroll
    for (int r = 0; r < 16; ++r) { p0[r] = __builtin_amdgcn_exp2f(p0[r]); p1[r] = __builtin_amdgcn_exp2f(p1[r]); s += p0[r] + p1[r]; }
    l += s;
}

#define AT_CONSUME4(a, b, c, d) asm volatile("" :: "v"(a), "v"(b), "v"(c), "v"(d))

__device__ __forceinline__ void fox_unit(Frame& F, int bh, int qb, int kt0, const int ABL) {
    int tid_ = cur_tid(F); asm volatile("" : "+v"(tid_));
    const int lane = tid_ & 63, r32 = lane & 31, hi = lane >> 5, wid = F.wave; const int b = bh >> 3, h = bh & 7;
    LAS unsigned char* shm = F.lds + RING_OFF; const unsigned lds0 = (unsigned)(uintptr_t)shm;
    LAS float* wsf = (LAS float*)(shm + L_WS + wid * 512);
    const size_t rowbase = (size_t)b * SEQ; const int q0 = qb * 256;
    const bf16* Q = wsp<bf16>(F, WS_FQ); const bf16* K = wsp<bf16>(F, WS_FK) + (rowbase + (size_t)kt0 * 64) * 512 + h * 64; const bf16* V = wsp<bf16>(F, WS_FV) + (rowbase + (size_t)kt0 * 64) * 512 + h * 64;
    const bf16* KX = wsp<bf16>(F, WS_FKX) + ((size_t)bh * SEQ + (size_t)kt0 * 64) * 16;
    const unsigned koff = (unsigned)(lane * 512 + wid * 8) * 2u, voff = (unsigned)((16 * (wid & 3) + (lane >> 2)) * 512 + (wid >> 2) * 32 + (lane & 3) * 8) * 2u;
    const unsigned xoff = (unsigned)((16 * (wid & 3) + (lane >> 2)) * 16 + (wid >> 2) * 8 + (lane & 3) * 2) * 2u;
    const unsigned kdst = lds0 + L_K + wid * 1024, vdst = lds0 + L_V + wid * 1024, xdst = lds0 + L_K + (8 + (wid >> 2)) * 1024 + (wid & 3) * 256;
#define FX_DMA_K(t, slot) do { glds16(K + (size_t)(t) * 64 * 512, koff, (unsigned)__builtin_amdgcn_readfirstlane(kdst + (slot) * KSLOT)); \
        glds4(KX + (size_t)(t) * 64 * 16, xoff, (unsigned)__builtin_amdgcn_readfirstlane(xdst + (slot) * KSLOT)); } while (0)
#define FX_DMA_V(t, slot) glds16(V + (size_t)(t) * 64 * 512, voff, (unsigned)__builtin_amdgcn_readfirstlane(vdst + (slot) * VSLOT))
    const int NT = 4 * qb + 4 - kt0;
    bf16x8 qr[5];
    { const bf16* Qw = Q + (rowbase + q0 + wid * 32 + r32) * 512 + h * 64;
#pragma unroll
      for (int d0 = 0; d0 < 4; ++d0) qr[d0] = *(const GAS bf16x8*)(Qw + d0 * 16 + hi * 8);
      const short one = (short)0x3F80; qr[4] = hi == 0 ? (bf16x8){one, one, one, 0, 0, 0, 0, 0} : (bf16x8){0, 0, 0, 0, 0, 0, 0, 0}; }
    const float ct = wsp<float>(F, WS_C)[(size_t)bh * SEQ + q0 + wid * 32 + r32] * LOG2E;
    asm volatile("" ::: "memory");
    FX_DMA_K(0, 0); FX_DMA_V(0, 0); FX_DMA_K(1, 1); FX_DMA_K(2, 2); FX_DMA_V(1, 1);
    f32x16 cinit;
    f32x16 o[2]; o[0] = f32x16{}; o[1] = f32x16{}; float l = 0.f;
    const int qrel = wid * 32 + r32;
    const LAS unsigned char* vtb = shm + L_V + ((lane >> 4) & 1) * 32 + (lane & 3) * 8 + (4 * hi + ((lane & 15) >> 2)) * 64;
    bf16x8 kf[10], vf[8];
    AT_WAIT_BAR(3);
    AT_CONSUME4(qr[0], qr[1], qr[2], qr[3]); asm volatile("" :: "v"(ct));
#pragma unroll
    for (int r = 0; r < 16; ++r) cinit[r] = ct;
    load_kf<5>(kf, shm + L_K, r32, hi);
    int s0 = 0, s1 = 1, s2 = 2;
#define FX_MASK(n) do { const int jb_ = (n) - (NT - 4); if (jb_ >= 0) { const int kb_ = 64 * jb_ + 4 * hi; \
        _Pragma("unroll") for (int r = 0; r < 16; ++r) { const int kv = kb_ + (r & 3) + 8 * (r >> 2); if (kv > qrel) p0[r] = AT_NEG; if (kv + 32 > qrel) p1[r] = AT_NEG; } } } while (0)
#define FX_ROT() do { const int t_ = s0; s0 = s1; s1 = s2; s2 = t_; } while (0)
    if (ABL != 7) {
    {
      AT_WAIT_BAR(3); FX_DMA_K(3, 0); FX_DMA_V(2, 2);
      f32x16 p0, p1; qk_regs<5>(p0, p1, kf, qr, cinit); v_load(vf, vtb); __builtin_amdgcn_sched_barrier(0);
      FX_MASK(0); softmax_first(p0, p1, cinit, l); pv_regs<5, true>(o, vf, p0, p1, kf, shm + L_K + KSLOT, r32, hi); FX_ROT(); }
    int n = 1;
    for (; n + 3 < NT; ++n) {
        if (ABL == 4) asm volatile("s_waitcnt vmcnt(3) lgkmcnt(0)" ::: "memory"); else AT_WAIT_BAR(3);
        if (ABL != 5) { FX_DMA_K(n + 3, s0); FX_DMA_V(n + 2, s2); }
        f32x16 p0, p1; if (ABL == 3) { p0 = cinit; p1 = cinit; asm volatile("" : "+v"(p0), "+v"(p1)); } else qk_regs<5>(p0, p1, kf, qr, cinit);
        v_load(vf, vtb + s0 * VSLOT); __builtin_amdgcn_sched_barrier(0);
        FX_MASK(n);
        if (ABL == 6) { asm volatile("" : "+v"(p0), "+v"(p1)); }
        else if (ABL == 1) { const float rm = rowmax32(p0, p1); l += rm; asm volatile("" : "+v"(p0), "+v"(p1)); }
        else softmax_next(p0, p1, cinit, l, o, wsf, r32, hi);
        if (ABL == 2) { asm volatile("" :: "v"(p0), "v"(p1), "v"(vf[0]), "v"(vf[1]), "v"(vf[2]), "v"(vf[3]), "v"(vf[4]), "v"(vf[5]), "v"(vf[6]), "v"(vf[7])); load_kf<5>(kf, shm + L_K + s1 * KSLOT, r32, hi); }
        else pv_regs<5, true>(o, vf, p0, p1, kf, shm + L_K + s1 * KSLOT, r32, hi);
        FX_ROT(); }
    {
      AT_WAIT_BAR(3); FX_DMA_V(n + 2, s2);
      f32x16 p0, p1; qk_regs<5>(p0, p1, kf, qr, cinit); v_load(vf, vtb + s0 * VSLOT); __builtin_amdgcn_sched_barrier(0);
      FX_MASK(n); softmax_next(p0, p1, cinit, l, o, wsf, r32, hi); pv_regs<5, true>(o, vf, p0, p1, kf, shm + L_K + s1 * KSLOT, r32, hi); FX_ROT(); ++n; }
    {
      AT_WAIT_BAR(1);
      f32x16 p0, p1; qk_regs<5>(p0, p1, kf, qr, cinit); v_load(vf, vtb + s0 * VSLOT); __builtin_amdgcn_sched_barrier(0);
      FX_MASK(n); softmax_next(p0, p1, cinit, l, o, wsf, r32, hi); pv_regs<5, true>(o, vf, p0, p1, kf, shm + L_K + s1 * KSLOT, r32, hi); FX_ROT(); ++n; }
    {
      AT_WAIT_BAR(0);
      f32x16 p0, p1; qk_regs<5>(p0, p1, kf, qr, cinit); v_load(vf, vtb + s0 * VSLOT); __builtin_amdgcn_sched_barrier(0);
      FX_MASK(n); softmax_next(p0, p1, cinit, l, o, wsf, r32, hi); pv_regs<5, false>(o, vf, p0, p1, kf, shm, r32, hi); }
    } else { asm volatile("s_waitcnt vmcnt(0)" ::: "memory"); l = 1.f; }
#undef FX_DMA_K
#undef FX_DMA_V
#undef FX_MASK
#undef FX_ROT
    l = sum_half(l); float rl[16]; row_bcast(1.0f / l, rl, wsf, r32, hi);
#pragma unroll
    for (int r = 0; r < 16; ++r) { o[0][r] *= rl[r]; o[1][r] *= rl[r]; }
    store_rows(o, shm + L_PARK + wid * 8192, wsp<bf16>(F, ABL ? WS_PROBE_O : WS_ATT) + (rowbase + q0 + wid * 32) * 1024 + 512 + h * 64, 1024, lane, r32, hi);
    AT_BAR();
}

__device__ __forceinline__ void nsa_unit(Frame& F, int bg, int j) {
    int tid_ = cur_tid(F); asm volatile("" : "+v"(tid_));
    const int tid = tid_, lane = tid & 63, r32 = lane & 31, hi = lane >> 5, wid = F.wave; const int b = bg >> 1, g = bg & 1, hh = wid >> 1, head = 4 * g + hh;
    LAS unsigned char* shm = F.lds + RING_OFF; const unsigned lds0 = (unsigned)(uintptr_t)shm;
    LAS float* wsf = (LAS float*)(shm + L_WS + wid * 512);
    LAS float* PSL = (LAS float*)(shm + L_PSL); LAS unsigned* SELM = (LAS unsigned*)(shm + L_SELM);
    const int qrel = 32 * (wid & 1) + r32, t = 64 * j + qrel; const size_t row = (size_t)b * SEQ + t;
    const bf16* KC = wsp<bf16>(F, WS_KCMP) + (size_t)bg * 128 * 64; const bf16* VC = wsp<bf16>(F, WS_VCMP) + (size_t)bg * 128 * 64;
    const bf16* KS = wsp<bf16>(F, WS_KV + 2 * KV_STRIDE) + (size_t)bg * SEQ * 64; const bf16* VS = wsp<bf16>(F, WS_KV + 3 * KV_STRIDE) + (size_t)bg * SEQ * 64;
    const bf16* KW = wsp<bf16>(F, WS_KV + 4 * KV_STRIDE) + (size_t)bg * SEQ * 64; const bf16* VW = wsp<bf16>(F, WS_KV + 5 * KV_STRIDE) + (size_t)bg * SEQ * 64;
    const unsigned koff = (unsigned)(lane * 64 + wid * 8) * 2u, voff = (unsigned)((16 * (wid & 3) + (lane >> 2)) * 64 + (wid >> 2) * 32 + (lane & 3) * 8) * 2u;
    const unsigned kdst = lds0 + L_K + wid * 1024, vdst = lds0 + L_V + wid * 1024, cdst = lds0 + L_CMP + wid * 1024;
    const int nsel = j + 1, nwin = j >= 8 ? 9 : j + 1, NR = nsel + nwin;
#define NS_TILE(m) ({ int m_ = (m); m_ = m_ < NR ? m_ : NR - 1; (m_ < nsel) ? m_ : (j - (m_ - nsel)) + 64; })
#define NS_DMA_K(m, slot) do { const int e_ = NS_TILE(m); const bf16* kp_ = (e_ < 64) ? KS + e_ * 4096 : KW + (e_ - 64) * 4096; glds16(kp_, koff, (unsigned)__builtin_amdgcn_readfirstlane(kdst + (slot) * KSLOT)); } while (0)
#define NS_DMA_V(m, slot) do { const int e_ = NS_TILE(m); const bf16* vp_ = (e_ < 64) ? VS + e_ * 4096 : VW + (e_ - 64) * 4096; glds16(vp_, voff, (unsigned)__builtin_amdgcn_readfirstlane(vdst + (slot) * VSLOT)); } while (0)
    bf16x8 qr[5];
    { const bf16* Qw = wsp<bf16>(F, WS_NQ) + row * 512 + head * 64;
#pragma unroll
      for (int d0 = 0; d0 < 4; ++d0) qr[d0] = *(const GAS bf16x8*)(Qw + d0 * 16 + hi * 8);
      qr[4] = (bf16x8){0, 0, 0, 0, 0, 0, 0, 0}; }
    const float* gt = wsp<float>(F, WS_GATE) + row * 24 + head * 3; const float g0 = gt[0], g1 = gt[1], g2 = gt[2];
    asm volatile("" ::: "memory");
    glds16(KC, koff, (unsigned)__builtin_amdgcn_readfirstlane(cdst)); glds16(KC + 4096, koff, (unsigned)__builtin_amdgcn_readfirstlane(cdst + 8192));
    glds16(VC, voff, (unsigned)__builtin_amdgcn_readfirstlane(cdst + 16384)); glds16(VC + 4096, voff, (unsigned)__builtin_amdgcn_readfirstlane(cdst + 24576));
    NS_DMA_K(0, 0); NS_DMA_V(0, 0); NS_DMA_K(1, 1); NS_DMA_K(2, 2); NS_DMA_V(1, 1);
    const LAS unsigned char* vlane = shm + ((lane >> 4) & 1) * 32 + (lane & 3) * 8 + (4 * hi + ((lane & 15) >> 2)) * 64;
    const LAS unsigned char* vtb = vlane + L_V;
    f32x16 o[2]; float rs[16]; bf16x8 kf[10], vf[8];
    LAS float* park = (LAS float*)(shm + L_PARK + wid * 8192) + lane;
    AT_WAIT_BAR(5);
    AT_CONSUME4(qr[0], qr[1], qr[2], qr[3]); asm volatile("" :: "v"(g0), "v"(g1), "v"(g2));
    { f32x16 zero = f32x16{}; f32x16 a0, a1, b0, b1;
      load_kf<4>(kf, shm + L_CMP, r32, hi); qk_regs<4>(a0, a1, kf, qr, zero); load_kf<4>(kf, shm + L_CMP + 8192, r32, hi); qk_regs<4>(b0, b1, kf, qr, zero);
      const int nmax = (t - 31) >> 4;
#pragma unroll
      for (int r = 0; r < 16; ++r) { const int n = (r & 3) + 8 * (r >> 2) + 4 * hi; if (n > nmax) a0[r] = AT_NEG; if (n + 32 > nmax) a1[r] = AT_NEG; if (n + 64 > nmax) b0[r] = AT_NEG; if (n + 96 > nmax) b1[r] = AT_NEG; }
      float m = __builtin_fmaxf(rowmax32(a0, a1), rowmax32(b0, b1)); m = (m == AT_NEG) ? 0.f : m;
      float s = 0.f;
#pragma unroll
      for (int r = 0; r < 16; ++r) { a0[r] = __builtin_amdgcn_exp2f(a0[r] - m); a1[r] = __builtin_amdgcn_exp2f(a1[r] - m); b0[r] = __builtin_amdgcn_exp2f(b0[r] - m); b1[r] = __builtin_amdgcn_exp2f(b1[r] - m); s += (a0[r] + a1[r]) + (b0[r] + b1[r]); }
      s = sum_half(s); const float inv = 1.0f / fmaxf(s, 1e-30f);
#pragma unroll
      for (int r = 0; r < 16; ++r) { a0[r] *= inv; a1[r] *= inv; b0[r] *= inv; b1[r] *= inv; }
      if (j >= 8) {
          float G[16], Lp[16];
#pragma unroll
          for (int i = 0; i < 4; ++i) { G[i] = (a0[4 * i] + a0[4 * i + 1]) + (a0[4 * i + 2] + a0[4 * i + 3]); G[4 + i] = (a1[4 * i] + a1[4 * i + 1]) + (a1[4 * i + 2] + a1[4 * i + 3]);
              G[8 + i] = (b0[4 * i] + b0[4 * i + 1]) + (b0[4 * i + 2] + b0[4 * i + 3]); G[12 + i] = (b1[4 * i] + b1[4 * i + 1]) + (b1[4 * i + 2] + b1[4 * i + 3]);
              Lp[i] = swap_half(a0[4 * i + 3], hi); Lp[4 + i] = swap_half(a1[4 * i + 3], hi); Lp[8 + i] = swap_half(b0[4 * i + 3], hi); Lp[12 + i] = swap_half(b1[4 * i + 3], hi); }
          LAS float* dst = PSL + (hh * 64 + qrel) * 33 + hi;
#pragma unroll
          for (int I = 0; I < 16; ++I) { const float prev = hi ? Lp[I] : (I > 0 ? Lp[I > 0 ? I - 1 : 0] : 0.f); dst[2 * I] = G[I] + prev; }
      }
      o[0] = f32x16{}; o[1] = f32x16{};
      pv(o, vlane + L_CMP + 16384, a0, a1); pv(o, vlane + L_CMP + 24576, b0, b1);
    }
    AT_BAR();
    if (j >= 8) { const int q = tid >> 3, sub = tid & 7;
        float v[4]; unsigned bits = 1u | (1u << j) | (1u << (j - 1));
#pragma unroll
        for (int c4 = 0; c4 < 4; ++c4) { const int k = 4 * sub + c4;
            const float ps = (PSL[(0 * 64 + q) * 33 + k] + PSL[(1 * 64 + q) * 33 + k]) + (PSL[(2 * 64 + q) * 33 + k] + PSL[(3 * 64 + q) * 33 + k]);
            v[c4] = (k > j - 2 || k == 0) ? -1e30f : ps; }
#pragma unroll 1
        for (int rnd = 0; rnd < 5; ++rnd) {
            float bv = v[0]; int bi = 4 * sub;
#pragma unroll
            for (int c4 = 1; c4 < 4; ++c4) if (v[c4] > bv) { bv = v[c4]; bi = 4 * sub + c4; }
#pragma unroll
            for (int o = 1; o < 8; o <<= 1) { const float ov = __shfl_xor(bv, o); const int oi = __shfl_xor(bi, o); if (ov > bv || (ov == bv && oi < bi)) { bv = ov; bi = oi; } }
            bits |= 1u << bi;
#pragma unroll
            for (int c4 = 0; c4 < 4; ++c4) if (bi == 4 * sub + c4) v[c4] = -3.0e38f; }
        if (sub == 0) SELM[q] = bits;
    } else { if (tid < 64) SELM[tid] = (2u << j) - 1u; }
    AT_BAR();
    const unsigned selm = SELM[qrel];
    row_bcast(g0, rs, wsf, r32, hi);
#pragma unroll
    for (int r = 0; r < 16; ++r) { park[r * 64] = o[0][r] * rs[r]; park[(16 + r) * 64] = o[1][r] * rs[r]; }
    f32x16 cinit; float l;
    AT_WAIT_BAR(2);
    load_kf<4>(kf, shm + L_K, r32, hi);
    int s0 = 0, s1 = 1, s2 = 2, m = 0;
#define NS_ROT() do { const int t_ = s0; s0 = s1; s1 = s2; s2 = t_; ++m; } while (0)
#define NS_HEAD() AT_WAIT_BAR(2); NS_DMA_K(m + 3, s0); NS_DMA_V(m + 2, s2); f32x16 p0, p1; qk_regs<4>(p0, p1, kf, qr, cinit); v_load(vf, vtb + s0 * VSLOT); __builtin_amdgcn_sched_barrier(0)
#define NS_MASK_SEL() do { const float keep_ = ((selm >> m) & 1u) ? 0.f : AT_NEG;        \
        _Pragma("unroll") for (int r = 0; r < 16; ++r) { p0[r] += keep_; p1[r] += keep_; } \
        if (m == j) {   \
        _Pragma("unroll") for (int r = 0; r < 16; ++r) { const int kk = (r & 3) + 8 * (r >> 2) + 4 * hi; if (kk > qrel) p0[r] = AT_NEG; if (kk + 32 > qrel) p1[r] = AT_NEG; } } } while (0)
#define NS_MASK_WIN() do { const int tt = j - (m - nsel); if (tt == j) { \
        _Pragma("unroll") for (int r = 0; r < 16; ++r) { const int kk = (r & 3) + 8 * (r >> 2) + 4 * hi; if (kk > qrel) p0[r] = AT_NEG; if (kk + 32 > qrel) p1[r] = AT_NEG; } } \
      else if (tt == j - 8) {   \
        _Pragma("unroll") for (int r = 0; r < 16; ++r) { const int kk = (r & 3) + 8 * (r >> 2) + 4 * hi; if (kk <= qrel) p0[r] = AT_NEG; if (kk + 32 <= qrel) p1[r] = AT_NEG; } } } while (0)
    cinit = f32x16{}; o[0] = f32x16{}; o[1] = f32x16{};
    { NS_HEAD(); NS_MASK_SEL(); softmax_first(p0, p1, cinit, l); pv_regs<4, true>(o, vf, p0, p1, kf, shm + L_K + s1 * KSLOT, r32, hi); NS_ROT(); }
    for (; m < nsel;) { NS_HEAD(); NS_MASK_SEL(); softmax_next(p0, p1, cinit, l, o, wsf, r32, hi); pv_regs<4, true>(o, vf, p0, p1, kf, shm + L_K + s1 * KSLOT, r32, hi); NS_ROT(); }
    l = sum_half(l); row_bcast(g1 / l, rs, wsf, r32, hi);
#pragma unroll
    for (int r = 0; r < 16; ++r) { park[r * 64] += o[0][r] * rs[r]; park[(16 + r) * 64] += o[1][r] * rs[r]; }
    cinit = f32x16{}; o[0] = f32x16{}; o[1] = f32x16{};
    { NS_HEAD(); NS_MASK_WIN(); softmax_first(p0, p1, cinit, l); pv_regs<4, true>(o, vf, p0, p1, kf, shm + L_K + s1 * KSLOT, r32, hi); NS_ROT(); }
    for (; m < NR;) { NS_HEAD(); NS_MASK_WIN(); softmax_next(p0, p1, cinit, l, o, wsf, r32, hi); pv_regs<4, true>(o, vf, p0, p1, kf, shm + L_K + s1 * KSLOT, r32, hi); NS_ROT(); }
#undef NS_HEAD
#undef NS_TILE
#undef NS_DMA_K
#undef NS_DMA_V
#undef NS_ROT
#undef NS_MASK_SEL
#undef NS_MASK_WIN
    l = sum_half(l); row_bcast(g2 / l, rs, wsf, r32, hi);
#pragma unroll
    for (int r = 0; r < 16; ++r) { o[0][r] = park[r * 64] + o[0][r] * rs[r]; o[1][r] = park[(16 + r) * 64] + o[1][r] * rs[r]; }
    asm volatile("s_waitcnt vmcnt(0) lgkmcnt(0)" ::: "memory");
    store_rows(o, shm + L_PARK + wid * 8192, wsp<bf16>(F, WS_ATT) + ((size_t)b * SEQ + 64 * j + 32 * (wid & 1)) * 1024 + head * 64, 1024, lane, r32, hi);
    AT_BAR();
}
constexpr int NUNITS = 4096;
__device__ const unsigned short BLK_TAB[64] = {64512, 63489, 62466, 61443, 60420, 59397, 58374, 57351, 56328, 55305, 54282, 53259, 52236, 51213, 50190, 49167, 48144, 47121, 46098, 45075, 44052, 43029, 42006, 40983, 39960, 38937, 37914, 36891, 35868, 2077, 2077, 2077, 2077, 3105, 3105, 3105, 3105, 4133, 4133, 4133, 4133, 5161, 5161, 5161, 5161, 6189, 6189, 6189, 6189, 7217, 7217, 7217, 7217, 34869, 1078, 1078, 1078, 1078, 33850, 32827, 60, 60, 60, 60};
}
__device__ __forceinline__ void p3_attention(Frame& F, const int MODE) {
    const int G = F.G, c = F.vcu, nrounds = (at::NUNITS + G - 1) / G;
    const gu32* KT0 = (const gu32*)wsp<unsigned>(F, WS_KT0);
#define P3_UNIT(i) ((i) * G + (((i) & 1) ? G - 1 - c : c))
#define P3_KT0_IDX(u) ({ const unsigned tb_ = at::BLK_TAB[(u) >> 6]; const int ix_ = (u) - (int)(tb_ & 1023u) * 64; (tb_ >> 15) ? 0 : ix_ * 8 + (int)((tb_ >> 10) & 31u); })
    unsigned kt_next = 0u;
    { const int u0 = P3_UNIT(0); if (u0 < at::NUNITS) kt_next = __hip_atomic_load(KT0 + P3_KT0_IDX(u0), RLX_AGENT); }
    for (int i = 0; i < nrounds; ++i) {
        const int u = P3_UNIT(i); if (u >= at::NUNITS) continue;
        const int kt0 = __builtin_amdgcn_readfirstlane((int)kt_next);
        { const int un = P3_UNIT(i + 1); if (i + 1 < nrounds && un < at::NUNITS) kt_next = __hip_atomic_load(KT0 + P3_KT0_IDX(un), RLX_AGENT); }
        const unsigned tab = at::BLK_TAB[u >> 6]; const int idx = u - (int)(tab & 1023u) * 64; const int par = (tab >> 10) & 31;
#ifndef PROBE_ABL
#define PROBE_ABL 0
#endif
        if (tab >> 15) { if (MODE != 1) at::nsa_unit(F, idx, par); } else { if (MODE != 2) at::fox_unit(F, idx, par, kt0, MODE == 1 ? PROBE_ABL : 0); }
    }
#undef P3_UNIT
#undef P3_KT0_IDX
    asm volatile("s_waitcnt vmcnt(0) lgkmcnt(0)" ::: "memory");
    __syncthreads();
}

struct Args { const float* in[18]; float* out; unsigned char* ws; int ph_lo, ph_hi, li, pad; };
__global__ void __launch_bounds__(NWAVES * 64, 2) fwd_kernel(Args args) {
    extern __shared__ __attribute__((aligned(16))) unsigned char lds[];
    Frame F;
    F.lds = (LAS unsigned char*)lds;
    F.MISC = (volatile LAS unsigned*)(F.lds + MISC_OFF);
    F.wave = __builtin_amdgcn_readfirstlane((int)threadIdx.x >> 6);
    F.G = gridDim.x; { const int bx = blockIdx.x; F.vcu = (F.G % 8 == 0) ? (bx % 8) * (F.G / 8) + bx / 8 : bx; }
    F.ws = args.ws; F.ctl = (gu32*)(args.ws + WS_CTL);
    F.x = args.in[0]; F.g_mix_pre = args.in[1]; F.g_mix_post = args.in[2]; F.g_mlp_pre = args.in[3]; F.g_mlp_post = args.in[4]; F.w_in = args.in[5]; F.b_forget = args.in[6];
    F.pos_k = args.in[7]; F.w1_k = args.in[8]; F.w2_k = args.in[9]; F.pos_v = args.in[10]; F.w1_v = args.in[11]; F.w2_v = args.in[12];
    F.w_fox = args.in[13]; F.w_nsa = args.in[14]; F.w_o = args.in[15]; F.w_up = args.in[16]; F.w_down = args.in[17]; F.out = args.out;
    for (int u = (int)threadIdx.x; u < (LDS_BYTES - LDSCTL_OFF) / 4; u += NWAVES * 64) ((LAS unsigned*)(F.lds + LDSCTL_OFF))[u] = 0u;
    __syncthreads();
    XcdBarrier bar; bar.bar = (unsigned*)(F.ctl + CW_BAR); bar.x = 0; bar.st = nullptr;
    if (N_LAUNCHES == 1) bar = xcd_barrier_post((unsigned*)(F.ctl + CW_BAR), F.MISC + 8);
#define GRID_BAR() do { if (N_LAUNCHES == 1) xcd_barrier(bar); } while (0)
    const int lo = args.ph_lo, hi = args.ph_hi;
#define IN(k) (lo <= (k) && (k) < hi)
#define BOTH(k) (IN(k) && IN((k) + 1))
#ifndef STAGGER_P7
#define STAGGER_P7 0
#endif
#ifndef STAGGER_P1
#define STAGGER_P1 0
#endif
#define XCD_STAGGER(ticks) do { if ((ticks) > 0) { const unsigned long long t0_ = rt(); const unsigned long long d_ = (unsigned long long)(xb_xcc_id() & 7u) * (unsigned)(ticks) / 8u; while (rt() - t0_ < d_) __builtin_amdgcn_s_sleep(8); } } while (0)
#ifndef PROBE_REPEAT
#define PROBE_REPEAT (-1)
#endif
#define REPS(k) for (int rep_ = 0; rep_ < ((PROBE_REPEAT == (k)) ? 2 : 1); ++rep_)
#define REP_BAR(k) do { if (PROBE_REPEAT == (k) && rep_ == 0) { VM_WAIT(); __syncthreads(); GRID_BAR(); } } while (0)

    if (IN(0)) { REPS(0) { p0_prologue(F); REP_BAR(0); } if (BOTH(0)) GRID_BAR(); }

    if (IN(1)) { XCD_STAGGER(STAGGER_P1);
        pg8::Gemm g{wsp<bf16>(F, WS_HB), wsp<bf16>(F, WS_WIN), MTOK, NPROJ, DMODEL}; pg8::StaticOrder S; S.init(MTOK, NPROJ, F.G, (int)blockIdx.x);
        pg8::EpiInProj E{wsp<bf16>(F, WS_FQ), wsp<bf16>(F, WS_NQ), wsp<bf16>(F, WS_KV), wsp<bf16>(F, WS_SGA),
                         wsp<float>(F, WS_LF), wsp<float>(F, WS_GATE), F.b_forget, wsp<float>(F, WS_ROPEC), wsp<float>(F, WS_ROPES), (WS_FK - WS_FQ) / 2, KV_STRIDE / 2, (WS_SGB - WS_SGA) / 2, QSCALE};
        REPS(1) { pg8::gemm_phase<pg8::EpiInProj, pg8::StaticOrder, true, true>(F.lds + RING_OFF, g, S, E, F.wave); REP_BAR(1); }
        if (BOTH(1)) GRID_BAR();
    }
    if (IN(2)) { REPS(2) { p2_phase(F); REP_BAR(2); } if (BOTH(2)) GRID_BAR(); }
#ifndef PROBE_P3_MODE
#define PROBE_P3_MODE 3
#endif
    if (IN(3)) {
#if PROBE_REPEAT == 3
        for (int rep_ = 0; rep_ < 2; ++rep_) { p3_attention(F, rep_ ? PROBE_P3_MODE : 0); if (rep_ == 0) { VM_WAIT(); __syncthreads(); GRID_BAR(); } }
#else
        p3_attention(F, 0);
#endif
        if (BOTH(3)) GRID_BAR(); }
    if (IN(4)) { REPS(4) {
        pg8::Gemm g{wsp<bf16>(F, WS_ATT), wsp<bf16>(F, WS_WF), MTOK, DMODEL, DMODEL}; pg8::StaticOrder S; S.init(MTOK, DMODEL, F.G, (int)blockIdx.x);
        pg8::EpiGateMid E{wsp<bf16>(F, WS_HB), wsp<bf16>(F, WS_SGA), wsp<bf16>(F, WS_SGB), DMODEL};
        pg8::gemm_phase<pg8::EpiGateMid, pg8::StaticOrder, true, true>(F.lds + RING_OFF, g, S, E, F.wave);
        REP_BAR(4); }
        if (BOTH(4)) GRID_BAR();
    }
    if (IN(5)) {
        pg8::Gemm g{wsp<bf16>(F, WS_HB), wsp<bf16>(F, WS_WO), MTOK, DMODEL, DMODEL}; pg8::StaticOrder S; S.init(MTOK, DMODEL, F.G, (int)blockIdx.x);
        pg8::EpiPlain<0> E{wsp<bf16>(F, WS_Y), DMODEL};
        REPS(5) { pg8::gemm_phase<pg8::EpiPlain<0>, pg8::StaticOrder, true, true>(F.lds + RING_OFF, g, S, E, F.wave); REP_BAR(5); }
        if (BOTH(5)) GRID_BAR();
    }
    if (IN(6)) { REPS(6) { row_pass<false>(F, F.x, nullptr, wsp<bf16>(F, WS_Y), F.g_mix_post, nullptr, wsp<bf16>(F, WS_HB), wsp<float>(F, WS_RSTD2)); REP_BAR(6); } if (BOTH(6)) GRID_BAR(); }
#ifndef MLP_CHUNKS
#define MLP_CHUNKS 1
#endif
    if (IN(7) || IN(8)) {
        constexpr int CH = MLP_CHUNKS, MC = MTOK / CH;
#pragma unroll
        for (int ch = 0; ch < CH; ++ch) {
            if (IN(7)) { XCD_STAGGER(STAGGER_P7);
                pg8::Gemm g{wsp<bf16>(F, WS_HB) + (size_t)ch * MC * DMODEL, wsp<bf16>(F, WS_WUP), MC, DFF, DMODEL}; pg8::StaticOrder S; S.init(MC, DFF, F.G, (int)blockIdx.x);
                pg8::EpiRelu2Rs E{wsp<bf16>(F, WS_U) + (size_t)ch * MC * DFF, wsp<float>(F, WS_RSTD2) + (size_t)ch * MC, DFF};
                pg8::gemm_phase<pg8::EpiRelu2Rs, pg8::StaticOrder, true, true>(F.lds + RING_OFF, g, S, E, F.wave);
                if (IN(8)) GRID_BAR(); }
            if (IN(8)) {
                pg8::Gemm g{wsp<bf16>(F, WS_U) + (size_t)ch * MC * DFF, wsp<bf16>(F, WS_WDN), MC, DMODEL, DFF}; pg8::StaticOrder S; S.init(MC, DMODEL, F.G, (int)blockIdx.x);
                pg8::EpiPlain<0> E{wsp<bf16>(F, WS_Y) + (size_t)ch * MC * DMODEL, DMODEL};
                pg8::gemm_phase<pg8::EpiPlain<0>, pg8::StaticOrder, true, true>(F.lds + RING_OFF, g, S, E, F.wave);
                if (ch + 1 == CH && BOTH(8)) GRID_BAR(); }
        }
    }
    if (IN(9)) { row_pass<true>(F, nullptr, wsp<bf16>(F, WS_HB), wsp<bf16>(F, WS_Y), F.g_mlp_post, F.out, nullptr, nullptr); }
#undef IN
#undef BOTH
#undef GRID_BAR
}

extern "C" void kernel_launch(void* const* d_in, const int* in_sizes, int n_in, void* d_out, int out_size, void* d_ws, size_t ws_size, hipStream_t stream) {
    static int grid = 0;
    if (grid == 0) {
        if (n_in != 18 || in_sizes[0] != MTOK * DMODEL || out_size != MTOK * DMODEL || ws_size < WS_END) {
            fprintf(stderr, "kernel_launch: built for 18 inputs, x/out of %d floats, >= %zu bytes of workspace; got n_in %d, in0 %d, out %d, ws %zu; nothing launched\n", MTOK * DMODEL, (size_t)WS_END, n_in, n_in > 0 ? in_sizes[0] : -1, out_size, ws_size); grid = -1; return; }
        int dev = 0, cus = 0, per_cu = 0;
        if (hipGetDevice(&dev) != hipSuccess || hipDeviceGetAttribute(&cus, hipDeviceAttributeMultiprocessorCount, dev) != hipSuccess) { fprintf(stderr, "kernel_launch: device query failed\n"); grid = -1; return; }
        if (hipFuncSetAttribute((const void*)fwd_kernel, hipFuncAttributeMaxDynamicSharedMemorySize, LDS_BYTES) != hipSuccess) { fprintf(stderr, "kernel_launch: hipFuncSetAttribute failed\n"); grid = -1; return; }
        if (hipOccupancyMaxActiveBlocksPerMultiprocessor(&per_cu, (const void*)fwd_kernel, NWAVES * 64, LDS_BYTES) != hipSuccess || per_cu < 1)
            fprintf(stderr, "kernel_launch: note: occupancy query reports %d workgroups per CU\n", per_cu);
        (void)hipGetLastError();
        grid = 256;
        if (cus < grid) fprintf(stderr, "kernel_launch: this device reports %d CUs; the 256-workgroup grid cannot be resident: the grid barrier will time out (bounded) and the output will be wrong\n", cus);
    }
    if (grid < 0) return;
    if (hipMemsetAsync((char*)d_ws + WS_CTL, 0, CTL_ZERO_BYTES, stream) != hipSuccess) { fprintf(stderr, "kernel_launch: hipMemsetAsync failed\n"); return; }
    Args a{};
    for (int i = 0; i < 18; ++i) a.in[i] = (const float*)d_in[i];
    a.out = (float*)d_out; a.ws = (unsigned char*)d_ws;
    for (int li = 0; li < N_LAUNCHES; ++li) {
        a.ph_lo = (N_LAUNCHES == 1) ? 0 : li; a.ph_hi = (N_LAUNCHES == 1) ? N_PHASES : li + 1; a.li = li; a.pad = 0;
        hipLaunchKernelGGL(fwd_kernel, dim3(grid), dim3(NWAVES * 64), LDS_BYTES, stream, a);
        const hipError_t le = hipPeekAtLastError();
        if (le != hipSuccess) { fprintf(stderr, "kernel_launch: launch %d failed: %s\n", li, hipGetErrorName(le)); break; }
    }
}
```

```cpp
#include <hip/hip_runtime.h>
#include <cstdio>
#include <cstdint>
#include <cmath>
namespace pg8 {
#define PG8_LAS __attribute__((address_space(3)))
typedef unsigned short bf16_t;
typedef short bf16x8 __attribute__((ext_vector_type(8)));
typedef float f32x4 __attribute__((ext_vector_type(4)));
typedef unsigned u32x4 __attribute__((ext_vector_type(4)));
constexpr int BM = 256, BK = 64, HALF = 128, HTB = HALF * BK * 2  , STAGE_BYTES = 8 * HTB, NXCD = 8, WGM = 8;

__host__ __device__ __forceinline__ int lds_byte(int r, int c) { const int st = (r >> 4) * 2 + (c >> 5), rr = r & 15, cc = c & 31, ob = rr * 64 + cc * 2; return st * 1024 + (ob ^ (((ob >> 9) & 1) << 5)); }
__host__ __device__ __forceinline__ void stage_rc(int b, int& R, int& C) { const int st = b / 1024, sb = b % 1024, swz = sb ^ (((sb >> 9) & 1) << 5); R = (st >> 1) * 16 + swz / 64; C = (st & 1) * 32 + (swz % 64) / 2; }
__host__ __device__ __forceinline__ int perm32(int rho) { const int n = rho >> 4, i = rho & 15; return 8 * (i >> 2) + 4 * n + (i & 3); }

struct Unit { int pm, pn; };
struct Gemm { const bf16_t* A; const bf16_t* Bt; int M, N, K; };

struct StaticOrder {
    int nM, nN, nwg, G, c;
    __host__ __device__ void init(int M, int N, int G_, int c_) { nM = M / BM; nN = N / BM; nwg = nM * nN; G = G_; c = c_; }
    __host__ __device__ bool next(int i, Unit& u) const {
        const long L = (long)i * G + c; if (L >= nwg) return false;
        int wgid = (int)L; { const int q = nwg / NXCD, r = nwg % NXCD, xcd = wgid % NXCD, off = wgid / NXCD; wgid = (xcd < r ? xcd * (q + 1) : r * (q + 1) + (xcd - r) * q) + off; }
        const int nig = WGM * nN, gid = wgid / nig, fm = gid * WGM, gsz = (nM - fm) < WGM ? (nM - fm) : WGM;
        u.pm = fm + ((wgid % nig) % gsz); u.pn = (wgid % nig) / gsz; return true;
    }
    __device__ __forceinline__ void a_ready(const Unit&) const {}
    __device__ __forceinline__ void done(const Unit&) const {}
};

__device__ __forceinline__ unsigned cvt_pk_bf16(float lo, float hi) { unsigned r; asm volatile("v_cvt_pk_bf16_f32 %0, %1, %2" : "=v"(r) : "v"(lo), "v"(hi)); return r; }
typedef float f32x2 __attribute__((ext_vector_type(2)));
typedef int i32x8 __attribute__((ext_vector_type(8)));
typedef int i32x4 __attribute__((ext_vector_type(4)));
__device__ __forceinline__ i32x8 cat8(const bf16x8& a, const bf16x8& b) { const i32x4 x = __builtin_bit_cast(i32x4, a), y = __builtin_bit_cast(i32x4, b); return __builtin_shufflevector(x, y, 0, 1, 2, 3, 4, 5, 6, 7); }
constexpr float F8_MAX = 448.f;
__device__ __forceinline__ unsigned cvt4_fp8(float a, float b, float c, float d) {
    int r = 0; r = __builtin_amdgcn_cvt_pk_fp8_f32(fminf(a, F8_MAX), fminf(b, F8_MAX), r, false); r = __builtin_amdgcn_cvt_pk_fp8_f32(fminf(c, F8_MAX), fminf(d, F8_MAX), r, true); return (unsigned)r; }
__device__ __forceinline__ void mfma_f8_inplace(f32x4& c, const i32x8 a, const i32x8 b) { asm volatile("v_mfma_f32_16x16x128_f8f6f4 %0, %1, %2, %0" : "+v"(c) : "v"(a), "v"(b)); }
__device__ __forceinline__ float bf_lo(unsigned w) { return __uint_as_float(w << 16); }
__device__ __forceinline__ float bf_hi(unsigned w) { return __uint_as_float(w & 0xffff0000u); }
__device__ __forceinline__ float sigmoid_f(float x) { return __builtin_amdgcn_rcpf(1.0f + __expf(-x)); }
typedef unsigned u32x2 __attribute__((ext_vector_type(2)));
__device__ __forceinline__ u32x4 pack8(const f32x4& a, const f32x4& b) { u32x4 w; w.x = cvt_pk_bf16(a[0], a[1]); w.y = cvt_pk_bf16(a[2], a[3]); w.z = cvt_pk_bf16(b[0], b[1]); w.w = cvt_pk_bf16(b[2], b[3]); return w; }
__device__ __forceinline__ u32x2 pack4(const f32x4& a) { u32x2 w; w.x = cvt_pk_bf16(a[0], a[1]); w.y = cvt_pk_bf16(a[2], a[3]); return w; }

struct EpiInProj {
    static constexpr bool PERM = true, AFTER_DRAIN = false, MIDK = false;
    bf16_t *QKV, *NQ, *KVB, *SG;
    float *LF, *GATE; const float* bforget; const float *ROPEC, *ROPES; size_t qkvs, kvs, sgs; float qscale;
    __device__ __forceinline__ void operator()(const f32x4 (&acc)[2][2][4][2], const Unit& u, int wr, int wc, int fr, int fq) const {
        const int pn = u.pn; const bool roped = pn >= 6 && pn < 11; const int i4 = (4 * (wc & 1) + fq) * 4;
#pragma unroll
        for (int ai = 0; ai < 2; ++ai) {
#pragma unroll
          for (int mp = 0; mp < 2; ++mp) {
            f32x4 csv[8];
            if (roped) {
#pragma unroll
                for (int mm = 0; mm < 2; ++mm) { const int t_ = (u.pm * BM + ai * HALF + wr * 64 + (2 * mp + mm) * 16 + fr) & 2047; csv[mm] = *(const f32x4*)(ROPEC + t_ * 32 + i4); csv[4 + mm] = *(const f32x4*)(ROPES + t_ * 32 + i4); }
                asm volatile("" : "+v"(csv[0]), "+v"(csv[1]), "+v"(csv[4]), "+v"(csv[5])); }
#pragma unroll
            for (int mm = 0; mm < 2; ++mm) { const int m = 2 * mp + mm;
                const int row = u.pm * BM + ai * HALF + wr * 64 + m * 16 + fr; const int t = row & 2047, b = row >> 11; (void)t;
#pragma unroll
                for (int bj = 0; bj < 2; ++bj) {
                    const int tc = bj * HALF + wc * 32 + 8 * fq;
                    f32x4 v0 = acc[ai][bj][m][0], v1 = acc[ai][bj][m][1];
                    if (pn < 6) {
                        bf16_t* base = QKV + (size_t)(pn >> 1) * qkvs; const float sc = pn < 2 ? qscale : 1.0f;
                        *(u32x4*)(base + (size_t)row * 512 + (pn & 1) * 256 + tc) = pack8(v0 * sc, v1 * sc);
                    } else if (pn < 8) {
                        const int head = (pn - 6) * 4 + (tc >> 6);
                        const f32x4 cs = csv[mm], sn = csv[4 + mm];
                        const f32x4 lo = (v0 * cs - v1 * sn) * qscale, hi = (v1 * cs + v0 * sn) * qscale;
                        bf16_t* d = NQ + (size_t)row * 512 + head * 64 + i4;
                        *(u32x2*)d = pack4(lo); *(u32x2*)(d + 32) = pack4(hi);
                    } else if (pn < 11) {
                        const int sel = pn - 8;
                        if (bj == 0) {
                            const int g = tc >> 6;
                            const f32x4 cs = csv[mm], sn = csv[4 + mm];
                            const f32x4 lo = v0 * cs - v1 * sn, hi = v1 * cs + v0 * sn;
                            bf16_t* d = KVB + (size_t)(2 * sel) * kvs + ((size_t)((b * 2 + g) * 2048 + t)) * 64 + i4;
                            *(u32x2*)d = pack4(lo); *(u32x2*)(d + 32) = pack4(hi);
                        } else {
                            const int tv = tc - HALF, g = tv >> 6, dd = tv & 63;
                            bf16_t* d = KVB + (size_t)(2 * sel + 1) * kvs + ((size_t)((b * 2 + g) * 2048 + t)) * 64 + dd;
                            *(u32x4*)d = pack8(v0, v1);
                        }
                    } else if (pn < 19) {
                        if (bj == 0) { const int ct = (pn - 11) * 128 + wc * 32 + 8 * fq; const f32x4 w0 = acc[ai][1][m][0], w1 = acc[ai][1][m][1];
                            f32x4 a, c, ra, rc;
#pragma unroll
                            for (int k = 0; k < 4; ++k) { const float ea = __expf(-v0[k]), ec = __expf(-v1[k]), fa = __expf(-w0[k]), fc = __expf(-w1[k]);
                                a[k] = __builtin_amdgcn_rcpf(1.0f + ea); c[k] = __builtin_amdgcn_rcpf(1.0f + ec); ra[k] = (1.0f + ea) * __builtin_amdgcn_rcpf(1.0f + fa); rc[k] = (1.0f + ec) * __builtin_amdgcn_rcpf(1.0f + fc); }
                            __builtin_nontemporal_store(pack8(a, c), (u32x4*)(SG + (size_t)row * 1024 + ct)); __builtin_nontemporal_store(pack8(ra, rc), (u32x4*)(SG + sgs + (size_t)row * 1024 + ct)); }
                    } else {
                        if (bj == 0 && wc == 0) {
                            if (fq == 0) {
                                f32x4 a, c;
#pragma unroll
                                for (int k = 0; k < 4; ++k) { const float x0 = v0[k] + bforget[k], x1 = v1[k] + bforget[4 + k];
                                    a[k] = fminf(x0, 0.f) - log1pf(__expf(-fabsf(x0))); c[k] = fminf(x1, 0.f) - log1pf(__expf(-fabsf(x1))); }
                                *(f32x4*)(LF + (size_t)row * 8) = a; *(f32x4*)(LF + (size_t)row * 8 + 4) = c;
                            } else {
                                f32x4 a, c;
#pragma unroll
                                for (int k = 0; k < 4; ++k) { a[k] = sigmoid_f(v0[k]); c[k] = sigmoid_f(v1[k]); }
                                *(f32x4*)(GATE + (size_t)row * 24 + 8 * (fq - 1)) = a; *(f32x4*)(GATE + (size_t)row * 24 + 8 * (fq - 1) + 4) = c;
                            }
                        }
                    }
                }
            }
          }
        }
    }
};
#define PIN8(a) asm volatile("" : "+v"(a[0]), "+v"(a[1]), "+v"(a[2]), "+v"(a[3]), "+v"(a[4]), "+v"(a[5]), "+v"(a[6]), "+v"(a[7]))
struct EpiGate {
    static constexpr bool PERM = true, AFTER_DRAIN = false, MIDK = false;
    bf16_t* O; const bf16_t* gate; const bf16_t* addend; int ldc;
    __device__ __forceinline__ void operator()(const f32x4 (&acc)[2][2][4][2], const Unit& u, int wr, int wc, int fr, int fq) const {
#pragma unroll
        for (int ai = 0; ai < 2; ++ai) {
            const size_t base = (size_t)(u.pm * BM + ai * HALF + wr * 64 + fr) * ldc + u.pn * BM + wc * 32 + 8 * fq;
            u32x4 gw[8], aw[8];
#pragma unroll
            for (int k = 0; k < 8; ++k) gw[k] = *(const u32x4*)(gate + base + (size_t)((k >> 1) * 16) * ldc + (k & 1) * HALF);
            PIN8(gw);
            if (addend) {
#pragma unroll
                for (int k = 0; k < 8; ++k) aw[k] = *(const u32x4*)(addend + base + (size_t)((k >> 1) * 16) * ldc + (k & 1) * HALF);
                PIN8(aw); }
#pragma unroll
            for (int k = 0; k < 8; ++k) { const int m = k >> 1, bj = k & 1; const u32x4 g = gw[k];
                f32x4 v0 = acc[ai][bj][m][0], v1 = acc[ai][bj][m][1];
                v0[0] *= bf_lo(g.x); v0[1] *= bf_hi(g.x); v0[2] *= bf_lo(g.y); v0[3] *= bf_hi(g.y);
                v1[0] *= bf_lo(g.z); v1[1] *= bf_hi(g.z); v1[2] *= bf_lo(g.w); v1[3] *= bf_hi(g.w);
                if (addend) { const u32x4 a = aw[k];
                    v0[0] += bf_lo(a.x); v0[1] += bf_hi(a.x); v0[2] += bf_lo(a.y); v0[3] += bf_hi(a.y);
                    v1[0] += bf_lo(a.z); v1[1] += bf_hi(a.z); v1[2] += bf_lo(a.w); v1[3] += bf_hi(a.w); }
                *(u32x4*)(O + base + (size_t)(m * 16) * ldc + bj * HALF) = pack8(v0, v1); }
        }
    }
};
struct EpiGateMid {
    static constexpr bool PERM = true, AFTER_DRAIN = false, MIDK = true;
    bf16_t* O; const bf16_t* sga; const bf16_t* rr; int ldc;
    __device__ __forceinline__ void scale(f32x4 (&acc)[2][2][4][2], const bf16_t* g, const Unit& u, int wr, int wc, int fr, int fq, bf16_t* out) const {
#pragma unroll
        for (int ai = 0; ai < 2; ++ai) {
            const size_t base = (size_t)(u.pm * BM + ai * HALF + wr * 64 + fr) * ldc + u.pn * BM + wc * 32 + 8 * fq;
            u32x4 gw[8];
#pragma unroll
            for (int k = 0; k < 8; ++k) gw[k] = *(const u32x4*)(g + base + (size_t)((k >> 1) * 16) * ldc + (k & 1) * HALF);
            PIN8(gw);
#pragma unroll
            for (int k = 0; k < 8; ++k) { const int m = k >> 1, bj = k & 1; const u32x4 w = gw[k];
                f32x4& v0 = acc[ai][bj][m][0]; f32x4& v1 = acc[ai][bj][m][1];
                v0[0] *= bf_lo(w.x); v0[1] *= bf_hi(w.x); v0[2] *= bf_lo(w.y); v0[3] *= bf_hi(w.y);
                v1[0] *= bf_lo(w.z); v1[1] *= bf_hi(w.z); v1[2] *= bf_lo(w.w); v1[3] *= bf_hi(w.w);
                if (out) *(u32x4*)(out + base + (size_t)(m * 16) * ldc + bj * HALF) = pack8(v0, v1); }
        }
    }
    __device__ __forceinline__ void mid(f32x4 (&acc)[2][2][4][2], const Unit& u, int wr, int wc, int fr, int fq) const { int fr_ = fr; asm volatile("" : "+v"(fr_));
        scale(acc, rr, u, wr, wc, fr_, fq, nullptr); }
    __device__ __forceinline__ void operator()(const f32x4 (&acc)[2][2][4][2], const Unit& u, int wr, int wc, int fr, int fq) const {
#pragma unroll
        for (int ai = 0; ai < 2; ++ai) {
            const size_t base = (size_t)(u.pm * BM + ai * HALF + wr * 64 + fr) * ldc + u.pn * BM + wc * 32 + 8 * fq;
            u32x4 gw[8];
#pragma unroll
            for (int k = 0; k < 8; ++k) gw[k] = *(const u32x4*)(sga + base + (size_t)((k >> 1) * 16) * ldc + (k & 1) * HALF);
            PIN8(gw);
#pragma unroll
            for (int k = 0; k < 8; ++k) { const int m = k >> 1, bj = k & 1; const u32x4 w = gw[k];
                f32x4 v0 = acc[ai][bj][m][0], v1 = acc[ai][bj][m][1];
                v0[0] *= bf_lo(w.x); v0[1] *= bf_hi(w.x); v0[2] *= bf_lo(w.y); v0[3] *= bf_hi(w.y);
                v1[0] *= bf_lo(w.z); v1[1] *= bf_hi(w.z); v1[2] *= bf_lo(w.w); v1[3] *= bf_hi(w.w);
                *(u32x4*)(O + base + (size_t)(m * 16) * ldc + bj * HALF) = pack8(v0, v1); }
        }
    }
};
template <int ACT> struct EpiPlain {
    static constexpr bool PERM = true, AFTER_DRAIN = false, MIDK = false;
    bf16_t* O; int ldc;
    __device__ __forceinline__ void operator()(const f32x4 (&acc)[2][2][4][2], const Unit& u, int wr, int wc, int fr, int fq) const {
#pragma unroll
        for (int ai = 0; ai < 2; ++ai)
#pragma unroll
            for (int m = 0; m < 4; ++m) {
                const size_t rowo = (size_t)(u.pm * BM + ai * HALF + wr * 64 + m * 16 + fr) * ldc + u.pn * BM + wc * 32 + 8 * fq;
#pragma unroll
                for (int bj = 0; bj < 2; ++bj) {
                    f32x4 v0 = acc[ai][bj][m][0], v1 = acc[ai][bj][m][1];
                    if (ACT == 1) {
#pragma unroll
                        for (int k = 0; k < 4; ++k) { const float a = fmaxf(v0[k], 0.f), c = fmaxf(v1[k], 0.f); v0[k] = a * a; v1[k] = c * c; }
                    }
                    *(u32x4*)(O + rowo + bj * HALF) = pack8(v0, v1);
                }
            }
    }
};

struct EpiRelu2Rs {
    static constexpr bool PERM = true, AFTER_DRAIN = false, MIDK = false;
    bf16_t* O; const float* rs; int ldc;
    __device__ __forceinline__ void operator()(const f32x4 (&acc)[2][2][4][2], const Unit& u, int wr, int wc, int fr, int fq) const {
        float rv[8];
#pragma unroll
        for (int k = 0; k < 8; ++k) rv[k] = rs[u.pm * BM + (k >> 2) * HALF + wr * 64 + (k & 3) * 16 + fr];
        PIN8(rv);
#pragma unroll
        for (int ai = 0; ai < 2; ++ai)
#pragma unroll
            for (int m = 0; m < 4; ++m) { const float r = rv[ai * 4 + m];
                const size_t rowo = (size_t)(u.pm * BM + ai * HALF + wr * 64 + m * 16 + fr) * ldc + u.pn * BM + wc * 32 + 8 * fq;
#pragma unroll
                for (int bj = 0; bj < 2; ++bj) { f32x4 v0 = acc[ai][bj][m][0], v1 = acc[ai][bj][m][1];
#pragma unroll
                    for (int k = 0; k < 4; ++k) { const float a = fmaxf(v0[k] * r, 0.f), c = fmaxf(v1[k] * r, 0.f); v0[k] = a * a; v1[k] = c * c; }
                    __builtin_nontemporal_store(pack8(v0, v1), (u32x4*)(O + rowo + bj * HALF)); } }
    }
};

struct EpiRelu2RsF8 {
    static constexpr bool PERM = true, AFTER_DRAIN = false, MIDK = false;
    unsigned char* O; const float* rs; int ldc;
    __device__ __forceinline__ void operator()(const f32x4 (&acc)[2][2][4][2], const Unit& u, int wr, int wc, int fr, int fq) const {
        float rv[8];
#pragma unroll
        for (int k = 0; k < 8; ++k) rv[k] = rs[u.pm * BM + (k >> 2) * HALF + wr * 64 + (k & 3) * 16 + fr];
        PIN8(rv);
#pragma unroll
        for (int ai = 0; ai < 2; ++ai)
#pragma unroll
            for (int m = 0; m < 4; ++m) { const float r = rv[ai * 4 + m];
                const size_t rowo = (size_t)(u.pm * BM + ai * HALF + wr * 64 + m * 16 + fr) * ldc + u.pn * BM + wc * 32 + 8 * fq;
#pragma unroll
                for (int bj = 0; bj < 2; ++bj) { f32x4 v0 = acc[ai][bj][m][0], v1 = acc[ai][bj][m][1];
#pragma unroll
                    for (int k = 0; k < 4; ++k) { const float a = fmaxf(v0[k] * r, 0.f), c = fmaxf(v1[k] * r, 0.f); v0[k] = a * a; v1[k] = c * c; }
                    f32x2 o; o.x = __builtin_bit_cast(float, cvt4_fp8(v0[0], v0[1], v0[2], v0[3])); o.y = __builtin_bit_cast(float, cvt4_fp8(v1[0], v1[1], v1[2], v1[3]));
                    __builtin_nontemporal_store(o, (f32x2*)(O + rowo + bj * HALF)); } }
    }
};
struct EpiScaled {
    static constexpr bool PERM = true, AFTER_DRAIN = false, MIDK = false;
    bf16_t* O; int ldc; float sc;
    __device__ __forceinline__ void operator()(const f32x4 (&acc)[2][2][4][2], const Unit& u, int wr, int wc, int fr, int fq) const {
#pragma unroll
        for (int ai = 0; ai < 2; ++ai)
#pragma unroll
            for (int m = 0; m < 4; ++m) {
                const size_t rowo = (size_t)(u.pm * BM + ai * HALF + wr * 64 + m * 16 + fr) * ldc + u.pn * BM + wc * 32 + 8 * fq;
#pragma unroll
                for (int bj = 0; bj < 2; ++bj) *(u32x4*)(O + rowo + bj * HALF) = pack8(acc[ai][bj][m][0] * sc, acc[ai][bj][m][1] * sc);
            }
    }
};
template <class Epi, class Sched, bool ALIGN_EPI = false, bool SP2 = false, bool F8 = false>
__device__ __forceinline__ void gemm_phase(PG8_LAS unsigned char* lds, const Gemm g, const Sched& S, const Epi& E, const int wave_id  ) {
    int tid_ = wave_id * 64 + (int)__builtin_amdgcn_mbcnt_hi(~0u, __builtin_amdgcn_mbcnt_lo(~0u, 0u)); asm volatile("" : "+v"(tid_));
    const int tid = tid_, wid = __builtin_amdgcn_readfirstlane(tid >> 6), lane = tid & 63, wr = wid >> 2, wc = wid & 3, fr = lane & 15, fq = lane >> 4;
    const int K = g.K, nt = K / BK;
    unsigned voffA[2], voffB[2];
#pragma unroll
    for (int i = 0; i < 2; ++i) { int R, C; stage_rc(tid * 16 + i * 8192, R, C); const int Rb = Epi::PERM ? ((R & ~31) + perm32(R & 31)) : R;
        voffA[i] = (unsigned)(R * K + C) * 2u; voffB[i] = (unsigned)(Rb * K + C) * 2u; }
    const size_t kstep = (size_t)(BK * 2);
    const size_t hstep = (size_t)HALF * K * 2;
    const size_t tstep = 2 * hstep;
    const unsigned ldsw = (unsigned)wid * 1024u;
    const int aoff = lds_byte(wr * 64 + fr, fq * 8), boff = lds_byte(wc * 32 + fr, fq * 8);
#define PG8_SA(b, h) (((b) * 2 + (h)) * HTB)
#define PG8_SB(b, h) ((4 + (b) * 2 + (h)) * HTB)
#define PG8_STAGE(bufoff, gbase, voff) do { _Pragma("unroll") for (int _i = 0; _i < 2; ++_i) \
        __builtin_amdgcn_global_load_lds((const unsigned*)((const char*)(gbase) + (voff)[_i]), (PG8_LAS unsigned*)(lds + (bufoff) + ldsw + _i * 8192), 16, 0, 0); } while (0)
#define PG8_LDA(dst, b, h) do { _Pragma("unroll") for (int m = 0; m < 4; ++m) _Pragma("unroll") for (int k = 0; k < 2; ++k) dst[m][k] = *(const PG8_LAS bf16x8*)(lds + PG8_SA(b, h) + aoff + m * 2048 + k * 1024); } while (0)
#define PG8_LDB(dst, b, h) do { _Pragma("unroll") for (int n = 0; n < 2; ++n) _Pragma("unroll") for (int k = 0; k < 2; ++k) dst[n][k] = *(const PG8_LAS bf16x8*)(lds + PG8_SB(b, h) + boff + n * 2048 + k * 1024); } while (0)
#define PG8_MMA(ai, bj, At, Bt) do { __builtin_amdgcn_s_setprio(1); _Pragma("unroll") for (int m = 0; m < 4; ++m) _Pragma("unroll") for (int n = 0; n < 2; ++n) { \
        if constexpr (F8) mfma_f8_inplace(acc[ai][bj][m][n], cat8(Bt[n][0], Bt[n][1]), cat8(At[m][0], At[m][1])); \
        else { _Pragma("unroll") for (int k = 0; k < 2; ++k) acc[ai][bj][m][n] = __builtin_amdgcn_mfma_f32_16x16x32_bf16(Bt[n][k], At[m][k], acc[ai][bj][m][n], 0, 0, 0); } } __builtin_amdgcn_s_setprio(0); } while (0)
#define PG8_WAIT_V(n) asm volatile("s_waitcnt vmcnt(" #n ")" ::: "memory")
#define PG8_WAIT_L(n) asm volatile("s_waitcnt lgkmcnt(" #n ")" ::: "memory")
#define PG8_BAR __builtin_amdgcn_s_barrier()
#define PG8_SCHED __builtin_amdgcn_sched_barrier(0)
    Unit cur, nxt; int ui = 0;
    if (!S.next(0, cur)) return;
    f32x4 acc[2][2][4][2];
#pragma unroll
    for (int a = 0; a < 2; ++a)
#pragma unroll
        for (int b = 0; b < 2; ++b)
#pragma unroll
            for (int m = 0; m < 4; ++m)
#pragma unroll
                for (int n = 0; n < 2; ++n) acc[a][b][m][n] = (f32x4){0.f, 0.f, 0.f, 0.f};
    bf16x8 At[4][2], B0[2][2], B1[2][2];
    const char* cA = (const char*)g.A + (size_t)cur.pm * tstep; const char* cB = (const char*)g.Bt + (size_t)cur.pn * tstep;
    S.a_ready(cur);
    if constexpr (SP2) {
        PG8_STAGE(PG8_SB(0, 0), cB, voffB); PG8_STAGE(PG8_SB(0, 1), cB + hstep, voffB); PG8_STAGE(PG8_SA(0, 0), cA, voffA); PG8_STAGE(PG8_SA(0, 1), cA + hstep, voffA);
        if (wr == 1) PG8_BAR;
        PG8_WAIT_V(2); PG8_BAR;
        PG8_STAGE(PG8_SB(1, 0), cB + kstep, voffB); PG8_STAGE(PG8_SA(1, 0), cA + kstep, voffA); PG8_STAGE(PG8_SB(1, 1), cB + hstep + kstep, voffB);
        PG8_WAIT_V(6); PG8_BAR;
    } else {
        PG8_STAGE(PG8_SB(0, 0), cB, voffB); PG8_STAGE(PG8_SA(0, 0), cA, voffA); PG8_STAGE(PG8_SB(0, 1), cB + hstep, voffB); PG8_STAGE(PG8_SA(0, 1), cA + hstep, voffA);
        if (wr == 1) PG8_BAR;
        PG8_WAIT_V(4); PG8_BAR;
        PG8_STAGE(PG8_SB(1, 0), cB + kstep, voffB); PG8_STAGE(PG8_SA(1, 0), cA + kstep, voffA); PG8_STAGE(PG8_SB(1, 1), cB + hstep + kstep, voffB);
        PG8_WAIT_V(6); PG8_BAR;
    }
    for (;;) {
        const bool has_next = S.next(ui + 1, nxt);
        const char* nA = has_next ? (const char*)g.A + (size_t)nxt.pm * tstep : cA; const char* nB = has_next ? (const char*)g.Bt + (size_t)nxt.pn * tstep : cB;
        for (int t = 0; t < nt; t += 2) {
            if constexpr (Epi::MIDK) { if (t == nt / 2) E.mid(acc, cur, wr, wc, fr, fq); }
            const bool last = (t == nt - 2);
            const char* a1 = cA + (size_t)(t + 1) * kstep;
            const char* a2 = last ? nA : cA + (size_t)(t + 2) * kstep; const char* b2 = last ? nB : cB + (size_t)(t + 2) * kstep;
            const char* a3 = a2 + kstep; const char* b3 = b2 + kstep;
            if (last && has_next) S.a_ready(nxt);
            if constexpr (SP2) {
            PG8_LDB(B0, 0, 0); PG8_LDB(B1, 0, 1); PG8_SCHED; PG8_LDA(At, 0, 0); PG8_STAGE(PG8_SA(1, 1), a1 + hstep, voffA);
            PG8_WAIT_V(8); PG8_WAIT_L(0); PG8_BAR; PG8_MMA(0, 0, At, B0); PG8_MMA(0, 1, At, B1); PG8_BAR; PG8_SCHED;
            PG8_LDA(At, 0, 1); PG8_STAGE(PG8_SB(0, 0), b2, voffB); PG8_STAGE(PG8_SB(0, 1), b2 + hstep, voffB); PG8_STAGE(PG8_SA(0, 0), a2, voffA);
            PG8_WAIT_V(8); PG8_WAIT_L(0); PG8_BAR; PG8_MMA(1, 0, At, B0); PG8_MMA(1, 1, At, B1); PG8_BAR; PG8_SCHED;
            PG8_LDB(B0, 1, 0); PG8_LDB(B1, 1, 1); PG8_SCHED; PG8_LDA(At, 1, 0); PG8_STAGE(PG8_SA(0, 1), a2 + hstep, voffA);
            PG8_WAIT_V(8); PG8_WAIT_L(0); PG8_BAR; PG8_MMA(0, 0, At, B0); PG8_MMA(0, 1, At, B1); PG8_BAR; PG8_SCHED;
            PG8_LDA(At, 1, 1); PG8_STAGE(PG8_SB(1, 0), b3, voffB); PG8_STAGE(PG8_SB(1, 1), b3 + hstep, voffB); PG8_STAGE(PG8_SA(1, 0), a3, voffA);
            PG8_WAIT_V(8); PG8_WAIT_L(0); PG8_BAR; PG8_MMA(1, 0, At, B0); PG8_MMA(1, 1, At, B1); PG8_BAR; PG8_SCHED;
            } else {
            PG8_LDB(B0, 0, 0); PG8_SCHED; PG8_LDA(At, 0, 0); PG8_STAGE(PG8_SA(1, 1), a1 + hstep, voffA);
            PG8_WAIT_L(8); PG8_BAR; PG8_WAIT_L(0); PG8_MMA(0, 0, At, B0); PG8_BAR; PG8_SCHED;
            PG8_LDB(B1, 0, 1); PG8_STAGE(PG8_SB(0, 0), b2, voffB);
            PG8_BAR; PG8_WAIT_L(0); PG8_MMA(0, 1, At, B1); PG8_BAR;
            PG8_LDA(At, 0, 1); PG8_STAGE(PG8_SA(0, 0), a2, voffA);
            PG8_BAR; PG8_WAIT_L(0); PG8_MMA(1, 0, At, B0); PG8_BAR; PG8_SCHED;
            PG8_STAGE(PG8_SB(0, 1), b2 + hstep, voffB);
            PG8_WAIT_V(6); PG8_BAR; PG8_MMA(1, 1, At, B1); PG8_BAR;
            PG8_LDB(B0, 1, 0); PG8_SCHED; PG8_LDA(At, 1, 0); PG8_STAGE(PG8_SA(0, 1), a2 + hstep, voffA);
            PG8_WAIT_L(8); PG8_BAR; PG8_WAIT_L(0); PG8_MMA(0, 0, At, B0); PG8_BAR; PG8_SCHED;
            PG8_LDB(B1, 1, 1); PG8_STAGE(PG8_SB(1, 0), b3, voffB);
            PG8_BAR; PG8_WAIT_L(0); PG8_MMA(0, 1, At, B1); PG8_BAR;
            PG8_LDA(At, 1, 1); PG8_STAGE(PG8_SA(1, 0), a3, voffA);
            PG8_BAR; PG8_WAIT_L(0); PG8_MMA(1, 0, At, B0); PG8_BAR; PG8_SCHED;
            PG8_STAGE(PG8_SB(1, 1), b3 + hstep, voffB);
            PG8_WAIT_V(6); PG8_BAR; PG8_MMA(1, 1, At, B1); PG8_BAR;
            }
        }
        if constexpr (F8) asm volatile("s_nop 15\n\ts_nop 15" ::: "memory");
        if constexpr (ALIGN_EPI) { if (wr == 0) PG8_BAR; }
        if constexpr (!Epi::AFTER_DRAIN) { E(acc, cur, wr, wc, fr, fq); S.done(cur); }
        if (!has_next) break;
#pragma unroll
        for (int a = 0; a < 2; ++a)
#pragma unroll
            for (int b = 0; b < 2; ++b)
#pragma unroll
                for (int m = 0; m < 4; ++m)
#pragma unroll
                    for (int n = 0; n < 2; ++n) acc[a][b][m][n] = (f32x4){0.f, 0.f, 0.f, 0.f};
        cur = nxt; cA = nA; cB = nB; ++ui;
        if constexpr (ALIGN_EPI) { if (wr == 1) PG8_BAR; }
    }
    PG8_WAIT_V(0);
    if constexpr (!ALIGN_EPI) { if (wr == 0) PG8_BAR; }
    PG8_BAR;
    if constexpr (Epi::AFTER_DRAIN) { E.fused(acc, cur, wr, wc, fr, fq, lds, wid, lane); S.done(cur); }
#undef PG8_SA
#undef PG8_SB
#undef PG8_STAGE
#undef PG8_LDA
#undef PG8_LDB
#undef PG8_MMA
#undef PG8_WAIT_V
#undef PG8_WAIT_L
#undef PG8_BAR
#undef PG8_SCHED
}
}
#define GAS __attribute__((address_space(1)))
#define LAS __attribute__((address_space(3)))
typedef unsigned short bf16;
typedef unsigned v4u __attribute__((ext_vector_type(4)));
typedef float f32x4 __attribute__((ext_vector_type(4)));
typedef short bf16x8 __attribute__((ext_vector_type(8)));
typedef GAS unsigned gu32;
typedef GAS unsigned long long gu64;
#define RLX_AGENT __ATOMIC_RELAXED, __HIP_MEMORY_SCOPE_AGENT
#define LDS_WAIT() asm volatile("s_waitcnt lgkmcnt(0)" ::: "memory")
#define VM_WAIT() asm volatile("s_waitcnt vmcnt(0)" ::: "memory")
__device__ __forceinline__ unsigned long long rt() { return __builtin_amdgcn_s_memrealtime(); }
__device__ __forceinline__ unsigned f2bf(float f) { unsigned u = __builtin_bit_cast(unsigned, f); return (u + 0x7fffu + ((u >> 16) & 1u)) >> 16; }
__device__ __forceinline__ unsigned pk2(float lo, float hi) { return f2bf(lo) | (f2bf(hi) << 16); }

#define XB_TMO      128
#define XB_XCNT(j)  (256  + 64 * (j))
#define XB_XSUB(j)  (1280 + 64 * (j))
#define XB_XGEN(j)  (2304 + 64 * (j))
#define XB_TOP      3328
#define XB_TOPGEN   3392
#define XCD_BAR_WORDS 3456
#define XB_SPIN_CAP (1u << 18)

__device__ __forceinline__ unsigned xb_ld(unsigned* p)              { return __hip_atomic_load(p, __ATOMIC_RELAXED, __HIP_MEMORY_SCOPE_AGENT); }
__device__ __forceinline__ unsigned xb_add(unsigned* p, unsigned v) { return __hip_atomic_fetch_add(p, v, __ATOMIC_RELAXED, __HIP_MEMORY_SCOPE_AGENT); }
__device__ __forceinline__ unsigned xb_xcc_id() { return (unsigned)__builtin_amdgcn_s_getreg((3 << 11) | 20) & 0xFu; }
#define XB_SPIN(cond, bar) do { unsigned _sp = 0; while (cond) { __builtin_amdgcn_s_sleep(1); \
    if ((++_sp & 255u) == 0u) { if (xb_ld(&(bar)[XB_TMO])) break; if (_sp > XB_SPIN_CAP) { atomicAdd(&(bar)[XB_TMO], 1u); break; } } } } while (0)

struct XcdBarrier {
    unsigned* bar; unsigned x;
    volatile LAS unsigned* st;
};

__device__ __forceinline__ XcdBarrier xcd_barrier_post(unsigned* bar, volatile LAS unsigned* st) {
    XcdBarrier b; b.bar = bar; b.x = xb_xcc_id(); b.st = st;
    if (threadIdx.x == 0) (void)xb_add(&bar[XB_XCNT(b.x)], 1u);
    return b;
}
__device__ __forceinline__ void xcd_barrier_complete(unsigned* bar, unsigned x, unsigned& nloc, unsigned& nx) {
    const unsigned G = gridDim.x * gridDim.y * gridDim.z;
    unsigned sum, cnt, mine, sp = 0u;
    for (;;) {
        sum = 0u; cnt = 0u; mine = 0u;
#pragma unroll
        for (unsigned j = 0; j < 16; ++j) { const unsigned c = xb_ld(&bar[XB_XCNT(j)]); sum += c; cnt += (c > 0u) ? 1u : 0u; mine = (j == x) ? c : mine; }
        if (sum == G) break;
        __builtin_amdgcn_s_sleep(1);
        if ((++sp & 255u) == 0u) { if (xb_ld(&bar[XB_TMO])) break; if (sp > XB_SPIN_CAP) { atomicAdd(&bar[XB_TMO], 1u); break; } }
    }
    nloc = mine > 0u ? mine : 1u; nx = cnt > 0u ? cnt : 1u;
}

__device__ __forceinline__ void xcd_barrier(const XcdBarrier& b) {
    asm volatile("s_waitcnt vmcnt(0)" ::: "memory");
    __syncthreads();
    if (threadIdx.x == 0) {
        unsigned* bar = b.bar;
        __builtin_amdgcn_s_waitcnt(0);
        unsigned nloc = b.st[0], nx = b.st[1];
        if (nloc == 0u) { xcd_barrier_complete(bar, b.x, nloc, nx); b.st[0] = nloc; b.st[1] = nx; }
        const unsigned old = xb_add(&bar[XB_XSUB(b.x)], 1u);
        const unsigned gen = old / nloc;
        if (old + 1u == (gen + 1u) * nloc) {
            __builtin_amdgcn_fence(__ATOMIC_RELEASE, "agent");
            asm volatile("s_waitcnt vmcnt(0)" ::: "memory");
            const unsigned og = xb_add(&bar[XB_TOP], 1u);
            const unsigned tg = og / nx;
            if (og + 1u == (tg + 1u) * nx) xb_add(&bar[XB_TOPGEN], 1u);
            else XB_SPIN(xb_ld(&bar[XB_TOPGEN]) == tg, bar);
            __builtin_amdgcn_fence(__ATOMIC_ACQUIRE, "agent");
            xb_add(&bar[XB_XGEN(b.x)], 1u);
            asm volatile("s_waitcnt vmcnt(0)" ::: "memory");
        } else {
            XB_SPIN(xb_ld(&bar[XB_XGEN(b.x)]) == gen, bar);
            __builtin_amdgcn_fence(__ATOMIC_ACQUIRE, "agent");
            asm volatile("s_waitcnt vmcnt(0)" ::: "memory");
        }
    }
    __syncthreads();
}

constexpr int NWAVES = 8;
constexpr int BATCH = 32, SEQ = 2048, DMODEL = 1024, MTOK = BATCH * SEQ, DFF = 4096, NPROJ = 5120, INCOLS = 4896;
constexpr float RMS_EPS = 1e-6f;
constexpr float QSCALE = 0.125f * 1.4426950408889634f;
constexpr float LOG2E = 1.4426950408889634f;
constexpr float WDN_SCALE = 256.f;
#ifndef MK_N_LAUNCHES
#define MK_N_LAUNCHES 1
#endif
constexpr int N_PHASES = 10;
constexpr int N_LAUNCHES = MK_N_LAUNCHES;
constexpr size_t MiB = 1u << 20, KiB = 1u << 10;
constexpr size_t WS_CTL = 0, CTL_ZERO_BYTES = 1 * MiB;
constexpr size_t WS_WIN = 2 * MiB, WS_WF = 12 * MiB, WS_WN = 13 * MiB, WS_WO = 14 * MiB, WS_WUP = 16 * MiB, WS_WDN = 24 * MiB;
constexpr size_t WS_W1K = 32 * MiB, WS_W1V = WS_W1K + 256 * KiB, WS_W2K = WS_W1V + 256 * KiB, WS_W2V = WS_W2K + 8 * KiB, WS_PBK = WS_W2V + 8 * KiB, WS_PBV = WS_PBK + 256;
constexpr size_t WS_KT0 = WS_PBV + 256;
constexpr size_t WS_RSTD2 = 46 * MiB;
constexpr size_t WS_ROPEC = 33 * MiB, WS_ROPES = WS_ROPEC + 256 * KiB;
constexpr size_t WS_KCMP = 34 * MiB, WS_VCMP = 35 * MiB, WS_C = 36 * MiB, WS_LF = 38 * MiB, WS_GATE = 40 * MiB;
constexpr size_t WS_HB = 48 * MiB;
constexpr size_t WS_FKX = 48 * MiB;
constexpr size_t WS_PROBE_O = 64 * MiB;
constexpr size_t WS_FQ = 176 * MiB, WS_FK = 240 * MiB, WS_FV = 304 * MiB, WS_NQ = 368 * MiB;
constexpr size_t WS_KV = 432 * MiB, KV_STRIDE = 16 * MiB;
constexpr size_t WS_SGA = 528 * MiB, WS_SGB = 656 * MiB;
constexpr size_t WS_Y = 784 * MiB;
constexpr size_t WS_ATT = WS_Y;
constexpr size_t WS_FOXO_UNUSED = WS_Y, WS_NSAO_UNUSED = WS_Y + 64 * MiB;
constexpr size_t WS_U = 176 * MiB;
constexpr size_t WS_END = 1024 * MiB;
static_assert(WS_FV - WS_FK == WS_FK - WS_FQ && WS_U + (size_t)MTOK * DFF * 2 <= WS_Y && WS_Y + (size_t)MTOK * 512 * 4 <= WS_END && WS_GATE + (size_t)MTOK * 24 * 4 <= WS_HB, "d_ws map");
constexpr int CW_TMO = 0, CW_CODE = 1, CW_BAR = 4096, CW_QUEUE = 16384;
constexpr int RING_OFF = 0, RING_BYTES = 131072;
constexpr int LDSCTL_OFF = RING_BYTES, MISC_OFF = LDSCTL_OFF + 320;
constexpr int LDS_BYTES = 147456;
static_assert(MISC_OFF + 128 <= LDS_BYTES, "LDS map");


typedef float f32x16 __attribute__((ext_vector_type(16)));
struct Frame {
    LAS unsigned char* lds;
    volatile LAS unsigned* MISC;
    gu32* ctl;
    int wave;
    int vcu, G;
    unsigned char* ws;
    const float* x; float* out;
    const float *g_mix_pre, *g_mix_post, *g_mlp_pre, *g_mlp_post, *w_in, *b_forget, *pos_k, *w1_k, *w2_k, *pos_v, *w1_v, *w2_v, *w_fox, *w_nsa, *w_o, *w_up, *w_down;
};
template <class T> __device__ __forceinline__ T* wsp(const Frame& F, size_t off) { return (T*)(F.ws + off); }
__device__ __forceinline__ int cur_lane() { return (int)__builtin_amdgcn_mbcnt_hi(~0u, __builtin_amdgcn_mbcnt_lo(~0u, 0u)); }
__device__ __forceinline__ int cur_tid(const Frame& F) { return F.wave * 64 + cur_lane(); }

__device__ __forceinline__ float wave_sum(float v) {
#pragma unroll
    for (int o = 1; o < 64; o <<= 1) v += __shfl_xor(v, o);
    return v;
}
__device__ __forceinline__ float bfl(unsigned w) { return __uint_as_float(w << 16); }
__device__ __forceinline__ float bfh(unsigned w) { return __uint_as_float(w & 0xffff0000u); }

__device__ __forceinline__ int rope_d(int w) { const int i = w >> 3, j = w & 7; return j < 4 ? 4 * i + j : 32 + 4 * i + (j - 4); }
__device__ __forceinline__ int in_src_col(int n) {
    if (n < 1536) return n;
    if (n < 2048) { const int l = n - 1536; return 1544 + (l & ~63) + rope_d(l & 63); }
    if (n < 2816) { const int s = (n - 2048) >> 8, l = (n - 2048) & 255; const int kb = 2056 + s * 256;
        return l < 128 ? kb + (l & ~63) + rope_d(l & 63) : kb + 128 + (l - 128); }
    if (n < 4864) { const int q = (n - 2816) >> 8, l = (n - 2816) & 255; return l < 128 ? 2848 + 128 * q + l : 3872 + 128 * q + (l - 128); }
    const int l = n - 4864; if (l < 8) return 1536 + l; if (l < 32) return 2824 + (l - 8); return -1;
}
template <class SrcCol>
__device__ __forceinline__ void p0_transpose_item(const float* W, int K, int Nsrc, bf16* WT, int nblk, LAS float* scr, int item, int lane, SrcCol srccol, const float* kgain = nullptr, int ldk = 0, int koff = 0) {
    const int kb = item / nblk, nb = item % nblk, k0 = 64 * kb, n0 = 32 * nb;
    const int sc = srccol(n0 + (lane & 31));
#pragma unroll 8
    for (int i = 0; i < 32; ++i) { const int kk = 2 * i + (lane >> 5); float w = sc >= 0 ? W[(size_t)(k0 + kk) * Nsrc + sc] : 0.f; if (kgain) w *= kgain[k0 + kk]; scr[kk * 33 + (lane & 31)] = w; }
    LDS_WAIT(); asm volatile("" ::: "memory");
    const int c = lane & 7;
#pragma unroll
    for (int j = 0; j < 4; ++j) { const int n = (lane >> 3) + 8 * j; const LAS float* s = scr + (8 * c) * 33 + n;
        v4u o; o.x = pk2(s[0 * 33], s[1 * 33]); o.y = pk2(s[2 * 33], s[3 * 33]); o.z = pk2(s[4 * 33], s[5 * 33]); o.w = pk2(s[6 * 33], s[7 * 33]);
        *(GAS v4u*)(WT + (size_t)(n0 + n) * (ldk ? ldk : K) + koff + k0 + 8 * c) = o; }
    LDS_WAIT(); asm volatile("" ::: "memory");
}
__device__ __forceinline__ void p0_transpose_item_f8(const float* W, int K, int N, unsigned char* WT, int nblk, LAS float* scr, int item, int lane, float scale) {
    const int kb = item / nblk, nb = item % nblk, k0 = 64 * kb, n0 = 32 * nb;
#pragma unroll 8
    for (int i = 0; i < 32; ++i) { const int kk = 2 * i + (lane >> 5); scr[kk * 33 + (lane & 31)] = W[(size_t)(k0 + kk) * N + n0 + (lane & 31)] * scale; }
    LDS_WAIT(); asm volatile("" ::: "memory");
    const int c = lane & 7;
#pragma unroll
    for (int j = 0; j < 4; ++j) { const int n = (lane >> 3) + 8 * j; const LAS float* s = scr + (8 * c) * 33 + n;
        pg8::f32x2 o; o.x = __builtin_bit_cast(float, pg8::cvt4_fp8(fmaxf(s[0 * 33], -pg8::F8_MAX), fmaxf(s[1 * 33], -pg8::F8_MAX), fmaxf(s[2 * 33], -pg8::F8_MAX), fmaxf(s[3 * 33], -pg8::F8_MAX)));
        o.y = __builtin_bit_cast(float, pg8::cvt4_fp8(fmaxf(s[4 * 33], -pg8::F8_MAX), fmaxf(s[5 * 33], -pg8::F8_MAX), fmaxf(s[6 * 33], -pg8::F8_MAX), fmaxf(s[7 * 33], -pg8::F8_MAX)));
        *(GAS pg8::f32x2*)(WT + (size_t)(n0 + n) * K + k0 + 8 * c) = o; }
    LDS_WAIT(); asm volatile("" ::: "memory");
}
__device__ __forceinline__ void rms_rows_to_bf16(int lane, int gw, int NGW, const float* X, const float* g, bf16* O) {
    constexpr int RP = 4;
    const GAS f32x4* gr = (const GAS f32x4*)g + lane; f32x4 gv[4];
#pragma unroll
    for (int j = 0; j < 4; ++j) gv[j] = gr[64 * j];
    for (int m0 = gw; m0 < MTOK; m0 += NGW * RP) {
        f32x4 v[RP][4];
#pragma unroll
        for (int r = 0; r < RP; ++r) { const GAS f32x4* xr = (const GAS f32x4*)(X + (size_t)(m0 + r * NGW) * DMODEL) + lane;
#pragma unroll
            for (int j = 0; j < 4; ++j) v[r][j] = __builtin_nontemporal_load(xr + 64 * j); }
#pragma unroll
        for (int r = 0; r < RP; ++r) { float s = 0.f;
#pragma unroll
            for (int j = 0; j < 4; ++j) s += (v[r][j].x * v[r][j].x + v[r][j].y * v[r][j].y) + (v[r][j].z * v[r][j].z + v[r][j].w * v[r][j].w);
            const float rr = 1.0f / sqrtf(wave_sum(s) * (1.f / DMODEL) + RMS_EPS);
            GAS unsigned long long* o8 = (GAS unsigned long long*)(O + (size_t)(m0 + r * NGW) * DMODEL) + lane;
#pragma unroll
            for (int j = 0; j < 4; ++j) { const f32x4 a = v[r][j], gg = gv[j];
                o8[64 * j] = (unsigned long long)pk2(a.x * rr * gg.x, a.y * rr * gg.y) | ((unsigned long long)pk2(a.z * rr * gg.z, a.w * rr * gg.w) << 32); } }
    }
}
__device__ __forceinline__ void p0_prologue(Frame& F) {
    LAS float* scr = (LAS float*)(F.lds + RING_OFF + F.wave * 16384);
    const int gw = F.vcu * NWAVES + F.wave, NGW = F.G * NWAVES, lane = cur_lane();
    constexpr int I_IN = 16 * (NPROJ / 32), I_F = 8 * 32, I_O = 16 * 32, I_UP = 16 * 128, I_DN = 64 * 32, I_W1 = 32 * 2, I_W2 = 1 * 2;
    constexpr int NITEMS = I_IN + 2 * I_F + I_O + I_UP + I_DN + 2 * I_W1 + 2 * I_W2;
    auto ident = [](int n) { return n; };
    for (int it = gw; it < NITEMS; it += NGW) {
        int r = it;
        if (r < I_IN) { p0_transpose_item(F.w_in, 1024, INCOLS, wsp<bf16>(F, WS_WIN), NPROJ / 32, scr, r, lane, [](int n) { return in_src_col(n); }); continue; } r -= I_IN;
        if (r < I_F) { p0_transpose_item(F.w_fox, 512, 1024, wsp<bf16>(F, WS_WF), 32, scr, r, lane, ident, nullptr, 1024, 512); continue; } r -= I_F;
        if (r < I_F) { p0_transpose_item(F.w_nsa, 512, 1024, wsp<bf16>(F, WS_WF), 32, scr, r, lane, ident, nullptr, 1024, 0); continue; } r -= I_F;
        if (r < I_O) { p0_transpose_item(F.w_o, 1024, 1024, wsp<bf16>(F, WS_WO), 32, scr, r, lane, ident); continue; } r -= I_O;
        if (r < I_UP) { p0_transpose_item(F.w_up, 1024, 4096, wsp<bf16>(F, WS_WUP), 128, scr, r, lane, ident, F.g_mlp_pre); continue; }     r -= I_UP;
        if (r < I_DN) { p0_transpose_item_f8(F.w_down, 4096, 1024, wsp<unsigned char>(F, WS_WDN), 32, scr, r, lane, WDN_SCALE); continue; } r -= I_DN;
        if (r < I_W1) { p0_transpose_item(F.w1_k, 2048, 64, wsp<bf16>(F, WS_W1K), 2, scr, r, lane, ident); continue; } r -= I_W1;
        if (r < I_W1) { p0_transpose_item(F.w1_v, 2048, 64, wsp<bf16>(F, WS_W1V), 2, scr, r, lane, ident); continue; } r -= I_W1;
        if (r < I_W2) { p0_transpose_item(F.w2_k, 64, 64, wsp<bf16>(F, WS_W2K), 2, scr, r, lane, ident); continue; } r -= I_W2;
        p0_transpose_item(F.w2_v, 64, 64, wsp<bf16>(F, WS_W2V), 2, scr, r, lane, ident);
    }
    { float* RC = wsp<float>(F, WS_ROPEC); float* RS = wsp<float>(F, WS_ROPES);
      for (int e = (F.vcu * NWAVES * 64 + cur_tid(F)); e < SEQ * 32; e += F.G * NWAVES * 64) { const int t = e >> 5, i = e & 31;
          const float inv = powf(10000.0f, -(float)(2 * i) / 64.0f); const float ang = (float)t * inv; RC[e] = cosf(ang); RS[e] = sinf(ang); } }
    if (F.wave == 0) for (int it = F.vcu; it < 128; it += F.G) { const int kv = it >> 6, c = it & 63; const float* pos = kv ? F.pos_v : F.pos_k; const float* w1 = kv ? F.w1_v : F.w1_k; float s = 0.f;
        for (int k = lane; k < 2048; k += 64) s += pos[k] * w1[(size_t)k * 64 + c];
        s = wave_sum(s); if (lane == 0) wsp<float>(F, kv ? WS_PBV : WS_PBK)[c] = s; }
    rms_rows_to_bf16(lane, gw, NGW, F.x, F.g_mix_pre, wsp<bf16>(F, WS_HB));
}

__device__ __forceinline__ int crow(int r, int hi) { return (r & 3) + 8 * (r >> 2) + 4 * hi; }
#define P2_PIN8(a) asm volatile("" : "+v"(a[0]), "+v"(a[1]), "+v"(a[2]), "+v"(a[3]), "+v"(a[4]), "+v"(a[5]), "+v"(a[6]), "+v"(a[7]))
__device__ __forceinline__ void p2_compress_unit(Frame& F, int unit) {
    const int bg = unit >> 2, kv = (unit >> 1) & 1, half = unit & 1, lane = cur_lane(), w = F.wave;
    const bf16* X = wsp<bf16>(F, WS_KV + (size_t)kv * KV_STRIDE) + (size_t)bg * SEQ * 64;
    const bf16* W1t = wsp<bf16>(F, kv ? WS_W1V : WS_W1K); const bf16* W2t = wsp<bf16>(F, kv ? WS_W2V : WS_W2K); const float* PB = wsp<float>(F, kv ? WS_PBV : WS_PBK);
    bf16* OUT = wsp<bf16>(F, kv ? WS_VCMP : WS_KCMP) + (size_t)bg * 128 * 64;
    const int rt = w & 1, ct = (w >> 1) & 1, kh = w >> 2, r = lane & 31, h = lane >> 5;
    const int irow = 64 * half + 32 * rt + r, ild = irow < 126 ? irow : 126;
    const GAS bf16x8* arow = (const GAS bf16x8*)(X + (size_t)ild * 1024 + kh * 1024); const GAS bf16x8* brow = (const GAS bf16x8*)(W1t + (size_t)(32 * ct + r) * 2048 + kh * 1024);
#define P2_KIDX(S) (8 * ((S) >> 2) + 4 * h + ((S) & 3))
    f32x16 acc = {};
    bf16x8 a0[8], b0[8], a1[8], b1[8];
#pragma unroll
    for (int s = 0; s < 8; ++s) { a0[s] = arow[P2_KIDX(s)]; b0[s] = brow[P2_KIDX(s)]; }
#pragma unroll 1
    for (int bt = 0; bt < 8; bt += 2) {
#pragma unroll
        for (int s = 0; s < 8; ++s) { a1[s] = arow[P2_KIDX(8 * (bt + 1) + s)]; b1[s] = brow[P2_KIDX(8 * (bt + 1) + s)]; }
        P2_PIN8(a0); P2_PIN8(b0);
#pragma unroll
        for (int s = 0; s < 8; ++s) acc = __builtin_amdgcn_mfma_f32_32x32x16_bf16(a0[s], b0[s], acc, 0, 0, 0);
        if (bt + 2 < 8) {
#pragma unroll
            for (int s = 0; s < 8; ++s) { a0[s] = arow[P2_KIDX(8 * (bt + 2) + s)]; b0[s] = brow[P2_KIDX(8 * (bt + 2) + s)]; } }
#undef P2_KIDX_DONE
        P2_PIN8(a1); P2_PIN8(b1);
#pragma unroll
        for (int s = 0; s < 8; ++s) acc = __builtin_amdgcn_mfma_f32_32x32x16_bf16(a1[s], b1[s], acc, 0, 0, 0);
    }
    LAS float* red = (LAS float*)(F.lds + RING_OFF);
    LAS bf16* Hs = (LAS bf16*)(F.lds + RING_OFF + 16384);
    if (kh == 1) {
#pragma unroll
        for (int i = 0; i < 16; ++i) red[((w & 3) * 16 + i) * 64 + lane] = acc[i];
    }
    __syncthreads();
    if (kh == 0) { const float pb = PB[32 * ct + r];
#pragma unroll
        for (int i = 0; i < 16; ++i) { float v = acc[i] + red[((w & 3) * 16 + i) * 64 + lane] + pb; v = v / (1.0f + __expf(-v)); Hs[(32 * rt + crow(i, h)) * 72 + 32 * ct + r] = (bf16)f2bf(v); }
    }
    __syncthreads();
    if (kh == 0) { f32x16 o = {};
#pragma unroll
        for (int s = 0; s < 4; ++s) { const bf16x8 a = *(const LAS bf16x8*)(Hs + (32 * rt + r) * 72 + 16 * s + 8 * h), b = *(const GAS bf16x8*)(W2t + (size_t)(32 * ct + r) * 64 + 16 * s + 8 * h);
            o = __builtin_amdgcn_mfma_f32_32x32x16_bf16(a, b, o, 0, 0, 0); }
#pragma unroll
        for (int i = 0; i < 16; ++i) { const int row = 64 * half + 32 * rt + crow(i, h); OUT[(size_t)row * 64 + 32 * ct + r] = (bf16)(row == 127 ? 0u : f2bf(o[i])); }
    }
    __syncthreads();
}
__device__ __forceinline__ void p2_phase(Frame& F) {
    for (int id = F.vcu; id < BATCH * 8; id += F.G) { const int b = id >> 3, h = id & 7, tid = cur_tid(F), lane = cur_lane(), w = F.wave;
        LAS float* wt = (LAS float*)(F.lds + RING_OFF + 32768);
        const float* lf = wsp<float>(F, WS_LF) + ((size_t)b * SEQ + 4 * tid) * 8 + h; float v[4];
#pragma unroll
        for (int i = 0; i < 4; ++i) v[i] = lf[i * 8];
        const float tot = (v[0] + v[1]) + (v[2] + v[3]); float incl = tot;
#pragma unroll
        for (int o = 1; o < 64; o <<= 1) { const float n = __shfl_up(incl, o); if (lane >= o) incl += n; }
        if (lane == 63) wt[w] = incl;
        __syncthreads();
        float run = incl - tot;
        for (int k = 0; k < w; ++k) run += wt[k];
        float* c = wsp<float>(F, WS_C) + (size_t)id * SEQ + 4 * tid; GAS v4u* kx = (GAS v4u*)(wsp<bf16>(F, WS_FKX) + ((size_t)id * SEQ + 4 * tid) * 16);
        float cv[4];
#pragma unroll
        for (int i = 0; i < 4; ++i) { run += v[i]; cv[i] = run;
            const float x = -run * LOG2E; const unsigned h1 = f2bf(x); const float r1 = x - __uint_as_float(h1 << 16); const unsigned h2 = f2bf(r1); const float r2 = r1 - __uint_as_float(h2 << 16); const unsigned h3 = f2bf(r2);
            kx[2 * i] = (v4u){h1 | (h2 << 16), h3, 0u, 0u}; kx[2 * i + 1] = (v4u){0u, 0u, 0u, 0u}; }
        *(GAS f32x4*)c = (f32x4){cv[0], cv[1], cv[2], cv[3]};
        { LAS float* cl = (LAS float*)(F.lds + RING_OFF + 36864); LAS float* wk = cl + 2048; LAS float* wq = wk + 256;
          *(LAS f32x4*)(cl + 4 * tid) = (f32x4){cv[0], cv[1], cv[2], cv[3]};
          const GAS v4u* kr = (const GAS v4u*)(wsp<bf16>(F, WS_FK) + ((size_t)b * SEQ + (tid >> 3)) * 512 + h * 64 + (tid & 7) * 8);
          const GAS v4u* qrw = (const GAS v4u*)(wsp<bf16>(F, WS_FQ) + ((size_t)b * SEQ + (tid >> 3)) * 512 + h * 64 + (tid & 7) * 8);
#pragma unroll 1
          for (int i0 = 0; i0 < 32; i0 += 16) { v4u ka[16], qa[16];
#pragma unroll
              for (int i = 0; i < 16; ++i) { ka[i] = kr[(size_t)(i0 + i) * 64 * 64]; qa[i] = qrw[(size_t)(i0 + i) * 64 * 64]; }
              asm volatile("" : "+v"(ka[0]), "+v"(ka[1]), "+v"(ka[2]), "+v"(ka[3]), "+v"(ka[4]), "+v"(ka[5]), "+v"(ka[6]), "+v"(ka[7]), "+v"(ka[8]), "+v"(ka[9]), "+v"(ka[10]), "+v"(ka[11]), "+v"(ka[12]), "+v"(ka[13]), "+v"(ka[14]), "+v"(ka[15]));
              asm volatile("" : "+v"(qa[0]), "+v"(qa[1]), "+v"(qa[2]), "+v"(qa[3]), "+v"(qa[4]), "+v"(qa[5]), "+v"(qa[6]), "+v"(qa[7]), "+v"(qa[8]), "+v"(qa[9]), "+v"(qa[10]), "+v"(qa[11]), "+v"(qa[12]), "+v"(qa[13]), "+v"(qa[14]), "+v"(qa[15]));
#pragma unroll
              for (int i = 0; i < 16; ++i) { const v4u a = ka[i], e = qa[i];
                  float sk = (bfl(a.x) * bfl(a.x) + bfh(a.x) * bfh(a.x)) + (bfl(a.y) * bfl(a.y) + bfh(a.y) * bfh(a.y)) + (bfl(a.z) * bfl(a.z) + bfh(a.z) * bfh(a.z)) + (bfl(a.w) * bfl(a.w) + bfh(a.w) * bfh(a.w));
                  float sq = (bfl(e.x) * bfl(e.x) + bfh(e.x) * bfh(e.x)) + (bfl(e.y) * bfl(e.y) + bfh(e.y) * bfh(e.y)) + (bfl(e.z) * bfl(e.z) + bfh(e.z) * bfh(e.z)) + (bfl(e.w) * bfl(e.w) + bfh(e.w) * bfh(e.w));
                  sk += __shfl_xor(sk, 1); sq += __shfl_xor(sq, 1); sk += __shfl_xor(sk, 2); sq += __shfl_xor(sq, 2); sk += __shfl_xor(sk, 4); sq += __shfl_xor(sq, 4);
                  sk = fmaxf(sk, __shfl_xor(sk, 8)); sq = fmaxf(sq, __shfl_xor(sq, 8)); sk = fmaxf(sk, __shfl_xor(sk, 16)); sq = fmaxf(sq, __shfl_xor(sq, 16)); sk = fmaxf(sk, __shfl_xor(sk, 32)); sq = fmaxf(sq, __shfl_xor(sq, 32));
                  if (lane == 0) { wk[w * 32 + i0 + i] = sk; wq[w * 32 + i0 + i] = sq; } } }
          __syncthreads();
          if (tid < 8) { const int qb = tid; float Qm = 0.f, Kband = 0.f;
              for (int t4 = 0; t4 < 4; ++t4) for (int ww = 0; ww < 8; ++ww) { Qm = fmaxf(Qm, wq[ww * 32 + 4 * qb + t4]); Kband = fmaxf(Kband, wk[ww * 32 + 4 * qb + t4]); }
              Qm = sqrtf(Qm) * 1.001f; Kband = sqrtf(Kband) * 1.001f;
              const float cq0 = cl[256 * qb]; int kt0 = 4 * qb;
              for (int kt = 4 * qb - 1; kt >= 0; --kt) { float kk = 0.f; for (int ww = 0; ww < 8; ++ww) kk = fmaxf(kk, wk[ww * 32 + kt]); kk = sqrtf(kk) * 1.001f;
                  const float bound = Qm * (kk + Kband) + (cq0 - cl[64 * kt + 63]) * LOG2E; if (bound >= -40.0f) kt0 = kt; }
              wsp<int>(F, WS_KT0)[id * 8 + qb] = kt0; } }
        __syncthreads(); }
    for (int u = F.vcu; u < 256; u += F.G) p2_compress_unit(F, u);
}

template <bool FINAL>
__device__ __forceinline__ void row_pass(Frame& F, const float* xin_f32, const bf16* xin_b16, const bf16* Y, const float* gpost, float* out_f32, bf16* X1B, float* RSTD2) {
    constexpr int RP = 4;
    const int gw = F.vcu * NWAVES + F.wave, NGW = F.G * NWAVES, lane = cur_lane();
    const GAS f32x4* gp = (const GAS f32x4*)gpost + lane;
    f32x4 gpv[4];
#pragma unroll
    for (int j = 0; j < 4; ++j) gpv[j] = gp[64 * j];
    for (int m0 = gw; m0 < MTOK; m0 += NGW * RP) {
        f32x4 xv[RP][4]; unsigned long long yw[RP][4];
#pragma unroll
        for (int r = 0; r < RP; ++r) { const size_t m = (size_t)(m0 + r * NGW);
            const GAS unsigned long long* yr = (const GAS unsigned long long*)(Y + m * DMODEL) + lane;
            if (FINAL) { const GAS unsigned long long* xr = (const GAS unsigned long long*)(xin_b16 + m * DMODEL) + lane;
#pragma unroll
                for (int j = 0; j < 4; ++j) { const unsigned long long w = __builtin_nontemporal_load(xr + 64 * j); const unsigned lo = (unsigned)w, hi = (unsigned)(w >> 32); xv[r][j] = (f32x4){bfl(lo), bfh(lo), bfl(hi), bfh(hi)}; yw[r][j] = __builtin_nontemporal_load(yr + 64 * j); }
            } else { const GAS f32x4* xr = (const GAS f32x4*)(xin_f32 + m * DMODEL) + lane;
#pragma unroll
                for (int j = 0; j < 4; ++j) { xv[r][j] = __builtin_nontemporal_load(xr + 64 * j); yw[r][j] = __builtin_nontemporal_load(yr + 64 * j); } } }
#pragma unroll
        for (int r = 0; r < RP; ++r) { const size_t m = (size_t)(m0 + r * NGW);
            f32x4 yv[4]; float s = 0.f;
#pragma unroll
            for (int j = 0; j < 4; ++j) { const unsigned lo = (unsigned)yw[r][j], hi = (unsigned)(yw[r][j] >> 32);
                yv[j] = (f32x4){bfl(lo), bfh(lo), bfl(hi), bfh(hi)}; s += (yv[j].x * yv[j].x + yv[j].y * yv[j].y) + (yv[j].z * yv[j].z + yv[j].w * yv[j].w); }
            const float rr = 1.0f / sqrtf(wave_sum(s) * (1.f / DMODEL) + RMS_EPS); float s2 = 0.f;
            if (FINAL) { GAS f32x4* xo = (GAS f32x4*)(out_f32 + m * DMODEL) + lane;
#pragma unroll
                for (int j = 0; j < 4; ++j) __builtin_nontemporal_store(xv[r][j] + yv[j] * rr * gpv[j], xo + 64 * j);
            } else { GAS unsigned long long* o8 = (GAS unsigned long long*)(X1B + m * DMODEL) + lane;
#pragma unroll
                for (int j = 0; j < 4; ++j) { const f32x4 v = xv[r][j] + yv[j] * rr * gpv[j]; s2 += (v.x * v.x + v.y * v.y) + (v.z * v.z + v.w * v.w);
                    o8[64 * j] = (unsigned long long)pk2(v.x, v.y) | ((unsigned long long)pk2(v.z, v.w) << 32); }
                const float r2 = 1.0f / sqrtf(wave_sum(s2) * (1.f / DMODEL) + RMS_EPS); if (lane == 0) RSTD2[m] = r2; }
        }
    }
}

namespace at {
constexpr int KSLOT = 10240, VSLOT = 8192, NSLOT = 3;
constexpr int L_K = 0, L_V = NSLOT * KSLOT, L_WS = L_V + NSLOT * VSLOT, L_PARK = L_WS + 8 * 512, L_PSL = L_PARK, L_CMP = L_PARK + 4 * 64 * 33 * 4, L_SELM = L_CMP + 4 * 8192, L_NEXT = L_SELM + 256, L_END = L_NEXT + 16;
static_assert(L_SELM >= L_PARK + 8 * 8192, "park region");
static_assert(L_END <= RING_BYTES, "attention LDS map");
constexpr float THR = 8.0f;
typedef short s16x4 __attribute__((ext_vector_type(4)));
typedef short v4i16_t __attribute__((ext_vector_type(4)));
#define AT_NEG (-INFINITY)
__device__ __forceinline__ void glds16(const void* sbase, unsigned voff, unsigned lds_dst) { unsigned keep;
    asm volatile("s_mov_b32 %0, m0\n\ts_mov_b32 m0, %3\n\ts_nop 2\n\tglobal_load_lds_dwordx4 %1, %2\n\ts_mov_b32 m0, %0" : "=&s"(keep) : "v"(voff), "s"(sbase), "s"(lds_dst) : "memory"); }
__device__ __forceinline__ void glds4(const void* sbase, unsigned voff, unsigned lds_dst) { unsigned keep;
    asm volatile("s_mov_b32 %0, m0\n\ts_mov_b32 m0, %3\n\ts_nop 2\n\tglobal_load_lds_dword %1, %2\n\ts_mov_b32 m0, %0" : "=&s"(keep) : "v"(voff), "s"(sbase), "s"(lds_dst) : "memory"); }
#define AT_WAIT_BAR(N) asm volatile("s_waitcnt vmcnt(" #N ") lgkmcnt(0)\n\ts_barrier" ::: "memory")
#define AT_BAR() asm volatile("s_waitcnt lgkmcnt(0)\n\ts_barrier" ::: "memory")
__device__ __forceinline__ unsigned cvtpk(float lo, float hi) { typedef float f2 __attribute__((ext_vector_type(2))); typedef __bf16 b2 __attribute__((ext_vector_type(2))); f2 v = {lo, hi}; b2 b = __builtin_convertvector(v, b2); return __builtin_bit_cast(unsigned, b); }
__device__ __forceinline__ float swap_half(float x, int hi) { auto rr = __builtin_amdgcn_permlane32_swap(__float_as_uint(x), __float_as_uint(x), false, false); return hi ? __uint_as_float(rr[0]) : __uint_as_float(rr[1]); }
__device__ __forceinline__ float max_half(float x) { auto rr = __builtin_amdgcn_permlane32_swap(__float_as_uint(x), __float_as_uint(x), false, false); return fmaxf(__uint_as_float(rr[0]), __uint_as_float(rr[1])); }
__device__ __forceinline__ float sum_half(float x) { auto rr = __builtin_amdgcn_permlane32_swap(__float_as_uint(x), __float_as_uint(x), false, false); return __uint_as_float(rr[0]) + __uint_as_float(rr[1]); }
template <int KS>
__device__ __forceinline__ void qk(f32x16& p0, f32x16& p1, const LAS unsigned char* Kslot, const bf16x8 (&qr)[5], const f32x16& cinit, int r32, int hi) {
    const LAS unsigned char* kb = Kslot + hi * 1024 + r32 * 16;
#pragma unroll
    for (int d0 = 0; d0 < KS; ++d0) { const bf16x8 b0 = *(const LAS bf16x8*)(kb + d0 * 2048), b1 = *(const LAS bf16x8*)(kb + d0 * 2048 + 512);
        if (d0 == 0) { p0 = __builtin_amdgcn_mfma_f32_32x32x16_bf16(b0, qr[0], cinit, 0, 0, 0); p1 = __builtin_amdgcn_mfma_f32_32x32x16_bf16(b1, qr[0], cinit, 0, 0, 0); }
        else { p0 = __builtin_amdgcn_mfma_f32_32x32x16_bf16(b0, qr[d0], p0, 0, 0, 0); p1 = __builtin_amdgcn_mfma_f32_32x32x16_bf16(b1, qr[d0], p1, 0, 0, 0); } }
}
__device__ __forceinline__ s16x4 vtr(const LAS unsigned char* p) { return __builtin_bit_cast(s16x4, __builtin_amdgcn_ds_read_tr16_b64_v4i16((LAS v4i16_t*)p)); }
__device__ __forceinline__ void pv(f32x16 (&o)[2], const LAS unsigned char* vb, const f32x16& p0, const f32x16& p1) {
    v4u pw[4];
#pragma unroll
    for (int k = 0; k < 2; ++k) { pw[k] = (v4u){cvtpk(p0[8 * k], p0[8 * k + 1]), cvtpk(p0[8 * k + 2], p0[8 * k + 3]), cvtpk(p0[8 * k + 4], p0[8 * k + 5]), cvtpk(p0[8 * k + 6], p0[8 * k + 7])};
        pw[2 + k] = (v4u){cvtpk(p1[8 * k], p1[8 * k + 1]), cvtpk(p1[8 * k + 2], p1[8 * k + 3]), cvtpk(p1[8 * k + 4], p1[8 * k + 5]), cvtpk(p1[8 * k + 6], p1[8 * k + 7])}; }
#pragma unroll
    for (int d0 = 0; d0 < 2; ++d0)
#pragma unroll
        for (int ks = 0; ks < 4; ++ks) { const s16x4 lo = vtr(vb + d0 * 4096 + ks * 1024), hi = vtr(vb + d0 * 4096 + ks * 1024 + 512);
            const bf16x8 vf = (bf16x8){lo[0], lo[1], lo[2], lo[3], hi[0], hi[1], hi[2], hi[3]};
            o[d0] = __builtin_amdgcn_mfma_f32_32x32x16_bf16(__builtin_bit_cast(bf16x8, pw[ks]), vf, o[d0], 0, 0, 0); }
}
template <int KS>
__device__ __forceinline__ void load_kf(bf16x8 (&kf)[10], const LAS unsigned char* Kslot, int r32, int hi) {
    const LAS unsigned char* kb = Kslot + hi * 1024 + r32 * 16;
#pragma unroll
    for (int d0 = 0; d0 < KS; ++d0) { kf[2 * d0] = *(const LAS bf16x8*)(kb + d0 * 2048); kf[2 * d0 + 1] = *(const LAS bf16x8*)(kb + d0 * 2048 + 512); }
}
__device__ __forceinline__ void v_load(bf16x8 (&vf)[8], const LAS unsigned char* vb) {
#pragma unroll
    for (int d0 = 0; d0 < 2; ++d0)
#pragma unroll
        for (int ks = 0; ks < 4; ++ks) { const s16x4 lo = vtr(vb + d0 * 4096 + ks * 1024), hi = vtr(vb + d0 * 4096 + ks * 1024 + 512);
            vf[d0 * 4 + ks] = (bf16x8){lo[0], lo[1], lo[2], lo[3], hi[0], hi[1], hi[2], hi[3]}; }
}
template <int KS, bool LOADK>
__device__ __forceinline__ void pv_regs(f32x16 (&o)[2], const bf16x8 (&vf)[8], const f32x16& p0, const f32x16& p1, bf16x8 (&kf)[10], const LAS unsigned char* Knext, int r32, int hi) {
    v4u pw[4];
#pragma unroll
    for (int k = 0; k < 2; ++k) { pw[k] = (v4u){cvtpk(p0[8 * k], p0[8 * k + 1]), cvtpk(p0[8 * k + 2], p0[8 * k + 3]), cvtpk(p0[8 * k + 4], p0[8 * k + 5]), cvtpk(p0[8 * k + 6], p0[8 * k + 7])};
        pw[2 + k] = (v4u){cvtpk(p1[8 * k], p1[8 * k + 1]), cvtpk(p1[8 * k + 2], p1[8 * k + 3]), cvtpk(p1[8 * k + 4], p1[8 * k + 5]), cvtpk(p1[8 * k + 6], p1[8 * k + 7])}; }
#pragma unroll
    for (int ks = 0; ks < 2; ++ks)
#pragma unroll
        for (int d0 = 0; d0 < 2; ++d0) o[d0] = __builtin_amdgcn_mfma_f32_32x32x16_bf16(__builtin_bit_cast(bf16x8, pw[ks]), vf[d0 * 4 + ks], o[d0], 0, 0, 0);
    if (LOADK) { __builtin_amdgcn_sched_barrier(0); load_kf<KS>(kf, Knext, r32, hi); __builtin_amdgcn_sched_barrier(0); }
#pragma unroll
    for (int ks = 2; ks < 4; ++ks)
#pragma unroll
        for (int d0 = 0; d0 < 2; ++d0) o[d0] = __builtin_amdgcn_mfma_f32_32x32x16_bf16(__builtin_bit_cast(bf16x8, pw[ks]), vf[d0 * 4 + ks], o[d0], 0, 0, 0);
}
__device__ __forceinline__ float max3f(float a, float b, float c) { float r; asm("v_max3_f32 %0, %1, %2, %3" : "=v"(r) : "v"(a), "v"(b), "v"(c)); return r; }
__device__ __forceinline__ float rowmax32(const f32x16& p0, const f32x16& p1) {
    float a = max3f(p0[0], p0[1], p1[0]), b = max3f(p0[2], p0[3], p1[1]); a = max3f(a, p1[2], p1[3]);
#pragma unroll
    for (int r = 4; r < 16; r += 4) { a = max3f(a, p0[r], p0[r + 1]); b = max3f(b, p0[r + 2], p0[r + 3]); a = max3f(a, p1[r], p1[r + 1]); b = max3f(b, p1[r + 2], p1[r + 3]); }
    return max_half(__builtin_fmaxf(a, b));
}
template <bool FIRST>
__device__ __forceinline__ void softmax_tile(f32x16& p0, f32x16& p1, f32x16& cinit, float& l, f32x16 (&o)[2], LAS float* wsf, int r32, int hi) {
    const float rm = rowmax32(p0, p1);
    bool resc = false;
    if (FIRST) { const float dl = rm;
#pragma unroll
        for (int r = 0; r < 16; ++r) { p0[r] -= dl; p1[r] -= dl; cinit[r] -= dl; } }
    else if (__any(rm > THR)) { const float dl = fmaxf(rm, 0.f);
#pragma unroll
        for (int r = 0; r < 16; ++r) { p0[r] -= dl; p1[r] -= dl; cinit[r] -= dl; }
        const float f = __builtin_amdgcn_exp2f(-dl); l *= f; if (hi == 0) wsf[r32] = f; resc = true; }
    float s = 0.f;
#pragma unroll
    for (int r = 0; r < 16; ++r) { p0[r] = __builtin_amdgcn_exp2f(p0[r]); p1[r] = __builtin_amdgcn_exp2f(p1[r]); s += p0[r] + p1[r]; }
    l += s;
    if (resc) {
#pragma unroll
        for (int i = 0; i < 4; ++i) { const f32x4 f4 = *(const LAS f32x4*)(wsf + 8 * i + 4 * hi);
#pragma unroll
            for (int k = 0; k < 4; ++k) { o[0][4 * i + k] *= f4[k]; o[1][4 * i + k] *= f4[k]; } } }
}
__device__ __forceinline__ void row_bcast(float v, float (&out)[16], LAS float* wsf, int r32, int hi) {
    asm volatile("s_waitcnt lgkmcnt(0)" ::: "memory");
    if (hi == 0) wsf[32 + r32] = v;
#pragma unroll
    for (int i = 0; i < 4; ++i) { const f32x4 f4 = *(const LAS f32x4*)(wsf + 32 + 8 * i + 4 * hi);
#pragma unroll
        for (int k = 0; k < 4; ++k) out[4 * i + k] = f4[k]; }
    asm volatile("s_waitcnt lgkmcnt(0)" ::: "memory");
}
__device__ __forceinline__ void store_rows(const f32x16 (&v)[2], LAS unsigned char* stg_, bf16* Ow, int pitch, int lane, int r32, int hi) {
    LAS bf16* stg = (LAS bf16*)stg_;
#pragma unroll
    for (int r = 0; r < 16; ++r) { const int orow = crow(r, hi);
#pragma unroll
        for (int d0 = 0; d0 < 2; ++d0) stg[orow * 64 + d0 * 32 + r32] = (bf16)f2bf(v[d0][r]); }
    asm volatile("s_waitcnt lgkmcnt(0)" ::: "memory");
#pragma unroll
    for (int i = 0; i < 4; ++i) { const int row = i * 8 + (lane >> 3), ch = lane & 7; const v4u w = *(const LAS v4u*)(stg + row * 64 + ch * 8); *(GAS v4u*)(Ow + (size_t)row * pitch + ch * 8) = w; }
    asm volatile("s_waitcnt lgkmcnt(0)" ::: "memory");
}


template <int KS>
__device__ __forceinline__ void qk_regs(f32x16& p0, f32x16& p1, const bf16x8 (&kf)[10], const bf16x8 (&qr)[5], const f32x16& cinit) {
    p0 = __builtin_amdgcn_mfma_f32_32x32x16_bf16(kf[0], qr[0], cinit, 0, 0, 0); p1 = __builtin_amdgcn_mfma_f32_32x32x16_bf16(kf[1], qr[0], cinit, 0, 0, 0);
#pragma unroll
    for (int d0 = 1; d0 < KS; ++d0) { p0 = __builtin_amdgcn_mfma_f32_32x32x16_bf16(kf[2 * d0], qr[d0], p0, 0, 0, 0); p1 = __builtin_amdgcn_mfma_f32_32x32x16_bf16(kf[2 * d0 + 1], qr[d0], p1, 0, 0, 0); }
}
__device__ __forceinline__ void softmax_first(f32x16& p0, f32x16& p1, f32x16& cinit, float& l) {
    const float dl = rowmax32(p0, p1); float s = 0.f;
#pragma unroll
    for (int r = 0; r < 16; ++r) { cinit[r] -= dl; p0[r] = __builtin_amdgcn_exp2f(p0[r] - dl); p1[r] = __builtin_amdgcn_exp2f(p1[r] - dl); s += p0[r] + p1[r]; }
    l = s;
}
__device__ __forceinline__ void softmax_next(f32x16& p0, f32x16& p1, f32x16& cinit, float& l, f32x16 (&o)[2], LAS float* wsf, int r32, int hi) {
    const float rm = rowmax32(p0, p1);
    if (__builtin_expect(__any(rm > THR), 0)) { const float dl = __builtin_fmaxf(rm, 0.f);
#pragma unroll
        for (int r = 0; r < 16; ++r) { p0[r] -= dl; p1[r] -= dl; cinit[r] -= dl; }
        const float f = __builtin_amdgcn_exp2f(-dl); l *= f; if (hi == 0) wsf[r32] = f;
#pragma unroll
        for (int i = 0; i < 4; ++i) { const f32x4 f4 = *(const LAS f32x4*)(wsf + 8 * i + 4 * hi);
#pragma unroll
            for (int k = 0; k < 4; ++k) { o[0][4 * i + k] *= f4[k]; o[1][4 * i + k] *= f4[k]; } } }
    float s = 0.f;
#pragma unroll
    for (int r = 0; r < 16; ++r) { p0[r] = __builtin_amdgcn_exp2f(p0[r]); p1[r] = __builtin_amdgcn_exp2f(p1[r]); s += p0[r] + p1[r]; }
    l += s;
}

#define AT_CONSUME4(a, b, c, d) asm volatile("" :: "v"(a), "v"(b), "v"(c), "v"(d))

__device__ __forceinline__ void fox_unit(Frame& F, int bh, int qb, int kt0, const int ABL) {
    int tid_ = cur_tid(F); asm volatile("" : "+v"(tid_));
    const int lane = tid_ & 63, r32 = lane & 31, hi = lane >> 5, wid = F.wave; const int b = bh >> 3, h = bh & 7;
    LAS unsigned char* shm = F.lds + RING_OFF; const unsigned lds0 = (unsigned)(uintptr_t)shm;
    LAS float* wsf = (LAS float*)(shm + L_WS + wid * 512);
    const size_t rowbase = (size_t)b * SEQ; const int q0 = qb * 256;
    const bf16* Q = wsp<bf16>(F, WS_FQ); const bf16* K = wsp<bf16>(F, WS_FK) + (rowbase + (size_t)kt0 * 64) * 512 + h * 64; const bf16* V = wsp<bf16>(F, WS_FV) + (rowbase + (size_t)kt0 * 64) * 512 + h * 64;
    const bf16* KX = wsp<bf16>(F, WS_FKX) + ((size_t)bh * SEQ + (size_t)kt0 * 64) * 16;
    const unsigned koff = (unsigned)(lane * 512 + wid * 8) * 2u, voff = (unsigned)((16 * (wid & 3) + (lane >> 2)) * 512 + (wid >> 2) * 32 + (lane & 3) * 8) * 2u;
    const unsigned xoff = (unsigned)((16 * (wid & 3) + (lane >> 2)) * 16 + (wid >> 2) * 8 + (lane & 3) * 2) * 2u;
    const unsigned kdst = lds0 + L_K + wid * 1024, vdst = lds0 + L_V + wid * 1024, xdst = lds0 + L_K + (8 + (wid >> 2)) * 1024 + (wid & 3) * 256;
#define FX_DMA_K(t, slot) do { glds16(K + (size_t)(t) * 64 * 512, koff, (unsigned)__builtin_amdgcn_readfirstlane(kdst + (slot) * KSLOT)); \
        glds4(KX + (size_t)(t) * 64 * 16, xoff, (unsigned)__builtin_amdgcn_readfirstlane(xdst + (slot) * KSLOT)); } while (0)
#define FX_DMA_V(t, slot) glds16(V + (size_t)(t) * 64 * 512, voff, (unsigned)__builtin_amdgcn_readfirstlane(vdst + (slot) * VSLOT))
    const int NT = 4 * qb + 4 - kt0;
    bf16x8 qr[5];
    { const bf16* Qw = Q + (rowbase + q0 + wid * 32 + r32) * 512 + h * 64;
#pragma unroll
      for (int d0 = 0; d0 < 4; ++d0) qr[d0] = *(const GAS bf16x8*)(Qw + d0 * 16 + hi * 8);
      const short one = (short)0x3F80; qr[4] = hi == 0 ? (bf16x8){one, one, one, 0, 0, 0, 0, 0} : (bf16x8){0, 0, 0, 0, 0, 0, 0, 0}; }
    const float ct = wsp<float>(F, WS_C)[(size_t)bh * SEQ + q0 + wid * 32 + r32] * LOG2E;
    asm volatile("" ::: "memory");
    FX_DMA_K(0, 0); FX_DMA_V(0, 0); FX_DMA_K(1, 1); FX_DMA_K(2, 2); FX_DMA_V(1, 1);
    f32x16 cinit;
    f32x16 o[2]; o[0] = f32x16{}; o[1] = f32x16{}; float l = 0.f;
    const int qrel = wid * 32 + r32;
    const LAS unsigned char* vtb = shm + L_V + ((lane >> 4) & 1) * 32 + (lane & 3) * 8 + (4 * hi + ((lane & 15) >> 2)) * 64;
    bf16x8 kf[10], vf[8];
    AT_WAIT_BAR(3);
    AT_CONSUME4(qr[0], qr[1], qr[2], qr[3]); asm volatile("" :: "v"(ct));
#pragma unroll
    for (int r = 0; r < 16; ++r) cinit[r] = ct;
    load_kf<5>(kf, shm + L_K, r32, hi);
    int s0 = 0, s1 = 1, s2 = 2;
#define FX_MASK(n) do { const int jb_ = (n) - (NT - 4); if (jb_ >= 0) { const int kb_ = 64 * jb_ + 4 * hi; \
        _Pragma("unroll") for (int r = 0; r < 16; ++r) { const int kv = kb_ + (r & 3) + 8 * (r >> 2); if (kv > qrel) p0[r] = AT_NEG; if (kv + 32 > qrel) p1[r] = AT_NEG; } } } while (0)
#define FX_ROT() do { const int t_ = s0; s0 = s1; s1 = s2; s2 = t_; } while (0)
    if (ABL != 7) {
    {
      AT_WAIT_BAR(3); FX_DMA_K(3, 0); FX_DMA_V(2, 2);
      f32x16 p0, p1; qk_regs<5>(p0, p1, kf, qr, cinit); v_load(vf, vtb); __builtin_amdgcn_sched_barrier(0);
      FX_MASK(0); softmax_first(p0, p1, cinit, l); pv_regs<5, true>(o, vf, p0, p1, kf, shm + L_K + KSLOT, r32, hi); FX_ROT(); }
    int n = 1;
    for (; n + 3 < NT; ++n) {
        if (ABL == 4) asm volatile("s_waitcnt vmcnt(3) lgkmcnt(0)" ::: "memory"); else AT_WAIT_BAR(3);
        if (ABL != 5) { FX_DMA_K(n + 3, s0); FX_DMA_V(n + 2, s2); }
        f32x16 p0, p1; if (ABL == 3) { p0 = cinit; p1 = cinit; asm volatile("" : "+v"(p0), "+v"(p1)); } else qk_regs<5>(p0, p1, kf, qr, cinit);
        v_load(vf, vtb + s0 * VSLOT); __builtin_amdgcn_sched_barrier(0);
        FX_MASK(n);
        if (ABL == 6) { asm volatile("" : "+v"(p0), "+v"(p1)); }
        else if (ABL == 1) { const float rm = rowmax32(p0, p1); l += rm; asm volatile("" : "+v"(p0), "+v"(p1)); }
        else softmax_next(p0, p1, cinit, l, o, wsf, r32, hi);
        if (ABL == 2) { asm volatile("" :: "v"(p0), "v"(p1), "v"(vf[0]), "v"(vf[1]), "v"(vf[2]), "v"(vf[3]), "v"(vf[4]), "v"(vf[5]), "v"(vf[6]), "v"(vf[7])); load_kf<5>(kf, shm + L_K + s1 * KSLOT, r32, hi); }
        else pv_regs<5, true>(o, vf, p0, p1, kf, shm + L_K + s1 * KSLOT, r32, hi);
        FX_ROT(); }
    {
      AT_WAIT_BAR(3); FX_DMA_V(n + 2, s2);
      f32x16 p0, p1; qk_regs<5>(p0, p1, kf, qr, cinit); v_load(vf, vtb + s0 * VSLOT); __builtin_amdgcn_sched_barrier(0);
      FX_MASK(n); softmax_next(p0, p1, cinit, l, o, wsf, r32, hi); pv_regs<5, true>(o, vf, p0, p1, kf, shm + L_K + s1 * KSLOT, r32, hi); FX_ROT(); ++n; }
    {
      AT_WAIT_BAR(1);
      f32x16 p0, p1; qk_regs<5>(p0, p1, kf, qr, cinit); v_load(vf, vtb + s0 * VSLOT); __builtin_amdgcn_sched_barrier(0);
      FX_MASK(n); softmax_next(p0, p1, cinit, l, o, wsf, r32, hi); pv_regs<5, true>(o, vf, p0, p1, kf, shm + L_K + s1 * KSLOT, r32, hi); FX_ROT(); ++n; }
    {
      AT_WAIT_BAR(0);
      f32x16 p0, p1; qk_regs<5>(p0, p1, kf, qr, cinit); v_load(vf, vtb + s0 * VSLOT); __builtin_amdgcn_sched_barrier(0);
      FX_MASK(n); softmax_next(p0, p1, cinit, l, o, wsf, r32, hi); pv_regs<5, false>(o, vf, p0, p1, kf, shm, r32, hi); }
    } else { asm volatile("s_waitcnt vmcnt(0)" ::: "memory"); l = 1.f; }
#undef FX_DMA_K
#undef FX_DMA_V
#undef FX_MASK
#undef FX_ROT
    l = sum_half(l); float rl[16]; row_bcast(1.0f / l, rl, wsf, r32, hi);
#pragma unroll
    for (int r = 0; r < 16; ++r) { o[0][r] *= rl[r]; o[1][r] *= rl[r]; }
    store_rows(o, shm + L_PARK + wid * 8192, wsp<bf16>(F, ABL ? WS_PROBE_O : WS_ATT) + (rowbase + q0 + wid * 32) * 1024 + 512 + h * 64, 1024, lane, r32, hi);
    AT_BAR();
}

__device__ __forceinline__ void nsa_unit(Frame& F, int bg, int j) {
    int tid_ = cur_tid(F); asm volatile("" : "+v"(tid_));
    const int tid = tid_, lane = tid & 63, r32 = lane & 31, hi = lane >> 5, wid = F.wave; const int b = bg >> 1, g = bg & 1, hh = wid >> 1, head = 4 * g + hh;
    LAS unsigned char* shm = F.lds + RING_OFF; const unsigned lds0 = (unsigned)(uintptr_t)shm;
    LAS float* wsf = (LAS float*)(shm + L_WS + wid * 512);
    LAS float* PSL = (LAS float*)(shm + L_PSL); LAS unsigned* SELM = (LAS unsigned*)(shm + L_SELM);
    const int qrel = 32 * (wid & 1) + r32, t = 64 * j + qrel; const size_t row = (size_t)b * SEQ + t;
    const bf16* KC = wsp<bf16>(F, WS_KCMP) + (size_t)bg * 128 * 64; const bf16* VC = wsp<bf16>(F, WS_VCMP) + (size_t)bg * 128 * 64;
    const bf16* KS = wsp<bf16>(F, WS_KV + 2 * KV_STRIDE) + (size_t)bg * SEQ * 64; const bf16* VS = wsp<bf16>(F, WS_KV + 3 * KV_STRIDE) + (size_t)bg * SEQ * 64;
    const bf16* KW = wsp<bf16>(F, WS_KV + 4 * KV_STRIDE) + (size_t)bg * SEQ * 64; const bf16* VW = wsp<bf16>(F, WS_KV + 5 * KV_STRIDE) + (size_t)bg * SEQ * 64;
    const unsigned koff = (unsigned)(lane * 64 + wid * 8) * 2u, voff = (unsigned)((16 * (wid & 3) + (lane >> 2)) * 64 + (wid >> 2) * 32 + (lane & 3) * 8) * 2u;
    const unsigned kdst = lds0 + L_K + wid * 1024, vdst = lds0 + L_V + wid * 1024, cdst = lds0 + L_CMP + wid * 1024;
    const int nsel = j + 1, nwin = j >= 8 ? 9 : j + 1, NR = nsel + nwin;
#define NS_TILE(m) ({ int m_ = (m); m_ = m_ < NR ? m_ : NR - 1; (m_ < nsel) ? m_ : (j - (m_ - nsel)) + 64; })
#define NS_DMA_K(m, slot) do { const int e_ = NS_TILE(m); const bf16* kp_ = (e_ < 64) ? KS + e_ * 4096 : KW + (e_ - 64) * 4096; glds16(kp_, koff, (unsigned)__builtin_amdgcn_readfirstlane(kdst + (slot) * KSLOT)); } while (0)
#define NS_DMA_V(m, slot) do { const int e_ = NS_TILE(m); const bf16* vp_ = (e_ < 64) ? VS + e_ * 4096 : VW + (e_ - 64) * 4096; glds16(vp_, voff, (unsigned)__builtin_amdgcn_readfirstlane(vdst + (slot) * VSLOT)); } while (0)
    bf16x8 qr[5];
    { const bf16* Qw = wsp<bf16>(F, WS_NQ) + row * 512 + head * 64;
#pragma unroll
      for (int d0 = 0; d0 < 4; ++d0) qr[d0] = *(const GAS bf16x8*)(Qw + d0 * 16 + hi * 8);
      qr[4] = (bf16x8){0, 0, 0, 0, 0, 0, 0, 0}; }
    const float* gt = wsp<float>(F, WS_GATE) + row * 24 + head * 3; const float g0 = gt[0], g1 = gt[1], g2 = gt[2];
    asm volatile("" ::: "memory");
    glds16(KC, koff, (unsigned)__builtin_amdgcn_readfirstlane(cdst)); glds16(KC + 4096, koff, (unsigned)__builtin_amdgcn_readfirstlane(cdst + 8192));
    glds16(VC, voff, (unsigned)__builtin_amdgcn_readfirstlane(cdst + 16384)); glds16(VC + 4096, voff, (unsigned)__builtin_amdgcn_readfirstlane(cdst + 24576));
    NS_DMA_K(0, 0); NS_DMA_V(0, 0); NS_DMA_K(1, 1); NS_DMA_K(2, 2); NS_DMA_V(1, 1);
    const LAS unsigned char* vlane = shm + ((lane >> 4) & 1) * 32 + (lane & 3) * 8 + (4 * hi + ((lane & 15) >> 2)) * 64;
    const LAS unsigned char* vtb = vlane + L_V;
    f32x16 o[2]; float rs[16]; bf16x8 kf[10], vf[8];
    LAS float* park = (LAS float*)(shm + L_PARK + wid * 8192) + lane;
    AT_WAIT_BAR(5);
    AT_CONSUME4(qr[0], qr[1], qr[2], qr[3]); asm volatile("" :: "v"(g0), "v"(g1), "v"(g2));
    { f32x16 zero = f32x16{}; f32x16 a0, a1, b0, b1;
      load_kf<4>(kf, shm + L_CMP, r32, hi); qk_regs<4>(a0, a1, kf, qr, zero); load_kf<4>(kf, shm + L_CMP + 8192, r32, hi); qk_regs<4>(b0, b1, kf, qr, zero);
      const int nmax = (t - 31) >> 4;
#pragma unroll
      for (int r = 0; r < 16; ++r) { const int n = (r & 3) + 8 * (r >> 2) + 4 * hi; if (n > nmax) a0[r] = AT_NEG; if (n + 32 > nmax) a1[r] = AT_NEG; if (n + 64 > nmax) b0[r] = AT_NEG; if (n + 96 > nmax) b1[r] = AT_NEG; }
      float m = __builtin_fmaxf(rowmax32(a0, a1), rowmax32(b0, b1)); m = (m == AT_NEG) ? 0.f : m;
      float s = 0.f;
#pragma unroll
      for (int r = 0; r < 16; ++r) { a0[r] = __builtin_amdgcn_exp2f(a0[r] - m); a1[r] = __builtin_amdgcn_exp2f(a1[r] - m); b0[r] = __builtin_amdgcn_exp2f(b0[r] - m); b1[r] = __builtin_amdgcn_exp2f(b1[r] - m); s += (a0[r] + a1[r]) + (b0[r] + b1[r]); }
      s = sum_half(s); const float inv = 1.0f / fmaxf(s, 1e-30f);
#pragma unroll
      for (int r = 0; r < 16; ++r) { a0[r] *= inv; a1[r] *= inv; b0[r] *= inv; b1[r] *= inv; }
      if (j >= 8) {
          float G[16], Lp[16];
#pragma unroll
          for (int i = 0; i < 4; ++i) { G[i] = (a0[4 * i] + a0[4 * i + 1]) + (a0[4 * i + 2] + a0[4 * i + 3]); G[4 + i] = (a1[4 * i] + a1[4 * i + 1]) + (a1[4 * i + 2] + a1[4 * i + 3]);
              G[8 + i] = (b0[4 * i] + b0[4 * i + 1]) + (b0[4 * i + 2] + b0[4 * i + 3]); G[12 + i] = (b1[4 * i] + b1[4 * i + 1]) + (b1[4 * i + 2] + b1[4 * i + 3]);
              Lp[i] = swap_half(a0[4 * i + 3], hi); Lp[4 + i] = swap_half(a1[4 * i + 3], hi); Lp[8 + i] = swap_half(b0[4 * i + 3], hi); Lp[12 + i] = swap_half(b1[4 * i + 3], hi); }
          LAS float* dst = PSL + (hh * 64 + qrel) * 33 + hi;
#pragma unroll
          for (int I = 0; I < 16; ++I) { const float prev = hi ? Lp[I] : (I > 0 ? Lp[I > 0 ? I - 1 : 0] : 0.f); dst[2 * I] = G[I] + prev; }
      }
      o[0] = f32x16{}; o[1] = f32x16{};
      pv(o, vlane + L_CMP + 16384, a0, a1); pv(o, vlane + L_CMP + 24576, b0, b1);
    }
    AT_BAR();
    if (j >= 8) { const int q = tid >> 3, sub = tid & 7;
        float v[4]; unsigned bits = 1u | (1u << j) | (1u << (j - 1));
#pragma unroll
        for (int c4 = 0; c4 < 4; ++c4) { const int k = 4 * sub + c4;
            const float ps = (PSL[(0 * 64 + q) * 33 + k] + PSL[(1 * 64 + q) * 33 + k]) + (PSL[(2 * 64 + q) * 33 + k] + PSL[(3 * 64 + q) * 33 + k]);
            v[c4] = (k > j - 2 || k == 0) ? -1e30f : ps; }
#pragma unroll 1
        for (int rnd = 0; rnd < 5; ++rnd) {
            float bv = v[0]; int bi = 4 * sub;
#pragma unroll
            for (int c4 = 1; c4 < 4; ++c4) if (v[c4] > bv) { bv = v[c4]; bi = 4 * sub + c4; }
#pragma unroll
            for (int o = 1; o < 8; o <<= 1) { const float ov = __shfl_xor(bv, o); const int oi = __shfl_xor(bi, o); if (ov > bv || (ov == bv && oi < bi)) { bv = ov; bi = oi; } }
            bits |= 1u << bi;
#pragma unroll
            for (int c4 = 0; c4 < 4; ++c4) if (bi == 4 * sub + c4) v[c4] = -3.0e38f; }
        if (sub == 0) SELM[q] = bits;
    } else { if (tid < 64) SELM[tid] = (2u << j) - 1u; }
    AT_BAR();
    const unsigned selm = SELM[qrel];
    row_bcast(g0, rs, wsf, r32, hi);
#pragma unroll
    for (int r = 0; r < 16; ++r) { park[r * 64] = o[0][r] * rs[r]; park[(16 + r) * 64] = o[1][r] * rs[r]; }
    f32x16 cinit; float l;
    AT_WAIT_BAR(2);
    load_kf<4>(kf, shm + L_K, r32, hi);
    int s0 = 0, s1 = 1, s2 = 2, m = 0;
#define NS_ROT() do { const int t_ = s0; s0 = s1; s1 = s2; s2 = t_; ++m; } while (0)
#define NS_HEAD() AT_WAIT_BAR(2); NS_DMA_K(m + 3, s0); NS_DMA_V(m + 2, s2); f32x16 p0, p1; qk_regs<4>(p0, p1, kf, qr, cinit); v_load(vf, vtb + s0 * VSLOT); __builtin_amdgcn_sched_barrier(0)
#define NS_MASK_SEL() do { const float keep_ = ((selm >> m) & 1u) ? 0.f : AT_NEG;        \
        _Pragma("unroll") for (int r = 0; r < 16; ++r) { p0[r] += keep_; p1[r] += keep_; } \
        if (m == j) {   \
        _Pragma("unroll") for (int r = 0; r < 16; ++r) { const int kk = (r & 3) + 8 * (r >> 2) + 4 * hi; if (kk > qrel) p0[r] = AT_NEG; if (kk + 32 > qrel) p1[r] = AT_NEG; } } } while (0)
#define NS_MASK_WIN() do { const int tt = j - (m - nsel); if (tt == j) { \
        _Pragma("unroll") for (int r = 0; r < 16; ++r) { const int kk = (r & 3) + 8 * (r >> 2) + 4 * hi; if (kk > qrel) p0[r] = AT_NEG; if (kk + 32 > qrel) p1[r] = AT_NEG; } } \
      else if (tt == j - 8) {   \
        _Pragma("unroll") for (int r = 0; r < 16; ++r) { const int kk = (r & 3) + 8 * (r >> 2) + 4 * hi; if (kk <= qrel) p0[r] = AT_NEG; if (kk + 32 <= qrel) p1[r] = AT_NEG; } } } while (0)
    cinit = f32x16{}; o[0] = f32x16{}; o[1] = f32x16{};
    { NS_HEAD(); NS_MASK_SEL(); softmax_first(p0, p1, cinit, l); pv_regs<4, true>(o, vf, p0, p1, kf, shm + L_K + s1 * KSLOT, r32, hi); NS_ROT(); }
    for (; m < nsel;) { NS_HEAD(); NS_MASK_SEL(); softmax_next(p0, p1, cinit, l, o, wsf, r32, hi); pv_regs<4, true>(o, vf, p0, p1, kf, shm + L_K + s1 * KSLOT, r32, hi); NS_ROT(); }
    l = sum_half(l); row_bcast(g1 / l, rs, wsf, r32, hi);
#pragma unroll
    for (int r = 0; r < 16; ++r) { park[r * 64] += o[0][r] * rs[r]; park[(16 + r) * 64] += o[1][r] * rs[r]; }
    cinit = f32x16{}; o[0] = f32x16{}; o[1] = f32x16{};
    { NS_HEAD(); NS_MASK_WIN(); softmax_first(p0, p1, cinit, l); pv_regs<4, true>(o, vf, p0, p1, kf, shm + L_K + s1 * KSLOT, r32, hi); NS_ROT(); }
    for (; m < NR;) { NS_HEAD(); NS_MASK_WIN(); softmax_next(p0, p1, cinit, l, o, wsf, r32, hi); pv_regs<4, true>(o, vf, p0, p1, kf, shm + L_K + s1 * KSLOT, r32, hi); NS_ROT(); }
#undef NS_HEAD
#undef NS_TILE
#undef NS_DMA_K
#undef NS_DMA_V
#undef NS_ROT
#undef NS_MASK_SEL
#undef NS_MASK_WIN
    l = sum_half(l); row_bcast(g2 / l, rs, wsf, r32, hi);
#pragma unroll
    for (int r = 0; r < 16; ++r) { o[0][r] = park[r * 64] + o[0][r] * rs[r]; o[1][r] = park[(16 + r) * 64] + o[1][r] * rs[r]; }
    asm volatile("s_waitcnt vmcnt(0) lgkmcnt(0)" ::: "memory");
    store_rows(o, shm + L_PARK + wid * 8192, wsp<bf16>(F, WS_ATT) + ((size_t)b * SEQ + 64 * j + 32 * (wid & 1)) * 1024 + head * 64, 1024, lane, r32, hi);
    AT_BAR();
}
constexpr int NUNITS = 4096;
__device__ const unsigned short BLK_TAB[64] = {64512, 63489, 62466, 61443, 60420, 59397, 58374, 57351, 56328, 55305, 54282, 53259, 52236, 51213, 50190, 49167, 48144, 47121, 46098, 45075, 44052, 43029, 42006, 40983, 39960, 38937, 37914, 36891, 35868, 2077, 2077, 2077, 2077, 3105, 3105, 3105, 3105, 4133, 4133, 4133, 4133, 5161, 5161, 5161, 5161, 6189, 6189, 6189, 6189, 7217, 7217, 7217, 7217, 34869, 1078, 1078, 1078, 1078, 33850, 32827, 60, 60, 60, 60};
}
#ifndef PROBE_ABL
#define PROBE_ABL 0
#endif
__device__ __forceinline__ void p3_attention(Frame& F, const int MODE) {
    const int G = F.G, c = F.vcu, nrounds = (at::NUNITS + G - 1) / G;
    const gu32* KT0 = (const gu32*)wsp<unsigned>(F, WS_KT0);
#define P3_UNIT(i) ((i) * G + (((i) & 1) ? G - 1 - c : c))
#define P3_KT0_IDX(u) ({ const unsigned tb_ = at::BLK_TAB[(u) >> 6]; const int ix_ = (u) - (int)(tb_ & 1023u) * 64; (tb_ >> 15) ? 0 : ix_ * 8 + (int)((tb_ >> 10) & 31u); })
    unsigned kt_next = 0u;
    { const int u0 = P3_UNIT(0); if (u0 < at::NUNITS) kt_next = __hip_atomic_load(KT0 + P3_KT0_IDX(u0), RLX_AGENT); }
    for (int i = 0; i < nrounds; ++i) {
        const int u = P3_UNIT(i); if (u >= at::NUNITS) continue;
        const int kt0 = __builtin_amdgcn_readfirstlane((int)kt_next);
        { const int un = P3_UNIT(i + 1); if (i + 1 < nrounds && un < at::NUNITS) kt_next = __hip_atomic_load(KT0 + P3_KT0_IDX(un), RLX_AGENT); }
        const unsigned tab = at::BLK_TAB[u >> 6]; const int idx = u - (int)(tab & 1023u) * 64; const int par = (tab >> 10) & 31;
        if (tab >> 15) { if (MODE != 1) at::nsa_unit(F, idx, par); } else { if (MODE != 2) at::fox_unit(F, idx, par, kt0, MODE == 1 ? PROBE_ABL : 0); }
    }
#undef P3_UNIT
#undef P3_KT0_IDX
    asm volatile("s_waitcnt vmcnt(0) lgkmcnt(0)" ::: "memory");
    __syncthreads();
}

struct Args { const float* in[18]; float* out; unsigned char* ws; int ph_lo, ph_hi, li, pad; };
__global__ void __launch_bounds__(NWAVES * 64, 2) fwd_kernel(Args args) {
    extern __shared__ __attribute__((aligned(16))) unsigned char lds[];
    Frame F;
    F.lds = (LAS unsigned char*)lds;
    F.MISC = (volatile LAS unsigned*)(F.lds + MISC_OFF);
    F.wave = __builtin_amdgcn_readfirstlane((int)threadIdx.x >> 6);
    F.G = gridDim.x; { const int bx = blockIdx.x; F.vcu = (F.G % 8 == 0) ? (bx % 8) * (F.G / 8) + bx / 8 : bx; }
    F.ws = args.ws; F.ctl = (gu32*)(args.ws + WS_CTL);
    F.x = args.in[0]; F.g_mix_pre = args.in[1]; F.g_mix_post = args.in[2]; F.g_mlp_pre = args.in[3]; F.g_mlp_post = args.in[4]; F.w_in = args.in[5]; F.b_forget = args.in[6];
    F.pos_k = args.in[7]; F.w1_k = args.in[8]; F.w2_k = args.in[9]; F.pos_v = args.in[10]; F.w1_v = args.in[11]; F.w2_v = args.in[12];
    F.w_fox = args.in[13]; F.w_nsa = args.in[14]; F.w_o = args.in[15]; F.w_up = args.in[16]; F.w_down = args.in[17]; F.out = args.out;
    for (int u = (int)threadIdx.x; u < (LDS_BYTES - LDSCTL_OFF) / 4; u += NWAVES * 64) ((LAS unsigned*)(F.lds + LDSCTL_OFF))[u] = 0u;
    __syncthreads();
    XcdBarrier bar; bar.bar = (unsigned*)(F.ctl + CW_BAR); bar.x = 0; bar.st = nullptr;
    if (N_LAUNCHES == 1) bar = xcd_barrier_post((unsigned*)(F.ctl + CW_BAR), F.MISC + 8);
#define GRID_BAR() do { if (N_LAUNCHES == 1) xcd_barrier(bar); } while (0)
    const int lo = args.ph_lo, hi = args.ph_hi;
#define IN(k) (lo <= (k) && (k) < hi)
#define BOTH(k) (IN(k) && IN((k) + 1))
#ifndef STAGGER_P7
#define STAGGER_P7 0
#endif
#ifndef STAGGER_P1
#define STAGGER_P1 0
#endif
#define XCD_STAGGER(ticks) do { if ((ticks) > 0) { const unsigned long long t0_ = rt(); const unsigned long long d_ = (unsigned long long)(xb_xcc_id() & 7u) * (unsigned)(ticks) / 8u; while (rt() - t0_ < d_) __builtin_amdgcn_s_sleep(8); } } while (0)
#ifndef PROBE_REPEAT
#define PROBE_REPEAT (-1)
#endif
#define REPS(k) for (int rep_ = 0; rep_ < ((PROBE_REPEAT == (k)) ? 2 : 1); ++rep_)
#define REP_BAR(k) do { if (PROBE_REPEAT == (k) && rep_ == 0) { VM_WAIT(); __syncthreads(); GRID_BAR(); } } while (0)

    if (IN(0)) { REPS(0) { p0_prologue(F); REP_BAR(0); } if (BOTH(0)) GRID_BAR(); }

    if (IN(1)) { XCD_STAGGER(STAGGER_P1);
        pg8::Gemm g{wsp<bf16>(F, WS_HB), wsp<bf16>(F, WS_WIN), MTOK, NPROJ, DMODEL}; pg8::StaticOrder S; S.init(MTOK, NPROJ, F.G, (int)blockIdx.x);
        pg8::EpiInProj E{wsp<bf16>(F, WS_FQ), wsp<bf16>(F, WS_NQ), wsp<bf16>(F, WS_KV), wsp<bf16>(F, WS_SGA),
                         wsp<float>(F, WS_LF), wsp<float>(F, WS_GATE), F.b_forget, wsp<float>(F, WS_ROPEC), wsp<float>(F, WS_ROPES), (WS_FK - WS_FQ) / 2, KV_STRIDE / 2, (WS_SGB - WS_SGA) / 2, QSCALE};
        REPS(1) { pg8::gemm_phase<pg8::EpiInProj, pg8::StaticOrder, true, true>(F.lds + RING_OFF, g, S, E, F.wave); REP_BAR(1); }
        if (BOTH(1)) GRID_BAR();
    }
    if (IN(2)) { REPS(2) { p2_phase(F); REP_BAR(2); } if (BOTH(2)) GRID_BAR(); }
#ifndef PROBE_P3_MODE
#define PROBE_P3_MODE 3
#endif
    if (IN(3)) {
#if PROBE_REPEAT == 3
        for (int rep_ = 0; rep_ < 2; ++rep_) { p3_attention(F, rep_ ? PROBE_P3_MODE : 0); if (rep_ == 0) { VM_WAIT(); __syncthreads(); GRID_BAR(); } }
#else
        p3_attention(F, 0);
#endif
        if (BOTH(3)) GRID_BAR(); }
    if (IN(4)) { REPS(4) {
        pg8::Gemm g{wsp<bf16>(F, WS_ATT), wsp<bf16>(F, WS_WF), MTOK, DMODEL, DMODEL}; pg8::StaticOrder S; S.init(MTOK, DMODEL, F.G, (int)blockIdx.x);
        pg8::EpiGateMid E{wsp<bf16>(F, WS_HB), wsp<bf16>(F, WS_SGA), wsp<bf16>(F, WS_SGB), DMODEL};
        pg8::gemm_phase<pg8::EpiGateMid, pg8::StaticOrder, true, true>(F.lds + RING_OFF, g, S, E, F.wave);
        REP_BAR(4); }
        if (BOTH(4)) GRID_BAR();
    }
    if (IN(5)) {
        pg8::Gemm g{wsp<bf16>(F, WS_HB), wsp<bf16>(F, WS_WO), MTOK, DMODEL, DMODEL}; pg8::StaticOrder S; S.init(MTOK, DMODEL, F.G, (int)blockIdx.x);
        pg8::EpiPlain<0> E{wsp<bf16>(F, WS_Y), DMODEL};
        REPS(5) { pg8::gemm_phase<pg8::EpiPlain<0>, pg8::StaticOrder, true, true>(F.lds + RING_OFF, g, S, E, F.wave); REP_BAR(5); }
        if (BOTH(5)) GRID_BAR();
    }
    if (IN(6)) { REPS(6) { row_pass<false>(F, F.x, nullptr, wsp<bf16>(F, WS_Y), F.g_mix_post, nullptr, wsp<bf16>(F, WS_HB), wsp<float>(F, WS_RSTD2)); REP_BAR(6); } if (BOTH(6)) GRID_BAR(); }
#ifndef MLP_CHUNKS
#define MLP_CHUNKS 1
#endif
    if (IN(7) || IN(8)) {
        constexpr int CH = MLP_CHUNKS, MC = MTOK / CH;
#pragma unroll
        for (int ch = 0; ch < CH; ++ch) {
            if (IN(7)) { XCD_STAGGER(STAGGER_P7);
                pg8::Gemm g{wsp<bf16>(F, WS_HB) + (size_t)ch * MC * DMODEL, wsp<bf16>(F, WS_WUP), MC, DFF, DMODEL}; pg8::StaticOrder S; S.init(MC, DFF, F.G, (int)blockIdx.x);
                pg8::EpiRelu2RsF8 E{wsp<unsigned char>(F, WS_U) + (size_t)ch * MC * DFF, wsp<float>(F, WS_RSTD2) + (size_t)ch * MC, DFF};
                pg8::gemm_phase<pg8::EpiRelu2RsF8, pg8::StaticOrder, true, true>(F.lds + RING_OFF, g, S, E, F.wave);
                if (IN(8)) GRID_BAR(); }
            if (IN(8)) {
                pg8::Gemm g{(const pg8::bf16_t*)(wsp<unsigned char>(F, WS_U) + (size_t)ch * MC * DFF), (const pg8::bf16_t*)wsp<unsigned char>(F, WS_WDN), MC, DMODEL, DFF / 2}; pg8::StaticOrder S; S.init(MC, DMODEL, F.G, (int)blockIdx.x);
                pg8::EpiScaled E{wsp<bf16>(F, WS_Y) + (size_t)ch * MC * DMODEL, DMODEL, 1.f / WDN_SCALE};
                pg8::gemm_phase<pg8::EpiScaled, pg8::StaticOrder, true, true, true>(F.lds + RING_OFF, g, S, E, F.wave);
                if (ch + 1 == CH && BOTH(8)) GRID_BAR(); }
        }
    }
    if (IN(9)) { row_pass<true>(F, nullptr, wsp<bf16>(F, WS_HB), wsp<bf16>(F, WS_Y), F.g_mlp_post, F.out, nullptr, nullptr); }
#undef IN
#undef BOTH
#undef GRID_BAR
}

extern "C" void kernel_launch(void* const* d_in, const int* in_sizes, int n_in, void* d_out, int out_size, void* d_ws, size_t ws_size, hipStream_t stream) {
    static int grid = 0;
    if (grid == 0) {
        if (n_in != 18 || in_sizes[0] != MTOK * DMODEL || out_size != MTOK * DMODEL || ws_size < WS_END) {
            fprintf(stderr, "kernel_launch: built for 18 inputs, x/out of %d floats, >= %zu bytes of workspace; got n_in %d, in0 %d, out %d, ws %zu; nothing launched\n", MTOK * DMODEL, (size_t)WS_END, n_in, n_in > 0 ? in_sizes[0] : -1, out_size, ws_size); grid = -1; return; }
        int dev = 0, cus = 0, per_cu = 0;
        if (hipGetDevice(&dev) != hipSuccess || hipDeviceGetAttribute(&cus, hipDeviceAttributeMultiprocessorCount, dev) != hipSuccess) { fprintf(stderr, "kernel_launch: device query failed\n"); grid = -1; return; }
        if (hipFuncSetAttribute((const void*)fwd_kernel, hipFuncAttributeMaxDynamicSharedMemorySize, LDS_BYTES) != hipSuccess) { fprintf(stderr, "kernel_launch: hipFuncSetAttribute failed\n"); grid = -1; return; }
        if (hipOccupancyMaxActiveBlocksPerMultiprocessor(&per_cu, (const void*)fwd_kernel, NWAVES * 64, LDS_BYTES) != hipSuccess || per_cu < 1)
            fprintf(stderr, "kernel_launch: note: occupancy query reports %d workgroups per CU\n", per_cu);
        (void)hipGetLastError();
        grid = 256;
        if (cus < grid) fprintf(stderr, "kernel_launch: this device reports %d CUs; the 256-workgroup grid cannot be resident: the grid barrier will time out (bounded) and the output will be wrong\n", cus);
    }
    if (grid < 0) return;
    if (hipMemsetAsync((char*)d_ws + WS_CTL, 0, CTL_ZERO_BYTES, stream) != hipSuccess) { fprintf(stderr, "kernel_launch: hipMemsetAsync failed\n"); return; }
    Args a{};
    for (int i = 0; i < 18; ++i) a.in[i] = (const float*)d_in[i];
    a.out = (float*)d_out; a.ws = (unsigned char*)d_ws;
    for (int li = 0; li < N_LAUNCHES; ++li) {
        a.ph_lo = (N_LAUNCHES == 1) ? 0 : li; a.ph_hi = (N_LAUNCHES == 1) ? N_PHASES : li + 1; a.li = li; a.pad = 0;
        hipLaunchKernelGGL(fwd_kernel, dim3(grid), dim3(NWAVES * 64), LDS_BYTES, stream, a);
        const hipError_t le = hipPeekAtLastError();
        if (le != hipSuccess) { fprintf(stderr, "kernel_launch: launch %d failed: %s\n", li, hipGetErrorName(le)); break; }
    }
}
```

```cpp
#include <hip/hip_runtime.h>
#include <cstdio>
#include <cstdint>
#include <cmath>
namespace pg8 {
#define PG8_LAS __attribute__((address_space(3)))
typedef unsigned short bf16_t;
typedef short bf16x8 __attribute__((ext_vector_type(8)));
typedef float f32x4 __attribute__((ext_vector_type(4)));
typedef unsigned u32x4 __attribute__((ext_vector_type(4)));
constexpr int BM = 256, BK = 64, HALF = 128, HTB = HALF * BK * 2  , STAGE_BYTES = 8 * HTB, NXCD = 8, WGM = 8;

__host__ __device__ __forceinline__ int lds_byte(int r, int c) { const int st = (r >> 4) * 2 + (c >> 5), rr = r & 15, cc = c & 31, ob = rr * 64 + cc * 2; return st * 1024 + (ob ^ (((ob >> 9) & 1) << 5)); }
__host__ __device__ __forceinline__ void stage_rc(int b, int& R, int& C) { const int st = b / 1024, sb = b % 1024, swz = sb ^ (((sb >> 9) & 1) << 5); R = (st >> 1) * 16 + swz / 64; C = (st & 1) * 32 + (swz % 64) / 2; }
__host__ __device__ __forceinline__ int perm32(int rho) { const int n = rho >> 4, i = rho & 15; return 8 * (i >> 2) + 4 * n + (i & 3); }

__host__ __device__ __forceinline__ int perm16(int R) { const int w = R >> 5, n = (R >> 4) & 1, i = R & 15; return 64 * w + 16 * (i >> 2) + 4 * n + (i & 3); }
struct Unit { int pm, pn; };
struct Gemm { const bf16_t* A; const bf16_t* Bt; int M, N, K; };

struct StaticOrder {
    int nM, nN, nwg, G, c;
    __host__ __device__ void init(int M, int N, int G_, int c_) { nM = M / BM; nN = N / BM; nwg = nM * nN; G = G_; c = c_; }
    __host__ __device__ bool next(int i, Unit& u) const {
        const long L = (long)i * G + c; if (L >= nwg) return false;
        int wgid = (int)L; { const int q = nwg / NXCD, r = nwg % NXCD, xcd = wgid % NXCD, off = wgid / NXCD; wgid = (xcd < r ? xcd * (q + 1) : r * (q + 1) + (xcd - r) * q) + off; }
        const int nig = WGM * nN, gid = wgid / nig, fm = gid * WGM, gsz = (nM - fm) < WGM ? (nM - fm) : WGM;
        u.pm = fm + ((wgid % nig) % gsz); u.pn = (wgid % nig) / gsz; return true;
    }
    __device__ __forceinline__ void a_ready(const Unit&) const {}
    __device__ __forceinline__ void done(const Unit&) const {}
};

__device__ __forceinline__ unsigned cvt_pk_bf16(float lo, float hi) { unsigned r; asm volatile("v_cvt_pk_bf16_f32 %0, %1, %2" : "=v"(r) : "v"(lo), "v"(hi)); return r; }
typedef float f32x2 __attribute__((ext_vector_type(2)));
typedef int i32x8 __attribute__((ext_vector_type(8)));
typedef int i32x4 __attribute__((ext_vector_type(4)));
__device__ __forceinline__ i32x8 cat8(const bf16x8& a, const bf16x8& b) { const i32x4 x = __builtin_bit_cast(i32x4, a), y = __builtin_bit_cast(i32x4, b); return __builtin_shufflevector(x, y, 0, 1, 2, 3, 4, 5, 6, 7); }
constexpr float F8_MAX = 448.f;
__device__ __forceinline__ unsigned cvt4_fp8(float a, float b, float c, float d) {
    int r = 0; r = __builtin_amdgcn_cvt_pk_fp8_f32(fminf(a, F8_MAX), fminf(b, F8_MAX), r, false); r = __builtin_amdgcn_cvt_pk_fp8_f32(fminf(c, F8_MAX), fminf(d, F8_MAX), r, true); return (unsigned)r; }
__device__ __forceinline__ void mfma_f8_inplace(f32x4& c, const i32x8 a, const i32x8 b) { asm volatile("v_mfma_f32_16x16x128_f8f6f4 %0, %1, %2, %0" : "+v"(c) : "v"(a), "v"(b)); }
__device__ __forceinline__ float bf_lo(unsigned w) { return __uint_as_float(w << 16); }
__device__ __forceinline__ float bf_hi(unsigned w) { return __uint_as_float(w & 0xffff0000u); }
__device__ __forceinline__ float sigmoid_f(float x) { return __builtin_amdgcn_rcpf(1.0f + __expf(-x)); }
typedef unsigned u32x2 __attribute__((ext_vector_type(2)));
__device__ __forceinline__ u32x4 pack8(const f32x4& a, const f32x4& b) { u32x4 w; w.x = cvt_pk_bf16(a[0], a[1]); w.y = cvt_pk_bf16(a[2], a[3]); w.z = cvt_pk_bf16(b[0], b[1]); w.w = cvt_pk_bf16(b[2], b[3]); return w; }
__device__ __forceinline__ u32x2 pack4(const f32x4& a) { u32x2 w; w.x = cvt_pk_bf16(a[0], a[1]); w.y = cvt_pk_bf16(a[2], a[3]); return w; }

struct EpiInProj {
    static constexpr bool PERM = true, PERM16 = false, AFTER_DRAIN = false, MIDK = false;
    bf16_t *QKV, *NQ, *KVB, *SG;
    float *LF, *GATE; const float* bforget; const float *ROPEC, *ROPES; size_t qkvs, kvs, sgs; float qscale;
    __device__ __forceinline__ void operator()(const f32x4 (&acc)[2][2][4][2], const Unit& u, int wr, int wc, int fr, int fq) const {
        const int pn = u.pn; const bool roped = pn >= 6 && pn < 11; const int i4 = (4 * (wc & 1) + fq) * 4;
#pragma unroll
        for (int ai = 0; ai < 2; ++ai) {
#pragma unroll
          for (int mp = 0; mp < 2; ++mp) {
            f32x4 csv[8];
            if (roped) {
#pragma unroll
                for (int mm = 0; mm < 2; ++mm) { const int t_ = (u.pm * BM + ai * HALF + wr * 64 + (2 * mp + mm) * 16 + fr) & 2047; csv[mm] = *(const f32x4*)(ROPEC + t_ * 32 + i4); csv[4 + mm] = *(const f32x4*)(ROPES + t_ * 32 + i4); }
                asm volatile("" : "+v"(csv[0]), "+v"(csv[1]), "+v"(csv[4]), "+v"(csv[5])); }
#pragma unroll
            for (int mm = 0; mm < 2; ++mm) { const int m = 2 * mp + mm;
                const int row = u.pm * BM + ai * HALF + wr * 64 + m * 16 + fr; const int t = row & 2047, b = row >> 11; (void)t;
#pragma unroll
                for (int bj = 0; bj < 2; ++bj) {
                    const int tc = bj * HALF + wc * 32 + 8 * fq;
                    f32x4 v0 = acc[ai][bj][m][0], v1 = acc[ai][bj][m][1];
                    if (pn < 6) {
                        bf16_t* base = QKV + (size_t)(pn >> 1) * qkvs; const float sc = pn < 2 ? qscale : 1.0f;
                        *(u32x4*)(base + (size_t)row * 512 + (pn & 1) * 256 + tc) = pack8(v0 * sc, v1 * sc);
                    } else if (pn < 8) {
                        const int head = (pn - 6) * 4 + (tc >> 6);
                        const f32x4 cs = csv[mm], sn = csv[4 + mm];
                        const f32x4 lo = (v0 * cs - v1 * sn) * qscale, hi = (v1 * cs + v0 * sn) * qscale;
                        bf16_t* d = NQ + (size_t)row * 512 + head * 64 + i4;
                        *(u32x2*)d = pack4(lo); *(u32x2*)(d + 32) = pack4(hi);
                    } else if (pn < 11) {
                        const int sel = pn - 8;
                        if (bj == 0) {
                            const int g = tc >> 6;
                            const f32x4 cs = csv[mm], sn = csv[4 + mm];
                            const f32x4 lo = v0 * cs - v1 * sn, hi = v1 * cs + v0 * sn;
                            bf16_t* d = KVB + (size_t)(2 * sel) * kvs + ((size_t)((b * 2 + g) * 2048 + t)) * 64 + i4;
                            *(u32x2*)d = pack4(lo); *(u32x2*)(d + 32) = pack4(hi);
                        } else {
                            const int tv = tc - HALF, g = tv >> 6, dd = tv & 63;
                            bf16_t* d = KVB + (size_t)(2 * sel + 1) * kvs + ((size_t)((b * 2 + g) * 2048 + t)) * 64 + dd;
                            *(u32x4*)d = pack8(v0, v1);
                        }
                    } else if (pn < 19) {
                        if (bj == 0) { const int ct = (pn - 11) * 128 + wc * 32 + 8 * fq; const f32x4 w0 = acc[ai][1][m][0], w1 = acc[ai][1][m][1];
                            f32x4 a, c, ra, rc;
#pragma unroll
                            for (int k = 0; k < 4; ++k) { const float ea = __expf(-v0[k]), ec = __expf(-v1[k]), fa = __expf(-w0[k]), fc = __expf(-w1[k]);
                                a[k] = __builtin_amdgcn_rcpf(1.0f + ea); c[k] = __builtin_amdgcn_rcpf(1.0f + ec); ra[k] = (1.0f + ea) * __builtin_amdgcn_rcpf(1.0f + fa); rc[k] = (1.0f + ec) * __builtin_amdgcn_rcpf(1.0f + fc); }
                            __builtin_nontemporal_store(pack8(a, c), (u32x4*)(SG + (size_t)row * 1024 + ct)); __builtin_nontemporal_store(pack8(ra, rc), (u32x4*)(SG + sgs + (size_t)row * 1024 + ct)); }
                    } else {
                        if (bj == 0 && wc == 0) {
                            if (fq == 0) {
                                f32x4 a, c;
#pragma unroll
                                for (int k = 0; k < 4; ++k) { const float x0 = v0[k] + bforget[k], x1 = v1[k] + bforget[4 + k];
                                    a[k] = fminf(x0, 0.f) - log1pf(__expf(-fabsf(x0))); c[k] = fminf(x1, 0.f) - log1pf(__expf(-fabsf(x1))); }
                                *(f32x4*)(LF + (size_t)row * 8) = a; *(f32x4*)(LF + (size_t)row * 8 + 4) = c;
                            } else {
                                f32x4 a, c;
#pragma unroll
                                for (int k = 0; k < 4; ++k) { a[k] = sigmoid_f(v0[k]); c[k] = sigmoid_f(v1[k]); }
                                *(f32x4*)(GATE + (size_t)row * 24 + 8 * (fq - 1)) = a; *(f32x4*)(GATE + (size_t)row * 24 + 8 * (fq - 1) + 4) = c;
                            }
                        }
                    }
                }
            }
          }
        }
    }
};
#define PIN8(a) asm volatile("" : "+v"(a[0]), "+v"(a[1]), "+v"(a[2]), "+v"(a[3]), "+v"(a[4]), "+v"(a[5]), "+v"(a[6]), "+v"(a[7]))
struct EpiGate {
    static constexpr bool PERM = true, PERM16 = false, AFTER_DRAIN = false, MIDK = false;
    bf16_t* O; const bf16_t* gate; const bf16_t* addend; int ldc;
    __device__ __forceinline__ void operator()(const f32x4 (&acc)[2][2][4][2], const Unit& u, int wr, int wc, int fr, int fq) const {
#pragma unroll
        for (int ai = 0; ai < 2; ++ai) {
            const size_t base = (size_t)(u.pm * BM + ai * HALF + wr * 64 + fr) * ldc + u.pn * BM + wc * 32 + 8 * fq;
            u32x4 gw[8], aw[8];
#pragma unroll
            for (int k = 0; k < 8; ++k) gw[k] = *(const u32x4*)(gate + base + (size_t)((k >> 1) * 16) * ldc + (k & 1) * HALF);
            PIN8(gw);
            if (addend) {
#pragma unroll
                for (int k = 0; k < 8; ++k) aw[k] = *(const u32x4*)(addend + base + (size_t)((k >> 1) * 16) * ldc + (k & 1) * HALF);
                PIN8(aw); }
#pragma unroll
            for (int k = 0; k < 8; ++k) { const int m = k >> 1, bj = k & 1; const u32x4 g = gw[k];
                f32x4 v0 = acc[ai][bj][m][0], v1 = acc[ai][bj][m][1];
                v0[0] *= bf_lo(g.x); v0[1] *= bf_hi(g.x); v0[2] *= bf_lo(g.y); v0[3] *= bf_hi(g.y);
                v1[0] *= bf_lo(g.z); v1[1] *= bf_hi(g.z); v1[2] *= bf_lo(g.w); v1[3] *= bf_hi(g.w);
                if (addend) { const u32x4 a = aw[k];
                    v0[0] += bf_lo(a.x); v0[1] += bf_hi(a.x); v0[2] += bf_lo(a.y); v0[3] += bf_hi(a.y);
                    v1[0] += bf_lo(a.z); v1[1] += bf_hi(a.z); v1[2] += bf_lo(a.w); v1[3] += bf_hi(a.w); }
                *(u32x4*)(O + base + (size_t)(m * 16) * ldc + bj * HALF) = pack8(v0, v1); }
        }
    }
};
struct EpiGateMid {
    static constexpr bool PERM = true, PERM16 = false, AFTER_DRAIN = false, MIDK = true;
    bf16_t* O; const bf16_t* sga; const bf16_t* rr; int ldc;
    __device__ __forceinline__ void scale(f32x4 (&acc)[2][2][4][2], const bf16_t* g, const Unit& u, int wr, int wc, int fr, int fq, bf16_t* out) const {
#pragma unroll
        for (int ai = 0; ai < 2; ++ai) {
            const size_t base = (size_t)(u.pm * BM + ai * HALF + wr * 64 + fr) * ldc + u.pn * BM + wc * 32 + 8 * fq;
            u32x4 gw[8];
#pragma unroll
            for (int k = 0; k < 8; ++k) gw[k] = *(const u32x4*)(g + base + (size_t)((k >> 1) * 16) * ldc + (k & 1) * HALF);
            PIN8(gw);
#pragma unroll
            for (int k = 0; k < 8; ++k) { const int m = k >> 1, bj = k & 1; const u32x4 w = gw[k];
                f32x4& v0 = acc[ai][bj][m][0]; f32x4& v1 = acc[ai][bj][m][1];
                v0[0] *= bf_lo(w.x); v0[1] *= bf_hi(w.x); v0[2] *= bf_lo(w.y); v0[3] *= bf_hi(w.y);
                v1[0] *= bf_lo(w.z); v1[1] *= bf_hi(w.z); v1[2] *= bf_lo(w.w); v1[3] *= bf_hi(w.w);
                if (out) *(u32x4*)(out + base + (size_t)(m * 16) * ldc + bj * HALF) = pack8(v0, v1); }
        }
    }
    __device__ __forceinline__ void mid(f32x4 (&acc)[2][2][4][2], const Unit& u, int wr, int wc, int fr, int fq) const { int fr_ = fr; asm volatile("" : "+v"(fr_));
        scale(acc, rr, u, wr, wc, fr_, fq, nullptr); }
    __device__ __forceinline__ void operator()(const f32x4 (&acc)[2][2][4][2], const Unit& u, int wr, int wc, int fr, int fq) const {
#pragma unroll
        for (int ai = 0; ai < 2; ++ai) {
            const size_t base = (size_t)(u.pm * BM + ai * HALF + wr * 64 + fr) * ldc + u.pn * BM + wc * 32 + 8 * fq;
            u32x4 gw[8];
#pragma unroll
            for (int k = 0; k < 8; ++k) gw[k] = *(const u32x4*)(sga + base + (size_t)((k >> 1) * 16) * ldc + (k & 1) * HALF);
            PIN8(gw);
#pragma unroll
            for (int k = 0; k < 8; ++k) { const int m = k >> 1, bj = k & 1; const u32x4 w = gw[k];
                f32x4 v0 = acc[ai][bj][m][0], v1 = acc[ai][bj][m][1];
                v0[0] *= bf_lo(w.x); v0[1] *= bf_hi(w.x); v0[2] *= bf_lo(w.y); v0[3] *= bf_hi(w.y);
                v1[0] *= bf_lo(w.z); v1[1] *= bf_hi(w.z); v1[2] *= bf_lo(w.w); v1[3] *= bf_hi(w.w);
                *(u32x4*)(O + base + (size_t)(m * 16) * ldc + bj * HALF) = pack8(v0, v1); }
        }
    }
};
template <int ACT> struct EpiPlain {
    static constexpr bool PERM = true, PERM16 = false, AFTER_DRAIN = false, MIDK = false;
    bf16_t* O; int ldc;
    __device__ __forceinline__ void operator()(const f32x4 (&acc)[2][2][4][2], const Unit& u, int wr, int wc, int fr, int fq) const {
#pragma unroll
        for (int ai = 0; ai < 2; ++ai)
#pragma unroll
            for (int m = 0; m < 4; ++m) {
                const size_t rowo = (size_t)(u.pm * BM + ai * HALF + wr * 64 + m * 16 + fr) * ldc + u.pn * BM + wc * 32 + 8 * fq;
#pragma unroll
                for (int bj = 0; bj < 2; ++bj) {
                    f32x4 v0 = acc[ai][bj][m][0], v1 = acc[ai][bj][m][1];
                    if (ACT == 1) {
#pragma unroll
                        for (int k = 0; k < 4; ++k) { const float a = fmaxf(v0[k], 0.f), c = fmaxf(v1[k], 0.f); v0[k] = a * a; v1[k] = c * c; }
                    }
                    *(u32x4*)(O + rowo + bj * HALF) = pack8(v0, v1);
                }
            }
    }
};

struct EpiRelu2Rs {
    static constexpr bool PERM = true, PERM16 = false, AFTER_DRAIN = false, MIDK = false;
    bf16_t* O; const float* rs; int ldc;
    __device__ __forceinline__ void operator()(const f32x4 (&acc)[2][2][4][2], const Unit& u, int wr, int wc, int fr, int fq) const {
        float rv[8];
#pragma unroll
        for (int k = 0; k < 8; ++k) rv[k] = rs[u.pm * BM + (k >> 2) * HALF + wr * 64 + (k & 3) * 16 + fr];
        PIN8(rv);
#pragma unroll
        for (int ai = 0; ai < 2; ++ai)
#pragma unroll
            for (int m = 0; m < 4; ++m) { const float r = rv[ai * 4 + m];
                const size_t rowo = (size_t)(u.pm * BM + ai * HALF + wr * 64 + m * 16 + fr) * ldc + u.pn * BM + wc * 32 + 8 * fq;
#pragma unroll
                for (int bj = 0; bj < 2; ++bj) { f32x4 v0 = acc[ai][bj][m][0], v1 = acc[ai][bj][m][1];
#pragma unroll
                    for (int k = 0; k < 4; ++k) { const float a = fmaxf(v0[k] * r, 0.f), c = fmaxf(v1[k] * r, 0.f); v0[k] = a * a; v1[k] = c * c; }
                    __builtin_nontemporal_store(pack8(v0, v1), (u32x4*)(O + rowo + bj * HALF)); } }
    }
};

struct EpiRelu2RsF8 {
    static constexpr bool PERM = true, PERM16 = true, AFTER_DRAIN = false, MIDK = false;
    unsigned char* O; const float* rs; int ldc;
    __device__ __forceinline__ void operator()(const f32x4 (&acc)[2][2][4][2], const Unit& u, int wr, int wc, int fr, int fq) const {
        float rv[8];
#pragma unroll
        for (int k = 0; k < 8; ++k) rv[k] = rs[u.pm * BM + (k >> 2) * HALF + wr * 64 + (k & 3) * 16 + fr];
        PIN8(rv);
#pragma unroll
        for (int ai = 0; ai < 2; ++ai)
#pragma unroll
            for (int m = 0; m < 4; ++m) { const float r = rv[ai * 4 + m];
                const size_t rowo = (size_t)(u.pm * BM + ai * HALF + wr * 64 + m * 16 + fr) * ldc + u.pn * BM + wc * 64 + 16 * fq;
                u32x4 o;
#pragma unroll
                for (int bj = 0; bj < 2; ++bj) { f32x4 v0 = acc[ai][bj][m][0], v1 = acc[ai][bj][m][1];
#pragma unroll
                    for (int k = 0; k < 4; ++k) { const float a = fmaxf(v0[k] * r, 0.f), c = fmaxf(v1[k] * r, 0.f); v0[k] = a * a; v1[k] = c * c; }
                    o[2 * bj] = cvt4_fp8(v0[0], v0[1], v0[2], v0[3]); o[2 * bj + 1] = cvt4_fp8(v1[0], v1[1], v1[2], v1[3]); }
                __builtin_nontemporal_store(o, (u32x4*)(O + rowo)); }
    }
};
struct EpiScaled {
    static constexpr bool PERM = true, PERM16 = false, AFTER_DRAIN = false, MIDK = false;
    bf16_t* O; int ldc; float sc;
    __device__ __forceinline__ void operator()(const f32x4 (&acc)[2][2][4][2], const Unit& u, int wr, int wc, int fr, int fq) const {
#pragma unroll
        for (int ai = 0; ai < 2; ++ai)
#pragma unroll
            for (int m = 0; m < 4; ++m) {
                const size_t rowo = (size_t)(u.pm * BM + ai * HALF + wr * 64 + m * 16 + fr) * ldc + u.pn * BM + wc * 32 + 8 * fq;
#pragma unroll
                for (int bj = 0; bj < 2; ++bj) *(u32x4*)(O + rowo + bj * HALF) = pack8(acc[ai][bj][m][0] * sc, acc[ai][bj][m][1] * sc);
            }
    }
};
template <class Epi, class Sched, bool ALIGN_EPI = false, bool SP2 = false, bool F8 = false>
__device__ __forceinline__ void gemm_phase(PG8_LAS unsigned char* lds, const Gemm g, const Sched& S, const Epi& E, const int wave_id  ) {
    int tid_ = wave_id * 64 + (int)__builtin_amdgcn_mbcnt_hi(~0u, __builtin_amdgcn_mbcnt_lo(~0u, 0u)); asm volatile("" : "+v"(tid_));
    const int tid = tid_, wid = __builtin_amdgcn_readfirstlane(tid >> 6), lane = tid & 63, wr = wid >> 2, wc = wid & 3, fr = lane & 15, fq = lane >> 4;
    const int K = g.K, nt = K / BK;
    unsigned voffA[2], voffB[2];
#pragma unroll
    for (int i = 0; i < 2; ++i) { int R, C; stage_rc(tid * 16 + i * 8192, R, C); const int Rb = Epi::PERM16 ? perm16(R) : Epi::PERM ? ((R & ~31) + perm32(R & 31)) : R;
        voffA[i] = (unsigned)(R * K + C) * 2u; voffB[i] = (unsigned)(Rb * K + C) * 2u; }
    const size_t kstep = (size_t)(BK * 2);
    const size_t hstep = (size_t)HALF * K * 2;
    const size_t bhstep = Epi::PERM16 ? (size_t)8 * K * 2 : hstep;
    const size_t tstep = 2 * hstep;
    const unsigned ldsw = (unsigned)wid * 1024u;
    const int aoff = lds_byte(wr * 64 + fr, fq * 8), boff = lds_byte(wc * 32 + fr, fq * 8);
#define PG8_SA(b, h) (((b) * 2 + (h)) * HTB)
#define PG8_SB(b, h) ((4 + (b) * 2 + (h)) * HTB)
#define PG8_STAGE(bufoff, gbase, voff) do { _Pragma("unroll") for (int _i = 0; _i < 2; ++_i) \
        __builtin_amdgcn_global_load_lds((const unsigned*)((const char*)(gbase) + (voff)[_i]), (PG8_LAS unsigned*)(lds + (bufoff) + ldsw + _i * 8192), 16, 0, 0); } while (0)
#define PG8_LDA(dst, b, h) do { _Pragma("unroll") for (int m = 0; m < 4; ++m) _Pragma("unroll") for (int k = 0; k < 2; ++k) dst[m][k] = *(const PG8_LAS bf16x8*)(lds + PG8_SA(b, h) + aoff + m * 2048 + k * 1024); } while (0)
#define PG8_LDB(dst, b, h) do { _Pragma("unroll") for (int n = 0; n < 2; ++n) _Pragma("unroll") for (int k = 0; k < 2; ++k) dst[n][k] = *(const PG8_LAS bf16x8*)(lds + PG8_SB(b, h) + boff + n * 2048 + k * 1024); } while (0)
#define PG8_MMA(ai, bj, At, Bt) do { __builtin_amdgcn_s_setprio(1); _Pragma("unroll") for (int m = 0; m < 4; ++m) _Pragma("unroll") for (int n = 0; n < 2; ++n) { \
        if constexpr (F8) mfma_f8_inplace(acc[ai][bj][m][n], cat8(Bt[n][0], Bt[n][1]), cat8(At[m][0], At[m][1])); \
        else { _Pragma("unroll") for (int k = 0; k < 2; ++k) acc[ai][bj][m][n] = __builtin_amdgcn_mfma_f32_16x16x32_bf16(Bt[n][k], At[m][k], acc[ai][bj][m][n], 0, 0, 0); } } __builtin_amdgcn_s_setprio(0); } while (0)
#define PG8_WAIT_V(n) asm volatile("s_waitcnt vmcnt(" #n ")" ::: "memory")
#define PG8_WAIT_L(n) asm volatile("s_waitcnt lgkmcnt(" #n ")" ::: "memory")
#define PG8_BAR __builtin_amdgcn_s_barrier()
#define PG8_SCHED __builtin_amdgcn_sched_barrier(0)
    Unit cur, nxt; int ui = 0;
    if (!S.next(0, cur)) return;
    f32x4 acc[2][2][4][2];
#pragma unroll
    for (int a = 0; a < 2; ++a)
#pragma unroll
        for (int b = 0; b < 2; ++b)
#pragma unroll
            for (int m = 0; m < 4; ++m)
#pragma unroll
                for (int n = 0; n < 2; ++n) acc[a][b][m][n] = (f32x4){0.f, 0.f, 0.f, 0.f};
    bf16x8 At[4][2], B0[2][2], B1[2][2];
    const char* cA = (const char*)g.A + (size_t)cur.pm * tstep; const char* cB = (const char*)g.Bt + (size_t)cur.pn * tstep;
    S.a_ready(cur);
    if constexpr (SP2) {
        PG8_STAGE(PG8_SB(0, 0), cB, voffB); PG8_STAGE(PG8_SB(0, 1), cB + bhstep, voffB); PG8_STAGE(PG8_SA(0, 0), cA, voffA); PG8_STAGE(PG8_SA(0, 1), cA + hstep, voffA);
        if (wr == 1) PG8_BAR;
        PG8_WAIT_V(2); PG8_BAR;
        PG8_STAGE(PG8_SB(1, 0), cB + kstep, voffB); PG8_STAGE(PG8_SA(1, 0), cA + kstep, voffA); PG8_STAGE(PG8_SB(1, 1), cB + bhstep + kstep, voffB);
        PG8_WAIT_V(6); PG8_BAR;
    } else {
        PG8_STAGE(PG8_SB(0, 0), cB, voffB); PG8_STAGE(PG8_SA(0, 0), cA, voffA); PG8_STAGE(PG8_SB(0, 1), cB + bhstep, voffB); PG8_STAGE(PG8_SA(0, 1), cA + hstep, voffA);
        if (wr == 1) PG8_BAR;
        PG8_WAIT_V(4); PG8_BAR;
        PG8_STAGE(PG8_SB(1, 0), cB + kstep, voffB); PG8_STAGE(PG8_SA(1, 0), cA + kstep, voffA); PG8_STAGE(PG8_SB(1, 1), cB + bhstep + kstep, voffB);
        PG8_WAIT_V(6); PG8_BAR;
    }
    for (;;) {
        const bool has_next = S.next(ui + 1, nxt);
        const char* nA = has_next ? (const char*)g.A + (size_t)nxt.pm * tstep : cA; const char* nB = has_next ? (const char*)g.Bt + (size_t)nxt.pn * tstep : cB;
        for (int t = 0; t < nt; t += 2) {
            if constexpr (Epi::MIDK) { if (t == nt / 2) E.mid(acc, cur, wr, wc, fr, fq); }
            const bool last = (t == nt - 2);
            const char* a1 = cA + (size_t)(t + 1) * kstep;
            const char* a2 = last ? nA : cA + (size_t)(t + 2) * kstep; const char* b2 = last ? nB : cB + (size_t)(t + 2) * kstep;
            const char* a3 = a2 + kstep; const char* b3 = b2 + kstep;
            if (last && has_next) S.a_ready(nxt);
            if constexpr (SP2) {
            PG8_LDB(B0, 0, 0); PG8_LDB(B1, 0, 1); PG8_SCHED; PG8_LDA(At, 0, 0); PG8_STAGE(PG8_SA(1, 1), a1 + hstep, voffA);
            PG8_WAIT_V(8); PG8_WAIT_L(0); PG8_BAR; PG8_MMA(0, 0, At, B0); PG8_MMA(0, 1, At, B1); PG8_BAR; PG8_SCHED;
            PG8_LDA(At, 0, 1); PG8_STAGE(PG8_SB(0, 0), b2, voffB); PG8_STAGE(PG8_SB(0, 1), b2 + bhstep, voffB); PG8_STAGE(PG8_SA(0, 0), a2, voffA);
            PG8_WAIT_V(8); PG8_WAIT_L(0); PG8_BAR; PG8_MMA(1, 0, At, B0); PG8_MMA(1, 1, At, B1); PG8_BAR; PG8_SCHED;
            PG8_LDB(B0, 1, 0); PG8_LDB(B1, 1, 1); PG8_SCHED; PG8_LDA(At, 1, 0); PG8_STAGE(PG8_SA(0, 1), a2 + hstep, voffA);
            PG8_WAIT_V(8); PG8_WAIT_L(0); PG8_BAR; PG8_MMA(0, 0, At, B0); PG8_MMA(0, 1, At, B1); PG8_BAR; PG8_SCHED;
            PG8_LDA(At, 1, 1); PG8_STAGE(PG8_SB(1, 0), b3, voffB); PG8_STAGE(PG8_SB(1, 1), b3 + bhstep, voffB); PG8_STAGE(PG8_SA(1, 0), a3, voffA);
            PG8_WAIT_V(8); PG8_WAIT_L(0); PG8_BAR; PG8_MMA(1, 0, At, B0); PG8_MMA(1, 1, At, B1); PG8_BAR; PG8_SCHED;
            } else {
            PG8_LDB(B0, 0, 0); PG8_SCHED; PG8_LDA(At, 0, 0); PG8_STAGE(PG8_SA(1, 1), a1 + hstep, voffA);
            PG8_WAIT_L(8); PG8_BAR; PG8_WAIT_L(0); PG8_MMA(0, 0, At, B0); PG8_BAR; PG8_SCHED;
            PG8_LDB(B1, 0, 1); PG8_STAGE(PG8_SB(0, 0), b2, voffB);
            PG8_BAR; PG8_WAIT_L(0); PG8_MMA(0, 1, At, B1); PG8_BAR;
            PG8_LDA(At, 0, 1); PG8_STAGE(PG8_SA(0, 0), a2, voffA);
            PG8_BAR; PG8_WAIT_L(0); PG8_MMA(1, 0, At, B0); PG8_BAR; PG8_SCHED;
            PG8_STAGE(PG8_SB(0, 1), b2 + bhstep, voffB);
            PG8_WAIT_V(6); PG8_BAR; PG8_MMA(1, 1, At, B1); PG8_BAR;
            PG8_LDB(B0, 1, 0); PG8_SCHED; PG8_LDA(At, 1, 0); PG8_STAGE(PG8_SA(0, 1), a2 + hstep, voffA);
            PG8_WAIT_L(8); PG8_BAR; PG8_WAIT_L(0); PG8_MMA(0, 0, At, B0); PG8_BAR; PG8_SCHED;
            PG8_LDB(B1, 1, 1); PG8_STAGE(PG8_SB(1, 0), b3, voffB);
            PG8_BAR; PG8_WAIT_L(0); PG8_MMA(0, 1, At, B1); PG8_BAR;
            PG8_LDA(At, 1, 1); PG8_STAGE(PG8_SA(1, 0), a3, voffA);
            PG8_BAR; PG8_WAIT_L(0); PG8_MMA(1, 0, At, B0); PG8_BAR; PG8_SCHED;
            PG8_STAGE(PG8_SB(1, 1), b3 + bhstep, voffB);
            PG8_WAIT_V(6); PG8_BAR; PG8_MMA(1, 1, At, B1); PG8_BAR;
            }
        }
        if constexpr (F8) asm volatile("s_nop 15\n\ts_nop 15" ::: "memory");
        if constexpr (ALIGN_EPI) { if (wr == 0) PG8_BAR; }
        if constexpr (!Epi::AFTER_DRAIN) { E(acc, cur, wr, wc, fr, fq); S.done(cur); }
        if (!has_next) break;
#pragma unroll
        for (int a = 0; a < 2; ++a)
#pragma unroll
            for (int b = 0; b < 2; ++b)
#pragma unroll
                for (int m = 0; m < 4; ++m)
#pragma unroll
                    for (int n = 0; n < 2; ++n) acc[a][b][m][n] = (f32x4){0.f, 0.f, 0.f, 0.f};
        cur = nxt; cA = nA; cB = nB; ++ui;
        if constexpr (ALIGN_EPI) { if (wr == 1) PG8_BAR; }
    }
    PG8_WAIT_V(0);
    if constexpr (!ALIGN_EPI) { if (wr == 0) PG8_BAR; }
    PG8_BAR;
    if constexpr (Epi::AFTER_DRAIN) { E.fused(acc, cur, wr, wc, fr, fq, lds, wid, lane); S.done(cur); }
#undef PG8_SA
#undef PG8_SB
#undef PG8_STAGE
#undef PG8_LDA
#undef PG8_LDB
#undef PG8_MMA
#undef PG8_WAIT_V
#undef PG8_WAIT_L
#undef PG8_BAR
#undef PG8_SCHED
}
}
#define GAS __attribute__((address_space(1)))
#define LAS __attribute__((address_space(3)))
typedef unsigned short bf16;
typedef unsigned v4u __attribute__((ext_vector_type(4)));
typedef float f32x4 __attribute__((ext_vector_type(4)));
typedef short bf16x8 __attribute__((ext_vector_type(8)));
typedef GAS unsigned gu32;
typedef GAS unsigned long long gu64;
#define RLX_AGENT __ATOMIC_RELAXED, __HIP_MEMORY_SCOPE_AGENT
#define LDS_WAIT() asm volatile("s_waitcnt lgkmcnt(0)" ::: "memory")
#define VM_WAIT() asm volatile("s_waitcnt vmcnt(0)" ::: "memory")
__device__ __forceinline__ unsigned long long rt() { return __builtin_amdgcn_s_memrealtime(); }
__device__ __forceinline__ unsigned f2bf(float f) { unsigned u = __builtin_bit_cast(unsigned, f); return (u + 0x7fffu + ((u >> 16) & 1u)) >> 16; }
__device__ __forceinline__ unsigned pk2(float lo, float hi) { return f2bf(lo) | (f2bf(hi) << 16); }

#define XB_TMO      128
#define XB_XCNT(j)  (256  + 64 * (j))
#define XB_XSUB(j)  (1280 + 64 * (j))
#define XB_XGEN(j)  (2304 + 64 * (j))
#define XB_TOP      3328
#define XB_TOPGEN   3392
#define XCD_BAR_WORDS 3456
#define XB_SPIN_CAP (1u << 18)

__device__ __forceinline__ unsigned xb_ld(unsigned* p)              { return __hip_atomic_load(p, __ATOMIC_RELAXED, __HIP_MEMORY_SCOPE_AGENT); }
__device__ __forceinline__ unsigned xb_add(unsigned* p, unsigned v) { return __hip_atomic_fetch_add(p, v, __ATOMIC_RELAXED, __HIP_MEMORY_SCOPE_AGENT); }
__device__ __forceinline__ unsigned xb_xcc_id() { return (unsigned)__builtin_amdgcn_s_getreg((3 << 11) | 20) & 0xFu; }
#define XB_SPIN(cond, bar) do { unsigned _sp = 0; while (cond) { __builtin_amdgcn_s_sleep(1); \
    if ((++_sp & 255u) == 0u) { if (xb_ld(&(bar)[XB_TMO])) break; if (_sp > XB_SPIN_CAP) { atomicAdd(&(bar)[XB_TMO], 1u); break; } } } } while (0)

struct XcdBarrier {
    unsigned* bar; unsigned x;
    volatile LAS unsigned* st;
};

__device__ __forceinline__ XcdBarrier xcd_barrier_post(unsigned* bar, volatile LAS unsigned* st) {
    XcdBarrier b; b.bar = bar; b.x = xb_xcc_id(); b.st = st;
    if (threadIdx.x == 0) (void)xb_add(&bar[XB_XCNT(b.x)], 1u);
    return b;
}
__device__ __forceinline__ void xcd_barrier_complete(unsigned* bar, unsigned x, unsigned& nloc, unsigned& nx) {
    const unsigned G = gridDim.x * gridDim.y * gridDim.z;
    unsigned sum, cnt, mine, sp = 0u;
    for (;;) {
        sum = 0u; cnt = 0u; mine = 0u;
#pragma unroll
        for (unsigned j = 0; j < 16; ++j) { const unsigned c = xb_ld(&bar[XB_XCNT(j)]); sum += c; cnt += (c > 0u) ? 1u : 0u; mine = (j == x) ? c : mine; }
        if (sum == G) break;
        __builtin_amdgcn_s_sleep(1);
        if ((++sp & 255u) == 0u) { if (xb_ld(&bar[XB_TMO])) break; if (sp > XB_SPIN_CAP) { atomicAdd(&bar[XB_TMO], 1u); break; } }
    }
    nloc = mine > 0u ? mine : 1u; nx = cnt > 0u ? cnt : 1u;
}

__device__ __forceinline__ void xcd_barrier(const XcdBarrier& b) {
    asm volatile("s_waitcnt vmcnt(0)" ::: "memory");
    __syncthreads();
    if (threadIdx.x == 0) {
        unsigned* bar = b.bar;
        __builtin_amdgcn_s_waitcnt(0);
        unsigned nloc = b.st[0], nx = b.st[1];
        if (nloc == 0u) { xcd_barrier_complete(bar, b.x, nloc, nx); b.st[0] = nloc; b.st[1] = nx; }
        const unsigned old = xb_add(&bar[XB_XSUB(b.x)], 1u);
        const unsigned gen = old / nloc;
        if (old + 1u == (gen + 1u) * nloc) {
            __builtin_amdgcn_fence(__ATOMIC_RELEASE, "agent");
            asm volatile("s_waitcnt vmcnt(0)" ::: "memory");
            const unsigned og = xb_add(&bar[XB_TOP], 1u);
            const unsigned tg = og / nx;
            if (og + 1u == (tg + 1u) * nx) xb_add(&bar[XB_TOPGEN], 1u);
            else XB_SPIN(xb_ld(&bar[XB_TOPGEN]) == tg, bar);
            __builtin_amdgcn_fence(__ATOMIC_ACQUIRE, "agent");
            xb_add(&bar[XB_XGEN(b.x)], 1u);
            asm volatile("s_waitcnt vmcnt(0)" ::: "memory");
        } else {
            XB_SPIN(xb_ld(&bar[XB_XGEN(b.x)]) == gen, bar);
            __builtin_amdgcn_fence(__ATOMIC_ACQUIRE, "agent");
            asm volatile("s_waitcnt vmcnt(0)" ::: "memory");
        }
    }
    __syncthreads();
}

constexpr int NWAVES = 8;
constexpr int BATCH = 32, SEQ = 2048, DMODEL = 1024, MTOK = BATCH * SEQ, DFF = 4096, NPROJ = 5120, INCOLS = 4896;
constexpr float RMS_EPS = 1e-6f;
constexpr float QSCALE = 0.125f * 1.4426950408889634f;
constexpr float LOG2E = 1.4426950408889634f;
constexpr float WDN_SCALE = 256.f;
#ifndef MK_N_LAUNCHES
#define MK_N_LAUNCHES 1
#endif
constexpr int N_PHASES = 10;
constexpr int N_LAUNCHES = MK_N_LAUNCHES;
constexpr size_t MiB = 1u << 20, KiB = 1u << 10;
constexpr size_t WS_CTL = 0, CTL_ZERO_BYTES = 1 * MiB;
constexpr size_t WS_WIN = 2 * MiB, WS_WF = 12 * MiB, WS_WN = 13 * MiB, WS_WO = 14 * MiB, WS_WUP = 16 * MiB, WS_WDN = 24 * MiB;
constexpr size_t WS_W1K = 32 * MiB, WS_W1V = WS_W1K + 256 * KiB, WS_W2K = WS_W1V + 256 * KiB, WS_W2V = WS_W2K + 8 * KiB, WS_PBK = WS_W2V + 8 * KiB, WS_PBV = WS_PBK + 256;
constexpr size_t WS_KT0 = WS_PBV + 256;
constexpr size_t WS_RSTD2 = 46 * MiB;
constexpr size_t WS_ROPEC = 33 * MiB, WS_ROPES = WS_ROPEC + 256 * KiB;
constexpr size_t WS_KCMP = 34 * MiB, WS_VCMP = 35 * MiB, WS_C = 36 * MiB, WS_LF = 38 * MiB, WS_GATE = 40 * MiB;
constexpr size_t WS_HB = 48 * MiB;
constexpr size_t WS_FKX = 48 * MiB;
constexpr size_t WS_PROBE_O = 64 * MiB;
constexpr size_t WS_FQ = 176 * MiB, WS_FK = 240 * MiB, WS_FV = 304 * MiB, WS_NQ = 368 * MiB;
constexpr size_t WS_KV = 432 * MiB, KV_STRIDE = 16 * MiB;
constexpr size_t WS_SGA = 528 * MiB, WS_SGB = 656 * MiB;
constexpr size_t WS_Y = 784 * MiB;
constexpr size_t WS_ATT = WS_Y;
constexpr size_t WS_FOXO_UNUSED = WS_Y, WS_NSAO_UNUSED = WS_Y + 64 * MiB;
constexpr size_t WS_U = 176 * MiB;
constexpr size_t WS_END = 1024 * MiB;
static_assert(WS_FV - WS_FK == WS_FK - WS_FQ && WS_U + (size_t)MTOK * DFF * 2 <= WS_Y && WS_Y + (size_t)MTOK * 512 * 4 <= WS_END && WS_GATE + (size_t)MTOK * 24 * 4 <= WS_HB, "d_ws map");
constexpr int CW_TMO = 0, CW_CODE = 1, CW_BAR = 4096, CW_QUEUE = 16384;
constexpr int RING_OFF = 0, RING_BYTES = 131072;
constexpr int LDSCTL_OFF = RING_BYTES, MISC_OFF = LDSCTL_OFF + 320;
constexpr int LDS_BYTES = 147456;
static_assert(MISC_OFF + 128 <= LDS_BYTES, "LDS map");


typedef float f32x16 __attribute__((ext_vector_type(16)));
struct Frame {
    LAS unsigned char* lds;
    volatile LAS unsigned* MISC;
    gu32* ctl;
    int wave;
    int vcu, G;
    unsigned char* ws;
    const float* x; float* out;
    const float *g_mix_pre, *g_mix_post, *g_mlp_pre, *g_mlp_post, *w_in, *b_forget, *pos_k, *w1_k, *w2_k, *pos_v, *w1_v, *w2_v, *w_fox, *w_nsa, *w_o, *w_up, *w_down;
};
template <class T> __device__ __forceinline__ T* wsp(const Frame& F, size_t off) { return (T*)(F.ws + off); }
__device__ __forceinline__ int cur_lane() { return (int)__builtin_amdgcn_mbcnt_hi(~0u, __builtin_amdgcn_mbcnt_lo(~0u, 0u)); }
__device__ __forceinline__ int cur_tid(const Frame& F) { return F.wave * 64 + cur_lane(); }

__device__ __forceinline__ float wave_sum(float v) {
#pragma unroll
    for (int o = 1; o < 64; o <<= 1) v += __shfl_xor(v, o);
    return v;
}
__device__ __forceinline__ float bfl(unsigned w) { return __uint_as_float(w << 16); }
__device__ __forceinline__ float bfh(unsigned w) { return __uint_as_float(w & 0xffff0000u); }

__device__ __forceinline__ int rope_d(int w) { const int i = w >> 3, j = w & 7; return j < 4 ? 4 * i + j : 32 + 4 * i + (j - 4); }
__device__ __forceinline__ int in_src_col(int n) {
    if (n < 1536) return n;
    if (n < 2048) { const int l = n - 1536; return 1544 + (l & ~63) + rope_d(l & 63); }
    if (n < 2816) { const int s = (n - 2048) >> 8, l = (n - 2048) & 255; const int kb = 2056 + s * 256;
        return l < 128 ? kb + (l & ~63) + rope_d(l & 63) : kb + 128 + (l - 128); }
    if (n < 4864) { const int q = (n - 2816) >> 8, l = (n - 2816) & 255; return l < 128 ? 2848 + 128 * q + l : 3872 + 128 * q + (l - 128); }
    const int l = n - 4864; if (l < 8) return 1536 + l; if (l < 32) return 2824 + (l - 8); return -1;
}
template <class SrcCol>
__device__ __forceinline__ void p0_transpose_item(const float* W, int K, int Nsrc, bf16* WT, int nblk, LAS float* scr, int item, int lane, SrcCol srccol, const float* kgain = nullptr, int ldk = 0, int koff = 0) {
    const int kb = item / nblk, nb = item % nblk, k0 = 64 * kb, n0 = 32 * nb;
    const int sc = srccol(n0 + (lane & 31));
#pragma unroll 8
    for (int i = 0; i < 32; ++i) { const int kk = 2 * i + (lane >> 5); float w = sc >= 0 ? W[(size_t)(k0 + kk) * Nsrc + sc] : 0.f; if (kgain) w *= kgain[k0 + kk]; scr[kk * 33 + (lane & 31)] = w; }
    LDS_WAIT(); asm volatile("" ::: "memory");
    const int c = lane & 7;
#pragma unroll
    for (int j = 0; j < 4; ++j) { const int n = (lane >> 3) + 8 * j; const LAS float* s = scr + (8 * c) * 33 + n;
        v4u o; o.x = pk2(s[0 * 33], s[1 * 33]); o.y = pk2(s[2 * 33], s[3 * 33]); o.z = pk2(s[4 * 33], s[5 * 33]); o.w = pk2(s[6 * 33], s[7 * 33]);
        *(GAS v4u*)(WT + (size_t)(n0 + n) * (ldk ? ldk : K) + koff + k0 + 8 * c) = o; }
    LDS_WAIT(); asm volatile("" ::: "memory");
}
__device__ __forceinline__ void p0_transpose_item_f8(const float* W, int K, int N, unsigned char* WT, int nblk, LAS float* scr, int item, int lane, float scale) {
    const int kb = item / nblk, nb = item % nblk, k0 = 64 * kb, n0 = 32 * nb;
#pragma unroll 8
    for (int i = 0; i < 32; ++i) { const int kk = 2 * i + (lane >> 5); scr[kk * 33 + (lane & 31)] = W[(size_t)(k0 + kk) * N + n0 + (lane & 31)] * scale; }
    LDS_WAIT(); asm volatile("" ::: "memory");
    const int c = lane & 7;
#pragma unroll
    for (int j = 0; j < 4; ++j) { const int n = (lane >> 3) + 8 * j; const LAS float* s = scr + (8 * c) * 33 + n;
        pg8::f32x2 o; o.x = __builtin_bit_cast(float, pg8::cvt4_fp8(fmaxf(s[0 * 33], -pg8::F8_MAX), fmaxf(s[1 * 33], -pg8::F8_MAX), fmaxf(s[2 * 33], -pg8::F8_MAX), fmaxf(s[3 * 33], -pg8::F8_MAX)));
        o.y = __builtin_bit_cast(float, pg8::cvt4_fp8(fmaxf(s[4 * 33], -pg8::F8_MAX), fmaxf(s[5 * 33], -pg8::F8_MAX), fmaxf(s[6 * 33], -pg8::F8_MAX), fmaxf(s[7 * 33], -pg8::F8_MAX)));
        *(GAS pg8::f32x2*)(WT + (size_t)(n0 + n) * K + k0 + 8 * c) = o; }
    LDS_WAIT(); asm volatile("" ::: "memory");
}
__device__ __forceinline__ void rms_rows_to_bf16(int lane, int gw, int NGW, const float* X, const float* g, bf16* O) {
    constexpr int RP = 4;
    const GAS f32x4* gr = (const GAS f32x4*)g + lane; f32x4 gv[4];
#pragma unroll
    for (int j = 0; j < 4; ++j) gv[j] = gr[64 * j];
    for (int m0 = gw; m0 < MTOK; m0 += NGW * RP) {
        f32x4 v[RP][4];
#pragma unroll
        for (int r = 0; r < RP; ++r) { const GAS f32x4* xr = (const GAS f32x4*)(X + (size_t)(m0 + r * NGW) * DMODEL) + lane;
#pragma unroll
            for (int j = 0; j < 4; ++j) v[r][j] = __builtin_nontemporal_load(xr + 64 * j); }
#pragma unroll
        for (int r = 0; r < RP; ++r) { float s = 0.f;
#pragma unroll
            for (int j = 0; j < 4; ++j) s += (v[r][j].x * v[r][j].x + v[r][j].y * v[r][j].y) + (v[r][j].z * v[r][j].z + v[r][j].w * v[r][j].w);
            const float rr = 1.0f / sqrtf(wave_sum(s) * (1.f / DMODEL) + RMS_EPS);
            GAS unsigned long long* o8 = (GAS unsigned long long*)(O + (size_t)(m0 + r * NGW) * DMODEL) + lane;
#pragma unroll
            for (int j = 0; j < 4; ++j) { const f32x4 a = v[r][j], gg = gv[j];
                o8[64 * j] = (unsigned long long)pk2(a.x * rr * gg.x, a.y * rr * gg.y) | ((unsigned long long)pk2(a.z * rr * gg.z, a.w * rr * gg.w) << 32); } }
    }
}
__device__ __forceinline__ void p0_prologue(Frame& F) {
    LAS float* scr = (LAS float*)(F.lds + RING_OFF + F.wave * 16384);
    const int gw = F.vcu * NWAVES + F.wave, NGW = F.G * NWAVES, lane = cur_lane();
    constexpr int I_IN = 16 * (NPROJ / 32), I_F = 8 * 32, I_O = 16 * 32, I_UP = 16 * 128, I_DN = 64 * 32, I_W1 = 32 * 2, I_W2 = 1 * 2;
    constexpr int NITEMS = I_IN + 2 * I_F + I_O + I_UP + I_DN + 2 * I_W1 + 2 * I_W2;
    auto ident = [](int n) { return n; };
    for (int it = gw; it < NITEMS; it += NGW) {
        int r = it;
        if (r < I_IN) { p0_transpose_item(F.w_in, 1024, INCOLS, wsp<bf16>(F, WS_WIN), NPROJ / 32, scr, r, lane, [](int n) { return in_src_col(n); }); continue; } r -= I_IN;
        if (r < I_F) { p0_transpose_item(F.w_fox, 512, 1024, wsp<bf16>(F, WS_WF), 32, scr, r, lane, ident, nullptr, 1024, 512); continue; } r -= I_F;
        if (r < I_F) { p0_transpose_item(F.w_nsa, 512, 1024, wsp<bf16>(F, WS_WF), 32, scr, r, lane, ident, nullptr, 1024, 0); continue; } r -= I_F;
        if (r < I_O) { p0_transpose_item(F.w_o, 1024, 1024, wsp<bf16>(F, WS_WO), 32, scr, r, lane, ident); continue; } r -= I_O;
        if (r < I_UP) { p0_transpose_item(F.w_up, 1024, 4096, wsp<bf16>(F, WS_WUP), 128, scr, r, lane, ident, F.g_mlp_pre); continue; }     r -= I_UP;
        if (r < I_DN) { p0_transpose_item_f8(F.w_down, 4096, 1024, wsp<unsigned char>(F, WS_WDN), 32, scr, r, lane, WDN_SCALE); continue; } r -= I_DN;
        if (r < I_W1) { p0_transpose_item(F.w1_k, 2048, 64, wsp<bf16>(F, WS_W1K), 2, scr, r, lane, ident); continue; } r -= I_W1;
        if (r < I_W1) { p0_transpose_item(F.w1_v, 2048, 64, wsp<bf16>(F, WS_W1V), 2, scr, r, lane, ident); continue; } r -= I_W1;
        if (r < I_W2) { p0_transpose_item(F.w2_k, 64, 64, wsp<bf16>(F, WS_W2K), 2, scr, r, lane, ident); continue; } r -= I_W2;
        p0_transpose_item(F.w2_v, 64, 64, wsp<bf16>(F, WS_W2V), 2, scr, r, lane, ident);
    }
    { float* RC = wsp<float>(F, WS_ROPEC); float* RS = wsp<float>(F, WS_ROPES);
      for (int e = (F.vcu * NWAVES * 64 + cur_tid(F)); e < SEQ * 32; e += F.G * NWAVES * 64) { const int t = e >> 5, i = e & 31;
          const float inv = powf(10000.0f, -(float)(2 * i) / 64.0f); const float ang = (float)t * inv; RC[e] = cosf(ang); RS[e] = sinf(ang); } }
    if (F.wave == 0) for (int it = F.vcu; it < 128; it += F.G) { const int kv = it >> 6, c = it & 63; const float* pos = kv ? F.pos_v : F.pos_k; const float* w1 = kv ? F.w1_v : F.w1_k; float s = 0.f;
        for (int k = lane; k < 2048; k += 64) s += pos[k] * w1[(size_t)k * 64 + c];
        s = wave_sum(s); if (lane == 0) wsp<float>(F, kv ? WS_PBV : WS_PBK)[c] = s; }
    rms_rows_to_bf16(lane, gw, NGW, F.x, F.g_mix_pre, wsp<bf16>(F, WS_HB));
}

__device__ __forceinline__ int crow(int r, int hi) { return (r & 3) + 8 * (r >> 2) + 4 * hi; }
#define P2_PIN8(a) asm volatile("" : "+v"(a[0]), "+v"(a[1]), "+v"(a[2]), "+v"(a[3]), "+v"(a[4]), "+v"(a[5]), "+v"(a[6]), "+v"(a[7]))
__device__ __forceinline__ void p2_compress_unit(Frame& F, int unit) {
    const int bg = unit >> 2, kv = (unit >> 1) & 1, half = unit & 1, lane = cur_lane(), w = F.wave;
    const bf16* X = wsp<bf16>(F, WS_KV + (size_t)kv * KV_STRIDE) + (size_t)bg * SEQ * 64;
    const bf16* W1t = wsp<bf16>(F, kv ? WS_W1V : WS_W1K); const bf16* W2t = wsp<bf16>(F, kv ? WS_W2V : WS_W2K); const float* PB = wsp<float>(F, kv ? WS_PBV : WS_PBK);
    bf16* OUT = wsp<bf16>(F, kv ? WS_VCMP : WS_KCMP) + (size_t)bg * 128 * 64;
    const int rt = w & 1, ct = (w >> 1) & 1, kh = w >> 2, r = lane & 31, h = lane >> 5;
    const int irow = 64 * half + 32 * rt + r, ild = irow < 126 ? irow : 126;
    const GAS bf16x8* arow = (const GAS bf16x8*)(X + (size_t)ild * 1024 + kh * 1024); const GAS bf16x8* brow = (const GAS bf16x8*)(W1t + (size_t)(32 * ct + r) * 2048 + kh * 1024);
#define P2_KIDX(S) (8 * ((S) >> 2) + 4 * h + ((S) & 3))
    f32x16 acc = {};
    bf16x8 a0[8], b0[8], a1[8], b1[8];
#pragma unroll
    for (int s = 0; s < 8; ++s) { a0[s] = arow[P2_KIDX(s)]; b0[s] = brow[P2_KIDX(s)]; }
#pragma unroll 1
    for (int bt = 0; bt < 8; bt += 2) {
#pragma unroll
        for (int s = 0; s < 8; ++s) { a1[s] = arow[P2_KIDX(8 * (bt + 1) + s)]; b1[s] = brow[P2_KIDX(8 * (bt + 1) + s)]; }
        P2_PIN8(a0); P2_PIN8(b0);
#pragma unroll
        for (int s = 0; s < 8; ++s) acc = __builtin_amdgcn_mfma_f32_32x32x16_bf16(a0[s], b0[s], acc, 0, 0, 0);
        if (bt + 2 < 8) {
#pragma unroll
            for (int s = 0; s < 8; ++s) { a0[s] = arow[P2_KIDX(8 * (bt + 2) + s)]; b0[s] = brow[P2_KIDX(8 * (bt + 2) + s)]; } }
#undef P2_KIDX_DONE
        P2_PIN8(a1); P2_PIN8(b1);
#pragma unroll
        for (int s = 0; s < 8; ++s) acc = __builtin_amdgcn_mfma_f32_32x32x16_bf16(a1[s], b1[s], acc, 0, 0, 0);
    }
    LAS float* red = (LAS float*)(F.lds + RING_OFF);
    LAS bf16* Hs = (LAS bf16*)(F.lds + RING_OFF + 16384);
    if (kh == 1) {
#pragma unroll
        for (int i = 0; i < 16; ++i) red[((w & 3) * 16 + i) * 64 + lane] = acc[i];
    }
    __syncthreads();
    if (kh == 0) { const float pb = PB[32 * ct + r];
#pragma unroll
        for (int i = 0; i < 16; ++i) { float v = acc[i] + red[((w & 3) * 16 + i) * 64 + lane] + pb; v = v / (1.0f + __expf(-v)); Hs[(32 * rt + crow(i, h)) * 72 + 32 * ct + r] = (bf16)f2bf(v); }
    }
    __syncthreads();
    if (kh == 0) { f32x16 o = {};
#pragma unroll
        for (int s = 0; s < 4; ++s) { const bf16x8 a = *(const LAS bf16x8*)(Hs + (32 * rt + r) * 72 + 16 * s + 8 * h), b = *(const GAS bf16x8*)(W2t + (size_t)(32 * ct + r) * 64 + 16 * s + 8 * h);
            o = __builtin_amdgcn_mfma_f32_32x32x16_bf16(a, b, o, 0, 0, 0); }
#pragma unroll
        for (int i = 0; i < 16; ++i) { const int row = 64 * half + 32 * rt + crow(i, h); OUT[(size_t)row * 64 + 32 * ct + r] = (bf16)(row == 127 ? 0u : f2bf(o[i])); }
    }
    __syncthreads();
}
__device__ __forceinline__ void p2_phase(Frame& F) {
    for (int id = F.vcu; id < BATCH * 8; id += F.G) { const int b = id >> 3, h = id & 7, tid = cur_tid(F), lane = cur_lane(), w = F.wave;
        LAS float* wt = (LAS float*)(F.lds + RING_OFF + 32768);
        const float* lf = wsp<float>(F, WS_LF) + ((size_t)b * SEQ + 4 * tid) * 8 + h; float v[4];
#pragma unroll
        for (int i = 0; i < 4; ++i) v[i] = lf[i * 8];
        const float tot = (v[0] + v[1]) + (v[2] + v[3]); float incl = tot;
#pragma unroll
        for (int o = 1; o < 64; o <<= 1) { const float n = __shfl_up(incl, o); if (lane >= o) incl += n; }
        if (lane == 63) wt[w] = incl;
        __syncthreads();
        float run = incl - tot;
        for (int k = 0; k < w; ++k) run += wt[k];
        float* c = wsp<float>(F, WS_C) + (size_t)id * SEQ + 4 * tid; GAS v4u* kx = (GAS v4u*)(wsp<bf16>(F, WS_FKX) + ((size_t)id * SEQ + 4 * tid) * 16);
        float cv[4];
#pragma unroll
        for (int i = 0; i < 4; ++i) { run += v[i]; cv[i] = run;
            const float x = -run * LOG2E; const unsigned h1 = f2bf(x); const float r1 = x - __uint_as_float(h1 << 16); const unsigned h2 = f2bf(r1); const float r2 = r1 - __uint_as_float(h2 << 16); const unsigned h3 = f2bf(r2);
            kx[2 * i] = (v4u){h1 | (h2 << 16), h3, 0u, 0u}; kx[2 * i + 1] = (v4u){0u, 0u, 0u, 0u}; }
        *(GAS f32x4*)c = (f32x4){cv[0], cv[1], cv[2], cv[3]};
        { LAS float* cl = (LAS float*)(F.lds + RING_OFF + 36864); LAS float* wk = cl + 2048; LAS float* wq = wk + 256;
          *(LAS f32x4*)(cl + 4 * tid) = (f32x4){cv[0], cv[1], cv[2], cv[3]};
          const GAS v4u* kr = (const GAS v4u*)(wsp<bf16>(F, WS_FK) + ((size_t)b * SEQ + (tid >> 3)) * 512 + h * 64 + (tid & 7) * 8);
          const GAS v4u* qrw = (const GAS v4u*)(wsp<bf16>(F, WS_FQ) + ((size_t)b * SEQ + (tid >> 3)) * 512 + h * 64 + (tid & 7) * 8);
#pragma unroll 1
          for (int i0 = 0; i0 < 32; i0 += 16) { v4u ka[16], qa[16];
#pragma unroll
              for (int i = 0; i < 16; ++i) { ka[i] = kr[(size_t)(i0 + i) * 64 * 64]; qa[i] = qrw[(size_t)(i0 + i) * 64 * 64]; }
              asm volatile("" : "+v"(ka[0]), "+v"(ka[1]), "+v"(ka[2]), "+v"(ka[3]), "+v"(ka[4]), "+v"(ka[5]), "+v"(ka[6]), "+v"(ka[7]), "+v"(ka[8]), "+v"(ka[9]), "+v"(ka[10]), "+v"(ka[11]), "+v"(ka[12]), "+v"(ka[13]), "+v"(ka[14]), "+v"(ka[15]));
              asm volatile("" : "+v"(qa[0]), "+v"(qa[1]), "+v"(qa[2]), "+v"(qa[3]), "+v"(qa[4]), "+v"(qa[5]), "+v"(qa[6]), "+v"(qa[7]), "+v"(qa[8]), "+v"(qa[9]), "+v"(qa[10]), "+v"(qa[11]), "+v"(qa[12]), "+v"(qa[13]), "+v"(qa[14]), "+v"(qa[15]));
#pragma unroll
              for (int i = 0; i < 16; ++i) { const v4u a = ka[i], e = qa[i];
                  float sk = (bfl(a.x) * bfl(a.x) + bfh(a.x) * bfh(a.x)) + (bfl(a.y) * bfl(a.y) + bfh(a.y) * bfh(a.y)) + (bfl(a.z) * bfl(a.z) + bfh(a.z) * bfh(a.z)) + (bfl(a.w) * bfl(a.w) + bfh(a.w) * bfh(a.w));
                  float sq = (bfl(e.x) * bfl(e.x) + bfh(e.x) * bfh(e.x)) + (bfl(e.y) * bfl(e.y) + bfh(e.y) * bfh(e.y)) + (bfl(e.z) * bfl(e.z) + bfh(e.z) * bfh(e.z)) + (bfl(e.w) * bfl(e.w) + bfh(e.w) * bfh(e.w));
                  sk += __shfl_xor(sk, 1); sq += __shfl_xor(sq, 1); sk += __shfl_xor(sk, 2); sq += __shfl_xor(sq, 2); sk += __shfl_xor(sk, 4); sq += __shfl_xor(sq, 4);
                  sk = fmaxf(sk, __shfl_xor(sk, 8)); sq = fmaxf(sq, __shfl_xor(sq, 8)); sk = fmaxf(sk, __shfl_xor(sk, 16)); sq = fmaxf(sq, __shfl_xor(sq, 16)); sk = fmaxf(sk, __shfl_xor(sk, 32)); sq = fmaxf(sq, __shfl_xor(sq, 32));
                  if (lane == 0) { wk[w * 32 + i0 + i] = sk; wq[w * 32 + i0 + i] = sq; } } }
          __syncthreads();
          if (tid < 8) { const int qb = tid; float Qm = 0.f, Kband = 0.f;
              for (int t4 = 0; t4 < 4; ++t4) for (int ww = 0; ww < 8; ++ww) { Qm = fmaxf(Qm, wq[ww * 32 + 4 * qb + t4]); Kband = fmaxf(Kband, wk[ww * 32 + 4 * qb + t4]); }
              Qm = sqrtf(Qm) * 1.001f; Kband = sqrtf(Kband) * 1.001f;
              const float cq0 = cl[256 * qb]; int kt0 = 4 * qb;
              for (int kt = 4 * qb - 1; kt >= 0; --kt) { float kk = 0.f; for (int ww = 0; ww < 8; ++ww) kk = fmaxf(kk, wk[ww * 32 + kt]); kk = sqrtf(kk) * 1.001f;
                  const float bound = Qm * (kk + Kband) + (cq0 - cl[64 * kt + 63]) * LOG2E; if (bound >= -40.0f) kt0 = kt; }
              wsp<int>(F, WS_KT0)[id * 8 + qb] = kt0; } }
        __syncthreads(); }
    for (int u = F.vcu; u < 256; u += F.G) p2_compress_unit(F, u);
}

template <bool FINAL>
__device__ __forceinline__ void row_pass(Frame& F, const float* xin_f32, const bf16* xin_b16, const bf16* Y, const float* gpost, float* out_f32, bf16* X1B, float* RSTD2) {
    constexpr int RP = 4;
    const int gw = F.vcu * NWAVES + F.wave, NGW = F.G * NWAVES, lane = cur_lane();
    const GAS f32x4* gp = (const GAS f32x4*)gpost + lane;
    f32x4 gpv[4];
#pragma unroll
    for (int j = 0; j < 4; ++j) gpv[j] = gp[64 * j];
    for (int m0 = gw; m0 < MTOK; m0 += NGW * RP) {
        f32x4 xv[RP][4]; unsigned long long yw[RP][4];
#pragma unroll
        for (int r = 0; r < RP; ++r) { const size_t m = (size_t)(m0 + r * NGW);
            const GAS unsigned long long* yr = (const GAS unsigned long long*)(Y + m * DMODEL) + lane;
            if (FINAL) { const GAS unsigned long long* xr = (const GAS unsigned long long*)(xin_b16 + m * DMODEL) + lane;
#pragma unroll
                for (int j = 0; j < 4; ++j) { const unsigned long long w = __builtin_nontemporal_load(xr + 64 * j); const unsigned lo = (unsigned)w, hi = (unsigned)(w >> 32); xv[r][j] = (f32x4){bfl(lo), bfh(lo), bfl(hi), bfh(hi)}; yw[r][j] = __builtin_nontemporal_load(yr + 64 * j); }
            } else { const GAS f32x4* xr = (const GAS f32x4*)(xin_f32 + m * DMODEL) + lane;
#pragma unroll
                for (int j = 0; j < 4; ++j) { xv[r][j] = __builtin_nontemporal_load(xr + 64 * j); yw[r][j] = __builtin_nontemporal_load(yr + 64 * j); } } }
#pragma unroll
        for (int r = 0; r < RP; ++r) { const size_t m = (size_t)(m0 + r * NGW);
            f32x4 yv[4]; float s = 0.f;
#pragma unroll
            for (int j = 0; j < 4; ++j) { const unsigned lo = (unsigned)yw[r][j], hi = (unsigned)(yw[r][j] >> 32);
                yv[j] = (f32x4){bfl(lo), bfh(lo), bfl(hi), bfh(hi)}; s += (yv[j].x * yv[j].x + yv[j].y * yv[j].y) + (yv[j].z * yv[j].z + yv[j].w * yv[j].w); }
            const float rr = 1.0f / sqrtf(wave_sum(s) * (1.f / DMODEL) + RMS_EPS); float s2 = 0.f;
            if (FINAL) { GAS f32x4* xo = (GAS f32x4*)(out_f32 + m * DMODEL) + lane;
#pragma unroll
                for (int j = 0; j < 4; ++j) __builtin_nontemporal_store(xv[r][j] + yv[j] * rr * gpv[j], xo + 64 * j);
            } else { GAS unsigned long long* o8 = (GAS unsigned long long*)(X1B + m * DMODEL) + lane;
#pragma unroll
                for (int j = 0; j < 4; ++j) { const f32x4 v = xv[r][j] + yv[j] * rr * gpv[j]; s2 += (v.x * v.x + v.y * v.y) + (v.z * v.z + v.w * v.w);
                    o8[64 * j] = (unsigned long long)pk2(v.x, v.y) | ((unsigned long long)pk2(v.z, v.w) << 32); }
                const float r2 = 1.0f / sqrtf(wave_sum(s2) * (1.f / DMODEL) + RMS_EPS); if (lane == 0) RSTD2[m] = r2; }
        }
    }
}

namespace at {
constexpr int KSLOT = 10240, VSLOT = 8192, NSLOT = 3;
constexpr int L_K = 0, L_V = NSLOT * KSLOT, L_WS = L_V + NSLOT * VSLOT, L_PARK = L_WS + 8 * 512, L_PSL = L_PARK, L_CMP = L_PARK + 4 * 64 * 33 * 4, L_SELM = L_CMP + 4 * 8192, L_NEXT = L_SELM + 256, L_END = L_NEXT + 16;
static_assert(L_SELM >= L_PARK + 8 * 8192, "park region");
static_assert(L_END <= RING_BYTES, "attention LDS map");
constexpr float THR = 8.0f;
typedef short s16x4 __attribute__((ext_vector_type(4)));
typedef short v4i16_t __attribute__((ext_vector_type(4)));
#define AT_NEG (-INFINITY)
__device__ __forceinline__ void glds16(const void* sbase, unsigned voff, unsigned lds_dst) { unsigned keep;
    asm volatile("s_mov_b32 %0, m0\n\ts_mov_b32 m0, %3\n\ts_nop 2\n\tglobal_load_lds_dwordx4 %1, %2\n\ts_mov_b32 m0, %0" : "=&s"(keep) : "v"(voff), "s"(sbase), "s"(lds_dst) : "memory"); }
__device__ __forceinline__ void glds4(const void* sbase, unsigned voff, unsigned lds_dst) { unsigned keep;
    asm volatile("s_mov_b32 %0, m0\n\ts_mov_b32 m0, %3\n\ts_nop 2\n\tglobal_load_lds_dword %1, %2\n\ts_mov_b32 m0, %0" : "=&s"(keep) : "v"(voff), "s"(sbase), "s"(lds_dst) : "memory"); }
#define AT_WAIT_BAR(N) asm volatile("s_waitcnt vmcnt(" #N ") lgkmcnt(0)\n\ts_barrier" ::: "memory")
#define AT_BAR() asm volatile("s_waitcnt lgkmcnt(0)\n\ts_barrier" ::: "memory")
__device__ __forceinline__ unsigned cvtpk(float lo, float hi) { typedef float f2 __attribute__((ext_vector_type(2))); typedef __bf16 b2 __attribute__((ext_vector_type(2))); f2 v = {lo, hi}; b2 b = __builtin_convertvector(v, b2); return __builtin_bit_cast(unsigned, b); }
__device__ __forceinline__ float swap_half(float x, int hi) { auto rr = __builtin_amdgcn_permlane32_swap(__float_as_uint(x), __float_as_uint(x), false, false); return hi ? __uint_as_float(rr[0]) : __uint_as_float(rr[1]); }
__device__ __forceinline__ float max_half(float x) { auto rr = __builtin_amdgcn_permlane32_swap(__float_as_uint(x), __float_as_uint(x), false, false); return fmaxf(__uint_as_float(rr[0]), __uint_as_float(rr[1])); }
__device__ __forceinline__ float sum_half(float x) { auto rr = __builtin_amdgcn_permlane32_swap(__float_as_uint(x), __float_as_uint(x), false, false); return __uint_as_float(rr[0]) + __uint_as_float(rr[1]); }
template <int KS>
__device__ __forceinline__ void qk(f32x16& p0, f32x16& p1, const LAS unsigned char* Kslot, const bf16x8 (&qr)[5], const f32x16& cinit, int r32, int hi) {
    const LAS unsigned char* kb = Kslot + hi * 1024 + r32 * 16;
#pragma unroll
    for (int d0 = 0; d0 < KS; ++d0) { const bf16x8 b0 = *(const LAS bf16x8*)(kb + d0 * 2048), b1 = *(const LAS bf16x8*)(kb + d0 * 2048 + 512);
        if (d0 == 0) { p0 = __builtin_amdgcn_mfma_f32_32x32x16_bf16(b0, qr[0], cinit, 0, 0, 0); p1 = __builtin_amdgcn_mfma_f32_32x32x16_bf16(b1, qr[0], cinit, 0, 0, 0); }
        else { p0 = __builtin_amdgcn_mfma_f32_32x32x16_bf16(b0, qr[d0], p0, 0, 0, 0); p1 = __builtin_amdgcn_mfma_f32_32x32x16_bf16(b1, qr[d0], p1, 0, 0, 0); } }
}
__device__ __forceinline__ s16x4 vtr(const LAS unsigned char* p) { return __builtin_bit_cast(s16x4, __builtin_amdgcn_ds_read_tr16_b64_v4i16((LAS v4i16_t*)p)); }
__device__ __forceinline__ void pv(f32x16 (&o)[2], const LAS unsigned char* vb, const f32x16& p0, const f32x16& p1) {
    v4u pw[4];
#pragma unroll
    for (int k = 0; k < 2; ++k) { pw[k] = (v4u){cvtpk(p0[8 * k], p0[8 * k + 1]), cvtpk(p0[8 * k + 2], p0[8 * k + 3]), cvtpk(p0[8 * k + 4], p0[8 * k + 5]), cvtpk(p0[8 * k + 6], p0[8 * k + 7])};
        pw[2 + k] = (v4u){cvtpk(p1[8 * k], p1[8 * k + 1]), cvtpk(p1[8 * k + 2], p1[8 * k + 3]), cvtpk(p1[8 * k + 4], p1[8 * k + 5]), cvtpk(p1[8 * k + 6], p1[8 * k + 7])}; }
#pragma unroll
    for (int d0 = 0; d0 < 2; ++d0)
#pragma unroll
        for (int ks = 0; ks < 4; ++ks) { const s16x4 lo = vtr(vb + d0 * 4096 + ks * 1024), hi = vtr(vb + d0 * 4096 + ks * 1024 + 512);
            const bf16x8 vf = (bf16x8){lo[0], lo[1], lo[2], lo[3], hi[0], hi[1], hi[2], hi[3]};
            o[d0] = __builtin_amdgcn_mfma_f32_32x32x16_bf16(__builtin_bit_cast(bf16x8, pw[ks]), vf, o[d0], 0, 0, 0); }
}
template <int KS>
__device__ __forceinline__ void load_kf(bf16x8 (&kf)[10], const LAS unsigned char* Kslot, int r32, int hi) {
    const LAS unsigned char* kb = Kslot + hi * 1024 + r32 * 16;
#pragma unroll
    for (int d0 = 0; d0 < KS; ++d0) { kf[2 * d0] = *(const LAS bf16x8*)(kb + d0 * 2048); kf[2 * d0 + 1] = *(const LAS bf16x8*)(kb + d0 * 2048 + 512); }
}
__device__ __forceinline__ void v_load(bf16x8 (&vf)[8], const LAS unsigned char* vb) {
#pragma unroll
    for (int d0 = 0; d0 < 2; ++d0)
#pragma unroll
        for (int ks = 0; ks < 4; ++ks) { const s16x4 lo = vtr(vb + d0 * 4096 + ks * 1024), hi = vtr(vb + d0 * 4096 + ks * 1024 + 512);
            vf[d0 * 4 + ks] = (bf16x8){lo[0], lo[1], lo[2], lo[3], hi[0], hi[1], hi[2], hi[3]}; }
}
template <int KS, bool LOADK>
__device__ __forceinline__ void pv_regs(f32x16 (&o)[2], const bf16x8 (&vf)[8], const f32x16& p0, const f32x16& p1, bf16x8 (&kf)[10], const LAS unsigned char* Knext, int r32, int hi) {
    v4u pw[4];
#pragma unroll
    for (int k = 0; k < 2; ++k) { pw[k] = (v4u){cvtpk(p0[8 * k], p0[8 * k + 1]), cvtpk(p0[8 * k + 2], p0[8 * k + 3]), cvtpk(p0[8 * k + 4], p0[8 * k + 5]), cvtpk(p0[8 * k + 6], p0[8 * k + 7])};
        pw[2 + k] = (v4u){cvtpk(p1[8 * k], p1[8 * k + 1]), cvtpk(p1[8 * k + 2], p1[8 * k + 3]), cvtpk(p1[8 * k + 4], p1[8 * k + 5]), cvtpk(p1[8 * k + 6], p1[8 * k + 7])}; }
#pragma unroll
    for (int ks = 0; ks < 2; ++ks)
#pragma unroll
        for (int d0 = 0; d0 < 2; ++d0) o[d0] = __builtin_amdgcn_mfma_f32_32x32x16_bf16(__builtin_bit_cast(bf16x8, pw[ks]), vf[d0 * 4 + ks], o[d0], 0, 0, 0);
    if (LOADK) { __builtin_amdgcn_sched_barrier(0); load_kf<KS>(kf, Knext, r32, hi); __builtin_amdgcn_sched_barrier(0); }
#pragma unroll
    for (int ks = 2; ks < 4; ++ks)
#pragma unroll
        for (int d0 = 0; d0 < 2; ++d0) o[d0] = __builtin_amdgcn_mfma_f32_32x32x16_bf16(__builtin_bit_cast(bf16x8, pw[ks]), vf[d0 * 4 + ks], o[d0], 0, 0, 0);
}
__device__ __forceinline__ float max3f(float a, float b, float c) { float r; asm("v_max3_f32 %0, %1, %2, %3" : "=v"(r) : "v"(a), "v"(b), "v"(c)); return r; }
__device__ __forceinline__ float rowmax32(const f32x16& p0, const f32x16& p1) {
    float a = max3f(p0[0], p0[1], p1[0]), b = max3f(p0[2], p0[3], p1[1]); a = max3f(a, p1[2], p1[3]);
#pragma unroll
    for (int r = 4; r < 16; r += 4) { a = max3f(a, p0[r], p0[r + 1]); b = max3f(b, p0[r + 2], p0[r + 3]); a = max3f(a, p1[r], p1[r + 1]); b = max3f(b, p1[r + 2], p1[r + 3]); }
    return max_half(__builtin_fmaxf(a, b));
}
template <bool FIRST>
__device__ __forceinline__ void softmax_tile(f32x16& p0, f32x16& p1, f32x16& cinit, float& l, f32x16 (&o)[2], LAS float* wsf, int r32, int hi) {
    const float rm = rowmax32(p0, p1);
    bool resc = false;
    if (FIRST) { const float dl = rm;
#pragma unroll
        for (int r = 0; r < 16; ++r) { p0[r] -= dl; p1[r] -= dl; cinit[r] -= dl; } }
    else if (__any(rm > THR)) { const float dl = fmaxf(rm, 0.f);
#pragma unroll
        for (int r = 0; r < 16; ++r) { p0[r] -= dl; p1[r] -= dl; cinit[r] -= dl; }
        const float f = __builtin_amdgcn_exp2f(-dl); l *= f; if (hi == 0) wsf[r32] = f; resc = true; }
    float s = 0.f;
#pragma unroll
    for (int r = 0; r < 16; ++r) { p0[r] = __builtin_amdgcn_exp2f(p0[r]); p1[r] = __builtin_amdgcn_exp2f(p1[r]); s += p0[r] + p1[r]; }
    l += s;
    if (resc) {
#pragma unroll
        for (int i = 0; i < 4; ++i) { const f32x4 f4 = *(const LAS f32x4*)(wsf + 8 * i + 4 * hi);
#pragma unroll
            for (int k = 0; k < 4; ++k) { o[0][4 * i + k] *= f4[k]; o[1][4 * i + k] *= f4[k]; } } }
}
__device__ __forceinline__ void row_bcast(float v, float (&out)[16], LAS float* wsf, int r32, int hi) {
    asm volatile("s_waitcnt lgkmcnt(0)" ::: "memory");
    if (hi == 0) wsf[32 + r32] = v;
#pragma unroll
    for (int i = 0; i < 4; ++i) { const f32x4 f4 = *(const LAS f32x4*)(wsf + 32 + 8 * i + 4 * hi);
#pragma unroll
        for (int k = 0; k < 4; ++k) out[4 * i + k] = f4[k]; }
    asm volatile("s_waitcnt lgkmcnt(0)" ::: "memory");
}
__device__ __forceinline__ void store_rows(const f32x16 (&v)[2], LAS unsigned char* stg_, bf16* Ow, int pitch, int lane, int r32, int hi) {
    LAS bf16* stg = (LAS bf16*)stg_;
#pragma unroll
    for (int r = 0; r < 16; ++r) { const int orow = crow(r, hi);
#pragma unroll
        for (int d0 = 0; d0 < 2; ++d0) stg[orow * 64 + d0 * 32 + r32] = (bf16)f2bf(v[d0][r]); }
    asm volatile("s_waitcnt lgkmcnt(0)" ::: "memory");
#pragma unroll
    for (int i = 0; i < 4; ++i) { const int row = i * 8 + (lane >> 3), ch = lane & 7; const v4u w = *(const LAS v4u*)(stg + row * 64 + ch * 8); *(GAS v4u*)(Ow + (size_t)row * pitch + ch * 8) = w; }
    asm volatile("s_waitcnt lgkmcnt(0)" ::: "memory");
}


template <int KS>
__device__ __forceinline__ void qk_regs(f32x16& p0, f32x16& p1, const bf16x8 (&kf)[10], const bf16x8 (&qr)[5], const f32x16& cinit) {
    p0 = __builtin_amdgcn_mfma_f32_32x32x16_bf16(kf[0], qr[0], cinit, 0, 0, 0); p1 = __builtin_amdgcn_mfma_f32_32x32x16_bf16(kf[1], qr[0], cinit, 0, 0, 0);
#pragma unroll
    for (int d0 = 1; d0 < KS; ++d0) { p0 = __builtin_amdgcn_mfma_f32_32x32x16_bf16(kf[2 * d0], qr[d0], p0, 0, 0, 0); p1 = __builtin_amdgcn_mfma_f32_32x32x16_bf16(kf[2 * d0 + 1], qr[d0], p1, 0, 0, 0); }
}
__device__ __forceinline__ void softmax_first(f32x16& p0, f32x16& p1, f32x16& cinit, float& l) {
    const float dl = rowmax32(p0, p1); float s = 0.f;
#pragma unroll
    for (int r = 0; r < 16; ++r) { cinit[r] -= dl; p0[r] = __builtin_amdgcn_exp2f(p0[r] - dl); p1[r] = __builtin_amdgcn_exp2f(p1[r] - dl); s += p0[r] + p1[r]; }
    l = s;
}
__device__ __forceinline__ void softmax_next(f32x16& p0, f32x16& p1, f32x16& cinit, float& l, f32x16 (&o)[2], LAS float* wsf, int r32, int hi) {
    const float rm = rowmax32(p0, p1);
    if (__builtin_expect(__any(rm > THR), 0)) { const float dl = __builtin_fmaxf(rm, 0.f);
#pragma unroll
        for (int r = 0; r < 16; ++r) { p0[r] -= dl; p1[r] -= dl; cinit[r] -= dl; }
        const float f = __builtin_amdgcn_exp2f(-dl); l *= f; if (hi == 0) wsf[r32] = f;
#pragma unroll
        for (int i = 0; i < 4; ++i) { const f32x4 f4 = *(const LAS f32x4*)(wsf + 8 * i + 4 * hi);
#pragma unroll
            for (int k = 0; k < 4; ++k) { o[0][4 * i + k] *= f4[k]; o[1][4 * i + k] *= f4[k]; } } }
    float s = 0.f;
#pragma unroll
    for (int r = 0; r < 16; ++r) { p0[r] = __builtin_amdgcn_exp2f(p0[r]); p1[r] = __builtin_amdgcn_exp2f(p1[r]); s += p0[r] + p1[r]; }
    l += s;
}

#define AT_CONSUME4(a, b, c, d) asm volatile("" :: "v"(a), "v"(b), "v"(c), "v"(d))

__device__ __forceinline__ void fox_unit(Frame& F, int bh, int qb, int kt0, const int ABL) {
    int tid_ = cur_tid(F); asm volatile("" : "+v"(tid_));
    const int lane = tid_ & 63, r32 = lane & 31, hi = lane >> 5, wid = F.wave; const int b = bh >> 3, h = bh & 7;
    LAS unsigned char* shm = F.lds + RING_OFF; const unsigned lds0 = (unsigned)(uintptr_t)shm;
    LAS float* wsf = (LAS float*)(shm + L_WS + wid * 512);
    const size_t rowbase = (size_t)b * SEQ; const int q0 = qb * 256;
    const bf16* Q = wsp<bf16>(F, WS_FQ); const bf16* K = wsp<bf16>(F, WS_FK) + (rowbase + (size_t)kt0 * 64) * 512 + h * 64; const bf16* V = wsp<bf16>(F, WS_FV) + (rowbase + (size_t)kt0 * 64) * 512 + h * 64;
    const bf16* KX = wsp<bf16>(F, WS_FKX) + ((size_t)bh * SEQ + (size_t)kt0 * 64) * 16;
    const unsigned koff = (unsigned)(lane * 512 + wid * 8) * 2u, voff = (unsigned)((16 * (wid & 3) + (lane >> 2)) * 512 + (wid >> 2) * 32 + (lane & 3) * 8) * 2u;
    const unsigned xoff = (unsigned)((16 * (wid & 3) + (lane >> 2)) * 16 + (wid >> 2) * 8 + (lane & 3) * 2) * 2u;
    const unsigned kdst = lds0 + L_K + wid * 1024, vdst = lds0 + L_V + wid * 1024, xdst = lds0 + L_K + (8 + (wid >> 2)) * 1024 + (wid & 3) * 256;
#define FX_DMA_K(t, slot) do { glds16(K + (size_t)(t) * 64 * 512, koff, (unsigned)__builtin_amdgcn_readfirstlane(kdst + (slot) * KSLOT)); \
        glds4(KX + (size_t)(t) * 64 * 16, xoff, (unsigned)__builtin_amdgcn_readfirstlane(xdst + (slot) * KSLOT)); } while (0)
#define FX_DMA_V(t, slot) glds16(V + (size_t)(t) * 64 * 512, voff, (unsigned)__builtin_amdgcn_readfirstlane(vdst + (slot) * VSLOT))
    const int NT = 4 * qb + 4 - kt0;
    bf16x8 qr[5];
    { const bf16* Qw = Q + (rowbase + q0 + wid * 32 + r32) * 512 + h * 64;
#pragma unroll
      for (int d0 = 0; d0 < 4; ++d0) qr[d0] = *(const GAS bf16x8*)(Qw + d0 * 16 + hi * 8);
      const short one = (short)0x3F80; qr[4] = hi == 0 ? (bf16x8){one, one, one, 0, 0, 0, 0, 0} : (bf16x8){0, 0, 0, 0, 0, 0, 0, 0}; }
    const float ct = wsp<float>(F, WS_C)[(size_t)bh * SEQ + q0 + wid * 32 + r32] * LOG2E;
    asm volatile("" ::: "memory");
    FX_DMA_K(0, 0); FX_DMA_V(0, 0); FX_DMA_K(1, 1); FX_DMA_K(2, 2); FX_DMA_V(1, 1);
    f32x16 cinit;
    f32x16 o[2]; o[0] = f32x16{}; o[1] = f32x16{}; float l = 0.f;
    const int qrel = wid * 32 + r32;
    const LAS unsigned char* vtb = shm + L_V + ((lane >> 4) & 1) * 32 + (lane & 3) * 8 + (4 * hi + ((lane & 15) >> 2)) * 64;
    bf16x8 kf[10], vf[8];
    AT_WAIT_BAR(3);
    AT_CONSUME4(qr[0], qr[1], qr[2], qr[3]); asm volatile("" :: "v"(ct));
#pragma unroll
    for (int r = 0; r < 16; ++r) cinit[r] = ct;
    load_kf<5>(kf, shm + L_K, r32, hi);
    int s0 = 0, s1 = 1, s2 = 2;
#define FX_MASK(n) do { const int jb_ = (n) - (NT - 4); if (jb_ >= 0) { const int kb_ = 64 * jb_ + 4 * hi; \
        _Pragma("unroll") for (int r = 0; r < 16; ++r) { const int kv = kb_ + (r & 3) + 8 * (r >> 2); if (kv > qrel) p0[r] = AT_NEG; if (kv + 32 > qrel) p1[r] = AT_NEG; } } } while (0)
#define FX_ROT() do { const int t_ = s0; s0 = s1; s1 = s2; s2 = t_; } while (0)
    if (ABL != 7) {
    {
      AT_WAIT_BAR(3); FX_DMA_K(3, 0); FX_DMA_V(2, 2);
      f32x16 p0, p1; qk_regs<5>(p0, p1, kf, qr, cinit); v_load(vf, vtb); __builtin_amdgcn_sched_barrier(0);
      FX_MASK(0); softmax_first(p0, p1, cinit, l); pv_regs<5, true>(o, vf, p0, p1, kf, shm + L_K + KSLOT, r32, hi); FX_ROT(); }
    int n = 1;
    for (; n + 3 < NT; ++n) {
        if (ABL == 4) asm volatile("s_waitcnt vmcnt(3) lgkmcnt(0)" ::: "memory"); else AT_WAIT_BAR(3);
        if (ABL != 5) { FX_DMA_K(n + 3, s0); FX_DMA_V(n + 2, s2); }
        f32x16 p0, p1; if (ABL == 3) { p0 = cinit; p1 = cinit; asm volatile("" : "+v"(p0), "+v"(p1)); } else qk_regs<5>(p0, p1, kf, qr, cinit);
        v_load(vf, vtb + s0 * VSLOT); __builtin_amdgcn_sched_barrier(0);
        FX_MASK(n);
        if (ABL == 6) { asm volatile("" : "+v"(p0), "+v"(p1)); }
        else if (ABL == 1) { const float rm = rowmax32(p0, p1); l += rm; asm volatile("" : "+v"(p0), "+v"(p1)); }
        else softmax_next(p0, p1, cinit, l, o, wsf, r32, hi);
        if (ABL == 2) { asm volatile("" :: "v"(p0), "v"(p1), "v"(vf[0]), "v"(vf[1]), "v"(vf[2]), "v"(vf[3]), "v"(vf[4]), "v"(vf[5]), "v"(vf[6]), "v"(vf[7])); load_kf<5>(kf, shm + L_K + s1 * KSLOT, r32, hi); }
        else pv_regs<5, true>(o, vf, p0, p1, kf, shm + L_K + s1 * KSLOT, r32, hi);
        FX_ROT(); }
    {
      AT_WAIT_BAR(3); FX_DMA_V(n + 2, s2);
      f32x16 p0, p1; qk_regs<5>(p0, p1, kf, qr, cinit); v_load(vf, vtb + s0 * VSLOT); __builtin_amdgcn_sched_barrier(0);
      FX_MASK(n); softmax_next(p0, p1, cinit, l, o, wsf, r32, hi); pv_regs<5, true>(o, vf, p0, p1, kf, shm + L_K + s1 * KSLOT, r32, hi); FX_ROT(); ++n; }
    {
      AT_WAIT_BAR(1);
      f32x16 p0, p1; qk_regs<5>(p0, p1, kf, qr, cinit); v_load(vf, vtb + s0 * VSLOT); __builtin_amdgcn_sched_barrier(0);
      FX_MASK(n); softmax_next(p0, p1, cinit, l, o, wsf, r32, hi); pv_regs<5, true>(o, vf, p0, p1, kf, shm + L_K + s1 * KSLOT, r32, hi); FX_ROT(); ++n; }
    {
      AT_WAIT_BAR(0);
      f32x16 p0, p1; qk_regs<5>(p0, p1, kf, qr, cinit); v_load(vf, vtb + s0 * VSLOT); __builtin_amdgcn_sched_barrier(0);
      FX_MASK(n); softmax_next(p0, p1, cinit, l, o, wsf, r32, hi); pv_regs<5, false>(o, vf, p0, p1, kf, shm, r32, hi); }
    } else { asm volatile("s_waitcnt vmcnt(0)" ::: "memory"); l = 1.f; }
#undef FX_DMA_K
#undef FX_DMA_V
#undef FX_MASK
#undef FX_ROT
    l = sum_half(l); float rl[16]; row_bcast(1.0f / l, rl, wsf, r32, hi);
#pragma unroll
    for (int r = 0; r < 16; ++r) { o[0][r] *= rl[r]; o[1][r] *= rl[r]; }
    store_rows(o, shm + L_PARK + wid * 8192, wsp<bf16>(F, ABL ? WS_PROBE_O : WS_ATT) + (rowbase + q0 + wid * 32) * 1024 + 512 + h * 64, 1024, lane, r32, hi);
    AT_BAR();
}

__device__ __forceinline__ void nsa_unit(Frame& F, int bg, int j) {
    int tid_ = cur_tid(F); asm volatile("" : "+v"(tid_));
    const int tid = tid_, lane = tid & 63, r32 = lane & 31, hi = lane >> 5, wid = F.wave; const int b = bg >> 1, g = bg & 1, hh = wid >> 1, head = 4 * g + hh;
    LAS unsigned char* shm = F.lds + RING_OFF; const unsigned lds0 = (unsigned)(uintptr_t)shm;
    LAS float* wsf = (LAS float*)(shm + L_WS + wid * 512);
    LAS float* PSL = (LAS float*)(shm + L_PSL); LAS unsigned* SELM = (LAS unsigned*)(shm + L_SELM);
    const int qrel = 32 * (wid & 1) + r32, t = 64 * j + qrel; const size_t row = (size_t)b * SEQ + t;
    const bf16* KC = wsp<bf16>(F, WS_KCMP) + (size_t)bg * 128 * 64; const bf16* VC = wsp<bf16>(F, WS_VCMP) + (size_t)bg * 128 * 64;
    const bf16* KS = wsp<bf16>(F, WS_KV + 2 * KV_STRIDE) + (size_t)bg * SEQ * 64; const bf16* VS = wsp<bf16>(F, WS_KV + 3 * KV_STRIDE) + (size_t)bg * SEQ * 64;
    const bf16* KW = wsp<bf16>(F, WS_KV + 4 * KV_STRIDE) + (size_t)bg * SEQ * 64; const bf16* VW = wsp<bf16>(F, WS_KV + 5 * KV_STRIDE) + (size_t)bg * SEQ * 64;
    const unsigned koff = (unsigned)(lane * 64 + wid * 8) * 2u, voff = (unsigned)((16 * (wid & 3) + (lane >> 2)) * 64 + (wid >> 2) * 32 + (lane & 3) * 8) * 2u;
    const unsigned kdst = lds0 + L_K + wid * 1024, vdst = lds0 + L_V + wid * 1024, cdst = lds0 + L_CMP + wid * 1024;
    const int nsel = j + 1, nwin = j >= 8 ? 9 : j + 1, NR = nsel + nwin;
#define NS_TILE(m) ({ int m_ = (m); m_ = m_ < NR ? m_ : NR - 1; (m_ < nsel) ? m_ : (j - (m_ - nsel)) + 64; })
#define NS_DMA_K(m, slot) do { const int e_ = NS_TILE(m); const bf16* kp_ = (e_ < 64) ? KS + e_ * 4096 : KW + (e_ - 64) * 4096; glds16(kp_, koff, (unsigned)__builtin_amdgcn_readfirstlane(kdst + (slot) * KSLOT)); } while (0)
#define NS_DMA_V(m, slot) do { const int e_ = NS_TILE(m); const bf16* vp_ = (e_ < 64) ? VS + e_ * 4096 : VW + (e_ - 64) * 4096; glds16(vp_, voff, (unsigned)__builtin_amdgcn_readfirstlane(vdst + (slot) * VSLOT)); } while (0)
    bf16x8 qr[5];
    { const bf16* Qw = wsp<bf16>(F, WS_NQ) + row * 512 + head * 64;
#pragma unroll
      for (int d0 = 0; d0 < 4; ++d0) qr[d0] = *(const GAS bf16x8*)(Qw + d0 * 16 + hi * 8);
      qr[4] = (bf16x8){0, 0, 0, 0, 0, 0, 0, 0}; }
    const float* gt = wsp<float>(F, WS_GATE) + row * 24 + head * 3; const float g0 = gt[0], g1 = gt[1], g2 = gt[2];
    asm volatile("" ::: "memory");
    glds16(KC, koff, (unsigned)__builtin_amdgcn_readfirstlane(cdst)); glds16(KC + 4096, koff, (unsigned)__builtin_amdgcn_readfirstlane(cdst + 8192));
    glds16(VC, voff, (unsigned)__builtin_amdgcn_readfirstlane(cdst + 16384)); glds16(VC + 4096, voff, (unsigned)__builtin_amdgcn_readfirstlane(cdst + 24576));
    NS_DMA_K(0, 0); NS_DMA_V(0, 0); NS_DMA_K(1, 1); NS_DMA_K(2, 2); NS_DMA_V(1, 1);
    const LAS unsigned char* vlane = shm + ((lane >> 4) & 1) * 32 + (lane & 3) * 8 + (4 * hi + ((lane & 15) >> 2)) * 64;
    const LAS unsigned char* vtb = vlane + L_V;
    f32x16 o[2]; float rs[16]; bf16x8 kf[10], vf[8];
    LAS float* park = (LAS float*)(shm + L_PARK + wid * 8192) + lane;
    AT_WAIT_BAR(5);
    AT_CONSUME4(qr[0], qr[1], qr[2], qr[3]); asm volatile("" :: "v"(g0), "v"(g1), "v"(g2));
    { f32x16 zero = f32x16{}; f32x16 a0, a1, b0, b1;
      load_kf<4>(kf, shm + L_CMP, r32, hi); qk_regs<4>(a0, a1, kf, qr, zero); load_kf<4>(kf, shm + L_CMP + 8192, r32, hi); qk_regs<4>(b0, b1, kf, qr, zero);
      const int nmax = (t - 31) >> 4;
#pragma unroll
      for (int r = 0; r < 16; ++r) { const int n = (r & 3) + 8 * (r >> 2) + 4 * hi; if (n > nmax) a0[r] = AT_NEG; if (n + 32 > nmax) a1[r] = AT_NEG; if (n + 64 > nmax) b0[r] = AT_NEG; if (n + 96 > nmax) b1[r] = AT_NEG; }
      float m = __builtin_fmaxf(rowmax32(a0, a1), rowmax32(b0, b1)); m = (m == AT_NEG) ? 0.f : m;
      float s = 0.f;
#pragma unroll
      for (int r = 0; r < 16; ++r) { a0[r] = __builtin_amdgcn_exp2f(a0[r] - m); a1[r] = __builtin_amdgcn_exp2f(a1[r] - m); b0[r] = __builtin_amdgcn_exp2f(b0[r] - m); b1[r] = __builtin_amdgcn_exp2f(b1[r] - m); s += (a0[r] + a1[r]) + (b0[r] + b1[r]); }
      s = sum_half(s); const float inv = 1.0f / fmaxf(s, 1e-30f);
#pragma unroll
      for (int r = 0; r < 16; ++r) { a0[r] *= inv; a1[r] *= inv; b0[r] *= inv; b1[r] *= inv; }
      if (j >= 8) {
          float G[16], Lp[16];
#pragma unroll
          for (int i = 0; i < 4; ++i) { G[i] = (a0[4 * i] + a0[4 * i + 1]) + (a0[4 * i + 2] + a0[4 * i + 3]); G[4 + i] = (a1[4 * i] + a1[4 * i + 1]) + (a1[4 * i + 2] + a1[4 * i + 3]);
              G[8 + i] = (b0[4 * i] + b0[4 * i + 1]) + (b0[4 * i + 2] + b0[4 * i + 3]); G[12 + i] = (b1[4 * i] + b1[4 * i + 1]) + (b1[4 * i + 2] + b1[4 * i + 3]);
              Lp[i] = swap_half(a0[4 * i + 3], hi); Lp[4 + i] = swap_half(a1[4 * i + 3], hi); Lp[8 + i] = swap_half(b0[4 * i + 3], hi); Lp[12 + i] = swap_half(b1[4 * i + 3], hi); }
          LAS float* dst = PSL + (hh * 64 + qrel) * 33 + hi;
#pragma unroll
          for (int I = 0; I < 16; ++I) { const float prev = hi ? Lp[I] : (I > 0 ? Lp[I > 0 ? I - 1 : 0] : 0.f); dst[2 * I] = G[I] + prev; }
      }
      o[0] = f32x16{}; o[1] = f32x16{};
      pv(o, vlane + L_CMP + 16384, a0, a1); pv(o, vlane + L_CMP + 24576, b0, b1);
    }
    AT_BAR();
    if (j >= 8) { const int q = tid >> 3, sub = tid & 7;
        float v[4]; unsigned bits = 1u | (1u << j) | (1u << (j - 1));
#pragma unroll
        for (int c4 = 0; c4 < 4; ++c4) { const int k = 4 * sub + c4;
            const float ps = (PSL[(0 * 64 + q) * 33 + k] + PSL[(1 * 64 + q) * 33 + k]) + (PSL[(2 * 64 + q) * 33 + k] + PSL[(3 * 64 + q) * 33 + k]);
            v[c4] = (k > j - 2 || k == 0) ? -1e30f : ps; }
#pragma unroll 1
        for (int rnd = 0; rnd < 5; ++rnd) {
            float bv = v[0]; int bi = 4 * sub;
#pragma unroll
            for (int c4 = 1; c4 < 4; ++c4) if (v[c4] > bv) { bv = v[c4]; bi = 4 * sub + c4; }
#pragma unroll
            for (int o = 1; o < 8; o <<= 1) { const float ov = __shfl_xor(bv, o); const int oi = __shfl_xor(bi, o); if (ov > bv || (ov == bv && oi < bi)) { bv = ov; bi = oi; } }
            bits |= 1u << bi;
#pragma unroll
            for (int c4 = 0; c4 < 4; ++c4) if (bi == 4 * sub + c4) v[c4] = -3.0e38f; }
        if (sub == 0) SELM[q] = bits;
    } else { if (tid < 64) SELM[tid] = (2u << j) - 1u; }
    AT_BAR();
    const unsigned selm = SELM[qrel];
    row_bcast(g0, rs, wsf, r32, hi);
#pragma unroll
    for (int r = 0; r < 16; ++r) { park[r * 64] = o[0][r] * rs[r]; park[(16 + r) * 64] = o[1][r] * rs[r]; }
    f32x16 cinit; float l;
    AT_WAIT_BAR(2);
    load_kf<4>(kf, shm + L_K, r32, hi);
    int s0 = 0, s1 = 1, s2 = 2, m = 0;
#define NS_ROT() do { const int t_ = s0; s0 = s1; s1 = s2; s2 = t_; ++m; } while (0)
#define NS_HEAD() AT_WAIT_BAR(2); NS_DMA_K(m + 3, s0); NS_DMA_V(m + 2, s2); f32x16 p0, p1; qk_regs<4>(p0, p1, kf, qr, cinit); v_load(vf, vtb + s0 * VSLOT); __builtin_amdgcn_sched_barrier(0)
#define NS_MASK_SEL() do { const float keep_ = ((selm >> m) & 1u) ? 0.f : AT_NEG;        \
        _Pragma("unroll") for (int r = 0; r < 16; ++r) { p0[r] += keep_; p1[r] += keep_; } \
        if (m == j) {   \
        _Pragma("unroll") for (int r = 0; r < 16; ++r) { const int kk = (r & 3) + 8 * (r >> 2) + 4 * hi; if (kk > qrel) p0[r] = AT_NEG; if (kk + 32 > qrel) p1[r] = AT_NEG; } } } while (0)
#define NS_MASK_WIN() do { const int tt = j - (m - nsel); if (tt == j) { \
        _Pragma("unroll") for (int r = 0; r < 16; ++r) { const int kk = (r & 3) + 8 * (r >> 2) + 4 * hi; if (kk > qrel) p0[r] = AT_NEG; if (kk + 32 > qrel) p1[r] = AT_NEG; } } \
      else if (tt == j - 8) {   \
        _Pragma("unroll") for (int r = 0; r < 16; ++r) { const int kk = (r & 3) + 8 * (r >> 2) + 4 * hi; if (kk <= qrel) p0[r] = AT_NEG; if (kk + 32 <= qrel) p1[r] = AT_NEG; } } } while (0)
    cinit = f32x16{}; o[0] = f32x16{}; o[1] = f32x16{};
    { NS_HEAD(); NS_MASK_SEL(); softmax_first(p0, p1, cinit, l); pv_regs<4, true>(o, vf, p0, p1, kf, shm + L_K + s1 * KSLOT, r32, hi); NS_ROT(); }
    for (; m < nsel;) { NS_HEAD(); NS_MASK_SEL(); softmax_next(p0, p1, cinit, l, o, wsf, r32, hi); pv_regs<4, true>(o, vf, p0, p1, kf, shm + L_K + s1 * KSLOT, r32, hi); NS_ROT(); }
    l = sum_half(l); row_bcast(g1 / l, rs, wsf, r32, hi);
#pragma unroll
    for (int r = 0; r < 16; ++r) { park[r * 64] += o[0][r] * rs[r]; park[(16 + r) * 64] += o[1][r] * rs[r]; }
    cinit = f32x16{}; o[0] = f32x16{}; o[1] = f32x16{};
    { NS_HEAD(); NS_MASK_WIN(); softmax_first(p0, p1, cinit, l); pv_regs<4, true>(o, vf, p0, p1, kf, shm + L_K + s1 * KSLOT, r32, hi); NS_ROT(); }
    for (; m < NR;) { NS_HEAD(); NS_MASK_WIN(); softmax_next(p0, p1, cinit, l, o, wsf, r32, hi); pv_regs<4, true>(o, vf, p0, p1, kf, shm + L_K + s1 * KSLOT, r32, hi); NS_ROT(); }
#undef NS_HEAD
#undef NS_TILE
#undef NS_DMA_K
#undef NS_DMA_V
#undef NS_ROT
#undef NS_MASK_SEL
#undef NS_MASK_WIN
    l = sum_half(l); row_bcast(g2 / l, rs, wsf, r32, hi);
#pragma unroll
    for (int r = 0; r < 16; ++r) { o[0][r] = park[r * 64] + o[0][r] * rs[r]; o[1][r] = park[(16 + r) * 64] + o[1][r] * rs[r]; }
    asm volatile("s_waitcnt vmcnt(0) lgkmcnt(0)" ::: "memory");
    store_rows(o, shm + L_PARK + wid * 8192, wsp<bf16>(F, WS_ATT) + ((size_t)b * SEQ + 64 * j + 32 * (wid & 1)) * 1024 + head * 64, 1024, lane, r32, hi);
    AT_BAR();
}
constexpr int NUNITS = 4096;
__device__ const unsigned short BLK_TAB[64] = {64512, 63489, 62466, 61443, 60420, 59397, 58374, 57351, 56328, 55305, 54282, 53259, 52236, 51213, 50190, 49167, 48144, 47121, 46098, 45075, 44052, 43029, 42006, 40983, 39960, 38937, 37914, 36891, 35868, 2077, 2077, 2077, 2077, 3105, 3105, 3105, 3105, 4133, 4133, 4133, 4133, 5161, 5161, 5161, 5161, 6189, 6189, 6189, 6189, 7217, 7217, 7217, 7217, 34869, 1078, 1078, 1078, 1078, 33850, 32827, 60, 60, 60, 60};
}
#ifndef PROBE_ABL
#define PROBE_ABL 0
#endif
__device__ __forceinline__ void p3_attention(Frame& F, const int MODE) {
    const int G = F.G, c = F.vcu, nrounds = (at::NUNITS + G - 1) / G;
    const gu32* KT0 = (const gu32*)wsp<unsigned>(F, WS_KT0);
#define P3_UNIT(i) ((i) * G + (((i) & 1) ? G - 1 - c : c))
#define P3_KT0_IDX(u) ({ const unsigned tb_ = at::BLK_TAB[(u) >> 6]; const int ix_ = (u) - (int)(tb_ & 1023u) * 64; (tb_ >> 15) ? 0 : ix_ * 8 + (int)((tb_ >> 10) & 31u); })
    unsigned kt_next = 0u;
    { const int u0 = P3_UNIT(0); if (u0 < at::NUNITS) kt_next = __hip_atomic_load(KT0 + P3_KT0_IDX(u0), RLX_AGENT); }
    for (int i = 0; i < nrounds; ++i) {
        const int u = P3_UNIT(i); if (u >= at::NUNITS) continue;
        const int kt0 = __builtin_amdgcn_readfirstlane((int)kt_next);
        { const int un = P3_UNIT(i + 1); if (i + 1 < nrounds && un < at::NUNITS) kt_next = __hip_atomic_load(KT0 + P3_KT0_IDX(un), RLX_AGENT); }
        const unsigned tab = at::BLK_TAB[u >> 6]; const int idx = u - (int)(tab & 1023u) * 64; const int par = (tab >> 10) & 31;
        if (tab >> 15) { if (MODE != 1) at::nsa_unit(F, idx, par); } else { if (MODE != 2) at::fox_unit(F, idx, par, kt0, MODE == 1 ? PROBE_ABL : 0); }
    }
#undef P3_UNIT
#undef P3_KT0_IDX
    asm volatile("s_waitcnt vmcnt(0) lgkmcnt(0)" ::: "memory");
    __syncthreads();
}

struct Args { const float* in[18]; float* out; unsigned char* ws; int ph_lo, ph_hi, li, pad; };
__global__ void __launch_bounds__(NWAVES * 64, 2) fwd_kernel(Args args) {
    extern __shared__ __attribute__((aligned(16))) unsigned char lds[];
    Frame F;
    F.lds = (LAS unsigned char*)lds;
    F.MISC = (volatile LAS unsigned*)(F.lds + MISC_OFF);
    F.wave = __builtin_amdgcn_readfirstlane((int)threadIdx.x >> 6);
    F.G = gridDim.x; { const int bx = blockIdx.x; F.vcu = (F.G % 8 == 0) ? (bx % 8) * (F.G / 8) + bx / 8 : bx; }
    F.ws = args.ws; F.ctl = (gu32*)(args.ws + WS_CTL);
    F.x = args.in[0]; F.g_mix_pre = args.in[1]; F.g_mix_post = args.in[2]; F.g_mlp_pre = args.in[3]; F.g_mlp_post = args.in[4]; F.w_in = args.in[5]; F.b_forget = args.in[6];
    F.pos_k = args.in[7]; F.w1_k = args.in[8]; F.w2_k = args.in[9]; F.pos_v = args.in[10]; F.w1_v = args.in[11]; F.w2_v = args.in[12];
    F.w_fox = args.in[13]; F.w_nsa = args.in[14]; F.w_o = args.in[15]; F.w_up = args.in[16]; F.w_down = args.in[17]; F.out = args.out;
    for (int u = (int)threadIdx.x; u < (LDS_BYTES - LDSCTL_OFF) / 4; u += NWAVES * 64) ((LAS unsigned*)(F.lds + LDSCTL_OFF))[u] = 0u;
    __syncthreads();
    XcdBarrier bar; bar.bar = (unsigned*)(F.ctl + CW_BAR); bar.x = 0; bar.st = nullptr;
    if (N_LAUNCHES == 1) bar = xcd_barrier_post((unsigned*)(F.ctl + CW_BAR), F.MISC + 8);
#define GRID_BAR() do { if (N_LAUNCHES == 1) xcd_barrier(bar); } while (0)
    const int lo = args.ph_lo, hi = args.ph_hi;
#define IN(k) (lo <= (k) && (k) < hi)
#define BOTH(k) (IN(k) && IN((k) + 1))
#ifndef STAGGER_P7
#define STAGGER_P7 0
#endif
#ifndef STAGGER_P1
#define STAGGER_P1 0
#endif
#define XCD_STAGGER(ticks) do { if ((ticks) > 0) { const unsigned long long t0_ = rt(); const unsigned long long d_ = (unsigned long long)(xb_xcc_id() & 7u) * (unsigned)(ticks) / 8u; while (rt() - t0_ < d_) __builtin_amdgcn_s_sleep(8); } } while (0)
#ifndef PROBE_REPEAT
#define PROBE_REPEAT (-1)
#endif
#define REPS(k) for (int rep_ = 0; rep_ < ((PROBE_REPEAT == (k)) ? 2 : 1); ++rep_)
#define REP_BAR(k) do { if (PROBE_REPEAT == (k) && rep_ == 0) { VM_WAIT(); __syncthreads(); GRID_BAR(); } } while (0)

    if (IN(0)) { REPS(0) { p0_prologue(F); REP_BAR(0); } if (BOTH(0)) GRID_BAR(); }

    if (IN(1)) { XCD_STAGGER(STAGGER_P1);
        pg8::Gemm g{wsp<bf16>(F, WS_HB), wsp<bf16>(F, WS_WIN), MTOK, NPROJ, DMODEL}; pg8::StaticOrder S; S.init(MTOK, NPROJ, F.G, (int)blockIdx.x);
        pg8::EpiInProj E{wsp<bf16>(F, WS_FQ), wsp<bf16>(F, WS_NQ), wsp<bf16>(F, WS_KV), wsp<bf16>(F, WS_SGA),
                         wsp<float>(F, WS_LF), wsp<float>(F, WS_GATE), F.b_forget, wsp<float>(F, WS_ROPEC), wsp<float>(F, WS_ROPES), (WS_FK - WS_FQ) / 2, KV_STRIDE / 2, (WS_SGB - WS_SGA) / 2, QSCALE};
        REPS(1) { pg8::gemm_phase<pg8::EpiInProj, pg8::StaticOrder, true, true>(F.lds + RING_OFF, g, S, E, F.wave); REP_BAR(1); }
        if (BOTH(1)) GRID_BAR();
    }
    if (IN(2)) { REPS(2) { p2_phase(F); REP_BAR(2); } if (BOTH(2)) GRID_BAR(); }
#ifndef PROBE_P3_MODE
#define PROBE_P3_MODE 3
#endif
    if (IN(3)) {
#if PROBE_REPEAT == 3
        for (int rep_ = 0; rep_ < 2; ++rep_) { p3_attention(F, rep_ ? PROBE_P3_MODE : 0); if (rep_ == 0) { VM_WAIT(); __syncthreads(); GRID_BAR(); } }
#else
        p3_attention(F, 0);
#endif
        if (BOTH(3)) GRID_BAR(); }
    if (IN(4)) { REPS(4) {
        pg8::Gemm g{wsp<bf16>(F, WS_ATT), wsp<bf16>(F, WS_WF), MTOK, DMODEL, DMODEL}; pg8::StaticOrder S; S.init(MTOK, DMODEL, F.G, (int)blockIdx.x);
        pg8::EpiGateMid E{wsp<bf16>(F, WS_HB), wsp<bf16>(F, WS_SGA), wsp<bf16>(F, WS_SGB), DMODEL};
        pg8::gemm_phase<pg8::EpiGateMid, pg8::StaticOrder, true, true>(F.lds + RING_OFF, g, S, E, F.wave);
        REP_BAR(4); }
        if (BOTH(4)) GRID_BAR();
    }
    if (IN(5)) {
        pg8::Gemm g{wsp<bf16>(F, WS_HB), wsp<bf16>(F, WS_WO), MTOK, DMODEL, DMODEL}; pg8::StaticOrder S; S.init(MTOK, DMODEL, F.G, (int)blockIdx.x);
        pg8::EpiPlain<0> E{wsp<bf16>(F, WS_Y), DMODEL};
        REPS(5) { pg8::gemm_phase<pg8::EpiPlain<0>, pg8::StaticOrder, true, true>(F.lds + RING_OFF, g, S, E, F.wave); REP_BAR(5); }
        if (BOTH(5)) GRID_BAR();
    }
    if (IN(6)) { REPS(6) { row_pass<false>(F, F.x, nullptr, wsp<bf16>(F, WS_Y), F.g_mix_post, nullptr, wsp<bf16>(F, WS_HB), wsp<float>(F, WS_RSTD2)); REP_BAR(6); } if (BOTH(6)) GRID_BAR(); }
#ifndef MLP_CHUNKS
#define MLP_CHUNKS 1
#endif
    if (IN(7) || IN(8)) {
        constexpr int CH = MLP_CHUNKS, MC = MTOK / CH;
#pragma unroll
        for (int ch = 0; ch < CH; ++ch) {
            if (IN(7)) { XCD_STAGGER(STAGGER_P7);
                pg8::Gemm g{wsp<bf16>(F, WS_HB) + (size_t)ch * MC * DMODEL, wsp<bf16>(F, WS_WUP), MC, DFF, DMODEL}; pg8::StaticOrder S; S.init(MC, DFF, F.G, (int)blockIdx.x);
                pg8::EpiRelu2RsF8 E{wsp<unsigned char>(F, WS_U) + (size_t)ch * MC * DFF, wsp<float>(F, WS_RSTD2) + (size_t)ch * MC, DFF};
                REPS(7) { pg8::gemm_phase<pg8::EpiRelu2RsF8, pg8::StaticOrder, true, true>(F.lds + RING_OFF, g, S, E, F.wave); REP_BAR(7); }
                if (IN(8)) GRID_BAR(); }
            if (IN(8)) {
                pg8::Gemm g{(const pg8::bf16_t*)(wsp<unsigned char>(F, WS_U) + (size_t)ch * MC * DFF), (const pg8::bf16_t*)wsp<unsigned char>(F, WS_WDN), MC, DMODEL, DFF / 2}; pg8::StaticOrder S; S.init(MC, DMODEL, F.G, (int)blockIdx.x);
                pg8::EpiScaled E{wsp<bf16>(F, WS_Y) + (size_t)ch * MC * DMODEL, DMODEL, 1.f / WDN_SCALE};
                REPS(8) { pg8::gemm_phase<pg8::EpiScaled, pg8::StaticOrder, true, true, true>(F.lds + RING_OFF, g, S, E, F.wave); REP_BAR(8); }
                if (ch + 1 == CH && BOTH(8)) GRID_BAR(); }
        }
    }
    if (IN(9)) { row_pass<true>(F, nullptr, wsp<bf16>(F, WS_HB), wsp<bf16>(F, WS_Y), F.g_mlp_post, F.out, nullptr, nullptr); }
#undef IN
#undef BOTH
#undef GRID_BAR
}

extern "C" void kernel_launch(void* const* d_in, const int* in_sizes, int n_in, void* d_out, int out_size, void* d_ws, size_t ws_size, hipStream_t stream) {
    static int grid = 0;
    if (grid == 0) {
        if (n_in != 18 || in_sizes[0] != MTOK * DMODEL || out_size != MTOK * DMODEL || ws_size < WS_END) {
            fprintf(stderr, "kernel_launch: built for 18 inputs, x/out of %d floats, >= %zu bytes of workspace; got n_in %d, in0 %d, out %d, ws %zu; nothing launched\n", MTOK * DMODEL, (size_t)WS_END, n_in, n_in > 0 ? in_sizes[0] : -1, out_size, ws_size); grid = -1; return; }
        int dev = 0, cus = 0, per_cu = 0;
        if (hipGetDevice(&dev) != hipSuccess || hipDeviceGetAttribute(&cus, hipDeviceAttributeMultiprocessorCount, dev) != hipSuccess) { fprintf(stderr, "kernel_launch: device query failed\n"); grid = -1; return; }
        if (hipFuncSetAttribute((const void*)fwd_kernel, hipFuncAttributeMaxDynamicSharedMemorySize, LDS_BYTES) != hipSuccess) { fprintf(stderr, "kernel_launch: hipFuncSetAttribute failed\n"); grid = -1; return; }
        if (hipOccupancyMaxActiveBlocksPerMultiprocessor(&per_cu, (const void*)fwd_kernel, NWAVES * 64, LDS_BYTES) != hipSuccess || per_cu < 1)
            fprintf(stderr, "kernel_launch: note: occupancy query reports %d workgroups per CU\n", per_cu);
        (void)hipGetLastError();
        grid = 256;
        if (cus < grid) fprintf(stderr, "kernel_launch: this device reports %d CUs; the 256-workgroup grid cannot be resident: the grid barrier will time out (bounded) and the output will be wrong\n", cus);
    }
    if (grid < 0) return;
    if (hipMemsetAsync((char*)d_ws + WS_CTL, 0, CTL_ZERO_BYTES, stream) != hipSuccess) { fprintf(stderr, "kernel_launch: hipMemsetAsync failed\n"); return; }
    Args a{};
    for (int i = 0; i < 18; ++i) a.in[i] = (const float*)d_in[i];
    a.out = (float*)d_out; a.ws = (unsigned char*)d_ws;
    for (int li = 0; li < N_LAUNCHES; ++li) {
        a.ph_lo = (N_LAUNCHES == 1) ? 0 : li; a.ph_hi = (N_LAUNCHES == 1) ? N_PHASES : li + 1; a.li = li; a.pad = 0;
        hipLaunchKernelGGL(fwd_kernel, dim3(grid), dim3(NWAVES * 64), LDS_BYTES, stream, a);
        const hipError_t le = hipPeekAtLastError();
        if (le != hipSuccess) { fprintf(stderr, "kernel_launch: launch %d failed: %s\n", li, hipGetErrorName(le)); break; }
    }
}
```

```cpp
#include <hip/hip_runtime.h>
#include <cstdio>
#include <cstdint>
#include <cmath>
namespace pg8 {
#define PG8_LAS __attribute__((address_space(3)))
typedef unsigned short bf16_t;
typedef short bf16x8 __attribute__((ext_vector_type(8)));
typedef float f32x4 __attribute__((ext_vector_type(4)));
typedef unsigned u32x4 __attribute__((ext_vector_type(4)));
constexpr int BM = 256, BK = 64, HALF = 128, HTB = HALF * BK * 2  , STAGE_BYTES = 8 * HTB, NXCD = 8, WGM = 8;

__host__ __device__ __forceinline__ int lds_byte(int r, int c) { const int st = (r >> 4) * 2 + (c >> 5), rr = r & 15, cc = c & 31, ob = rr * 64 + cc * 2; return st * 1024 + (ob ^ (((ob >> 9) & 1) << 5)); }
__host__ __device__ __forceinline__ void stage_rc(int b, int& R, int& C) { const int st = b / 1024, sb = b % 1024, swz = sb ^ (((sb >> 9) & 1) << 5); R = (st >> 1) * 16 + swz / 64; C = (st & 1) * 32 + (swz % 64) / 2; }
__host__ __device__ __forceinline__ int perm32(int rho) { const int n = rho >> 4, i = rho & 15; return 8 * (i >> 2) + 4 * n + (i & 3); }

__host__ __device__ __forceinline__ int perm16(int R) { const int w = R >> 5, n = (R >> 4) & 1, i = R & 15; return 64 * w + 16 * (i >> 2) + 4 * n + (i & 3); }
struct Unit { int pm, pn; };
struct Gemm { const bf16_t* A; const bf16_t* Bt; int M, N, K; };

struct StaticOrder {
    int nM, nN, nwg, G, c;
    __host__ __device__ void init(int M, int N, int G_, int c_) { nM = M / BM; nN = N / BM; nwg = nM * nN; G = G_; c = c_; }
    __host__ __device__ bool next(int i, Unit& u) const {
        const long L = (long)i * G + c; if (L >= nwg) return false;
        int wgid = (int)L; { const int q = nwg / NXCD, r = nwg % NXCD, xcd = wgid % NXCD, off = wgid / NXCD; wgid = (xcd < r ? xcd * (q + 1) : r * (q + 1) + (xcd - r) * q) + off; }
        const int nig = WGM * nN, gid = wgid / nig, fm = gid * WGM, gsz = (nM - fm) < WGM ? (nM - fm) : WGM;
        u.pm = fm + ((wgid % nig) % gsz); u.pn = (wgid % nig) / gsz; return true;
    }
    __device__ __forceinline__ void a_ready(const Unit&) const {}
    __device__ __forceinline__ void done(const Unit&) const {}
};

__device__ __forceinline__ unsigned cvt_pk_bf16(float lo, float hi) { unsigned r; asm volatile("v_cvt_pk_bf16_f32 %0, %1, %2" : "=v"(r) : "v"(lo), "v"(hi)); return r; }
typedef float f32x2 __attribute__((ext_vector_type(2)));
typedef int i32x8 __attribute__((ext_vector_type(8)));
typedef int i32x4 __attribute__((ext_vector_type(4)));
__device__ __forceinline__ i32x8 cat8(const bf16x8& a, const bf16x8& b) { const i32x4 x = __builtin_bit_cast(i32x4, a), y = __builtin_bit_cast(i32x4, b); return __builtin_shufflevector(x, y, 0, 1, 2, 3, 4, 5, 6, 7); }
constexpr float F8_MAX = 448.f;
__device__ __forceinline__ unsigned cvt4_fp8(float a, float b, float c, float d) {
    int r = 0; r = __builtin_amdgcn_cvt_pk_fp8_f32(fminf(a, F8_MAX), fminf(b, F8_MAX), r, false); r = __builtin_amdgcn_cvt_pk_fp8_f32(fminf(c, F8_MAX), fminf(d, F8_MAX), r, true); return (unsigned)r; }
__device__ __forceinline__ void mfma_f8_inplace(f32x4& c, const i32x8 a, const i32x8 b) { asm volatile("v_mfma_f32_16x16x128_f8f6f4 %0, %1, %2, %0" : "+v"(c) : "v"(a), "v"(b)); }
__device__ __forceinline__ float bf_lo(unsigned w) { return __uint_as_float(w << 16); }
__device__ __forceinline__ float bf_hi(unsigned w) { return __uint_as_float(w & 0xffff0000u); }
__device__ __forceinline__ float sigmoid_f(float x) { return __builtin_amdgcn_rcpf(1.0f + __expf(-x)); }
typedef unsigned u32x2 __attribute__((ext_vector_type(2)));
__device__ __forceinline__ u32x4 pack8(const f32x4& a, const f32x4& b) { u32x4 w; w.x = cvt_pk_bf16(a[0], a[1]); w.y = cvt_pk_bf16(a[2], a[3]); w.z = cvt_pk_bf16(b[0], b[1]); w.w = cvt_pk_bf16(b[2], b[3]); return w; }
__device__ __forceinline__ u32x2 pack4(const f32x4& a) { u32x2 w; w.x = cvt_pk_bf16(a[0], a[1]); w.y = cvt_pk_bf16(a[2], a[3]); return w; }

struct EpiInProj {
    static constexpr bool PERM = true, PERM16 = false, AFTER_DRAIN = false, MIDK = false;
    bf16_t *QKV, *NQ, *KVB, *SG;
    float *LF, *GATE; const float* bforget; const float *ROPEC, *ROPES; size_t qkvs, kvs, sgs; float qscale;
    __device__ __forceinline__ void operator()(const f32x4 (&acc)[2][2][4][2], const Unit& u, int wr, int wc, int fr, int fq) const {
        const int pn = u.pn; const bool roped = pn >= 6 && pn < 11; const int i4 = (4 * (wc & 1) + fq) * 4;
#pragma unroll
        for (int ai = 0; ai < 2; ++ai) {
#pragma unroll
          for (int mp = 0; mp < 2; ++mp) {
            f32x4 csv[8];
            if (roped) {
#pragma unroll
                for (int mm = 0; mm < 2; ++mm) { const int t_ = (u.pm * BM + ai * HALF + wr * 64 + (2 * mp + mm) * 16 + fr) & 2047; csv[mm] = *(const f32x4*)(ROPEC + t_ * 32 + i4); csv[4 + mm] = *(const f32x4*)(ROPES + t_ * 32 + i4); }
                asm volatile("" : "+v"(csv[0]), "+v"(csv[1]), "+v"(csv[4]), "+v"(csv[5])); }
#pragma unroll
            for (int mm = 0; mm < 2; ++mm) { const int m = 2 * mp + mm;
                const int row = u.pm * BM + ai * HALF + wr * 64 + m * 16 + fr; const int t = row & 2047, b = row >> 11; (void)t;
#pragma unroll
                for (int bj = 0; bj < 2; ++bj) {
                    const int tc = bj * HALF + wc * 32 + 8 * fq;
                    f32x4 v0 = acc[ai][bj][m][0], v1 = acc[ai][bj][m][1];
                    if (pn < 6) {
                        bf16_t* base = QKV + (size_t)(pn >> 1) * qkvs; const float sc = pn < 2 ? qscale : 1.0f;
                        *(u32x4*)(base + (size_t)row * 512 + (pn & 1) * 256 + tc) = pack8(v0 * sc, v1 * sc);
                    } else if (pn < 8) {
                        const int head = (pn - 6) * 4 + (tc >> 6);
                        const f32x4 cs = csv[mm], sn = csv[4 + mm];
                        const f32x4 lo = (v0 * cs - v1 * sn) * qscale, hi = (v1 * cs + v0 * sn) * qscale;
                        bf16_t* d = NQ + (size_t)row * 512 + head * 64 + i4;
                        *(u32x2*)d = pack4(lo); *(u32x2*)(d + 32) = pack4(hi);
                    } else if (pn < 11) {
                        const int sel = pn - 8;
                        if (bj == 0) {
                            const int g = tc >> 6;
                            const f32x4 cs = csv[mm], sn = csv[4 + mm];
                            const f32x4 lo = v0 * cs - v1 * sn, hi = v1 * cs + v0 * sn;
                            bf16_t* d = KVB + (size_t)(2 * sel) * kvs + ((size_t)((b * 2 + g) * 2048 + t)) * 64 + i4;
                            *(u32x2*)d = pack4(lo); *(u32x2*)(d + 32) = pack4(hi);
                        } else {
                            const int tv = tc - HALF, g = tv >> 6, dd = tv & 63;
                            bf16_t* d = KVB + (size_t)(2 * sel + 1) * kvs + ((size_t)((b * 2 + g) * 2048 + t)) * 64 + dd;
                            *(u32x4*)d = pack8(v0, v1);
                        }
                    } else if (pn < 19) {
                        if (bj == 0) { const int ct = (pn - 11) * 128 + wc * 32 + 8 * fq; const f32x4 w0 = acc[ai][1][m][0], w1 = acc[ai][1][m][1];
                            f32x4 a, c, ra, rc;
#pragma unroll
                            for (int k = 0; k < 4; ++k) { const float ea = __expf(-v0[k]), ec = __expf(-v1[k]), fa = __expf(-w0[k]), fc = __expf(-w1[k]);
                                a[k] = __builtin_amdgcn_rcpf(1.0f + ea); c[k] = __builtin_amdgcn_rcpf(1.0f + ec); ra[k] = (1.0f + ea) * __builtin_amdgcn_rcpf(1.0f + fa); rc[k] = (1.0f + ec) * __builtin_amdgcn_rcpf(1.0f + fc); }
                            __builtin_nontemporal_store(pack8(a, c), (u32x4*)(SG + (size_t)row * 1024 + ct)); __builtin_nontemporal_store(pack8(ra, rc), (u32x4*)(SG + sgs + (size_t)row * 1024 + ct)); }
                    } else {
                        if (bj == 0 && wc == 0) {
                            if (fq == 0) {
                                f32x4 a, c;
#pragma unroll
                                for (int k = 0; k < 4; ++k) { const float x0 = v0[k] + bforget[k], x1 = v1[k] + bforget[4 + k];
                                    a[k] = fminf(x0, 0.f) - log1pf(__expf(-fabsf(x0))); c[k] = fminf(x1, 0.f) - log1pf(__expf(-fabsf(x1))); }
                                *(f32x4*)(LF + (size_t)row * 8) = a; *(f32x4*)(LF + (size_t)row * 8 + 4) = c;
                            } else {
                                f32x4 a, c;
#pragma unroll
                                for (int k = 0; k < 4; ++k) { a[k] = sigmoid_f(v0[k]); c[k] = sigmoid_f(v1[k]); }
                                *(f32x4*)(GATE + (size_t)row * 24 + 8 * (fq - 1)) = a; *(f32x4*)(GATE + (size_t)row * 24 + 8 * (fq - 1) + 4) = c;
                            }
                        }
                    }
                }
            }
          }
        }
    }
};
#define PIN8(a) asm volatile("" : "+v"(a[0]), "+v"(a[1]), "+v"(a[2]), "+v"(a[3]), "+v"(a[4]), "+v"(a[5]), "+v"(a[6]), "+v"(a[7]))
struct EpiGate {
    static constexpr bool PERM = true, PERM16 = false, AFTER_DRAIN = false, MIDK = false;
    bf16_t* O; const bf16_t* gate; const bf16_t* addend; int ldc;
    __device__ __forceinline__ void operator()(const f32x4 (&acc)[2][2][4][2], const Unit& u, int wr, int wc, int fr, int fq) const {
#pragma unroll
        for (int ai = 0; ai < 2; ++ai) {
            const size_t base = (size_t)(u.pm * BM + ai * HALF + wr * 64 + fr) * ldc + u.pn * BM + wc * 32 + 8 * fq;
            u32x4 gw[8], aw[8];
#pragma unroll
            for (int k = 0; k < 8; ++k) gw[k] = *(const u32x4*)(gate + base + (size_t)((k >> 1) * 16) * ldc + (k & 1) * HALF);
            PIN8(gw);
            if (addend) {
#pragma unroll
                for (int k = 0; k < 8; ++k) aw[k] = *(const u32x4*)(addend + base + (size_t)((k >> 1) * 16) * ldc + (k & 1) * HALF);
                PIN8(aw); }
#pragma unroll
            for (int k = 0; k < 8; ++k) { const int m = k >> 1, bj = k & 1; const u32x4 g = gw[k];
                f32x4 v0 = acc[ai][bj][m][0], v1 = acc[ai][bj][m][1];
                v0[0] *= bf_lo(g.x); v0[1] *= bf_hi(g.x); v0[2] *= bf_lo(g.y); v0[3] *= bf_hi(g.y);
                v1[0] *= bf_lo(g.z); v1[1] *= bf_hi(g.z); v1[2] *= bf_lo(g.w); v1[3] *= bf_hi(g.w);
                if (addend) { const u32x4 a = aw[k];
                    v0[0] += bf_lo(a.x); v0[1] += bf_hi(a.x); v0[2] += bf_lo(a.y); v0[3] += bf_hi(a.y);
                    v1[0] += bf_lo(a.z); v1[1] += bf_hi(a.z); v1[2] += bf_lo(a.w); v1[3] += bf_hi(a.w); }
                *(u32x4*)(O + base + (size_t)(m * 16) * ldc + bj * HALF) = pack8(v0, v1); }
        }
    }
};
struct EpiGateMid {
    static constexpr bool PERM = true, PERM16 = false, AFTER_DRAIN = false, MIDK = true;
    bf16_t* O; const bf16_t* sga; const bf16_t* rr; int ldc;
    __device__ __forceinline__ void scale(f32x4 (&acc)[2][2][4][2], const bf16_t* g, const Unit& u, int wr, int wc, int fr, int fq, bf16_t* out) const {
#pragma unroll
        for (int ai = 0; ai < 2; ++ai) {
            const size_t base = (size_t)(u.pm * BM + ai * HALF + wr * 64 + fr) * ldc + u.pn * BM + wc * 32 + 8 * fq;
            u32x4 gw[8];
#pragma unroll
            for (int k = 0; k < 8; ++k) gw[k] = *(const u32x4*)(g + base + (size_t)((k >> 1) * 16) * ldc + (k & 1) * HALF);
            PIN8(gw);
#pragma unroll
            for (int k = 0; k < 8; ++k) { const int m = k >> 1, bj = k & 1; const u32x4 w = gw[k];
                f32x4& v0 = acc[ai][bj][m][0]; f32x4& v1 = acc[ai][bj][m][1];
                v0[0] *= bf_lo(w.x); v0[1] *= bf_hi(w.x); v0[2] *= bf_lo(w.y); v0[3] *= bf_hi(w.y);
                v1[0] *= bf_lo(w.z); v1[1] *= bf_hi(w.z); v1[2] *= bf_lo(w.w); v1[3] *= bf_hi(w.w);
                if (out) *(u32x4*)(out + base + (size_t)(m * 16) * ldc + bj * HALF) = pack8(v0, v1); }
        }
    }
    __device__ __forceinline__ void mid(f32x4 (&acc)[2][2][4][2], const Unit& u, int wr, int wc, int fr, int fq) const { int fr_ = fr; asm volatile("" : "+v"(fr_));
        scale(acc, rr, u, wr, wc, fr_, fq, nullptr); }
    __device__ __forceinline__ void operator()(const f32x4 (&acc)[2][2][4][2], const Unit& u, int wr, int wc, int fr, int fq) const {
#pragma unroll
        for (int ai = 0; ai < 2; ++ai) {
            const size_t base = (size_t)(u.pm * BM + ai * HALF + wr * 64 + fr) * ldc + u.pn * BM + wc * 32 + 8 * fq;
            u32x4 gw[8];
#pragma unroll
            for (int k = 0; k < 8; ++k) gw[k] = *(const u32x4*)(sga + base + (size_t)((k >> 1) * 16) * ldc + (k & 1) * HALF);
            PIN8(gw);
#pragma unroll
            for (int k = 0; k < 8; ++k) { const int m = k >> 1, bj = k & 1; const u32x4 w = gw[k];
                f32x4 v0 = acc[ai][bj][m][0], v1 = acc[ai][bj][m][1];
                v0[0] *= bf_lo(w.x); v0[1] *= bf_hi(w.x); v0[2] *= bf_lo(w.y); v0[3] *= bf_hi(w.y);
                v1[0] *= bf_lo(w.z); v1[1] *= bf_hi(w.z); v1[2] *= bf_lo(w.w); v1[3] *= bf_hi(w.w);
                *(u32x4*)(O + base + (size_t)(m * 16) * ldc + bj * HALF) = pack8(v0, v1); }
        }
    }
};
template <int ACT> struct EpiPlain {
    static constexpr bool PERM = true, PERM16 = false, AFTER_DRAIN = false, MIDK = false;
    bf16_t* O; int ldc;
    __device__ __forceinline__ void operator()(const f32x4 (&acc)[2][2][4][2], const Unit& u, int wr, int wc, int fr, int fq) const {
#pragma unroll
        for (int ai = 0; ai < 2; ++ai)
#pragma unroll
            for (int m = 0; m < 4; ++m) {
                const size_t rowo = (size_t)(u.pm * BM + ai * HALF + wr * 64 + m * 16 + fr) * ldc + u.pn * BM + wc * 32 + 8 * fq;
#pragma unroll
                for (int bj = 0; bj < 2; ++bj) {
                    f32x4 v0 = acc[ai][bj][m][0], v1 = acc[ai][bj][m][1];
                    if (ACT == 1) {
#pragma unroll
                        for (int k = 0; k < 4; ++k) { const float a = fmaxf(v0[k], 0.f), c = fmaxf(v1[k], 0.f); v0[k] = a * a; v1[k] = c * c; }
                    }
                    *(u32x4*)(O + rowo + bj * HALF) = pack8(v0, v1);
                }
            }
    }
};

struct EpiRelu2Rs {
    static constexpr bool PERM = true, PERM16 = false, AFTER_DRAIN = false, MIDK = false;
    bf16_t* O; const float* rs; int ldc;
    __device__ __forceinline__ void operator()(const f32x4 (&acc)[2][2][4][2], const Unit& u, int wr, int wc, int fr, int fq) const {
        float rv[8];
#pragma unroll
        for (int k = 0; k < 8; ++k) rv[k] = rs[u.pm * BM + (k >> 2) * HALF + wr * 64 + (k & 3) * 16 + fr];
        PIN8(rv);
#pragma unroll
        for (int ai = 0; ai < 2; ++ai)
#pragma unroll
            for (int m = 0; m < 4; ++m) { const float r = rv[ai * 4 + m];
                const size_t rowo = (size_t)(u.pm * BM + ai * HALF + wr * 64 + m * 16 + fr) * ldc + u.pn * BM + wc * 32 + 8 * fq;
#pragma unroll
                for (int bj = 0; bj < 2; ++bj) { f32x4 v0 = acc[ai][bj][m][0], v1 = acc[ai][bj][m][1];
#pragma unroll
                    for (int k = 0; k < 4; ++k) { const float a = fmaxf(v0[k] * r, 0.f), c = fmaxf(v1[k] * r, 0.f); v0[k] = a * a; v1[k] = c * c; }
                    __builtin_nontemporal_store(pack8(v0, v1), (u32x4*)(O + rowo + bj * HALF)); } }
    }
};

struct EpiRelu2RsF8 {
    static constexpr bool PERM = true, PERM16 = true, AFTER_DRAIN = false, MIDK = false;
    unsigned char* O; const float* rs; int ldc;
    __device__ __forceinline__ void operator()(const f32x4 (&acc)[2][2][4][2], const Unit& u, int wr, int wc, int fr, int fq) const {
        float rv[8];
#pragma unroll
        for (int k = 0; k < 8; ++k) rv[k] = rs[u.pm * BM + (k >> 2) * HALF + wr * 64 + (k & 3) * 16 + fr];
        PIN8(rv);
#pragma unroll
        for (int ai = 0; ai < 2; ++ai)
#pragma unroll
            for (int m = 0; m < 4; ++m) { const float r = rv[ai * 4 + m];
                const size_t rowo = (size_t)(u.pm * BM + ai * HALF + wr * 64 + m * 16 + fr) * ldc + u.pn * BM + wc * 64 + 16 * fq;
                u32x4 o;
#pragma unroll
                for (int bj = 0; bj < 2; ++bj) { f32x4 v0 = acc[ai][bj][m][0], v1 = acc[ai][bj][m][1];
#pragma unroll
                    for (int k = 0; k < 4; ++k) { const float a = fmaxf(v0[k] * r, 0.f), c = fmaxf(v1[k] * r, 0.f); v0[k] = a * a; v1[k] = c * c; }
                    o[2 * bj] = cvt4_fp8(v0[0], v0[1], v0[2], v0[3]); o[2 * bj + 1] = cvt4_fp8(v1[0], v1[1], v1[2], v1[3]); }
                __builtin_nontemporal_store(o, (u32x4*)(O + rowo)); }
    }
};
struct EpiScaled {
    static constexpr bool PERM = true, PERM16 = false, AFTER_DRAIN = false, MIDK = false;
    bf16_t* O; int ldc; float sc;
    __device__ __forceinline__ void operator()(const f32x4 (&acc)[2][2][4][2], const Unit& u, int wr, int wc, int fr, int fq) const {
#pragma unroll
        for (int ai = 0; ai < 2; ++ai)
#pragma unroll
            for (int m = 0; m < 4; ++m) {
                const size_t rowo = (size_t)(u.pm * BM + ai * HALF + wr * 64 + m * 16 + fr) * ldc + u.pn * BM + wc * 32 + 8 * fq;
#pragma unroll
                for (int bj = 0; bj < 2; ++bj) *(u32x4*)(O + rowo + bj * HALF) = pack8(acc[ai][bj][m][0] * sc, acc[ai][bj][m][1] * sc);
            }
    }
};
template <class Epi, class Sched, bool ALIGN_EPI = false, bool SP2 = false, bool F8 = false>
__device__ __forceinline__ void gemm_phase(PG8_LAS unsigned char* lds, const Gemm g, const Sched& S, const Epi& E, const int wave_id  ) {
    int tid_ = wave_id * 64 + (int)__builtin_amdgcn_mbcnt_hi(~0u, __builtin_amdgcn_mbcnt_lo(~0u, 0u)); asm volatile("" : "+v"(tid_));
    const int tid = tid_, wid = __builtin_amdgcn_readfirstlane(tid >> 6), lane = tid & 63, wr = wid >> 2, wc = wid & 3, fr = lane & 15, fq = lane >> 4;
    const int K = g.K, nt = K / BK;
    unsigned voffA[2], voffB[2];
#pragma unroll
    for (int i = 0; i < 2; ++i) { int R, C; stage_rc(tid * 16 + i * 8192, R, C); const int Rb = Epi::PERM16 ? perm16(R) : Epi::PERM ? ((R & ~31) + perm32(R & 31)) : R;
        voffA[i] = (unsigned)(R * K + C) * 2u; voffB[i] = (unsigned)(Rb * K + C) * 2u; }
    const size_t kstep = (size_t)(BK * 2);
    const size_t hstep = (size_t)HALF * K * 2;
    const size_t bhstep = Epi::PERM16 ? (size_t)8 * K * 2 : hstep;
    const size_t tstep = 2 * hstep;
    const unsigned ldsw = (unsigned)wid * 1024u;
    const int aoff = lds_byte(wr * 64 + fr, fq * 8), boff = lds_byte(wc * 32 + fr, fq * 8);
#define PG8_SA(b, h) (((b) * 2 + (h)) * HTB)
#define PG8_SB(b, h) ((4 + (b) * 2 + (h)) * HTB)
#define PG8_STAGE(bufoff, gbase, voff) do { _Pragma("unroll") for (int _i = 0; _i < 2; ++_i) \
        __builtin_amdgcn_global_load_lds((const unsigned*)((const char*)(gbase) + (voff)[_i]), (PG8_LAS unsigned*)(lds + (bufoff) + ldsw + _i * 8192), 16, 0, 0); } while (0)
#define PG8_LDA(dst, b, h) do { _Pragma("unroll") for (int m = 0; m < 4; ++m) _Pragma("unroll") for (int k = 0; k < 2; ++k) dst[m][k] = *(const PG8_LAS bf16x8*)(lds + PG8_SA(b, h) + aoff + m * 2048 + k * 1024); } while (0)
#define PG8_LDB(dst, b, h) do { _Pragma("unroll") for (int n = 0; n < 2; ++n) _Pragma("unroll") for (int k = 0; k < 2; ++k) dst[n][k] = *(const PG8_LAS bf16x8*)(lds + PG8_SB(b, h) + boff + n * 2048 + k * 1024); } while (0)
#define PG8_MMA(ai, bj, At, Bt) do { __builtin_amdgcn_s_setprio(1); _Pragma("unroll") for (int m = 0; m < 4; ++m) _Pragma("unroll") for (int n = 0; n < 2; ++n) { \
        if constexpr (F8) mfma_f8_inplace(acc[ai][bj][m][n], cat8(Bt[n][0], Bt[n][1]), cat8(At[m][0], At[m][1])); \
        else { _Pragma("unroll") for (int k = 0; k < 2; ++k) acc[ai][bj][m][n] = __builtin_amdgcn_mfma_f32_16x16x32_bf16(Bt[n][k], At[m][k], acc[ai][bj][m][n], 0, 0, 0); } } __builtin_amdgcn_s_setprio(0); } while (0)
#define PG8_WAIT_V(n) asm volatile("s_waitcnt vmcnt(" #n ")" ::: "memory")
#define PG8_WAIT_L(n) asm volatile("s_waitcnt lgkmcnt(" #n ")" ::: "memory")
#define PG8_BAR __builtin_amdgcn_s_barrier()
#define PG8_SCHED __builtin_amdgcn_sched_barrier(0)
    Unit cur, nxt; int ui = 0;
    if (!S.next(0, cur)) return;
    f32x4 acc[2][2][4][2];
#pragma unroll
    for (int a = 0; a < 2; ++a)
#pragma unroll
        for (int b = 0; b < 2; ++b)
#pragma unroll
            for (int m = 0; m < 4; ++m)
#pragma unroll
                for (int n = 0; n < 2; ++n) acc[a][b][m][n] = (f32x4){0.f, 0.f, 0.f, 0.f};
    bf16x8 At[4][2], B0[2][2], B1[2][2];
    const char* cA = (const char*)g.A + (size_t)cur.pm * tstep; const char* cB = (const char*)g.Bt + (size_t)cur.pn * tstep;
    S.a_ready(cur);
    if constexpr (SP2) {
        PG8_STAGE(PG8_SB(0, 0), cB, voffB); PG8_STAGE(PG8_SB(0, 1), cB + bhstep, voffB); PG8_STAGE(PG8_SA(0, 0), cA, voffA); PG8_STAGE(PG8_SA(0, 1), cA + hstep, voffA);
        if (wr == 1) PG8_BAR;
        PG8_WAIT_V(2); PG8_BAR;
        PG8_STAGE(PG8_SB(1, 0), cB + kstep, voffB); PG8_STAGE(PG8_SA(1, 0), cA + kstep, voffA); PG8_STAGE(PG8_SB(1, 1), cB + bhstep + kstep, voffB);
        PG8_WAIT_V(6); PG8_BAR;
    } else {
        PG8_STAGE(PG8_SB(0, 0), cB, voffB); PG8_STAGE(PG8_SA(0, 0), cA, voffA); PG8_STAGE(PG8_SB(0, 1), cB + bhstep, voffB); PG8_STAGE(PG8_SA(0, 1), cA + hstep, voffA);
        if (wr == 1) PG8_BAR;
        PG8_WAIT_V(4); PG8_BAR;
        PG8_STAGE(PG8_SB(1, 0), cB + kstep, voffB); PG8_STAGE(PG8_SA(1, 0), cA + kstep, voffA); PG8_STAGE(PG8_SB(1, 1), cB + bhstep + kstep, voffB);
        PG8_WAIT_V(6); PG8_BAR;
    }
    for (;;) {
        const bool has_next = S.next(ui + 1, nxt);
        const char* nA = has_next ? (const char*)g.A + (size_t)nxt.pm * tstep : cA; const char* nB = has_next ? (const char*)g.Bt + (size_t)nxt.pn * tstep : cB;
        for (int t = 0; t < nt; t += 2) {
            if constexpr (Epi::MIDK) { if (t == nt / 2) E.mid(acc, cur, wr, wc, fr, fq); }
            const bool last = (t == nt - 2);
            const char* a1 = cA + (size_t)(t + 1) * kstep;
            const char* a2 = last ? nA : cA + (size_t)(t + 2) * kstep; const char* b2 = last ? nB : cB + (size_t)(t + 2) * kstep;
            const char* a3 = a2 + kstep; const char* b3 = b2 + kstep;
            if (last && has_next) S.a_ready(nxt);
            if constexpr (SP2) {
            PG8_LDB(B0, 0, 0); PG8_LDB(B1, 0, 1); PG8_SCHED; PG8_LDA(At, 0, 0); PG8_STAGE(PG8_SA(1, 1), a1 + hstep, voffA);
            PG8_WAIT_V(8); PG8_WAIT_L(0); PG8_BAR; PG8_MMA(0, 0, At, B0); PG8_MMA(0, 1, At, B1); PG8_BAR; PG8_SCHED;
            PG8_LDA(At, 0, 1); PG8_STAGE(PG8_SB(0, 0), b2, voffB); PG8_STAGE(PG8_SB(0, 1), b2 + bhstep, voffB); PG8_STAGE(PG8_SA(0, 0), a2, voffA);
            PG8_WAIT_V(8); PG8_WAIT_L(0); PG8_BAR; PG8_MMA(1, 0, At, B0); PG8_MMA(1, 1, At, B1); PG8_BAR; PG8_SCHED;
            PG8_LDB(B0, 1, 0); PG8_LDB(B1, 1, 1); PG8_SCHED; PG8_LDA(At, 1, 0); PG8_STAGE(PG8_SA(0, 1), a2 + hstep, voffA);
            PG8_WAIT_V(8); PG8_WAIT_L(0); PG8_BAR; PG8_MMA(0, 0, At, B0); PG8_MMA(0, 1, At, B1); PG8_BAR; PG8_SCHED;
            PG8_LDA(At, 1, 1); PG8_STAGE(PG8_SB(1, 0), b3, voffB); PG8_STAGE(PG8_SB(1, 1), b3 + bhstep, voffB); PG8_STAGE(PG8_SA(1, 0), a3, voffA);
            PG8_WAIT_V(8); PG8_WAIT_L(0); PG8_BAR; PG8_MMA(1, 0, At, B0); PG8_MMA(1, 1, At, B1); PG8_BAR; PG8_SCHED;
            } else {
            PG8_LDB(B0, 0, 0); PG8_SCHED; PG8_LDA(At, 0, 0); PG8_STAGE(PG8_SA(1, 1), a1 + hstep, voffA);
            PG8_WAIT_L(8); PG8_BAR; PG8_WAIT_L(0); PG8_MMA(0, 0, At, B0); PG8_BAR; PG8_SCHED;
            PG8_LDB(B1, 0, 1); PG8_STAGE(PG8_SB(0, 0), b2, voffB);
            PG8_BAR; PG8_WAIT_L(0); PG8_MMA(0, 1, At, B1); PG8_BAR;
            PG8_LDA(At, 0, 1); PG8_STAGE(PG8_SA(0, 0), a2, voffA);
            PG8_BAR; PG8_WAIT_L(0); PG8_MMA(1, 0, At, B0); PG8_BAR; PG8_SCHED;
            PG8_STAGE(PG8_SB(0, 1), b2 + bhstep, voffB);
            PG8_WAIT_V(6); PG8_BAR; PG8_MMA(1, 1, At, B1); PG8_BAR;
            PG8_LDB(B0, 1, 0); PG8_SCHED; PG8_LDA(At, 1, 0); PG8_STAGE(PG8_SA(0, 1), a2 + hstep, voffA);
            PG8_WAIT_L(8); PG8_BAR; PG8_WAIT_L(0); PG8_MMA(0, 0, At, B0); PG8_BAR; PG8_SCHED;
            PG8_LDB(B1, 1, 1); PG8_STAGE(PG8_SB(1, 0), b3, voffB);
            PG8_BAR; PG8_WAIT_L(0); PG8_MMA(0, 1, At, B1); PG8_BAR;
            PG8_LDA(At, 1, 1); PG8_STAGE(PG8_SA(1, 0), a3, voffA);
            PG8_BAR; PG8_WAIT_L(0); PG8_MMA(1, 0, At, B0); PG8_BAR; PG8_SCHED;
            PG8_STAGE(PG8_SB(1, 1), b3 + bhstep, voffB);
            PG8_WAIT_V(6); PG8_BAR; PG8_MMA(1, 1, At, B1); PG8_BAR;
            }
        }
        if constexpr (F8) asm volatile("s_nop 15\n\ts_nop 15" ::: "memory");
        if constexpr (ALIGN_EPI) { if (wr == 0) PG8_BAR; }
        if constexpr (!Epi::AFTER_DRAIN) { E(acc, cur, wr, wc, fr, fq); S.done(cur); }
        if (!has_next) break;
#pragma unroll
        for (int a = 0; a < 2; ++a)
#pragma unroll
            for (int b = 0; b < 2; ++b)
#pragma unroll
                for (int m = 0; m < 4; ++m)
#pragma unroll
                    for (int n = 0; n < 2; ++n) acc[a][b][m][n] = (f32x4){0.f, 0.f, 0.f, 0.f};
        cur = nxt; cA = nA; cB = nB; ++ui;
        if constexpr (ALIGN_EPI) { if (wr == 1) PG8_BAR; }
    }
    PG8_WAIT_V(0);
    if constexpr (!ALIGN_EPI) { if (wr == 0) PG8_BAR; }
    PG8_BAR;
    if constexpr (Epi::AFTER_DRAIN) { E.fused(acc, cur, wr, wc, fr, fq, lds, wid, lane); S.done(cur); }
#undef PG8_SA
#undef PG8_SB
#undef PG8_STAGE
#undef PG8_LDA
#undef PG8_LDB
#undef PG8_MMA
#undef PG8_WAIT_V
#undef PG8_WAIT_L
#undef PG8_BAR
#undef PG8_SCHED
}
}
#define GAS __attribute__((address_space(1)))
#define LAS __attribute__((address_space(3)))
typedef unsigned short bf16;
typedef unsigned v4u __attribute__((ext_vector_type(4)));
typedef float f32x4 __attribute__((ext_vector_type(4)));
typedef short bf16x8 __attribute__((ext_vector_type(8)));
typedef GAS unsigned gu32;
typedef GAS unsigned long long gu64;
#define RLX_AGENT __ATOMIC_RELAXED, __HIP_MEMORY_SCOPE_AGENT
#define LDS_WAIT() asm volatile("s_waitcnt lgkmcnt(0)" ::: "memory")
#define VM_WAIT() asm volatile("s_waitcnt vmcnt(0)" ::: "memory")
__device__ __forceinline__ unsigned long long rt() { return __builtin_amdgcn_s_memrealtime(); }
__device__ __forceinline__ unsigned f2bf(float f) { unsigned u = __builtin_bit_cast(unsigned, f); return (u + 0x7fffu + ((u >> 16) & 1u)) >> 16; }
__device__ __forceinline__ unsigned pk2(float lo, float hi) { return f2bf(lo) | (f2bf(hi) << 16); }

#define XB_TMO      128
#define XB_XCNT(j)  (256  + 64 * (j))
#define XB_XSUB(j)  (1280 + 64 * (j))
#define XB_XGEN(j)  (2304 + 64 * (j))
#define XB_TOP      3328
#define XB_TOPGEN   3392
#define XCD_BAR_WORDS 3456
#define XB_SPIN_CAP (1u << 18)

__device__ __forceinline__ unsigned xb_ld(unsigned* p)              { return __hip_atomic_load(p, __ATOMIC_RELAXED, __HIP_MEMORY_SCOPE_AGENT); }
__device__ __forceinline__ unsigned xb_add(unsigned* p, unsigned v) { return __hip_atomic_fetch_add(p, v, __ATOMIC_RELAXED, __HIP_MEMORY_SCOPE_AGENT); }
__device__ __forceinline__ unsigned xb_xcc_id() { return (unsigned)__builtin_amdgcn_s_getreg((3 << 11) | 20) & 0xFu; }
#define XB_SPIN(cond, bar) do { unsigned _sp = 0; while (cond) { __builtin_amdgcn_s_sleep(1); \
    if ((++_sp & 255u) == 0u) { if (xb_ld(&(bar)[XB_TMO])) break; if (_sp > XB_SPIN_CAP) { atomicAdd(&(bar)[XB_TMO], 1u); break; } } } } while (0)

struct XcdBarrier {
    unsigned* bar; unsigned x;
    volatile LAS unsigned* st;
};

__device__ __forceinline__ XcdBarrier xcd_barrier_post(unsigned* bar, volatile LAS unsigned* st) {
    XcdBarrier b; b.bar = bar; b.x = xb_xcc_id(); b.st = st;
    if (threadIdx.x == 0) (void)xb_add(&bar[XB_XCNT(b.x)], 1u);
    return b;
}
__device__ __forceinline__ void xcd_barrier_complete(unsigned* bar, unsigned x, unsigned& nloc, unsigned& nx) {
    const unsigned G = gridDim.x * gridDim.y * gridDim.z;
    unsigned sum, cnt, mine, sp = 0u;
    for (;;) {
        sum = 0u; cnt = 0u; mine = 0u;
#pragma unroll
        for (unsigned j = 0; j < 16; ++j) { const unsigned c = xb_ld(&bar[XB_XCNT(j)]); sum += c; cnt += (c > 0u) ? 1u : 0u; mine = (j == x) ? c : mine; }
        if (sum == G) break;
        __builtin_amdgcn_s_sleep(1);
        if ((++sp & 255u) == 0u) { if (xb_ld(&bar[XB_TMO])) break; if (sp > XB_SPIN_CAP) { atomicAdd(&bar[XB_TMO], 1u); break; } }
    }
    nloc = mine > 0u ? mine : 1u; nx = cnt > 0u ? cnt : 1u;
}

__device__ __forceinline__ void xcd_barrier(const XcdBarrier& b) {
    asm volatile("s_waitcnt vmcnt(0)" ::: "memory");
    __syncthreads();
    if (threadIdx.x == 0) {
        unsigned* bar = b.bar;
        __builtin_amdgcn_s_waitcnt(0);
        unsigned nloc = b.st[0], nx = b.st[1];
        if (nloc == 0u) { xcd_barrier_complete(bar, b.x, nloc, nx); b.st[0] = nloc; b.st[1] = nx; }
        const unsigned old = xb_add(&bar[XB_XSUB(b.x)], 1u);
        const unsigned gen = old / nloc;
        if (old + 1u == (gen + 1u) * nloc) {
            __builtin_amdgcn_fence(__ATOMIC_RELEASE, "agent");
            asm volatile("s_waitcnt vmcnt(0)" ::: "memory");
            const unsigned og = xb_add(&bar[XB_TOP], 1u);
            const unsigned tg = og / nx;
            if (og + 1u == (tg + 1u) * nx) xb_add(&bar[XB_TOPGEN], 1u);
            else XB_SPIN(xb_ld(&bar[XB_TOPGEN]) == tg, bar);
            __builtin_amdgcn_fence(__ATOMIC_ACQUIRE, "agent");
            xb_add(&bar[XB_XGEN(b.x)], 1u);
            asm volatile("s_waitcnt vmcnt(0)" ::: "memory");
        } else {
            XB_SPIN(xb_ld(&bar[XB_XGEN(b.x)]) == gen, bar);
            __builtin_amdgcn_fence(__ATOMIC_ACQUIRE, "agent");
            asm volatile("s_waitcnt vmcnt(0)" ::: "memory");
        }
    }
    __syncthreads();
}

constexpr int NWAVES = 8;
constexpr int BATCH = 32, SEQ = 2048, DMODEL = 1024, MTOK = BATCH * SEQ, DFF = 4096, NPROJ = 5120, INCOLS = 4896;
constexpr float RMS_EPS = 1e-6f;
constexpr float QSCALE = 0.125f * 1.4426950408889634f;
constexpr float LOG2E = 1.4426950408889634f;
constexpr float WDN_SCALE = 256.f;
#ifndef MK_N_LAUNCHES
#define MK_N_LAUNCHES 1
#endif
constexpr int N_PHASES = 10;
constexpr int N_LAUNCHES = MK_N_LAUNCHES;
constexpr size_t MiB = 1u << 20, KiB = 1u << 10;
constexpr size_t WS_CTL = 0, CTL_ZERO_BYTES = 1 * MiB;
constexpr size_t WS_WIN = 2 * MiB, WS_WF = 12 * MiB, WS_WN = 13 * MiB, WS_WO = 14 * MiB, WS_WUP = 16 * MiB, WS_WDN = 24 * MiB;
constexpr size_t WS_W1K = 32 * MiB, WS_W1V = WS_W1K + 256 * KiB, WS_W2K = WS_W1V + 256 * KiB, WS_W2V = WS_W2K + 8 * KiB, WS_PBK = WS_W2V + 8 * KiB, WS_PBV = WS_PBK + 256;
constexpr size_t WS_KT0 = WS_PBV + 256;
constexpr size_t WS_RSTD2 = 46 * MiB;
constexpr size_t WS_ROPEC = 33 * MiB, WS_ROPES = WS_ROPEC + 256 * KiB;
constexpr size_t WS_KCMP = 34 * MiB, WS_VCMP = 35 * MiB, WS_C = 36 * MiB, WS_LF = 38 * MiB, WS_GATE = 40 * MiB;
constexpr size_t WS_HB = 48 * MiB;
constexpr size_t WS_FKX = 48 * MiB;
constexpr size_t WS_PROBE_O = 64 * MiB;
constexpr size_t WS_FQ = 176 * MiB, WS_FK = 240 * MiB, WS_FV = 304 * MiB, WS_NQ = 368 * MiB;
constexpr size_t WS_KV = 432 * MiB, KV_STRIDE = 16 * MiB;
constexpr size_t WS_SGA = 528 * MiB, WS_SGB = 656 * MiB;
constexpr size_t WS_Y = 784 * MiB;
constexpr size_t WS_ATT = WS_Y;
constexpr size_t WS_FOXO_UNUSED = WS_Y, WS_NSAO_UNUSED = WS_Y + 64 * MiB;
constexpr size_t WS_U = 176 * MiB;
constexpr size_t WS_END = 1024 * MiB;
static_assert(WS_FV - WS_FK == WS_FK - WS_FQ && WS_U + (size_t)MTOK * DFF * 2 <= WS_Y && WS_Y + (size_t)MTOK * 512 * 4 <= WS_END && WS_GATE + (size_t)MTOK * 24 * 4 <= WS_HB, "d_ws map");
constexpr int CW_TMO = 0, CW_CODE = 1, CW_BAR = 4096, CW_QUEUE = 16384;
constexpr int RING_OFF = 0, RING_BYTES = 131072;
constexpr int LDSCTL_OFF = RING_BYTES, MISC_OFF = LDSCTL_OFF + 320;
constexpr int LDS_BYTES = 147456;
static_assert(MISC_OFF + 128 <= LDS_BYTES, "LDS map");


typedef float f32x16 __attribute__((ext_vector_type(16)));
struct Frame {
    LAS unsigned char* lds;
    volatile LAS unsigned* MISC;
    gu32* ctl;
    int wave;
    int vcu, G;
    unsigned char* ws;
    const float* x; float* out;
    const float *g_mix_pre, *g_mix_post, *g_mlp_pre, *g_mlp_post, *w_in, *b_forget, *pos_k, *w1_k, *w2_k, *pos_v, *w1_v, *w2_v, *w_fox, *w_nsa, *w_o, *w_up, *w_down;
};
template <class T> __device__ __forceinline__ T* wsp(const Frame& F, size_t off) { return (T*)(F.ws + off); }
__device__ __forceinline__ int cur_lane() { return (int)__builtin_amdgcn_mbcnt_hi(~0u, __builtin_amdgcn_mbcnt_lo(~0u, 0u)); }
__device__ __forceinline__ int cur_tid(const Frame& F) { return F.wave * 64 + cur_lane(); }

__device__ __forceinline__ float wave_sum(float v) {
#pragma unroll
    for (int o = 1; o < 64; o <<= 1) v += __shfl_xor(v, o);
    return v;
}
__device__ __forceinline__ float bfl(unsigned w) { return __uint_as_float(w << 16); }
__device__ __forceinline__ float bfh(unsigned w) { return __uint_as_float(w & 0xffff0000u); }

__device__ __forceinline__ int rope_d(int w) { const int i = w >> 3, j = w & 7; return j < 4 ? 4 * i + j : 32 + 4 * i + (j - 4); }
__device__ __forceinline__ int in_src_col(int n) {
    if (n < 1536) return n;
    if (n < 2048) { const int l = n - 1536; return 1544 + (l & ~63) + rope_d(l & 63); }
    if (n < 2816) { const int s = (n - 2048) >> 8, l = (n - 2048) & 255; const int kb = 2056 + s * 256;
        return l < 128 ? kb + (l & ~63) + rope_d(l & 63) : kb + 128 + (l - 128); }
    if (n < 4864) { const int q = (n - 2816) >> 8, l = (n - 2816) & 255; return l < 128 ? 2848 + 128 * q + l : 3872 + 128 * q + (l - 128); }
    const int l = n - 4864; if (l < 8) return 1536 + l; if (l < 32) return 2824 + (l - 8); return -1;
}
template <class SrcCol>
__device__ __forceinline__ void p0_transpose_item(const float* W, int K, int Nsrc, bf16* WT, int nblk, LAS float* scr, int item, int lane, SrcCol srccol, const float* kgain = nullptr, int ldk = 0, int koff = 0) {
    const int kb = item / nblk, nb = item % nblk, k0 = 64 * kb, n0 = 32 * nb;
    const int sc = srccol(n0 + (lane & 31));
#pragma unroll 8
    for (int i = 0; i < 32; ++i) { const int kk = 2 * i + (lane >> 5); float w = sc >= 0 ? W[(size_t)(k0 + kk) * Nsrc + sc] : 0.f; if (kgain) w *= kgain[k0 + kk]; scr[kk * 33 + (lane & 31)] = w; }
    LDS_WAIT(); asm volatile("" ::: "memory");
    const int c = lane & 7;
#pragma unroll
    for (int j = 0; j < 4; ++j) { const int n = (lane >> 3) + 8 * j; const LAS float* s = scr + (8 * c) * 33 + n;
        v4u o; o.x = pk2(s[0 * 33], s[1 * 33]); o.y = pk2(s[2 * 33], s[3 * 33]); o.z = pk2(s[4 * 33], s[5 * 33]); o.w = pk2(s[6 * 33], s[7 * 33]);
        *(GAS v4u*)(WT + (size_t)(n0 + n) * (ldk ? ldk : K) + koff + k0 + 8 * c) = o; }
    LDS_WAIT(); asm volatile("" ::: "memory");
}
__device__ __forceinline__ void p0_transpose_item_f8(const float* W, int K, int N, unsigned char* WT, int nblk, LAS float* scr, int item, int lane, float scale) {
    const int kb = item / nblk, nb = item % nblk, k0 = 64 * kb, n0 = 32 * nb;
#pragma unroll 8
    for (int i = 0; i < 32; ++i) { const int kk = 2 * i + (lane >> 5); scr[kk * 33 + (lane & 31)] = W[(size_t)(k0 + kk) * N + n0 + (lane & 31)] * scale; }
    LDS_WAIT(); asm volatile("" ::: "memory");
    const int c = lane & 7;
#pragma unroll
    for (int j = 0; j < 4; ++j) { const int n = (lane >> 3) + 8 * j; const LAS float* s = scr + (8 * c) * 33 + n;
        pg8::f32x2 o; o.x = __builtin_bit_cast(float, pg8::cvt4_fp8(fmaxf(s[0 * 33], -pg8::F8_MAX), fmaxf(s[1 * 33], -pg8::F8_MAX), fmaxf(s[2 * 33], -pg8::F8_MAX), fmaxf(s[3 * 33], -pg8::F8_MAX)));
        o.y = __builtin_bit_cast(float, pg8::cvt4_fp8(fmaxf(s[4 * 33], -pg8::F8_MAX), fmaxf(s[5 * 33], -pg8::F8_MAX), fmaxf(s[6 * 33], -pg8::F8_MAX), fmaxf(s[7 * 33], -pg8::F8_MAX)));
        *(GAS pg8::f32x2*)(WT + (size_t)(n0 + n) * K + k0 + 8 * c) = o; }
    LDS_WAIT(); asm volatile("" ::: "memory");
}
__device__ __forceinline__ void rms_rows_to_bf16(int lane, int gw, int NGW, const float* X, const float* g, bf16* O) {
    constexpr int RP = 4;
    const GAS f32x4* gr = (const GAS f32x4*)g + lane; f32x4 gv[4];
#pragma unroll
    for (int j = 0; j < 4; ++j) gv[j] = gr[64 * j];
    for (int m0 = gw; m0 < MTOK; m0 += NGW * RP) {
        f32x4 v[RP][4];
#pragma unroll
        for (int r = 0; r < RP; ++r) { const GAS f32x4* xr = (const GAS f32x4*)(X + (size_t)(m0 + r * NGW) * DMODEL) + lane;
#pragma unroll
            for (int j = 0; j < 4; ++j) v[r][j] = __builtin_nontemporal_load(xr + 64 * j); }
#pragma unroll
        for (int r = 0; r < RP; ++r) { float s = 0.f;
#pragma unroll
            for (int j = 0; j < 4; ++j) s += (v[r][j].x * v[r][j].x + v[r][j].y * v[r][j].y) + (v[r][j].z * v[r][j].z + v[r][j].w * v[r][j].w);
            const float rr = 1.0f / sqrtf(wave_sum(s) * (1.f / DMODEL) + RMS_EPS);
            GAS unsigned long long* o8 = (GAS unsigned long long*)(O + (size_t)(m0 + r * NGW) * DMODEL) + lane;
#pragma unroll
            for (int j = 0; j < 4; ++j) { const f32x4 a = v[r][j], gg = gv[j];
                o8[64 * j] = (unsigned long long)pk2(a.x * rr * gg.x, a.y * rr * gg.y) | ((unsigned long long)pk2(a.z * rr * gg.z, a.w * rr * gg.w) << 32); } }
    }
}
__device__ __forceinline__ void p0_prologue(Frame& F) {
    LAS float* scr = (LAS float*)(F.lds + RING_OFF + F.wave * 16384);
    const int gw = F.vcu * NWAVES + F.wave, NGW = F.G * NWAVES, lane = cur_lane();
    constexpr int I_IN = 16 * (NPROJ / 32), I_F = 8 * 32, I_O = 16 * 32, I_UP = 16 * 128, I_DN = 64 * 32, I_W1 = 32 * 2, I_W2 = 1 * 2;
    constexpr int NITEMS = I_IN + 2 * I_F + I_O + I_UP + I_DN + 2 * I_W1 + 2 * I_W2;
    auto ident = [](int n) { return n; };
    for (int it = gw; it < NITEMS; it += NGW) {
        int r = it;
        if (r < I_IN) { p0_transpose_item(F.w_in, 1024, INCOLS, wsp<bf16>(F, WS_WIN), NPROJ / 32, scr, r, lane, [](int n) { return in_src_col(n); }); continue; } r -= I_IN;
        if (r < I_F) { p0_transpose_item(F.w_fox, 512, 1024, wsp<bf16>(F, WS_WF), 32, scr, r, lane, ident, nullptr, 1024, 512); continue; } r -= I_F;
        if (r < I_F) { p0_transpose_item(F.w_nsa, 512, 1024, wsp<bf16>(F, WS_WF), 32, scr, r, lane, ident, nullptr, 1024, 0); continue; } r -= I_F;
        if (r < I_O) { p0_transpose_item(F.w_o, 1024, 1024, wsp<bf16>(F, WS_WO), 32, scr, r, lane, ident); continue; } r -= I_O;
        if (r < I_UP) { p0_transpose_item(F.w_up, 1024, 4096, wsp<bf16>(F, WS_WUP), 128, scr, r, lane, ident, F.g_mlp_pre); continue; }     r -= I_UP;
        if (r < I_DN) { p0_transpose_item_f8(F.w_down, 4096, 1024, wsp<unsigned char>(F, WS_WDN), 32, scr, r, lane, WDN_SCALE); continue; } r -= I_DN;
        if (r < I_W1) { p0_transpose_item(F.w1_k, 2048, 64, wsp<bf16>(F, WS_W1K), 2, scr, r, lane, ident); continue; } r -= I_W1;
        if (r < I_W1) { p0_transpose_item(F.w1_v, 2048, 64, wsp<bf16>(F, WS_W1V), 2, scr, r, lane, ident); continue; } r -= I_W1;
        if (r < I_W2) { p0_transpose_item(F.w2_k, 64, 64, wsp<bf16>(F, WS_W2K), 2, scr, r, lane, ident); continue; } r -= I_W2;
        p0_transpose_item(F.w2_v, 64, 64, wsp<bf16>(F, WS_W2V), 2, scr, r, lane, ident);
    }
    { float* RC = wsp<float>(F, WS_ROPEC); float* RS = wsp<float>(F, WS_ROPES);
      for (int e = (F.vcu * NWAVES * 64 + cur_tid(F)); e < SEQ * 32; e += F.G * NWAVES * 64) { const int t = e >> 5, i = e & 31;
          const float inv = powf(10000.0f, -(float)(2 * i) / 64.0f); const float ang = (float)t * inv; RC[e] = cosf(ang); RS[e] = sinf(ang); } }
    if (F.wave == 0) for (int it = F.vcu; it < 128; it += F.G) { const int kv = it >> 6, c = it & 63; const float* pos = kv ? F.pos_v : F.pos_k; const float* w1 = kv ? F.w1_v : F.w1_k; float s = 0.f;
        for (int k = lane; k < 2048; k += 64) s += pos[k] * w1[(size_t)k * 64 + c];
        s = wave_sum(s); if (lane == 0) wsp<float>(F, kv ? WS_PBV : WS_PBK)[c] = s; }
    rms_rows_to_bf16(lane, gw, NGW, F.x, F.g_mix_pre, wsp<bf16>(F, WS_HB));
}

__device__ __forceinline__ int crow(int r, int hi) { return (r & 3) + 8 * (r >> 2) + 4 * hi; }
#define P2_PIN8(a) asm volatile("" : "+v"(a[0]), "+v"(a[1]), "+v"(a[2]), "+v"(a[3]), "+v"(a[4]), "+v"(a[5]), "+v"(a[6]), "+v"(a[7]))
__device__ __forceinline__ void p2_compress_unit(Frame& F, int unit) {
    const int bg = unit >> 2, kv = (unit >> 1) & 1, half = unit & 1, lane = cur_lane(), w = F.wave;
    const bf16* X = wsp<bf16>(F, WS_KV + (size_t)kv * KV_STRIDE) + (size_t)bg * SEQ * 64;
    const bf16* W1t = wsp<bf16>(F, kv ? WS_W1V : WS_W1K); const bf16* W2t = wsp<bf16>(F, kv ? WS_W2V : WS_W2K); const float* PB = wsp<float>(F, kv ? WS_PBV : WS_PBK);
    bf16* OUT = wsp<bf16>(F, kv ? WS_VCMP : WS_KCMP) + (size_t)bg * 128 * 64;
    const int rt = w & 1, ct = (w >> 1) & 1, kh = w >> 2, r = lane & 31, h = lane >> 5;
    const int irow = 64 * half + 32 * rt + r, ild = irow < 126 ? irow : 126;
    const GAS bf16x8* arow = (const GAS bf16x8*)(X + (size_t)ild * 1024 + kh * 1024); const GAS bf16x8* brow = (const GAS bf16x8*)(W1t + (size_t)(32 * ct + r) * 2048 + kh * 1024);
#define P2_KIDX(S) (8 * ((S) >> 2) + 4 * h + ((S) & 3))
    f32x16 acc = {};
    bf16x8 a0[8], b0[8], a1[8], b1[8];
#pragma unroll
    for (int s = 0; s < 8; ++s) { a0[s] = arow[P2_KIDX(s)]; b0[s] = brow[P2_KIDX(s)]; }
#pragma unroll 1
    for (int bt = 0; bt < 8; bt += 2) {
#pragma unroll
        for (int s = 0; s < 8; ++s) { a1[s] = arow[P2_KIDX(8 * (bt + 1) + s)]; b1[s] = brow[P2_KIDX(8 * (bt + 1) + s)]; }
        P2_PIN8(a0); P2_PIN8(b0);
#pragma unroll
        for (int s = 0; s < 8; ++s) acc = __builtin_amdgcn_mfma_f32_32x32x16_bf16(a0[s], b0[s], acc, 0, 0, 0);
        if (bt + 2 < 8) {
#pragma unroll
            for (int s = 0; s < 8; ++s) { a0[s] = arow[P2_KIDX(8 * (bt + 2) + s)]; b0[s] = brow[P2_KIDX(8 * (bt + 2) + s)]; } }
#undef P2_KIDX_DONE
        P2_PIN8(a1); P2_PIN8(b1);
#pragma unroll
        for (int s = 0; s < 8; ++s) acc = __builtin_amdgcn_mfma_f32_32x32x16_bf16(a1[s], b1[s], acc, 0, 0, 0);
    }
    LAS float* red = (LAS float*)(F.lds + RING_OFF);
    LAS bf16* Hs = (LAS bf16*)(F.lds + RING_OFF + 16384);
    if (kh == 1) {
#pragma unroll
        for (int i = 0; i < 16; ++i) red[((w & 3) * 16 + i) * 64 + lane] = acc[i];
    }
    __syncthreads();
    if (kh == 0) { const float pb = PB[32 * ct + r];
#pragma unroll
        for (int i = 0; i < 16; ++i) { float v = acc[i] + red[((w & 3) * 16 + i) * 64 + lane] + pb; v = v / (1.0f + __expf(-v)); Hs[(32 * rt + crow(i, h)) * 72 + 32 * ct + r] = (bf16)f2bf(v); }
    }
    __syncthreads();
    if (kh == 0) { f32x16 o = {};
#pragma unroll
        for (int s = 0; s < 4; ++s) { const bf16x8 a = *(const LAS bf16x8*)(Hs + (32 * rt + r) * 72 + 16 * s + 8 * h), b = *(const GAS bf16x8*)(W2t + (size_t)(32 * ct + r) * 64 + 16 * s + 8 * h);
            o = __builtin_amdgcn_mfma_f32_32x32x16_bf16(a, b, o, 0, 0, 0); }
#pragma unroll
        for (int i = 0; i < 16; ++i) { const int row = 64 * half + 32 * rt + crow(i, h); OUT[(size_t)row * 64 + 32 * ct + r] = (bf16)(row == 127 ? 0u : f2bf(o[i])); }
    }
    __syncthreads();
}
__device__ __forceinline__ void p2_phase(Frame& F) {
    for (int id = F.vcu; id < BATCH * 8; id += F.G) { const int b = id >> 3, h = id & 7, tid = cur_tid(F), lane = cur_lane(), w = F.wave;
        LAS float* wt = (LAS float*)(F.lds + RING_OFF + 32768);
        const float* lf = wsp<float>(F, WS_LF) + ((size_t)b * SEQ + 4 * tid) * 8 + h; float v[4];
#pragma unroll
        for (int i = 0; i < 4; ++i) v[i] = lf[i * 8];
        const float tot = (v[0] + v[1]) + (v[2] + v[3]); float incl = tot;
#pragma unroll
        for (int o = 1; o < 64; o <<= 1) { const float n = __shfl_up(incl, o); if (lane >= o) incl += n; }
        if (lane == 63) wt[w] = incl;
        __syncthreads();
        float run = incl - tot;
        for (int k = 0; k < w; ++k) run += wt[k];
        float* c = wsp<float>(F, WS_C) + (size_t)id * SEQ + 4 * tid; GAS v4u* kx = (GAS v4u*)(wsp<bf16>(F, WS_FKX) + ((size_t)id * SEQ + 4 * tid) * 16);
        float cv[4];
#pragma unroll
        for (int i = 0; i < 4; ++i) { run += v[i]; cv[i] = run;
            const float x = -run * LOG2E; const unsigned h1 = f2bf(x); const float r1 = x - __uint_as_float(h1 << 16); const unsigned h2 = f2bf(r1); const float r2 = r1 - __uint_as_float(h2 << 16); const unsigned h3 = f2bf(r2);
            kx[2 * i] = (v4u){h1 | (h2 << 16), h3, 0u, 0u}; kx[2 * i + 1] = (v4u){0u, 0u, 0u, 0u}; }
        *(GAS f32x4*)c = (f32x4){cv[0], cv[1], cv[2], cv[3]};
        { LAS float* cl = (LAS float*)(F.lds + RING_OFF + 36864); LAS float* wk = cl + 2048; LAS float* wq = wk + 256;
          *(LAS f32x4*)(cl + 4 * tid) = (f32x4){cv[0], cv[1], cv[2], cv[3]};
          const GAS v4u* kr = (const GAS v4u*)(wsp<bf16>(F, WS_FK) + ((size_t)b * SEQ + (tid >> 3)) * 512 + h * 64 + (tid & 7) * 8);
          const GAS v4u* qrw = (const GAS v4u*)(wsp<bf16>(F, WS_FQ) + ((size_t)b * SEQ + (tid >> 3)) * 512 + h * 64 + (tid & 7) * 8);
#pragma unroll 1
          for (int i0 = 0; i0 < 32; i0 += 16) { v4u ka[16], qa[16];
#pragma unroll
              for (int i = 0; i < 16; ++i) { ka[i] = kr[(size_t)(i0 + i) * 64 * 64]; qa[i] = qrw[(size_t)(i0 + i) * 64 * 64]; }
              asm volatile("" : "+v"(ka[0]), "+v"(ka[1]), "+v"(ka[2]), "+v"(ka[3]), "+v"(ka[4]), "+v"(ka[5]), "+v"(ka[6]), "+v"(ka[7]), "+v"(ka[8]), "+v"(ka[9]), "+v"(ka[10]), "+v"(ka[11]), "+v"(ka[12]), "+v"(ka[13]), "+v"(ka[14]), "+v"(ka[15]));
              asm volatile("" : "+v"(qa[0]), "+v"(qa[1]), "+v"(qa[2]), "+v"(qa[3]), "+v"(qa[4]), "+v"(qa[5]), "+v"(qa[6]), "+v"(qa[7]), "+v"(qa[8]), "+v"(qa[9]), "+v"(qa[10]), "+v"(qa[11]), "+v"(qa[12]), "+v"(qa[13]), "+v"(qa[14]), "+v"(qa[15]));
#pragma unroll
              for (int i = 0; i < 16; ++i) { const v4u a = ka[i], e = qa[i];
                  float sk = (bfl(a.x) * bfl(a.x) + bfh(a.x) * bfh(a.x)) + (bfl(a.y) * bfl(a.y) + bfh(a.y) * bfh(a.y)) + (bfl(a.z) * bfl(a.z) + bfh(a.z) * bfh(a.z)) + (bfl(a.w) * bfl(a.w) + bfh(a.w) * bfh(a.w));
                  float sq = (bfl(e.x) * bfl(e.x) + bfh(e.x) * bfh(e.x)) + (bfl(e.y) * bfl(e.y) + bfh(e.y) * bfh(e.y)) + (bfl(e.z) * bfl(e.z) + bfh(e.z) * bfh(e.z)) + (bfl(e.w) * bfl(e.w) + bfh(e.w) * bfh(e.w));
                  sk += __shfl_xor(sk, 1); sq += __shfl_xor(sq, 1); sk += __shfl_xor(sk, 2); sq += __shfl_xor(sq, 2); sk += __shfl_xor(sk, 4); sq += __shfl_xor(sq, 4);
                  sk = fmaxf(sk, __shfl_xor(sk, 8)); sq = fmaxf(sq, __shfl_xor(sq, 8)); sk = fmaxf(sk, __shfl_xor(sk, 16)); sq = fmaxf(sq, __shfl_xor(sq, 16)); sk = fmaxf(sk, __shfl_xor(sk, 32)); sq = fmaxf(sq, __shfl_xor(sq, 32));
                  if (lane == 0) { wk[w * 32 + i0 + i] = sk; wq[w * 32 + i0 + i] = sq; } } }
          __syncthreads();
          if (tid < 8) { const int qb = tid; float Qm = 0.f, Kband = 0.f;
              for (int t4 = 0; t4 < 4; ++t4) for (int ww = 0; ww < 8; ++ww) { Qm = fmaxf(Qm, wq[ww * 32 + 4 * qb + t4]); Kband = fmaxf(Kband, wk[ww * 32 + 4 * qb + t4]); }
              Qm = sqrtf(Qm) * 1.001f; Kband = sqrtf(Kband) * 1.001f;
              const float cq0 = cl[256 * qb]; int kt0 = 4 * qb;
              for (int kt = 4 * qb - 1; kt >= 0; --kt) { float kk = 0.f; for (int ww = 0; ww < 8; ++ww) kk = fmaxf(kk, wk[ww * 32 + kt]); kk = sqrtf(kk) * 1.001f;
                  const float bound = Qm * (kk + Kband) + (cq0 - cl[64 * kt + 63]) * LOG2E; if (bound >= -40.0f) kt0 = kt; }
              wsp<int>(F, WS_KT0)[id * 8 + qb] = kt0; } }
        __syncthreads(); }
    for (int u = F.vcu; u < 256; u += F.G) p2_compress_unit(F, u);
}

template <bool FINAL>
__device__ __forceinline__ void row_pass(Frame& F, const float* xin_f32, const bf16* xin_b16, const bf16* Y, const float* gpost, float* out_f32, bf16* X1B, float* RSTD2) {
#ifndef RP_FINAL
#define RP_FINAL 4
#endif
    constexpr int RP = FINAL ? RP_FINAL : 4;
    const int gw = F.vcu * NWAVES + F.wave, NGW = F.G * NWAVES, lane = cur_lane();
    const GAS f32x4* gp = (const GAS f32x4*)gpost + lane;
    f32x4 gpv[4];
#pragma unroll
    for (int j = 0; j < 4; ++j) gpv[j] = gp[64 * j];
    for (int m0 = gw; m0 < MTOK; m0 += NGW * RP) {
        f32x4 xv[FINAL ? 1 : RP][4]; unsigned long long xw[FINAL ? RP : 1][4]; unsigned long long yw[RP][4];
#pragma unroll
        for (int r = 0; r < RP; ++r) { const size_t m = (size_t)(m0 + r * NGW);
            const GAS unsigned long long* yr = (const GAS unsigned long long*)(Y + m * DMODEL) + lane;
            if (FINAL) { const GAS unsigned long long* xr = (const GAS unsigned long long*)(xin_b16 + m * DMODEL) + lane;
#pragma unroll
                for (int j = 0; j < 4; ++j) { xw[r][j] = __builtin_nontemporal_load(xr + 64 * j); yw[r][j] = __builtin_nontemporal_load(yr + 64 * j); }
            } else { const GAS f32x4* xr = (const GAS f32x4*)(xin_f32 + m * DMODEL) + lane;
#pragma unroll
                for (int j = 0; j < 4; ++j) { xv[r][j] = __builtin_nontemporal_load(xr + 64 * j); yw[r][j] = __builtin_nontemporal_load(yr + 64 * j); } } }
#pragma unroll
        for (int r = 0; r < RP; ++r) { const size_t m = (size_t)(m0 + r * NGW);
            f32x4 yv[4]; float s = 0.f;
#pragma unroll
            for (int j = 0; j < 4; ++j) { const unsigned lo = (unsigned)yw[r][j], hi = (unsigned)(yw[r][j] >> 32);
                yv[j] = (f32x4){bfl(lo), bfh(lo), bfl(hi), bfh(hi)}; s += (yv[j].x * yv[j].x + yv[j].y * yv[j].y) + (yv[j].z * yv[j].z + yv[j].w * yv[j].w); }
            const float rr = 1.0f / sqrtf(wave_sum(s) * (1.f / DMODEL) + RMS_EPS); float s2 = 0.f;
            if (FINAL) { GAS f32x4* xo = (GAS f32x4*)(out_f32 + m * DMODEL) + lane;
#pragma unroll
                for (int j = 0; j < 4; ++j) { const unsigned lo = (unsigned)xw[r][j], hi = (unsigned)(xw[r][j] >> 32); const f32x4 xf = (f32x4){bfl(lo), bfh(lo), bfl(hi), bfh(hi)}; __builtin_nontemporal_store(xf + yv[j] * rr * gpv[j], xo + 64 * j); }
            } else { GAS unsigned long long* o8 = (GAS unsigned long long*)(X1B + m * DMODEL) + lane;
#pragma unroll
                for (int j = 0; j < 4; ++j) { const f32x4 v = xv[r][j] + yv[j] * rr * gpv[j]; s2 += (v.x * v.x + v.y * v.y) + (v.z * v.z + v.w * v.w);
                    o8[64 * j] = (unsigned long long)pk2(v.x, v.y) | ((unsigned long long)pk2(v.z, v.w) << 32); }
                const float r2 = 1.0f / sqrtf(wave_sum(s2) * (1.f / DMODEL) + RMS_EPS); if (lane == 0) RSTD2[m] = r2; }
        }
    }
}

namespace at {
constexpr int KSLOT = 10240, VSLOT = 8192, NSLOT = 3;
constexpr int L_K = 0, L_V = NSLOT * KSLOT, L_WS = L_V + NSLOT * VSLOT, L_PARK = L_WS + 8 * 512, L_PSL = L_PARK, L_CMP = L_PARK + 4 * 64 * 33 * 4, L_SELM = L_CMP + 4 * 8192, L_NEXT = L_SELM + 256, L_END = L_NEXT + 16;
static_assert(L_SELM >= L_PARK + 8 * 8192, "park region");
static_assert(L_END <= RING_BYTES, "attention LDS map");
constexpr float THR = 8.0f;
typedef short s16x4 __attribute__((ext_vector_type(4)));
typedef short v4i16_t __attribute__((ext_vector_type(4)));
#define AT_NEG (-INFINITY)
__device__ __forceinline__ void glds16(const void* sbase, unsigned voff, unsigned lds_dst) { unsigned keep;
    asm volatile("s_mov_b32 %0, m0\n\ts_mov_b32 m0, %3\n\ts_nop 2\n\tglobal_load_lds_dwordx4 %1, %2\n\ts_mov_b32 m0, %0" : "=&s"(keep) : "v"(voff), "s"(sbase), "s"(lds_dst) : "memory"); }
__device__ __forceinline__ void glds4(const void* sbase, unsigned voff, unsigned lds_dst) { unsigned keep;
    asm volatile("s_mov_b32 %0, m0\n\ts_mov_b32 m0, %3\n\ts_nop 2\n\tglobal_load_lds_dword %1, %2\n\ts_mov_b32 m0, %0" : "=&s"(keep) : "v"(voff), "s"(sbase), "s"(lds_dst) : "memory"); }
#define AT_WAIT_BAR(N) asm volatile("s_waitcnt vmcnt(" #N ") lgkmcnt(0)\n\ts_barrier" ::: "memory")
#ifndef AT_PRIO_MODE
#define AT_PRIO_MODE 1
#endif
#define AT_PRIO(w) do { if (AT_PRIO_MODE == 1) { if ((w) < 4) __builtin_amdgcn_s_setprio(2); else __builtin_amdgcn_s_setprio(0); } else if (AT_PRIO_MODE == 2) { if (((w) & 1) == 0) __builtin_amdgcn_s_setprio(2); else __builtin_amdgcn_s_setprio(0); } } while (0)
#define AT_BAR() asm volatile("s_waitcnt lgkmcnt(0)\n\ts_barrier" ::: "memory")
__device__ __forceinline__ unsigned cvtpk(float lo, float hi) { typedef float f2 __attribute__((ext_vector_type(2))); typedef __bf16 b2 __attribute__((ext_vector_type(2))); f2 v = {lo, hi}; b2 b = __builtin_convertvector(v, b2); return __builtin_bit_cast(unsigned, b); }
__device__ __forceinline__ float swap_half(float x, int hi) { auto rr = __builtin_amdgcn_permlane32_swap(__float_as_uint(x), __float_as_uint(x), false, false); return hi ? __uint_as_float(rr[0]) : __uint_as_float(rr[1]); }
__device__ __forceinline__ float max_half(float x) { auto rr = __builtin_amdgcn_permlane32_swap(__float_as_uint(x), __float_as_uint(x), false, false); return fmaxf(__uint_as_float(rr[0]), __uint_as_float(rr[1])); }
__device__ __forceinline__ float sum_half(float x) { auto rr = __builtin_amdgcn_permlane32_swap(__float_as_uint(x), __float_as_uint(x), false, false); return __uint_as_float(rr[0]) + __uint_as_float(rr[1]); }
template <int KS>
__device__ __forceinline__ void qk(f32x16& p0, f32x16& p1, const LAS unsigned char* Kslot, const bf16x8 (&qr)[5], const f32x16& cinit, int r32, int hi) {
    const LAS unsigned char* kb = Kslot + hi * 1024 + r32 * 16;
#pragma unroll
    for (int d0 = 0; d0 < KS; ++d0) { const bf16x8 b0 = *(const LAS bf16x8*)(kb + d0 * 2048), b1 = *(const LAS bf16x8*)(kb + d0 * 2048 + 512);
        if (d0 == 0) { p0 = __builtin_amdgcn_mfma_f32_32x32x16_bf16(b0, qr[0], cinit, 0, 0, 0); p1 = __builtin_amdgcn_mfma_f32_32x32x16_bf16(b1, qr[0], cinit, 0, 0, 0); }
        else { p0 = __builtin_amdgcn_mfma_f32_32x32x16_bf16(b0, qr[d0], p0, 0, 0, 0); p1 = __builtin_amdgcn_mfma_f32_32x32x16_bf16(b1, qr[d0], p1, 0, 0, 0); } }
}
__device__ __forceinline__ s16x4 vtr(const LAS unsigned char* p) { return __builtin_bit_cast(s16x4, __builtin_amdgcn_ds_read_tr16_b64_v4i16((LAS v4i16_t*)p)); }
__device__ __forceinline__ void pv(f32x16 (&o)[2], const LAS unsigned char* vb, const f32x16& p0, const f32x16& p1) {
    v4u pw[4];
#pragma unroll
    for (int k = 0; k < 2; ++k) { pw[k] = (v4u){cvtpk(p0[8 * k], p0[8 * k + 1]), cvtpk(p0[8 * k + 2], p0[8 * k + 3]), cvtpk(p0[8 * k + 4], p0[8 * k + 5]), cvtpk(p0[8 * k + 6], p0[8 * k + 7])};
        pw[2 + k] = (v4u){cvtpk(p1[8 * k], p1[8 * k + 1]), cvtpk(p1[8 * k + 2], p1[8 * k + 3]), cvtpk(p1[8 * k + 4], p1[8 * k + 5]), cvtpk(p1[8 * k + 6], p1[8 * k + 7])}; }
#pragma unroll
    for (int d0 = 0; d0 < 2; ++d0)
#pragma unroll
        for (int ks = 0; ks < 4; ++ks) { const s16x4 lo = vtr(vb + d0 * 4096 + ks * 1024), hi = vtr(vb + d0 * 4096 + ks * 1024 + 512);
            const bf16x8 vf = (bf16x8){lo[0], lo[1], lo[2], lo[3], hi[0], hi[1], hi[2], hi[3]};
            o[d0] = __builtin_amdgcn_mfma_f32_32x32x16_bf16(__builtin_bit_cast(bf16x8, pw[ks]), vf, o[d0], 0, 0, 0); }
}
template <int KS>
__device__ __forceinline__ void load_kf(bf16x8 (&kf)[10], const LAS unsigned char* Kslot, int r32, int hi) {
    const LAS unsigned char* kb = Kslot + hi * 1024 + r32 * 16;
#pragma unroll
    for (int d0 = 0; d0 < KS; ++d0) { kf[2 * d0] = *(const LAS bf16x8*)(kb + d0 * 2048); kf[2 * d0 + 1] = *(const LAS bf16x8*)(kb + d0 * 2048 + 512); }
}
__device__ __forceinline__ void v_load(bf16x8 (&vf)[8], const LAS unsigned char* vb) {
#pragma unroll
    for (int d0 = 0; d0 < 2; ++d0)
#pragma unroll
        for (int ks = 0; ks < 4; ++ks) { const s16x4 lo = vtr(vb + d0 * 4096 + ks * 1024), hi = vtr(vb + d0 * 4096 + ks * 1024 + 512);
            vf[d0 * 4 + ks] = (bf16x8){lo[0], lo[1], lo[2], lo[3], hi[0], hi[1], hi[2], hi[3]}; }
}
template <int KS, bool LOADK>
__device__ __forceinline__ void pv_regs(f32x16 (&o)[2], const bf16x8 (&vf)[8], const f32x16& p0, const f32x16& p1, bf16x8 (&kf)[10], const LAS unsigned char* Knext, int r32, int hi) {
    v4u pw[4];
#pragma unroll
    for (int k = 0; k < 2; ++k) { pw[k] = (v4u){cvtpk(p0[8 * k], p0[8 * k + 1]), cvtpk(p0[8 * k + 2], p0[8 * k + 3]), cvtpk(p0[8 * k + 4], p0[8 * k + 5]), cvtpk(p0[8 * k + 6], p0[8 * k + 7])};
        pw[2 + k] = (v4u){cvtpk(p1[8 * k], p1[8 * k + 1]), cvtpk(p1[8 * k + 2], p1[8 * k + 3]), cvtpk(p1[8 * k + 4], p1[8 * k + 5]), cvtpk(p1[8 * k + 6], p1[8 * k + 7])}; }
#pragma unroll
    for (int ks = 0; ks < 2; ++ks)
#pragma unroll
        for (int d0 = 0; d0 < 2; ++d0) o[d0] = __builtin_amdgcn_mfma_f32_32x32x16_bf16(__builtin_bit_cast(bf16x8, pw[ks]), vf[d0 * 4 + ks], o[d0], 0, 0, 0);
    if (LOADK) { __builtin_amdgcn_sched_barrier(0); load_kf<KS>(kf, Knext, r32, hi); __builtin_amdgcn_sched_barrier(0); }
#pragma unroll
    for (int ks = 2; ks < 4; ++ks)
#pragma unroll
        for (int d0 = 0; d0 < 2; ++d0) o[d0] = __builtin_amdgcn_mfma_f32_32x32x16_bf16(__builtin_bit_cast(bf16x8, pw[ks]), vf[d0 * 4 + ks], o[d0], 0, 0, 0);
}
__device__ __forceinline__ float max3f(float a, float b, float c) { float r; asm("v_max3_f32 %0, %1, %2, %3" : "=v"(r) : "v"(a), "v"(b), "v"(c)); return r; }
__device__ __forceinline__ float rowmax32(const f32x16& p0, const f32x16& p1) {
    float a = max3f(p0[0], p0[1], p1[0]), b = max3f(p0[2], p0[3], p1[1]); a = max3f(a, p1[2], p1[3]);
#pragma unroll
    for (int r = 4; r < 16; r += 4) { a = max3f(a, p0[r], p0[r + 1]); b = max3f(b, p0[r + 2], p0[r + 3]); a = max3f(a, p1[r], p1[r + 1]); b = max3f(b, p1[r + 2], p1[r + 3]); }
    return max_half(__builtin_fmaxf(a, b));
}
template <bool FIRST>
__device__ __forceinline__ void softmax_tile(f32x16& p0, f32x16& p1, f32x16& cinit, float& l, f32x16 (&o)[2], LAS float* wsf, int r32, int hi) {
    const float rm = rowmax32(p0, p1);
    bool resc = false;
    if (FIRST) { const float dl = rm;
#pragma unroll
        for (int r = 0; r < 16; ++r) { p0[r] -= dl; p1[r] -= dl; cinit[r] -= dl; } }
    else if (__any(rm > THR)) { const float dl = fmaxf(rm, 0.f);
#pragma unroll
        for (int r = 0; r < 16; ++r) { p0[r] -= dl; p1[r] -= dl; cinit[r] -= dl; }
        const float f = __builtin_amdgcn_exp2f(-dl); l *= f; if (hi == 0) wsf[r32] = f; resc = true; }
    float s = 0.f;
#pragma unroll
    for (int r = 0; r < 16; ++r) { p0[r] = __builtin_amdgcn_exp2f(p0[r]); p1[r] = __builtin_amdgcn_exp2f(p1[r]); s += p0[r] + p1[r]; }
    l += s;
    if (resc) {
#pragma unroll
        for (int i = 0; i < 4; ++i) { const f32x4 f4 = *(const LAS f32x4*)(wsf + 8 * i + 4 * hi);
#pragma unroll
            for (int k = 0; k < 4; ++k) { o[0][4 * i + k] *= f4[k]; o[1][4 * i + k] *= f4[k]; } } }
}
__device__ __forceinline__ void row_bcast(float v, float (&out)[16], LAS float* wsf, int r32, int hi) {
    asm volatile("s_waitcnt lgkmcnt(0)" ::: "memory");
    if (hi == 0) wsf[32 + r32] = v;
#pragma unroll
    for (int i = 0; i < 4; ++i) { const f32x4 f4 = *(const LAS f32x4*)(wsf + 32 + 8 * i + 4 * hi);
#pragma unroll
        for (int k = 0; k < 4; ++k) out[4 * i + k] = f4[k]; }
    asm volatile("s_waitcnt lgkmcnt(0)" ::: "memory");
}
__device__ __forceinline__ void store_rows(const f32x16 (&v)[2], LAS unsigned char* stg_, bf16* Ow, int pitch, int lane, int r32, int hi) {
    LAS bf16* stg = (LAS bf16*)stg_;
#pragma unroll
    for (int r = 0; r < 16; ++r) { const int orow = crow(r, hi);
#pragma unroll
        for (int d0 = 0; d0 < 2; ++d0) stg[orow * 64 + d0 * 32 + r32] = (bf16)f2bf(v[d0][r]); }
    asm volatile("s_waitcnt lgkmcnt(0)" ::: "memory");
#pragma unroll
    for (int i = 0; i < 4; ++i) { const int row = i * 8 + (lane >> 3), ch = lane & 7; const v4u w = *(const LAS v4u*)(stg + row * 64 + ch * 8); *(GAS v4u*)(Ow + (size_t)row * pitch + ch * 8) = w; }
    asm volatile("s_waitcnt lgkmcnt(0)" ::: "memory");
}


template <int KS>
__device__ __forceinline__ void qk_regs(f32x16& p0, f32x16& p1, const bf16x8 (&kf)[10], const bf16x8 (&qr)[5], const f32x16& cinit) {
    p0 = __builtin_amdgcn_mfma_f32_32x32x16_bf16(kf[0], qr[0], cinit, 0, 0, 0); p1 = __builtin_amdgcn_mfma_f32_32x32x16_bf16(kf[1], qr[0], cinit, 0, 0, 0);
#pragma unroll
    for (int d0 = 1; d0 < KS; ++d0) { p0 = __builtin_amdgcn_mfma_f32_32x32x16_bf16(kf[2 * d0], qr[d0], p0, 0, 0, 0); p1 = __builtin_amdgcn_mfma_f32_32x32x16_bf16(kf[2 * d0 + 1], qr[d0], p1, 0, 0, 0); }
}
__device__ __forceinline__ void softmax_first(f32x16& p0, f32x16& p1, f32x16& cinit, float& l) {
    const float dl = rowmax32(p0, p1); float s = 0.f;
#pragma unroll
    for (int r = 0; r < 16; ++r) { cinit[r] -= dl; p0[r] = __builtin_amdgcn_exp2f(p0[r] - dl); p1[r] = __builtin_amdgcn_exp2f(p1[r] - dl); s += p0[r] + p1[r]; }
    l = s;
}
__device__ __forceinline__ void softmax_next(f32x16& p0, f32x16& p1, f32x16& cinit, float& l, f32x16 (&o)[2], LAS float* wsf, int r32, int hi) {
    const float rm = rowmax32(p0, p1);
    if (__builtin_expect(__any(rm > THR), 0)) { const float dl = __builtin_fmaxf(rm, 0.f);
#pragma unroll
        for (int r = 0; r < 16; ++r) { p0[r] -= dl; p1[r] -= dl; cinit[r] -= dl; }
        const float f = __builtin_amdgcn_exp2f(-dl); l *= f; if (hi == 0) wsf[r32] = f;
#pragma unroll
        for (int i = 0; i < 4; ++i) { const f32x4 f4 = *(const LAS f32x4*)(wsf + 8 * i + 4 * hi);
#pragma unroll
            for (int k = 0; k < 4; ++k) { o[0][4 * i + k] *= f4[k]; o[1][4 * i + k] *= f4[k]; } } }
    float s = 0.f;
#pragma unroll
    for (int r = 0; r < 16; ++r) { p0[r] = __builtin_amdgcn_exp2f(p0[r]); p1[r] = __builtin_amdgcn_exp2f(p1[r]); s += p0[r] + p1[r]; }
    l += s;
}

#define AT_CONSUME4(a, b, c, d) asm volatile("" :: "v"(a), "v"(b), "v"(c), "v"(d))

__device__ __forceinline__ void fox_unit(Frame& F, int bh, int qb, int kt0, const int ABL) {
    int tid_ = cur_tid(F); asm volatile("" : "+v"(tid_));
    AT_PRIO(F.wave);
    const int lane = tid_ & 63, r32 = lane & 31, hi = lane >> 5, wid = F.wave; const int b = bh >> 3, h = bh & 7;
    LAS unsigned char* shm = F.lds + RING_OFF; const unsigned lds0 = (unsigned)(uintptr_t)shm;
    LAS float* wsf = (LAS float*)(shm + L_WS + wid * 512);
    const size_t rowbase = (size_t)b * SEQ; const int q0 = qb * 256;
    const bf16* Q = wsp<bf16>(F, WS_FQ); const bf16* K = wsp<bf16>(F, WS_FK) + (rowbase + (size_t)kt0 * 64) * 512 + h * 64; const bf16* V = wsp<bf16>(F, WS_FV) + (rowbase + (size_t)kt0 * 64) * 512 + h * 64;
    const bf16* KX = wsp<bf16>(F, WS_FKX) + ((size_t)bh * SEQ + (size_t)kt0 * 64) * 16;
    const unsigned koff = (unsigned)(lane * 512 + wid * 8) * 2u, voff = (unsigned)((16 * (wid & 3) + (lane >> 2)) * 512 + (wid >> 2) * 32 + (lane & 3) * 8) * 2u;
    const unsigned xoff = (unsigned)((16 * (wid & 3) + (lane >> 2)) * 16 + (wid >> 2) * 8 + (lane & 3) * 2) * 2u;
    const unsigned kdst = lds0 + L_K + wid * 1024, vdst = lds0 + L_V + wid * 1024, xdst = lds0 + L_K + (8 + (wid >> 2)) * 1024 + (wid & 3) * 256;
#define FX_DMA_K(t, slot) do { glds16(K + (size_t)(t) * 64 * 512, koff, (unsigned)__builtin_amdgcn_readfirstlane(kdst + (slot) * KSLOT)); \
        glds4(KX + (size_t)(t) * 64 * 16, xoff, (unsigned)__builtin_amdgcn_readfirstlane(xdst + (slot) * KSLOT)); } while (0)
#define FX_DMA_V(t, slot) glds16(V + (size_t)(t) * 64 * 512, voff, (unsigned)__builtin_amdgcn_readfirstlane(vdst + (slot) * VSLOT))
    const int NT = 4 * qb + 4 - kt0;
    bf16x8 qr[5];
    { const bf16* Qw = Q + (rowbase + q0 + wid * 32 + r32) * 512 + h * 64;
#pragma unroll
      for (int d0 = 0; d0 < 4; ++d0) { if (ABL == 10) { qr[d0] = (bf16x8){(short)lane, 0, 0, 0, 0, 0, 0, 0}; asm volatile("" : "+v"(qr[d0])); } else qr[d0] = *(const GAS bf16x8*)(Qw + d0 * 16 + hi * 8); }
      const short one = (short)0x3F80; qr[4] = hi == 0 ? (bf16x8){one, one, one, 0, 0, 0, 0, 0} : (bf16x8){0, 0, 0, 0, 0, 0, 0, 0}; }
    const float ct = wsp<float>(F, WS_C)[(size_t)bh * SEQ + q0 + wid * 32 + r32] * LOG2E;
    asm volatile("" ::: "memory");
    if (ABL != 9) { FX_DMA_K(0, 0); FX_DMA_V(0, 0); FX_DMA_K(1, 1); FX_DMA_K(2, 2); FX_DMA_V(1, 1); }
    f32x16 cinit;
    f32x16 o[2]; o[0] = f32x16{}; o[1] = f32x16{}; float l = 0.f;
    const int qrel = wid * 32 + r32;
    const LAS unsigned char* vtb = shm + L_V + ((lane >> 4) & 1) * 32 + (lane & 3) * 8 + (4 * hi + ((lane & 15) >> 2)) * 64;
    bf16x8 kf[10], vf[8];
    AT_WAIT_BAR(3);
    AT_CONSUME4(qr[0], qr[1], qr[2], qr[3]); asm volatile("" :: "v"(ct));
#pragma unroll
    for (int r = 0; r < 16; ++r) cinit[r] = ct;
    load_kf<5>(kf, shm + L_K, r32, hi);
    int s0 = 0, s1 = 1, s2 = 2;
#define FX_MASK(n) do { const int jb_ = (n) - (NT - 4); if (jb_ >= 0) { const int kb_ = 64 * jb_ + 4 * hi; \
        _Pragma("unroll") for (int r = 0; r < 16; ++r) { const int kv = kb_ + (r & 3) + 8 * (r >> 2); if (kv > qrel) p0[r] = AT_NEG; if (kv + 32 > qrel) p1[r] = AT_NEG; } } } while (0)
#define FX_ROT() do { const int t_ = s0; s0 = s1; s1 = s2; s2 = t_; } while (0)
    if (ABL < 7) {
    {
      AT_WAIT_BAR(3); FX_DMA_K(3, 0); FX_DMA_V(2, 2);
      f32x16 p0, p1; qk_regs<5>(p0, p1, kf, qr, cinit); v_load(vf, vtb); __builtin_amdgcn_sched_barrier(0);
      FX_MASK(0); softmax_first(p0, p1, cinit, l); pv_regs<5, true>(o, vf, p0, p1, kf, shm + L_K + KSLOT, r32, hi); FX_ROT(); }
    int n = 1;
    for (; n + 3 < NT; ++n) {
        if (ABL == 4) asm volatile("s_waitcnt vmcnt(3) lgkmcnt(0)" ::: "memory"); else AT_WAIT_BAR(3);
        if (ABL != 5) { FX_DMA_K(n + 3, s0); FX_DMA_V(n + 2, s2); }
        f32x16 p0, p1; if (ABL == 3) { p0 = cinit; p1 = cinit; asm volatile("" : "+v"(p0), "+v"(p1)); } else qk_regs<5>(p0, p1, kf, qr, cinit);
        v_load(vf, vtb + s0 * VSLOT); __builtin_amdgcn_sched_barrier(0);
        FX_MASK(n);
        if (ABL == 6) { asm volatile("" : "+v"(p0), "+v"(p1)); }
        else if (ABL == 1) { const float rm = rowmax32(p0, p1); l += rm; asm volatile("" : "+v"(p0), "+v"(p1)); }
        else softmax_next(p0, p1, cinit, l, o, wsf, r32, hi);
        if (ABL == 2) { asm volatile("" :: "v"(p0), "v"(p1), "v"(vf[0]), "v"(vf[1]), "v"(vf[2]), "v"(vf[3]), "v"(vf[4]), "v"(vf[5]), "v"(vf[6]), "v"(vf[7])); load_kf<5>(kf, shm + L_K + s1 * KSLOT, r32, hi); }
        else pv_regs<5, true>(o, vf, p0, p1, kf, shm + L_K + s1 * KSLOT, r32, hi);
        FX_ROT(); }
    {
      AT_WAIT_BAR(3); FX_DMA_V(n + 2, s2);
      f32x16 p0, p1; qk_regs<5>(p0, p1, kf, qr, cinit); v_load(vf, vtb + s0 * VSLOT); __builtin_amdgcn_sched_barrier(0);
      FX_MASK(n); softmax_next(p0, p1, cinit, l, o, wsf, r32, hi); pv_regs<5, true>(o, vf, p0, p1, kf, shm + L_K + s1 * KSLOT, r32, hi); FX_ROT(); ++n; }
    {
      AT_WAIT_BAR(1);
      f32x16 p0, p1; qk_regs<5>(p0, p1, kf, qr, cinit); v_load(vf, vtb + s0 * VSLOT); __builtin_amdgcn_sched_barrier(0);
      FX_MASK(n); softmax_next(p0, p1, cinit, l, o, wsf, r32, hi); pv_regs<5, true>(o, vf, p0, p1, kf, shm + L_K + s1 * KSLOT, r32, hi); FX_ROT(); ++n; }
    {
      AT_WAIT_BAR(0);
      f32x16 p0, p1; qk_regs<5>(p0, p1, kf, qr, cinit); v_load(vf, vtb + s0 * VSLOT); __builtin_amdgcn_sched_barrier(0);
      FX_MASK(n); softmax_next(p0, p1, cinit, l, o, wsf, r32, hi); pv_regs<5, false>(o, vf, p0, p1, kf, shm, r32, hi); }
    } else { asm volatile("s_waitcnt vmcnt(0)" ::: "memory"); l = 1.f; }
#undef FX_DMA_K
#undef FX_DMA_V
#undef FX_MASK
#undef FX_ROT
    l = sum_half(l); float rl[16]; row_bcast(1.0f / l, rl, wsf, r32, hi);
#pragma unroll
    for (int r = 0; r < 16; ++r) { o[0][r] *= rl[r]; o[1][r] *= rl[r]; }
    if (ABL != 8) store_rows(o, shm + L_PARK + wid * 8192, wsp<bf16>(F, ABL ? WS_PROBE_O : WS_ATT) + (rowbase + q0 + wid * 32) * 1024 + 512 + h * 64, 1024, lane, r32, hi);
    AT_BAR();
}

__device__ __forceinline__ void nsa_unit(Frame& F, int bg, int j) {
    int tid_ = cur_tid(F); asm volatile("" : "+v"(tid_));
    AT_PRIO(F.wave);
    const int tid = tid_, lane = tid & 63, r32 = lane & 31, hi = lane >> 5, wid = F.wave; const int b = bg >> 1, g = bg & 1, hh = wid >> 1, head = 4 * g + hh;
    LAS unsigned char* shm = F.lds + RING_OFF; const unsigned lds0 = (unsigned)(uintptr_t)shm;
    LAS float* wsf = (LAS float*)(shm + L_WS + wid * 512);
    LAS float* PSL = (LAS float*)(shm + L_PSL); LAS unsigned* SELM = (LAS unsigned*)(shm + L_SELM);
    const int qrel = 32 * (wid & 1) + r32, t = 64 * j + qrel; const size_t row = (size_t)b * SEQ + t;
    const bf16* KC = wsp<bf16>(F, WS_KCMP) + (size_t)bg * 128 * 64; const bf16* VC = wsp<bf16>(F, WS_VCMP) + (size_t)bg * 128 * 64;
    const bf16* KS = wsp<bf16>(F, WS_KV + 2 * KV_STRIDE) + (size_t)bg * SEQ * 64; const bf16* VS = wsp<bf16>(F, WS_KV + 3 * KV_STRIDE) + (size_t)bg * SEQ * 64;
    const bf16* KW = wsp<bf16>(F, WS_KV + 4 * KV_STRIDE) + (size_t)bg * SEQ * 64; const bf16* VW = wsp<bf16>(F, WS_KV + 5 * KV_STRIDE) + (size_t)bg * SEQ * 64;
    const unsigned koff = (unsigned)(lane * 64 + wid * 8) * 2u, voff = (unsigned)((16 * (wid & 3) + (lane >> 2)) * 64 + (wid >> 2) * 32 + (lane & 3) * 8) * 2u;
    const unsigned kdst = lds0 + L_K + wid * 1024, vdst = lds0 + L_V + wid * 1024, cdst = lds0 + L_CMP + wid * 1024;
    const int nsel = j + 1, nwin = j >= 8 ? 9 : j + 1, NR = nsel + nwin;
#define NS_TILE(m) ({ int m_ = (m); m_ = m_ < NR ? m_ : NR - 1; (m_ < nsel) ? m_ : (j - (m_ - nsel)) + 64; })
#define NS_DMA_K(m, slot) do { const int e_ = NS_TILE(m); const bf16* kp_ = (e_ < 64) ? KS + e_ * 4096 : KW + (e_ - 64) * 4096; glds16(kp_, koff, (unsigned)__builtin_amdgcn_readfirstlane(kdst + (slot) * KSLOT)); } while (0)
#define NS_DMA_V(m, slot) do { const int e_ = NS_TILE(m); const bf16* vp_ = (e_ < 64) ? VS + e_ * 4096 : VW + (e_ - 64) * 4096; glds16(vp_, voff, (unsigned)__builtin_amdgcn_readfirstlane(vdst + (slot) * VSLOT)); } while (0)
    bf16x8 qr[5];
    { const bf16* Qw = wsp<bf16>(F, WS_NQ) + row * 512 + head * 64;
#pragma unroll
      for (int d0 = 0; d0 < 4; ++d0) qr[d0] = *(const GAS bf16x8*)(Qw + d0 * 16 + hi * 8);
      qr[4] = (bf16x8){0, 0, 0, 0, 0, 0, 0, 0}; }
    const float* gt = wsp<float>(F, WS_GATE) + row * 24 + head * 3; const float g0 = gt[0], g1 = gt[1], g2 = gt[2];
    asm volatile("" ::: "memory");
    glds16(KC, koff, (unsigned)__builtin_amdgcn_readfirstlane(cdst)); glds16(KC + 4096, koff, (unsigned)__builtin_amdgcn_readfirstlane(cdst + 8192));
    glds16(VC, voff, (unsigned)__builtin_amdgcn_readfirstlane(cdst + 16384)); glds16(VC + 4096, voff, (unsigned)__builtin_amdgcn_readfirstlane(cdst + 24576));
    NS_DMA_K(0, 0); NS_DMA_V(0, 0); NS_DMA_K(1, 1); NS_DMA_K(2, 2); NS_DMA_V(1, 1);
    const LAS unsigned char* vlane = shm + ((lane >> 4) & 1) * 32 + (lane & 3) * 8 + (4 * hi + ((lane & 15) >> 2)) * 64;
    const LAS unsigned char* vtb = vlane + L_V;
    f32x16 o[2]; float rs[16]; bf16x8 kf[10], vf[8];
    LAS float* park = (LAS float*)(shm + L_PARK + wid * 8192) + lane;
    AT_WAIT_BAR(5);
    AT_CONSUME4(qr[0], qr[1], qr[2], qr[3]); asm volatile("" :: "v"(g0), "v"(g1), "v"(g2));
    { f32x16 zero = f32x16{}; f32x16 a0, a1, b0, b1;
      load_kf<4>(kf, shm + L_CMP, r32, hi); qk_regs<4>(a0, a1, kf, qr, zero); load_kf<4>(kf, shm + L_CMP + 8192, r32, hi); qk_regs<4>(b0, b1, kf, qr, zero);
      const int nmax = (t - 31) >> 4;
#pragma unroll
      for (int r = 0; r < 16; ++r) { const int n = (r & 3) + 8 * (r >> 2) + 4 * hi; if (n > nmax) a0[r] = AT_NEG; if (n + 32 > nmax) a1[r] = AT_NEG; if (n + 64 > nmax) b0[r] = AT_NEG; if (n + 96 > nmax) b1[r] = AT_NEG; }
      float m = __builtin_fmaxf(rowmax32(a0, a1), rowmax32(b0, b1)); m = (m == AT_NEG) ? 0.f : m;
      float s = 0.f;
#pragma unroll
      for (int r = 0; r < 16; ++r) { a0[r] = __builtin_amdgcn_exp2f(a0[r] - m); a1[r] = __builtin_amdgcn_exp2f(a1[r] - m); b0[r] = __builtin_amdgcn_exp2f(b0[r] - m); b1[r] = __builtin_amdgcn_exp2f(b1[r] - m); s += (a0[r] + a1[r]) + (b0[r] + b1[r]); }
      s = sum_half(s); const float inv = 1.0f / fmaxf(s, 1e-30f);
#pragma unroll
      for (int r = 0; r < 16; ++r) { a0[r] *= inv; a1[r] *= inv; b0[r] *= inv; b1[r] *= inv; }
      if (j >= 8) {
          float G[16], Lp[16];
#pragma unroll
          for (int i = 0; i < 4; ++i) { G[i] = (a0[4 * i] + a0[4 * i + 1]) + (a0[4 * i + 2] + a0[4 * i + 3]); G[4 + i] = (a1[4 * i] + a1[4 * i + 1]) + (a1[4 * i + 2] + a1[4 * i + 3]);
              G[8 + i] = (b0[4 * i] + b0[4 * i + 1]) + (b0[4 * i + 2] + b0[4 * i + 3]); G[12 + i] = (b1[4 * i] + b1[4 * i + 1]) + (b1[4 * i + 2] + b1[4 * i + 3]);
              Lp[i] = swap_half(a0[4 * i + 3], hi); Lp[4 + i] = swap_half(a1[4 * i + 3], hi); Lp[8 + i] = swap_half(b0[4 * i + 3], hi); Lp[12 + i] = swap_half(b1[4 * i + 3], hi); }
          LAS float* dst = PSL + (hh * 64 + qrel) * 33 + hi;
#pragma unroll
          for (int I = 0; I < 16; ++I) { const float prev = hi ? Lp[I] : (I > 0 ? Lp[I > 0 ? I - 1 : 0] : 0.f); dst[2 * I] = G[I] + prev; }
      }
      o[0] = f32x16{}; o[1] = f32x16{};
      pv(o, vlane + L_CMP + 16384, a0, a1); pv(o, vlane + L_CMP + 24576, b0, b1);
    }
    AT_BAR();
    if (j >= 8) { const int q = tid >> 3, sub = tid & 7;
        float v[4]; unsigned bits = 1u | (1u << j) | (1u << (j - 1));
#pragma unroll
        for (int c4 = 0; c4 < 4; ++c4) { const int k = 4 * sub + c4;
            const float ps = (PSL[(0 * 64 + q) * 33 + k] + PSL[(1 * 64 + q) * 33 + k]) + (PSL[(2 * 64 + q) * 33 + k] + PSL[(3 * 64 + q) * 33 + k]);
            v[c4] = (k > j - 2 || k == 0) ? -1e30f : ps; }
#pragma unroll 1
        for (int rnd = 0; rnd < 5; ++rnd) {
            float bv = v[0]; int bi = 4 * sub;
#pragma unroll
            for (int c4 = 1; c4 < 4; ++c4) if (v[c4] > bv) { bv = v[c4]; bi = 4 * sub + c4; }
#pragma unroll
            for (int o = 1; o < 8; o <<= 1) { const float ov = __shfl_xor(bv, o); const int oi = __shfl_xor(bi, o); if (ov > bv || (ov == bv && oi < bi)) { bv = ov; bi = oi; } }
            bits |= 1u << bi;
#pragma unroll
            for (int c4 = 0; c4 < 4; ++c4) if (bi == 4 * sub + c4) v[c4] = -3.0e38f; }
        if (sub == 0) SELM[q] = bits;
    } else { if (tid < 64) SELM[tid] = (2u << j) - 1u; }
    AT_BAR();
    const unsigned selm = SELM[qrel];
    row_bcast(g0, rs, wsf, r32, hi);
#pragma unroll
    for (int r = 0; r < 16; ++r) { park[r * 64] = o[0][r] * rs[r]; park[(16 + r) * 64] = o[1][r] * rs[r]; }
    f32x16 cinit; float l;
    AT_WAIT_BAR(2);
    load_kf<4>(kf, shm + L_K, r32, hi);
    int s0 = 0, s1 = 1, s2 = 2, m = 0;
#define NS_ROT() do { const int t_ = s0; s0 = s1; s1 = s2; s2 = t_; ++m; } while (0)
#define NS_HEAD() AT_WAIT_BAR(2); NS_DMA_K(m + 3, s0); NS_DMA_V(m + 2, s2); f32x16 p0, p1; qk_regs<4>(p0, p1, kf, qr, cinit); v_load(vf, vtb + s0 * VSLOT); __builtin_amdgcn_sched_barrier(0)
#define NS_MASK_SEL() do { const float keep_ = ((selm >> m) & 1u) ? 0.f : AT_NEG;        \
        _Pragma("unroll") for (int r = 0; r < 16; ++r) { p0[r] += keep_; p1[r] += keep_; } \
        if (m == j) {   \
        _Pragma("unroll") for (int r = 0; r < 16; ++r) { const int kk = (r & 3) + 8 * (r >> 2) + 4 * hi; if (kk > qrel) p0[r] = AT_NEG; if (kk + 32 > qrel) p1[r] = AT_NEG; } } } while (0)
#define NS_MASK_WIN() do { const int tt = j - (m - nsel); if (tt == j) { \
        _Pragma("unroll") for (int r = 0; r < 16; ++r) { const int kk = (r & 3) + 8 * (r >> 2) + 4 * hi; if (kk > qrel) p0[r] = AT_NEG; if (kk + 32 > qrel) p1[r] = AT_NEG; } } \
      else if (tt == j - 8) {   \
        _Pragma("unroll") for (int r = 0; r < 16; ++r) { const int kk = (r & 3) + 8 * (r >> 2) + 4 * hi; if (kk <= qrel) p0[r] = AT_NEG; if (kk + 32 <= qrel) p1[r] = AT_NEG; } } } while (0)
    cinit = f32x16{}; o[0] = f32x16{}; o[1] = f32x16{};
    { NS_HEAD(); NS_MASK_SEL(); softmax_first(p0, p1, cinit, l); pv_regs<4, true>(o, vf, p0, p1, kf, shm + L_K + s1 * KSLOT, r32, hi); NS_ROT(); }
    for (; m < nsel;) { NS_HEAD(); NS_MASK_SEL(); softmax_next(p0, p1, cinit, l, o, wsf, r32, hi); pv_regs<4, true>(o, vf, p0, p1, kf, shm + L_K + s1 * KSLOT, r32, hi); NS_ROT(); }
    l = sum_half(l); row_bcast(g1 / l, rs, wsf, r32, hi);
#pragma unroll
    for (int r = 0; r < 16; ++r) { park[r * 64] += o[0][r] * rs[r]; park[(16 + r) * 64] += o[1][r] * rs[r]; }
    cinit = f32x16{}; o[0] = f32x16{}; o[1] = f32x16{};
    { NS_HEAD(); NS_MASK_WIN(); softmax_first(p0, p1, cinit, l); pv_regs<4, true>(o, vf, p0, p1, kf, shm + L_K + s1 * KSLOT, r32, hi); NS_ROT(); }
    for (; m < NR;) { NS_HEAD(); NS_MASK_WIN(); softmax_next(p0, p1, cinit, l, o, wsf, r32, hi); pv_regs<4, true>(o, vf, p0, p1, kf, shm + L_K + s1 * KSLOT, r32, hi); NS_ROT(); }
#undef NS_HEAD
#undef NS_TILE
#undef NS_DMA_K
#undef NS_DMA_V
#undef NS_ROT
#undef NS_MASK_SEL
#undef NS_MASK_WIN
    l = sum_half(l); row_bcast(g2 / l, rs, wsf, r32, hi);
#pragma unroll
    for (int r = 0; r < 16; ++r) { o[0][r] = park[r * 64] + o[0][r] * rs[r]; o[1][r] = park[(16 + r) * 64] + o[1][r] * rs[r]; }
    asm volatile("s_waitcnt vmcnt(0) lgkmcnt(0)" ::: "memory");
    store_rows(o, shm + L_PARK + wid * 8192, wsp<bf16>(F, WS_ATT) + ((size_t)b * SEQ + 64 * j + 32 * (wid & 1)) * 1024 + head * 64, 1024, lane, r32, hi);
    AT_BAR();
}
constexpr int NUNITS = 4096;
__device__ const unsigned short BLK_TAB[64] = {64512, 63489, 62466, 61443, 60420, 59397, 58374, 57351, 56328, 55305, 54282, 53259, 52236, 51213, 50190, 49167, 48144, 47121, 46098, 45075, 44052, 43029, 42006, 40983, 39960, 38937, 37914, 36891, 35868, 2077, 2077, 2077, 2077, 3105, 3105, 3105, 3105, 4133, 4133, 4133, 4133, 5161, 5161, 5161, 5161, 6189, 6189, 6189, 6189, 7217, 7217, 7217, 7217, 34869, 1078, 1078, 1078, 1078, 33850, 32827, 60, 60, 60, 60};
}
#ifndef PROBE_ABL
#define PROBE_ABL 0
#endif
__device__ __forceinline__ void p3_attention(Frame& F, const int MODE) {
    const int G = F.G, c = F.vcu, nrounds = (at::NUNITS + G - 1) / G;
    const gu32* KT0 = (const gu32*)wsp<unsigned>(F, WS_KT0);
#define P3_UNIT(i) ((i) * G + (((i) & 1) ? G - 1 - c : c))
#define P3_KT0_IDX(u) ({ const unsigned tb_ = at::BLK_TAB[(u) >> 6]; const int ix_ = (u) - (int)(tb_ & 1023u) * 64; (tb_ >> 15) ? 0 : ix_ * 8 + (int)((tb_ >> 10) & 31u); })
    unsigned kt_next = 0u;
    { const int u0 = P3_UNIT(0); if (u0 < at::NUNITS) kt_next = __hip_atomic_load(KT0 + P3_KT0_IDX(u0), RLX_AGENT); }
    for (int i = 0; i < nrounds; ++i) {
        const int u = P3_UNIT(i); if (u >= at::NUNITS) continue;
        const int kt0 = __builtin_amdgcn_readfirstlane((int)kt_next);
        { const int un = P3_UNIT(i + 1); if (i + 1 < nrounds && un < at::NUNITS) kt_next = __hip_atomic_load(KT0 + P3_KT0_IDX(un), RLX_AGENT); }
        const unsigned tab = at::BLK_TAB[u >> 6]; const int idx = u - (int)(tab & 1023u) * 64; const int par = (tab >> 10) & 31;
        if (tab >> 15) { if (MODE != 1 && MODE != 5) at::nsa_unit(F, idx, par); } else { if (MODE != 2 && MODE != 5) at::fox_unit(F, idx, par, kt0, MODE == 1 ? PROBE_ABL : 0); }
    }
#undef P3_UNIT
#undef P3_KT0_IDX
    if (AT_PRIO_MODE != 0) __builtin_amdgcn_s_setprio(0);
    asm volatile("s_waitcnt vmcnt(0) lgkmcnt(0)" ::: "memory");
    __syncthreads();
}

struct Args { const float* in[18]; float* out; unsigned char* ws; int ph_lo, ph_hi, li, pad; };
__global__ void __launch_bounds__(NWAVES * 64, 2) fwd_kernel(Args args) {
    extern __shared__ __attribute__((aligned(16))) unsigned char lds[];
    Frame F;
    F.lds = (LAS unsigned char*)lds;
    F.MISC = (volatile LAS unsigned*)(F.lds + MISC_OFF);
    F.wave = __builtin_amdgcn_readfirstlane((int)threadIdx.x >> 6);
    F.G = gridDim.x; { const int bx = blockIdx.x; F.vcu = (F.G % 8 == 0) ? (bx % 8) * (F.G / 8) + bx / 8 : bx; }
    F.ws = args.ws; F.ctl = (gu32*)(args.ws + WS_CTL);
    F.x = args.in[0]; F.g_mix_pre = args.in[1]; F.g_mix_post = args.in[2]; F.g_mlp_pre = args.in[3]; F.g_mlp_post = args.in[4]; F.w_in = args.in[5]; F.b_forget = args.in[6];
    F.pos_k = args.in[7]; F.w1_k = args.in[8]; F.w2_k = args.in[9]; F.pos_v = args.in[10]; F.w1_v = args.in[11]; F.w2_v = args.in[12];
    F.w_fox = args.in[13]; F.w_nsa = args.in[14]; F.w_o = args.in[15]; F.w_up = args.in[16]; F.w_down = args.in[17]; F.out = args.out;
    for (int u = (int)threadIdx.x; u < (LDS_BYTES - LDSCTL_OFF) / 4; u += NWAVES * 64) ((LAS unsigned*)(F.lds + LDSCTL_OFF))[u] = 0u;
    __syncthreads();
    XcdBarrier bar; bar.bar = (unsigned*)(F.ctl + CW_BAR); bar.x = 0; bar.st = nullptr;
    if (N_LAUNCHES == 1) bar = xcd_barrier_post((unsigned*)(F.ctl + CW_BAR), F.MISC + 8);
#define GRID_BAR() do { if (N_LAUNCHES == 1) xcd_barrier(bar); } while (0)
    const int lo = args.ph_lo, hi = args.ph_hi;
#define IN(k) (lo <= (k) && (k) < hi)
#define BOTH(k) (IN(k) && IN((k) + 1))
#ifndef STAGGER_P7
#define STAGGER_P7 0
#endif
#ifndef STAGGER_P1
#define STAGGER_P1 0
#endif
#define XCD_STAGGER(ticks) do { if ((ticks) > 0) { const unsigned long long t0_ = rt(); const unsigned long long d_ = (unsigned long long)(xb_xcc_id() & 7u) * (unsigned)(ticks) / 8u; while (rt() - t0_ < d_) __builtin_amdgcn_s_sleep(8); } } while (0)
#ifndef PROBE_REPEAT
#define PROBE_REPEAT (-1)
#endif
#define REPS(k) for (int rep_ = 0; rep_ < ((PROBE_REPEAT == (k)) ? 2 : 1); ++rep_)
#define REP_BAR(k) do { if (PROBE_REPEAT == (k) && rep_ == 0) { VM_WAIT(); __syncthreads(); GRID_BAR(); } } while (0)

    if (IN(0)) { REPS(0) { p0_prologue(F); REP_BAR(0); } if (BOTH(0)) GRID_BAR(); }

    if (IN(1)) { XCD_STAGGER(STAGGER_P1);
        pg8::Gemm g{wsp<bf16>(F, WS_HB), wsp<bf16>(F, WS_WIN), MTOK, NPROJ, DMODEL}; pg8::StaticOrder S; S.init(MTOK, NPROJ, F.G, (int)blockIdx.x);
        pg8::EpiInProj E{wsp<bf16>(F, WS_FQ), wsp<bf16>(F, WS_NQ), wsp<bf16>(F, WS_KV), wsp<bf16>(F, WS_SGA),
                         wsp<float>(F, WS_LF), wsp<float>(F, WS_GATE), F.b_forget, wsp<float>(F, WS_ROPEC), wsp<float>(F, WS_ROPES), (WS_FK - WS_FQ) / 2, KV_STRIDE / 2, (WS_SGB - WS_SGA) / 2, QSCALE};
        REPS(1) { pg8::gemm_phase<pg8::EpiInProj, pg8::StaticOrder, true, true>(F.lds + RING_OFF, g, S, E, F.wave); REP_BAR(1); }
        if (BOTH(1)) GRID_BAR();
    }
    if (IN(2)) { REPS(2) { p2_phase(F); REP_BAR(2); } if (BOTH(2)) GRID_BAR(); }
#ifndef PROBE_P3_MODE
#define PROBE_P3_MODE 3
#endif
    if (IN(3)) {
#if PROBE_REPEAT == 3
        for (int rep_ = 0; rep_ < 2; ++rep_) { p3_attention(F, rep_ ? PROBE_P3_MODE : 0); if (rep_ == 0) { VM_WAIT(); __syncthreads(); GRID_BAR(); } }
#else
        p3_attention(F, 0);
#endif
        if (BOTH(3)) GRID_BAR(); }
    if (IN(4)) { REPS(4) {
        pg8::Gemm g{wsp<bf16>(F, WS_ATT), wsp<bf16>(F, WS_WF), MTOK, DMODEL, DMODEL}; pg8::StaticOrder S; S.init(MTOK, DMODEL, F.G, (int)blockIdx.x);
        pg8::EpiGateMid E{wsp<bf16>(F, WS_HB), wsp<bf16>(F, WS_SGA), wsp<bf16>(F, WS_SGB), DMODEL};
        pg8::gemm_phase<pg8::EpiGateMid, pg8::StaticOrder, true, true>(F.lds + RING_OFF, g, S, E, F.wave);
        REP_BAR(4); }
        if (BOTH(4)) GRID_BAR();
    }
    if (IN(5)) {
        pg8::Gemm g{wsp<bf16>(F, WS_HB), wsp<bf16>(F, WS_WO), MTOK, DMODEL, DMODEL}; pg8::StaticOrder S; S.init(MTOK, DMODEL, F.G, (int)blockIdx.x);
        pg8::EpiPlain<0> E{wsp<bf16>(F, WS_Y), DMODEL};
        REPS(5) { pg8::gemm_phase<pg8::EpiPlain<0>, pg8::StaticOrder, true, true>(F.lds + RING_OFF, g, S, E, F.wave); REP_BAR(5); }
        if (BOTH(5)) GRID_BAR();
    }
    if (IN(6)) { REPS(6) { row_pass<false>(F, F.x, nullptr, wsp<bf16>(F, WS_Y), F.g_mix_post, nullptr, wsp<bf16>(F, WS_HB), wsp<float>(F, WS_RSTD2)); REP_BAR(6); } if (BOTH(6)) GRID_BAR(); }
#ifndef MLP_CHUNKS
#define MLP_CHUNKS 1
#endif
    if (IN(7) || IN(8)) {
        constexpr int CH = MLP_CHUNKS, MC = MTOK / CH;
#pragma unroll
        for (int ch = 0; ch < CH; ++ch) {
            if (IN(7)) { XCD_STAGGER(STAGGER_P7);
                pg8::Gemm g{wsp<bf16>(F, WS_HB) + (size_t)ch * MC * DMODEL, wsp<bf16>(F, WS_WUP), MC, DFF, DMODEL}; pg8::StaticOrder S; S.init(MC, DFF, F.G, (int)blockIdx.x);
                pg8::EpiRelu2RsF8 E{wsp<unsigned char>(F, WS_U) + (size_t)ch * MC * DFF, wsp<float>(F, WS_RSTD2) + (size_t)ch * MC, DFF};
                REPS(7) { pg8::gemm_phase<pg8::EpiRelu2RsF8, pg8::StaticOrder, true, true>(F.lds + RING_OFF, g, S, E, F.wave); REP_BAR(7); }
                if (IN(8)) GRID_BAR(); }
            if (IN(8)) {
                pg8::Gemm g{(const pg8::bf16_t*)(wsp<unsigned char>(F, WS_U) + (size_t)ch * MC * DFF), (const pg8::bf16_t*)wsp<unsigned char>(F, WS_WDN), MC, DMODEL, DFF / 2}; pg8::StaticOrder S; S.init(MC, DMODEL, F.G, (int)blockIdx.x);
                pg8::EpiScaled E{wsp<bf16>(F, WS_Y) + (size_t)ch * MC * DMODEL, DMODEL, 1.f / WDN_SCALE};
                REPS(8) { pg8::gemm_phase<pg8::EpiScaled, pg8::StaticOrder, true, true, true>(F.lds + RING_OFF, g, S, E, F.wave); REP_BAR(8); }
                if (ch + 1 == CH && BOTH(8)) GRID_BAR(); }
        }
    }
    if (IN(9)) { row_pass<true>(F, nullptr, wsp<bf16>(F, WS_HB), wsp<bf16>(F, WS_Y), F.g_mlp_post, F.out, nullptr, nullptr); }
#undef IN
#undef BOTH
#undef GRID_BAR
}

extern "C" void kernel_launch(void* const* d_in, const int* in_sizes, int n_in, void* d_out, int out_size, void* d_ws, size_t ws_size, hipStream_t stream) {
    static int grid = 0;
    if (grid == 0) {
        if (n_in != 18 || in_sizes[0] != MTOK * DMODEL || out_size != MTOK * DMODEL || ws_size < WS_END) {
            fprintf(stderr, "kernel_launch: built for 18 inputs, x/out of %d floats, >= %zu bytes of workspace; got n_in %d, in0 %d, out %d, ws %zu; nothing launched\n", MTOK * DMODEL, (size_t)WS_END, n_in, n_in > 0 ? in_sizes[0] : -1, out_size, ws_size); grid = -1; return; }
        int dev = 0, cus = 0, per_cu = 0;
        if (hipGetDevice(&dev) != hipSuccess || hipDeviceGetAttribute(&cus, hipDeviceAttributeMultiprocessorCount, dev) != hipSuccess) { fprintf(stderr, "kernel_launch: device query failed\n"); grid = -1; return; }
        if (hipFuncSetAttribute((const void*)fwd_kernel, hipFuncAttributeMaxDynamicSharedMemorySize, LDS_BYTES) != hipSuccess) { fprintf(stderr, "kernel_launch: hipFuncSetAttribute failed\n"); grid = -1; return; }
        if (hipOccupancyMaxActiveBlocksPerMultiprocessor(&per_cu, (const void*)fwd_kernel, NWAVES * 64, LDS_BYTES) != hipSuccess || per_cu < 1)
            fprintf(stderr, "kernel_launch: note: occupancy query reports %d workgroups per CU\n", per_cu);
        (void)hipGetLastError();
        grid = 256;
        if (cus < grid) fprintf(stderr, "kernel_launch: this device reports %d CUs; the 256-workgroup grid cannot be resident: the grid barrier will time out (bounded) and the output will be wrong\n", cus);
    }
    if (grid < 0) return;
    if (hipMemsetAsync((char*)d_ws + WS_CTL, 0, CTL_ZERO_BYTES, stream) != hipSuccess) { fprintf(stderr, "kernel_launch: hipMemsetAsync failed\n"); return; }
    Args a{};
    for (int i = 0; i < 18; ++i) a.in[i] = (const float*)d_in[i];
    a.out = (float*)d_out; a.ws = (unsigned char*)d_ws;
    for (int li = 0; li < N_LAUNCHES; ++li) {
        a.ph_lo = (N_LAUNCHES == 1) ? 0 : li; a.ph_hi = (N_LAUNCHES == 1) ? N_PHASES : li + 1; a.li = li; a.pad = 0;
        hipLaunchKernelGGL(fwd_kernel, dim3(grid), dim3(NWAVES * 64), LDS_BYTES, stream, a);
        const hipError_t le = hipPeekAtLastError();
        if (le != hipSuccess) { fprintf(stderr, "kernel_launch: launch %d failed: %s\n", li, hipGetErrorName(le)); break; }
    }
}
```

```cpp
#include <hip/hip_runtime.h>
#include <cstdio>
#include <cstdint>
#include <cmath>
namespace pg8 {
#define PG8_LAS __attribute__((address_space(3)))
typedef unsigned short bf16_t;
typedef short bf16x8 __attribute__((ext_vector_type(8)));
typedef float f32x4 __attribute__((ext_vector_type(4)));
typedef unsigned u32x4 __attribute__((ext_vector_type(4)));
constexpr int BM = 256, BK = 64, HALF = 128, HTB = HALF * BK * 2  , STAGE_BYTES = 8 * HTB, NXCD = 8, WGM = 8;

__host__ __device__ __forceinline__ int lds_byte(int r, int c) { const int st = (r >> 4) * 2 + (c >> 5), rr = r & 15, cc = c & 31, ob = rr * 64 + cc * 2; return st * 1024 + (ob ^ (((ob >> 9) & 1) << 5)); }
__host__ __device__ __forceinline__ void stage_rc(int b, int& R, int& C) { const int st = b / 1024, sb = b % 1024, swz = sb ^ (((sb >> 9) & 1) << 5); R = (st >> 1) * 16 + swz / 64; C = (st & 1) * 32 + (swz % 64) / 2; }
__host__ __device__ __forceinline__ int perm32(int rho) { const int n = rho >> 4, i = rho & 15; return 8 * (i >> 2) + 4 * n + (i & 3); }

__host__ __device__ __forceinline__ int perm16(int R) { const int w = R >> 5, n = (R >> 4) & 1, i = R & 15; return 64 * w + 16 * (i >> 2) + 4 * n + (i & 3); }
struct Unit { int pm, pn; };
struct Gemm { const bf16_t* A; const bf16_t* Bt; int M, N, K; };

struct StaticOrder {
    int nM, nN, nwg, G, c;
    __host__ __device__ void init(int M, int N, int G_, int c_) { nM = M / BM; nN = N / BM; nwg = nM * nN; G = G_; c = c_; }
    __host__ __device__ bool next(int i, Unit& u) const {
        const long L = (long)i * G + c; if (L >= nwg) return false;
        int wgid = (int)L; { const int q = nwg / NXCD, r = nwg % NXCD, xcd = wgid % NXCD, off = wgid / NXCD; wgid = (xcd < r ? xcd * (q + 1) : r * (q + 1) + (xcd - r) * q) + off; }
        const int nig = WGM * nN, gid = wgid / nig, fm = gid * WGM, gsz = (nM - fm) < WGM ? (nM - fm) : WGM;
        u.pm = fm + ((wgid % nig) % gsz); u.pn = (wgid % nig) / gsz; return true;
    }
    __device__ __forceinline__ void a_ready(const Unit&) const {}
    __device__ __forceinline__ void done(const Unit&) const {}
};

__device__ __forceinline__ unsigned cvt_pk_bf16(float lo, float hi) { unsigned r; asm volatile("v_cvt_pk_bf16_f32 %0, %1, %2" : "=v"(r) : "v"(lo), "v"(hi)); return r; }
typedef float f32x2 __attribute__((ext_vector_type(2)));
typedef int i32x8 __attribute__((ext_vector_type(8)));
typedef int i32x4 __attribute__((ext_vector_type(4)));
__device__ __forceinline__ i32x8 cat8(const bf16x8& a, const bf16x8& b) { const i32x4 x = __builtin_bit_cast(i32x4, a), y = __builtin_bit_cast(i32x4, b); return __builtin_shufflevector(x, y, 0, 1, 2, 3, 4, 5, 6, 7); }
constexpr float F8_MAX = 448.f;
__device__ __forceinline__ unsigned cvt4_fp8(float a, float b, float c, float d) {
    int r = 0; r = __builtin_amdgcn_cvt_pk_fp8_f32(fminf(a, F8_MAX), fminf(b, F8_MAX), r, false); r = __builtin_amdgcn_cvt_pk_fp8_f32(fminf(c, F8_MAX), fminf(d, F8_MAX), r, true); return (unsigned)r; }
__device__ __forceinline__ void mfma_f8_inplace(f32x4& c, const i32x8 a, const i32x8 b) { asm volatile("v_mfma_f32_16x16x128_f8f6f4 %0, %1, %2, %0" : "+v"(c) : "v"(a), "v"(b)); }
__device__ __forceinline__ float bf_lo(unsigned w) { return __uint_as_float(w << 16); }
__device__ __forceinline__ float bf_hi(unsigned w) { return __uint_as_float(w & 0xffff0000u); }
__device__ __forceinline__ float sigmoid_f(float x) { return __builtin_amdgcn_rcpf(1.0f + __expf(-x)); }
typedef unsigned u32x2 __attribute__((ext_vector_type(2)));
__device__ __forceinline__ u32x4 pack8(const f32x4& a, const f32x4& b) { u32x4 w; w.x = cvt_pk_bf16(a[0], a[1]); w.y = cvt_pk_bf16(a[2], a[3]); w.z = cvt_pk_bf16(b[0], b[1]); w.w = cvt_pk_bf16(b[2], b[3]); return w; }
__device__ __forceinline__ u32x2 pack4(const f32x4& a) { u32x2 w; w.x = cvt_pk_bf16(a[0], a[1]); w.y = cvt_pk_bf16(a[2], a[3]); return w; }

struct EpiInProj {
    static constexpr bool PERM = true, PERM16 = false, AFTER_DRAIN = false, MIDK = false;
    bf16_t *QKV, *NQ, *KVB, *SG;
    float *LF, *GATE; const float* bforget; const float *ROPEC, *ROPES; size_t qkvs, kvs, sgs; float qscale;
    __device__ __forceinline__ void operator()(const f32x4 (&acc)[2][2][4][2], const Unit& u, int wr, int wc, int fr, int fq) const {
        const int pn = u.pn; const bool roped = pn >= 6 && pn < 11; const int i4 = (4 * (wc & 1) + fq) * 4;
#pragma unroll
        for (int ai = 0; ai < 2; ++ai) {
#pragma unroll
          for (int mp = 0; mp < 2; ++mp) {
            f32x4 csv[8];
            if (roped) {
#pragma unroll
                for (int mm = 0; mm < 2; ++mm) { const int t_ = (u.pm * BM + ai * HALF + wr * 64 + (2 * mp + mm) * 16 + fr) & 2047; csv[mm] = *(const f32x4*)(ROPEC + t_ * 32 + i4); csv[4 + mm] = *(const f32x4*)(ROPES + t_ * 32 + i4); }
                asm volatile("" : "+v"(csv[0]), "+v"(csv[1]), "+v"(csv[4]), "+v"(csv[5])); }
#pragma unroll
            for (int mm = 0; mm < 2; ++mm) { const int m = 2 * mp + mm;
                const int row = u.pm * BM + ai * HALF + wr * 64 + m * 16 + fr; const int t = row & 2047, b = row >> 11; (void)t;
#pragma unroll
                for (int bj = 0; bj < 2; ++bj) {
                    const int tc = bj * HALF + wc * 32 + 8 * fq;
                    f32x4 v0 = acc[ai][bj][m][0], v1 = acc[ai][bj][m][1];
                    if (pn < 6) {
                        bf16_t* base = QKV + (size_t)(pn >> 1) * qkvs; const float sc = pn < 2 ? qscale : 1.0f;
                        *(u32x4*)(base + (size_t)row * 512 + (pn & 1) * 256 + tc) = pack8(v0 * sc, v1 * sc);
                    } else if (pn < 8) {
                        const int head = (pn - 6) * 4 + (tc >> 6);
                        const f32x4 cs = csv[mm], sn = csv[4 + mm];
                        const f32x4 lo = (v0 * cs - v1 * sn) * qscale, hi = (v1 * cs + v0 * sn) * qscale;
                        bf16_t* d = NQ + (size_t)row * 512 + head * 64 + i4;
                        *(u32x2*)d = pack4(lo); *(u32x2*)(d + 32) = pack4(hi);
                    } else if (pn < 11) {
                        const int sel = pn - 8;
                        if (bj == 0) {
                            const int g = tc >> 6;
                            const f32x4 cs = csv[mm], sn = csv[4 + mm];
                            const f32x4 lo = v0 * cs - v1 * sn, hi = v1 * cs + v0 * sn;
                            bf16_t* d = KVB + (size_t)(2 * sel) * kvs + ((size_t)((b * 2 + g) * 2048 + t)) * 64 + i4;
                            *(u32x2*)d = pack4(lo); *(u32x2*)(d + 32) = pack4(hi);
                        } else {
                            const int tv = tc - HALF, g = tv >> 6, dd = tv & 63;
                            bf16_t* d = KVB + (size_t)(2 * sel + 1) * kvs + ((size_t)((b * 2 + g) * 2048 + t)) * 64 + dd;
                            *(u32x4*)d = pack8(v0, v1);
                        }
                    } else if (pn < 19) {
                        if (bj == 0) { const int ct = (pn - 11) * 128 + wc * 32 + 8 * fq; const f32x4 w0 = acc[ai][1][m][0], w1 = acc[ai][1][m][1];
                            f32x4 a, c, ra, rc;
#pragma unroll
                            for (int k = 0; k < 4; ++k) { const float ea = __expf(-v0[k]), ec = __expf(-v1[k]), fa = __expf(-w0[k]), fc = __expf(-w1[k]);
                                a[k] = __builtin_amdgcn_rcpf(1.0f + ea); c[k] = __builtin_amdgcn_rcpf(1.0f + ec); ra[k] = (1.0f + ea) * __builtin_amdgcn_rcpf(1.0f + fa); rc[k] = (1.0f + ec) * __builtin_amdgcn_rcpf(1.0f + fc); }
                            __builtin_nontemporal_store(pack8(a, c), (u32x4*)(SG + (size_t)row * 1024 + ct)); __builtin_nontemporal_store(pack8(ra, rc), (u32x4*)(SG + sgs + (size_t)row * 1024 + ct)); }
                    } else {
                        if (bj == 0 && wc == 0) {
                            if (fq == 0) {
                                f32x4 a, c;
#pragma unroll
                                for (int k = 0; k < 4; ++k) { const float x0 = v0[k] + bforget[k], x1 = v1[k] + bforget[4 + k];
                                    a[k] = fminf(x0, 0.f) - log1pf(__expf(-fabsf(x0))); c[k] = fminf(x1, 0.f) - log1pf(__expf(-fabsf(x1))); }
                                *(f32x4*)(LF + (size_t)row * 8) = a; *(f32x4*)(LF + (size_t)row * 8 + 4) = c;
                            } else {
                                f32x4 a, c;
#pragma unroll
                                for (int k = 0; k < 4; ++k) { a[k] = sigmoid_f(v0[k]); c[k] = sigmoid_f(v1[k]); }
                                *(f32x4*)(GATE + (size_t)row * 24 + 8 * (fq - 1)) = a; *(f32x4*)(GATE + (size_t)row * 24 + 8 * (fq - 1) + 4) = c;
                            }
                        }
                    }
                }
            }
          }
        }
    }
};
#define PIN8(a) asm volatile("" : "+v"(a[0]), "+v"(a[1]), "+v"(a[2]), "+v"(a[3]), "+v"(a[4]), "+v"(a[5]), "+v"(a[6]), "+v"(a[7]))
struct EpiGate {
    static constexpr bool PERM = true, PERM16 = false, AFTER_DRAIN = false, MIDK = false;
    bf16_t* O; const bf16_t* gate; const bf16_t* addend; int ldc;
    __device__ __forceinline__ void operator()(const f32x4 (&acc)[2][2][4][2], const Unit& u, int wr, int wc, int fr, int fq) const {
#pragma unroll
        for (int ai = 0; ai < 2; ++ai) {
            const size_t base = (size_t)(u.pm * BM + ai * HALF + wr * 64 + fr) * ldc + u.pn * BM + wc * 32 + 8 * fq;
            u32x4 gw[8], aw[8];
#pragma unroll
            for (int k = 0; k < 8; ++k) gw[k] = *(const u32x4*)(gate + base + (size_t)((k >> 1) * 16) * ldc + (k & 1) * HALF);
            PIN8(gw);
            if (addend) {
#pragma unroll
                for (int k = 0; k < 8; ++k) aw[k] = *(const u32x4*)(addend + base + (size_t)((k >> 1) * 16) * ldc + (k & 1) * HALF);
                PIN8(aw); }
#pragma unroll
            for (int k = 0; k < 8; ++k) { const int m = k >> 1, bj = k & 1; const u32x4 g = gw[k];
                f32x4 v0 = acc[ai][bj][m][0], v1 = acc[ai][bj][m][1];
                v0[0] *= bf_lo(g.x); v0[1] *= bf_hi(g.x); v0[2] *= bf_lo(g.y); v0[3] *= bf_hi(g.y);
                v1[0] *= bf_lo(g.z); v1[1] *= bf_hi(g.z); v1[2] *= bf_lo(g.w); v1[3] *= bf_hi(g.w);
                if (addend) { const u32x4 a = aw[k];
                    v0[0] += bf_lo(a.x); v0[1] += bf_hi(a.x); v0[2] += bf_lo(a.y); v0[3] += bf_hi(a.y);
                    v1[0] += bf_lo(a.z); v1[1] += bf_hi(a.z); v1[2] += bf_lo(a.w); v1[3] += bf_hi(a.w); }
                *(u32x4*)(O + base + (size_t)(m * 16) * ldc + bj * HALF) = pack8(v0, v1); }
        }
    }
};
struct EpiGateMid {
    static constexpr bool PERM = true, PERM16 = false, AFTER_DRAIN = false, MIDK = true;
    bf16_t* O; const bf16_t* sga; const bf16_t* rr; int ldc;
    __device__ __forceinline__ void scale(f32x4 (&acc)[2][2][4][2], const bf16_t* g, const Unit& u, int wr, int wc, int fr, int fq, bf16_t* out) const {
#pragma unroll
        for (int ai = 0; ai < 2; ++ai) {
            const size_t base = (size_t)(u.pm * BM + ai * HALF + wr * 64 + fr) * ldc + u.pn * BM + wc * 32 + 8 * fq;
            u32x4 gw[8];
#pragma unroll
            for (int k = 0; k < 8; ++k) gw[k] = *(const u32x4*)(g + base + (size_t)((k >> 1) * 16) * ldc + (k & 1) * HALF);
            PIN8(gw);
#pragma unroll
            for (int k = 0; k < 8; ++k) { const int m = k >> 1, bj = k & 1; const u32x4 w = gw[k];
                f32x4& v0 = acc[ai][bj][m][0]; f32x4& v1 = acc[ai][bj][m][1];
                v0[0] *= bf_lo(w.x); v0[1] *= bf_hi(w.x); v0[2] *= bf_lo(w.y); v0[3] *= bf_hi(w.y);
                v1[0] *= bf_lo(w.z); v1[1] *= bf_hi(w.z); v1[2] *= bf_lo(w.w); v1[3] *= bf_hi(w.w);
                if (out) *(u32x4*)(out + base + (size_t)(m * 16) * ldc + bj * HALF) = pack8(v0, v1); }
        }
    }
    __device__ __forceinline__ void mid(f32x4 (&acc)[2][2][4][2], const Unit& u, int wr, int wc, int fr, int fq) const { int fr_ = fr; asm volatile("" : "+v"(fr_));
        scale(acc, rr, u, wr, wc, fr_, fq, nullptr); }
    __device__ __forceinline__ void operator()(const f32x4 (&acc)[2][2][4][2], const Unit& u, int wr, int wc, int fr, int fq) const {
#pragma unroll
        for (int ai = 0; ai < 2; ++ai) {
            const size_t base = (size_t)(u.pm * BM + ai * HALF + wr * 64 + fr) * ldc + u.pn * BM + wc * 32 + 8 * fq;
            u32x4 gw[8];
#pragma unroll
            for (int k = 0; k < 8; ++k) gw[k] = *(const u32x4*)(sga + base + (size_t)((k >> 1) * 16) * ldc + (k & 1) * HALF);
            PIN8(gw);
#pragma unroll
            for (int k = 0; k < 8; ++k) { const int m = k >> 1, bj = k & 1; const u32x4 w = gw[k];
                f32x4 v0 = acc[ai][bj][m][0], v1 = acc[ai][bj][m][1];
                v0[0] *= bf_lo(w.x); v0[1] *= bf_hi(w.x); v0[2] *= bf_lo(w.y); v0[3] *= bf_hi(w.y);
                v1[0] *= bf_lo(w.z); v1[1] *= bf_hi(w.z); v1[2] *= bf_lo(w.w); v1[3] *= bf_hi(w.w);
                *(u32x4*)(O + base + (size_t)(m * 16) * ldc + bj * HALF) = pack8(v0, v1); }
        }
    }
};
template <int ACT> struct EpiPlain {
    static constexpr bool PERM = true, PERM16 = false, AFTER_DRAIN = false, MIDK = false;
    bf16_t* O; int ldc;
    __device__ __forceinline__ void operator()(const f32x4 (&acc)[2][2][4][2], const Unit& u, int wr, int wc, int fr, int fq) const {
#pragma unroll
        for (int ai = 0; ai < 2; ++ai)
#pragma unroll
            for (int m = 0; m < 4; ++m) {
                const size_t rowo = (size_t)(u.pm * BM + ai * HALF + wr * 64 + m * 16 + fr) * ldc + u.pn * BM + wc * 32 + 8 * fq;
#pragma unroll
                for (int bj = 0; bj < 2; ++bj) {
                    f32x4 v0 = acc[ai][bj][m][0], v1 = acc[ai][bj][m][1];
                    if (ACT == 1) {
#pragma unroll
                        for (int k = 0; k < 4; ++k) { const float a = fmaxf(v0[k], 0.f), c = fmaxf(v1[k], 0.f); v0[k] = a * a; v1[k] = c * c; }
                    }
                    *(u32x4*)(O + rowo + bj * HALF) = pack8(v0, v1);
                }
            }
    }
};

struct EpiRelu2Rs {
    static constexpr bool PERM = true, PERM16 = false, AFTER_DRAIN = false, MIDK = false;
    bf16_t* O; const float* rs; int ldc;
    __device__ __forceinline__ void operator()(const f32x4 (&acc)[2][2][4][2], const Unit& u, int wr, int wc, int fr, int fq) const {
        float rv[8];
#pragma unroll
        for (int k = 0; k < 8; ++k) rv[k] = rs[u.pm * BM + (k >> 2) * HALF + wr * 64 + (k & 3) * 16 + fr];
        PIN8(rv);
#pragma unroll
        for (int ai = 0; ai < 2; ++ai)
#pragma unroll
            for (int m = 0; m < 4; ++m) { const float r = rv[ai * 4 + m];
                const size_t rowo = (size_t)(u.pm * BM + ai * HALF + wr * 64 + m * 16 + fr) * ldc + u.pn * BM + wc * 32 + 8 * fq;
#pragma unroll
                for (int bj = 0; bj < 2; ++bj) { f32x4 v0 = acc[ai][bj][m][0], v1 = acc[ai][bj][m][1];
#pragma unroll
                    for (int k = 0; k < 4; ++k) { const float a = fmaxf(v0[k] * r, 0.f), c = fmaxf(v1[k] * r, 0.f); v0[k] = a * a; v1[k] = c * c; }
                    __builtin_nontemporal_store(pack8(v0, v1), (u32x4*)(O + rowo + bj * HALF)); } }
    }
};

struct EpiRelu2F8 {
    static constexpr bool PERM = true, PERM16 = true, AFTER_DRAIN = false, MIDK = false;
    unsigned char* O; int ldc;
    __device__ __forceinline__ void operator()(const f32x4 (&acc)[2][2][4][2], const Unit& u, int wr, int wc, int fr, int fq) const {
#pragma unroll
        for (int ai = 0; ai < 2; ++ai)
#pragma unroll
            for (int m = 0; m < 4; ++m) {
                const size_t rowo = (size_t)(u.pm * BM + ai * HALF + wr * 64 + m * 16 + fr) * ldc + u.pn * BM + wc * 64 + 16 * fq;
                u32x4 o;
#pragma unroll
                for (int bj = 0; bj < 2; ++bj) { f32x4 v0 = acc[ai][bj][m][0], v1 = acc[ai][bj][m][1];
#pragma unroll
                    for (int k = 0; k < 4; ++k) { const float a = fmaxf(v0[k], 0.f), c = fmaxf(v1[k], 0.f); v0[k] = a * a; v1[k] = c * c; }
                    o[2 * bj] = cvt4_fp8(v0[0], v0[1], v0[2], v0[3]); o[2 * bj + 1] = cvt4_fp8(v1[0], v1[1], v1[2], v1[3]); }
                __builtin_nontemporal_store(o, (u32x4*)(O + rowo)); }
    }
};
struct EpiScaled {
    static constexpr bool PERM = true, PERM16 = false, AFTER_DRAIN = false, MIDK = false;
    bf16_t* O; int ldc; float sc;
    __device__ __forceinline__ void operator()(const f32x4 (&acc)[2][2][4][2], const Unit& u, int wr, int wc, int fr, int fq) const {
#pragma unroll
        for (int ai = 0; ai < 2; ++ai)
#pragma unroll
            for (int m = 0; m < 4; ++m) {
                const size_t rowo = (size_t)(u.pm * BM + ai * HALF + wr * 64 + m * 16 + fr) * ldc + u.pn * BM + wc * 32 + 8 * fq;
#pragma unroll
                for (int bj = 0; bj < 2; ++bj) *(u32x4*)(O + rowo + bj * HALF) = pack8(acc[ai][bj][m][0] * sc, acc[ai][bj][m][1] * sc);
            }
    }
};
template <class Epi, class Sched, bool ALIGN_EPI = false, bool SP2 = false, bool F8 = false>
__device__ __forceinline__ void gemm_phase(PG8_LAS unsigned char* lds, const Gemm g, const Sched& S, const Epi& E, const int wave_id  ) {
    int tid_ = wave_id * 64 + (int)__builtin_amdgcn_mbcnt_hi(~0u, __builtin_amdgcn_mbcnt_lo(~0u, 0u)); asm volatile("" : "+v"(tid_));
    const int tid = tid_, wid = __builtin_amdgcn_readfirstlane(tid >> 6), lane = tid & 63, wr = wid >> 2, wc = wid & 3, fr = lane & 15, fq = lane >> 4;
    const int K = g.K, nt = K / BK;
    unsigned voffA[2], voffB[2];
#pragma unroll
    for (int i = 0; i < 2; ++i) { int R, C; stage_rc(tid * 16 + i * 8192, R, C); const int Rb = Epi::PERM16 ? perm16(R) : Epi::PERM ? ((R & ~31) + perm32(R & 31)) : R;
        voffA[i] = (unsigned)(R * K + C) * 2u; voffB[i] = (unsigned)(Rb * K + C) * 2u; }
    const size_t kstep = (size_t)(BK * 2);
    const size_t hstep = (size_t)HALF * K * 2;
    const size_t bhstep = Epi::PERM16 ? (size_t)8 * K * 2 : hstep;
    const size_t tstep = 2 * hstep;
    const unsigned ldsw = (unsigned)wid * 1024u;
    const int aoff = lds_byte(wr * 64 + fr, fq * 8), boff = lds_byte(wc * 32 + fr, fq * 8);
#define PG8_SA(b, h) (((b) * 2 + (h)) * HTB)
#define PG8_SB(b, h) ((4 + (b) * 2 + (h)) * HTB)
#define PG8_STAGE(bufoff, gbase, voff) do { _Pragma("unroll") for (int _i = 0; _i < 2; ++_i) \
        __builtin_amdgcn_global_load_lds((const unsigned*)((const char*)(gbase) + (voff)[_i]), (PG8_LAS unsigned*)(lds + (bufoff) + ldsw + _i * 8192), 16, 0, 0); } while (0)
#define PG8_LDA(dst, b, h) do { _Pragma("unroll") for (int m = 0; m < 4; ++m) _Pragma("unroll") for (int k = 0; k < 2; ++k) dst[m][k] = *(const PG8_LAS bf16x8*)(lds + PG8_SA(b, h) + aoff + m * 2048 + k * 1024); } while (0)
#define PG8_LDB(dst, b, h) do { _Pragma("unroll") for (int n = 0; n < 2; ++n) _Pragma("unroll") for (int k = 0; k < 2; ++k) dst[n][k] = *(const PG8_LAS bf16x8*)(lds + PG8_SB(b, h) + boff + n * 2048 + k * 1024); } while (0)
#define PG8_MMA(ai, bj, At, Bt) do { __builtin_amdgcn_s_setprio(1); _Pragma("unroll") for (int m = 0; m < 4; ++m) _Pragma("unroll") for (int n = 0; n < 2; ++n) { \
        if constexpr (F8) mfma_f8_inplace(acc[ai][bj][m][n], cat8(Bt[n][0], Bt[n][1]), cat8(At[m][0], At[m][1])); \
        else { _Pragma("unroll") for (int k = 0; k < 2; ++k) acc[ai][bj][m][n] = __builtin_amdgcn_mfma_f32_16x16x32_bf16(Bt[n][k], At[m][k], acc[ai][bj][m][n], 0, 0, 0); } } __builtin_amdgcn_s_setprio(0); } while (0)
#define PG8_WAIT_V(n) asm volatile("s_waitcnt vmcnt(" #n ")" ::: "memory")
#define PG8_WAIT_L(n) asm volatile("s_waitcnt lgkmcnt(" #n ")" ::: "memory")
#define PG8_BAR __builtin_amdgcn_s_barrier()
#define PG8_SCHED __builtin_amdgcn_sched_barrier(0)
    Unit cur, nxt; int ui = 0;
    if (!S.next(0, cur)) return;
    f32x4 acc[2][2][4][2];
#pragma unroll
    for (int a = 0; a < 2; ++a)
#pragma unroll
        for (int b = 0; b < 2; ++b)
#pragma unroll
            for (int m = 0; m < 4; ++m)
#pragma unroll
                for (int n = 0; n < 2; ++n) acc[a][b][m][n] = (f32x4){0.f, 0.f, 0.f, 0.f};
    bf16x8 At[4][2], B0[2][2], B1[2][2];
    const char* cA = (const char*)g.A + (size_t)cur.pm * tstep; const char* cB = (const char*)g.Bt + (size_t)cur.pn * tstep;
    S.a_ready(cur);
    if constexpr (SP2) {
        PG8_STAGE(PG8_SB(0, 0), cB, voffB); PG8_STAGE(PG8_SB(0, 1), cB + bhstep, voffB); PG8_STAGE(PG8_SA(0, 0), cA, voffA); PG8_STAGE(PG8_SA(0, 1), cA + hstep, voffA);
        if (wr == 1) PG8_BAR;
        PG8_WAIT_V(2); PG8_BAR;
        PG8_STAGE(PG8_SB(1, 0), cB + kstep, voffB); PG8_STAGE(PG8_SA(1, 0), cA + kstep, voffA); PG8_STAGE(PG8_SB(1, 1), cB + bhstep + kstep, voffB);
        PG8_WAIT_V(6); PG8_BAR;
    } else {
        PG8_STAGE(PG8_SB(0, 0), cB, voffB); PG8_STAGE(PG8_SA(0, 0), cA, voffA); PG8_STAGE(PG8_SB(0, 1), cB + bhstep, voffB); PG8_STAGE(PG8_SA(0, 1), cA + hstep, voffA);
        if (wr == 1) PG8_BAR;
        PG8_WAIT_V(4); PG8_BAR;
        PG8_STAGE(PG8_SB(1, 0), cB + kstep, voffB); PG8_STAGE(PG8_SA(1, 0), cA + kstep, voffA); PG8_STAGE(PG8_SB(1, 1), cB + bhstep + kstep, voffB);
        PG8_WAIT_V(6); PG8_BAR;
    }
    for (;;) {
        const bool has_next = S.next(ui + 1, nxt);
        const char* nA = has_next ? (const char*)g.A + (size_t)nxt.pm * tstep : cA; const char* nB = has_next ? (const char*)g.Bt + (size_t)nxt.pn * tstep : cB;
        for (int t = 0; t < nt; t += 2) {
            if constexpr (Epi::MIDK) { if (t == nt / 2) E.mid(acc, cur, wr, wc, fr, fq); }
            const bool last = (t == nt - 2);
            const char* a1 = cA + (size_t)(t + 1) * kstep;
            const char* a2 = last ? nA : cA + (size_t)(t + 2) * kstep; const char* b2 = last ? nB : cB + (size_t)(t + 2) * kstep;
            const char* a3 = a2 + kstep; const char* b3 = b2 + kstep;
            if (last && has_next) S.a_ready(nxt);
            if constexpr (SP2) {
            PG8_LDB(B0, 0, 0); PG8_LDB(B1, 0, 1); PG8_SCHED; PG8_LDA(At, 0, 0); PG8_STAGE(PG8_SA(1, 1), a1 + hstep, voffA);
            PG8_WAIT_V(8); PG8_WAIT_L(0); PG8_BAR; PG8_MMA(0, 0, At, B0); PG8_MMA(0, 1, At, B1); PG8_BAR; PG8_SCHED;
            PG8_LDA(At, 0, 1); PG8_STAGE(PG8_SB(0, 0), b2, voffB); PG8_STAGE(PG8_SB(0, 1), b2 + bhstep, voffB); PG8_STAGE(PG8_SA(0, 0), a2, voffA);
            PG8_WAIT_V(8); PG8_WAIT_L(0); PG8_BAR; PG8_MMA(1, 0, At, B0); PG8_MMA(1, 1, At, B1); PG8_BAR; PG8_SCHED;
            PG8_LDB(B0, 1, 0); PG8_LDB(B1, 1, 1); PG8_SCHED; PG8_LDA(At, 1, 0); PG8_STAGE(PG8_SA(0, 1), a2 + hstep, voffA);
            PG8_WAIT_V(8); PG8_WAIT_L(0); PG8_BAR; PG8_MMA(0, 0, At, B0); PG8_MMA(0, 1, At, B1); PG8_BAR; PG8_SCHED;
            PG8_LDA(At, 1, 1); PG8_STAGE(PG8_SB(1, 0), b3, voffB); PG8_STAGE(PG8_SB(1, 1), b3 + bhstep, voffB); PG8_STAGE(PG8_SA(1, 0), a3, voffA);
            PG8_WAIT_V(8); PG8_WAIT_L(0); PG8_BAR; PG8_MMA(1, 0, At, B0); PG8_MMA(1, 1, At, B1); PG8_BAR; PG8_SCHED;
            } else {
            PG8_LDB(B0, 0, 0); PG8_SCHED; PG8_LDA(At, 0, 0); PG8_STAGE(PG8_SA(1, 1), a1 + hstep, voffA);
            PG8_WAIT_L(8); PG8_BAR; PG8_WAIT_L(0); PG8_MMA(0, 0, At, B0); PG8_BAR; PG8_SCHED;
            PG8_LDB(B1, 0, 1); PG8_STAGE(PG8_SB(0, 0), b2, voffB);
            PG8_BAR; PG8_WAIT_L(0); PG8_MMA(0, 1, At, B1); PG8_BAR;
            PG8_LDA(At, 0, 1); PG8_STAGE(PG8_SA(0, 0), a2, voffA);
            PG8_BAR; PG8_WAIT_L(0); PG8_MMA(1, 0, At, B0); PG8_BAR; PG8_SCHED;
            PG8_STAGE(PG8_SB(0, 1), b2 + bhstep, voffB);
            PG8_WAIT_V(6); PG8_BAR; PG8_MMA(1, 1, At, B1); PG8_BAR;
            PG8_LDB(B0, 1, 0); PG8_SCHED; PG8_LDA(At, 1, 0); PG8_STAGE(PG8_SA(0, 1), a2 + hstep, voffA);
            PG8_WAIT_L(8); PG8_BAR; PG8_WAIT_L(0); PG8_MMA(0, 0, At, B0); PG8_BAR; PG8_SCHED;
            PG8_LDB(B1, 1, 1); PG8_STAGE(PG8_SB(1, 0), b3, voffB);
            PG8_BAR; PG8_WAIT_L(0); PG8_MMA(0, 1, At, B1); PG8_BAR;
            PG8_LDA(At, 1, 1); PG8_STAGE(PG8_SA(1, 0), a3, voffA);
            PG8_BAR; PG8_WAIT_L(0); PG8_MMA(1, 0, At, B0); PG8_BAR; PG8_SCHED;
            PG8_STAGE(PG8_SB(1, 1), b3 + bhstep, voffB);
            PG8_WAIT_V(6); PG8_BAR; PG8_MMA(1, 1, At, B1); PG8_BAR;
            }
        }
        if constexpr (F8) asm volatile("s_nop 15\n\ts_nop 15" ::: "memory");
        if constexpr (ALIGN_EPI) { if (wr == 0) PG8_BAR; }
        if constexpr (!Epi::AFTER_DRAIN) { E(acc, cur, wr, wc, fr, fq); S.done(cur); }
        if (!has_next) break;
#pragma unroll
        for (int a = 0; a < 2; ++a)
#pragma unroll
            for (int b = 0; b < 2; ++b)
#pragma unroll
                for (int m = 0; m < 4; ++m)
#pragma unroll
                    for (int n = 0; n < 2; ++n) acc[a][b][m][n] = (f32x4){0.f, 0.f, 0.f, 0.f};
        cur = nxt; cA = nA; cB = nB; ++ui;
        if constexpr (ALIGN_EPI) { if (wr == 1) PG8_BAR; }
    }
    PG8_WAIT_V(0);
    if constexpr (!ALIGN_EPI) { if (wr == 0) PG8_BAR; }
    PG8_BAR;
    if constexpr (Epi::AFTER_DRAIN) { E.fused(acc, cur, wr, wc, fr, fq, lds, wid, lane); S.done(cur); }
#undef PG8_SA
#undef PG8_SB
#undef PG8_STAGE
#undef PG8_LDA
#undef PG8_LDB
#undef PG8_MMA
#undef PG8_WAIT_V
#undef PG8_WAIT_L
#undef PG8_BAR
#undef PG8_SCHED
}
}
#define GAS __attribute__((address_space(1)))
#define LAS __attribute__((address_space(3)))
typedef unsigned short bf16;
typedef unsigned v4u __attribute__((ext_vector_type(4)));
typedef float f32x4 __attribute__((ext_vector_type(4)));
typedef short bf16x8 __attribute__((ext_vector_type(8)));
typedef GAS unsigned gu32;
typedef GAS unsigned long long gu64;
#define RLX_AGENT __ATOMIC_RELAXED, __HIP_MEMORY_SCOPE_AGENT
#define LDS_WAIT() asm volatile("s_waitcnt lgkmcnt(0)" ::: "memory")
#define VM_WAIT() asm volatile("s_waitcnt vmcnt(0)" ::: "memory")
__device__ __forceinline__ unsigned long long rt() { return __builtin_amdgcn_s_memrealtime(); }
__device__ __forceinline__ unsigned f2bf(float f) { unsigned u = __builtin_bit_cast(unsigned, f); return (u + 0x7fffu + ((u >> 16) & 1u)) >> 16; }
__device__ __forceinline__ unsigned pk2(float lo, float hi) { return f2bf(lo) | (f2bf(hi) << 16); }

#define XB_TMO      128
#define XB_XCNT(j)  (256  + 64 * (j))
#define XB_XSUB(j)  (1280 + 64 * (j))
#define XB_XGEN(j)  (2304 + 64 * (j))
#define XB_TOP      3328
#define XB_TOPGEN   3392
#define XCD_BAR_WORDS 3456
#define XB_SPIN_CAP (1u << 18)

__device__ __forceinline__ unsigned xb_ld(unsigned* p)              { return __hip_atomic_load(p, __ATOMIC_RELAXED, __HIP_MEMORY_SCOPE_AGENT); }
__device__ __forceinline__ unsigned xb_add(unsigned* p, unsigned v) { return __hip_atomic_fetch_add(p, v, __ATOMIC_RELAXED, __HIP_MEMORY_SCOPE_AGENT); }
__device__ __forceinline__ unsigned xb_xcc_id() { return (unsigned)__builtin_amdgcn_s_getreg((3 << 11) | 20) & 0xFu; }
#define XB_SPIN(cond, bar) do { unsigned _sp = 0; while (cond) { __builtin_amdgcn_s_sleep(1); \
    if ((++_sp & 255u) == 0u) { if (xb_ld(&(bar)[XB_TMO])) break; if (_sp > XB_SPIN_CAP) { atomicAdd(&(bar)[XB_TMO], 1u); break; } } } } while (0)

struct XcdBarrier {
    unsigned* bar; unsigned x;
    volatile LAS unsigned* st;
};

__device__ __forceinline__ XcdBarrier xcd_barrier_post(unsigned* bar, volatile LAS unsigned* st) {
    XcdBarrier b; b.bar = bar; b.x = xb_xcc_id(); b.st = st;
    if (threadIdx.x == 0) (void)xb_add(&bar[XB_XCNT(b.x)], 1u);
    return b;
}
__device__ __forceinline__ void xcd_barrier_complete(unsigned* bar, unsigned x, unsigned& nloc, unsigned& nx) {
    const unsigned G = gridDim.x * gridDim.y * gridDim.z;
    unsigned sum, cnt, mine, sp = 0u;
    for (;;) {
        sum = 0u; cnt = 0u; mine = 0u;
#pragma unroll
        for (unsigned j = 0; j < 16; ++j) { const unsigned c = xb_ld(&bar[XB_XCNT(j)]); sum += c; cnt += (c > 0u) ? 1u : 0u; mine = (j == x) ? c : mine; }
        if (sum == G) break;
        __builtin_amdgcn_s_sleep(1);
        if ((++sp & 255u) == 0u) { if (xb_ld(&bar[XB_TMO])) break; if (sp > XB_SPIN_CAP) { atomicAdd(&bar[XB_TMO], 1u); break; } }
    }
    nloc = mine > 0u ? mine : 1u; nx = cnt > 0u ? cnt : 1u;
}

__device__ __forceinline__ void xcd_barrier(const XcdBarrier& b) {
    asm volatile("s_waitcnt vmcnt(0)" ::: "memory");
    __syncthreads();
    if (threadIdx.x == 0) {
        unsigned* bar = b.bar;
        __builtin_amdgcn_s_waitcnt(0);
        unsigned nloc = b.st[0], nx = b.st[1];
        if (nloc == 0u) { xcd_barrier_complete(bar, b.x, nloc, nx); b.st[0] = nloc; b.st[1] = nx; }
        const unsigned old = xb_add(&bar[XB_XSUB(b.x)], 1u);
        const unsigned gen = old / nloc;
        if (old + 1u == (gen + 1u) * nloc) {
            __builtin_amdgcn_fence(__ATOMIC_RELEASE, "agent");
            asm volatile("s_waitcnt vmcnt(0)" ::: "memory");
            const unsigned og = xb_add(&bar[XB_TOP], 1u);
            const unsigned tg = og / nx;
            if (og + 1u == (tg + 1u) * nx) xb_add(&bar[XB_TOPGEN], 1u);
            else XB_SPIN(xb_ld(&bar[XB_TOPGEN]) == tg, bar);
            __builtin_amdgcn_fence(__ATOMIC_ACQUIRE, "agent");
            xb_add(&bar[XB_XGEN(b.x)], 1u);
            asm volatile("s_waitcnt vmcnt(0)" ::: "memory");
        } else {
            XB_SPIN(xb_ld(&bar[XB_XGEN(b.x)]) == gen, bar);
            __builtin_amdgcn_fence(__ATOMIC_ACQUIRE, "agent");
            asm volatile("s_waitcnt vmcnt(0)" ::: "memory");
        }
    }
    __syncthreads();
}

constexpr int NWAVES = 8;
constexpr int BATCH = 32, SEQ = 2048, DMODEL = 1024, MTOK = BATCH * SEQ, DFF = 4096, NPROJ = 5120, INCOLS = 4896;
constexpr float RMS_EPS = 1e-6f;
constexpr float QSCALE = 0.125f * 1.4426950408889634f;
constexpr float LOG2E = 1.4426950408889634f;
constexpr float WDN_SCALE = 256.f;
#ifndef MK_N_LAUNCHES
#define MK_N_LAUNCHES 1
#endif
constexpr int N_PHASES = 10;
constexpr int N_LAUNCHES = MK_N_LAUNCHES;
constexpr size_t MiB = 1u << 20, KiB = 1u << 10;
constexpr size_t WS_CTL = 0, CTL_ZERO_BYTES = 1 * MiB;
constexpr size_t WS_WIN = 2 * MiB, WS_WF = 12 * MiB, WS_WN = 13 * MiB, WS_WO = 14 * MiB, WS_WUP = 16 * MiB, WS_WDN = 24 * MiB;
constexpr size_t WS_W1K = 32 * MiB, WS_W1V = WS_W1K + 256 * KiB, WS_W2K = WS_W1V + 256 * KiB, WS_W2V = WS_W2K + 8 * KiB, WS_PBK = WS_W2V + 8 * KiB, WS_PBV = WS_PBK + 256;
constexpr size_t WS_KT0 = WS_PBV + 256;
constexpr size_t WS_RSTD2 = 46 * MiB;
constexpr size_t WS_ROPEC = 33 * MiB, WS_ROPES = WS_ROPEC + 256 * KiB;
constexpr size_t WS_KCMP = 34 * MiB, WS_VCMP = 35 * MiB, WS_C = 36 * MiB, WS_LF = 38 * MiB, WS_GATE = 40 * MiB;
constexpr size_t WS_HB = 48 * MiB;
constexpr size_t WS_FKX = 48 * MiB;
constexpr size_t WS_PROBE_O = 64 * MiB;
constexpr size_t WS_FQ = 176 * MiB, WS_FK = 240 * MiB, WS_FV = 304 * MiB, WS_NQ = 368 * MiB;
constexpr size_t WS_KV = 432 * MiB, KV_STRIDE = 16 * MiB;
constexpr size_t WS_SGA = 528 * MiB, WS_SGB = 656 * MiB;
#ifndef WS_Y_SKEW
#define WS_Y_SKEW 0
#endif
constexpr size_t WS_Y = 784 * MiB + WS_Y_SKEW;
constexpr size_t WS_ATT = WS_Y;
constexpr size_t WS_FOXO_UNUSED = WS_Y, WS_NSAO_UNUSED = WS_Y + 64 * MiB;
constexpr size_t WS_U = 176 * MiB;
constexpr size_t WS_END = 1024 * MiB;
static_assert(WS_FV - WS_FK == WS_FK - WS_FQ && WS_U + (size_t)MTOK * DFF * 2 <= WS_Y && WS_Y + (size_t)MTOK * 512 * 4 <= WS_END && WS_GATE + (size_t)MTOK * 24 * 4 <= WS_HB, "d_ws map");
constexpr int CW_TMO = 0, CW_CODE = 1, CW_BAR = 4096, CW_QUEUE = 16384;
constexpr int RING_OFF = 0, RING_BYTES = 131072;
constexpr int LDSCTL_OFF = RING_BYTES, MISC_OFF = LDSCTL_OFF + 320;
constexpr int LDS_BYTES = 147456;
static_assert(MISC_OFF + 128 <= LDS_BYTES, "LDS map");


typedef float f32x16 __attribute__((ext_vector_type(16)));
struct Frame {
    LAS unsigned char* lds;
    volatile LAS unsigned* MISC;
    gu32* ctl;
    int wave;
    int vcu, G;
    unsigned char* ws;
    const float* x; float* out;
    const float *g_mix_pre, *g_mix_post, *g_mlp_pre, *g_mlp_post, *w_in, *b_forget, *pos_k, *w1_k, *w2_k, *pos_v, *w1_v, *w2_v, *w_fox, *w_nsa, *w_o, *w_up, *w_down;
};
template <class T> __device__ __forceinline__ T* wsp(const Frame& F, size_t off) { return (T*)(F.ws + off); }
__device__ __forceinline__ int cur_lane() { return (int)__builtin_amdgcn_mbcnt_hi(~0u, __builtin_amdgcn_mbcnt_lo(~0u, 0u)); }
__device__ __forceinline__ int cur_tid(const Frame& F) { return F.wave * 64 + cur_lane(); }

__device__ __forceinline__ float wave_sum(float v) {
#pragma unroll
    for (int o = 1; o < 64; o <<= 1) v += __shfl_xor(v, o);
    return v;
}
__device__ __forceinline__ float bfl(unsigned w) { return __uint_as_float(w << 16); }
__device__ __forceinline__ float bfh(unsigned w) { return __uint_as_float(w & 0xffff0000u); }

__device__ __forceinline__ int rope_d(int w) { const int i = w >> 3, j = w & 7; return j < 4 ? 4 * i + j : 32 + 4 * i + (j - 4); }
__device__ __forceinline__ int in_src_col(int n) {
    if (n < 1536) return n;
    if (n < 2048) { const int l = n - 1536; return 1544 + (l & ~63) + rope_d(l & 63); }
    if (n < 2816) { const int s = (n - 2048) >> 8, l = (n - 2048) & 255; const int kb = 2056 + s * 256;
        return l < 128 ? kb + (l & ~63) + rope_d(l & 63) : kb + 128 + (l - 128); }
    if (n < 4864) { const int q = (n - 2816) >> 8, l = (n - 2816) & 255; return l < 128 ? 2848 + 128 * q + l : 3872 + 128 * q + (l - 128); }
    const int l = n - 4864; if (l < 8) return 1536 + l; if (l < 32) return 2824 + (l - 8); return -1;
}
template <class SrcCol>
__device__ __forceinline__ void p0_transpose_item(const float* W, int K, int Nsrc, bf16* WT, int nblk, LAS float* scr, int item, int lane, SrcCol srccol, const float* kgain = nullptr, int ldk = 0, int koff = 0) {
    const int kb = item / nblk, nb = item % nblk, k0 = 64 * kb, n0 = 32 * nb;
    const int sc = srccol(n0 + (lane & 31));
#pragma unroll 8
    for (int i = 0; i < 32; ++i) { const int kk = 2 * i + (lane >> 5); float w = sc >= 0 ? W[(size_t)(k0 + kk) * Nsrc + sc] : 0.f; if (kgain) w *= kgain[k0 + kk]; scr[kk * 33 + (lane & 31)] = w; }
    LDS_WAIT(); asm volatile("" ::: "memory");
    const int c = lane & 7;
#pragma unroll
    for (int j = 0; j < 4; ++j) { const int n = (lane >> 3) + 8 * j; const LAS float* s = scr + (8 * c) * 33 + n;
        v4u o; o.x = pk2(s[0 * 33], s[1 * 33]); o.y = pk2(s[2 * 33], s[3 * 33]); o.z = pk2(s[4 * 33], s[5 * 33]); o.w = pk2(s[6 * 33], s[7 * 33]);
        *(GAS v4u*)(WT + (size_t)(n0 + n) * (ldk ? ldk : K) + koff + k0 + 8 * c) = o; }
    LDS_WAIT(); asm volatile("" ::: "memory");
}
__device__ __forceinline__ void p0_transpose_item_f8(const float* W, int K, int N, unsigned char* WT, int nblk, LAS float* scr, int item, int lane, float scale) {
    const int kb = item / nblk, nb = item % nblk, k0 = 64 * kb, n0 = 32 * nb;
#pragma unroll 8
    for (int i = 0; i < 32; ++i) { const int kk = 2 * i + (lane >> 5); scr[kk * 33 + (lane & 31)] = W[(size_t)(k0 + kk) * N + n0 + (lane & 31)] * scale; }
    LDS_WAIT(); asm volatile("" ::: "memory");
    const int c = lane & 7;
#pragma unroll
    for (int j = 0; j < 4; ++j) { const int n = (lane >> 3) + 8 * j; const LAS float* s = scr + (8 * c) * 33 + n;
        pg8::f32x2 o; o.x = __builtin_bit_cast(float, pg8::cvt4_fp8(fmaxf(s[0 * 33], -pg8::F8_MAX), fmaxf(s[1 * 33], -pg8::F8_MAX), fmaxf(s[2 * 33], -pg8::F8_MAX), fmaxf(s[3 * 33], -pg8::F8_MAX)));
        o.y = __builtin_bit_cast(float, pg8::cvt4_fp8(fmaxf(s[4 * 33], -pg8::F8_MAX), fmaxf(s[5 * 33], -pg8::F8_MAX), fmaxf(s[6 * 33], -pg8::F8_MAX), fmaxf(s[7 * 33], -pg8::F8_MAX)));
        *(GAS pg8::f32x2*)(WT + (size_t)(n0 + n) * K + k0 + 8 * c) = o; }
    LDS_WAIT(); asm volatile("" ::: "memory");
}
__device__ __forceinline__ void rms_rows_to_bf16(int lane, int gw, int NGW, const float* X, const float* g, bf16* O) {
    constexpr int RP = 4;
    const GAS f32x4* gr = (const GAS f32x4*)g + lane; f32x4 gv[4];
#pragma unroll
    for (int j = 0; j < 4; ++j) gv[j] = gr[64 * j];
    for (int m0 = gw; m0 < MTOK; m0 += NGW * RP) {
        f32x4 v[RP][4];
#pragma unroll
        for (int r = 0; r < RP; ++r) { const GAS f32x4* xr = (const GAS f32x4*)(X + (size_t)(m0 + r * NGW) * DMODEL) + lane;
#pragma unroll
            for (int j = 0; j < 4; ++j) v[r][j] = __builtin_nontemporal_load(xr + 64 * j); }
#pragma unroll
        for (int r = 0; r < RP; ++r) { float s = 0.f;
#pragma unroll
            for (int j = 0; j < 4; ++j) s += (v[r][j].x * v[r][j].x + v[r][j].y * v[r][j].y) + (v[r][j].z * v[r][j].z + v[r][j].w * v[r][j].w);
            const float rr = 1.0f / sqrtf(wave_sum(s) * (1.f / DMODEL) + RMS_EPS);
            GAS unsigned long long* o8 = (GAS unsigned long long*)(O + (size_t)(m0 + r * NGW) * DMODEL) + lane;
#pragma unroll
            for (int j = 0; j < 4; ++j) { const f32x4 a = v[r][j], gg = gv[j];
                o8[64 * j] = (unsigned long long)pk2(a.x * rr * gg.x, a.y * rr * gg.y) | ((unsigned long long)pk2(a.z * rr * gg.z, a.w * rr * gg.w) << 32); } }
    }
}
__device__ __forceinline__ void p0_prologue(Frame& F) {
    LAS float* scr = (LAS float*)(F.lds + RING_OFF + F.wave * 16384);
    const int gw = F.vcu * NWAVES + F.wave, NGW = F.G * NWAVES, lane = cur_lane();
    constexpr int I_IN = 16 * (NPROJ / 32), I_F = 8 * 32, I_O = 16 * 32, I_UP = 16 * 128, I_DN = 64 * 32, I_W1 = 32 * 2, I_W2 = 1 * 2;
    constexpr int NITEMS = I_IN + 2 * I_F + I_O + I_UP + I_DN + 2 * I_W1 + 2 * I_W2;
    auto ident = [](int n) { return n; };
    for (int it = gw; it < NITEMS; it += NGW) {
        int r = it;
        if (r < I_IN) { p0_transpose_item(F.w_in, 1024, INCOLS, wsp<bf16>(F, WS_WIN), NPROJ / 32, scr, r, lane, [](int n) { return in_src_col(n); }); continue; } r -= I_IN;
        if (r < I_F) { p0_transpose_item(F.w_fox, 512, 1024, wsp<bf16>(F, WS_WF), 32, scr, r, lane, ident, nullptr, 1024, 512); continue; } r -= I_F;
        if (r < I_F) { p0_transpose_item(F.w_nsa, 512, 1024, wsp<bf16>(F, WS_WF), 32, scr, r, lane, ident, nullptr, 1024, 0); continue; } r -= I_F;
        if (r < I_O) { p0_transpose_item(F.w_o, 1024, 1024, wsp<bf16>(F, WS_WO), 32, scr, r, lane, ident); continue; } r -= I_O;
        if (r < I_UP) { p0_transpose_item(F.w_up, 1024, 4096, wsp<bf16>(F, WS_WUP), 128, scr, r, lane, ident, F.g_mlp_pre); continue; }     r -= I_UP;
        if (r < I_DN) { p0_transpose_item_f8(F.w_down, 4096, 1024, wsp<unsigned char>(F, WS_WDN), 32, scr, r, lane, WDN_SCALE); continue; } r -= I_DN;
        if (r < I_W1) { p0_transpose_item(F.w1_k, 2048, 64, wsp<bf16>(F, WS_W1K), 2, scr, r, lane, ident); continue; } r -= I_W1;
        if (r < I_W1) { p0_transpose_item(F.w1_v, 2048, 64, wsp<bf16>(F, WS_W1V), 2, scr, r, lane, ident); continue; } r -= I_W1;
        if (r < I_W2) { p0_transpose_item(F.w2_k, 64, 64, wsp<bf16>(F, WS_W2K), 2, scr, r, lane, ident); continue; } r -= I_W2;
        p0_transpose_item(F.w2_v, 64, 64, wsp<bf16>(F, WS_W2V), 2, scr, r, lane, ident);
    }
    { float* RC = wsp<float>(F, WS_ROPEC); float* RS = wsp<float>(F, WS_ROPES);
      for (int e = (F.vcu * NWAVES * 64 + cur_tid(F)); e < SEQ * 32; e += F.G * NWAVES * 64) { const int t = e >> 5, i = e & 31;
          const float inv = powf(10000.0f, -(float)(2 * i) / 64.0f); const float ang = (float)t * inv; RC[e] = cosf(ang); RS[e] = sinf(ang); } }
    if (F.wave == 0) for (int it = F.vcu; it < 128; it += F.G) { const int kv = it >> 6, c = it & 63; const float* pos = kv ? F.pos_v : F.pos_k; const float* w1 = kv ? F.w1_v : F.w1_k; float s = 0.f;
        for (int k = lane; k < 2048; k += 64) s += pos[k] * w1[(size_t)k * 64 + c];
        s = wave_sum(s); if (lane == 0) wsp<float>(F, kv ? WS_PBV : WS_PBK)[c] = s; }
    rms_rows_to_bf16(lane, gw, NGW, F.x, F.g_mix_pre, wsp<bf16>(F, WS_HB));
}

__device__ __forceinline__ int crow(int r, int hi) { return (r & 3) + 8 * (r >> 2) + 4 * hi; }
#define P2_PIN8(a) asm volatile("" : "+v"(a[0]), "+v"(a[1]), "+v"(a[2]), "+v"(a[3]), "+v"(a[4]), "+v"(a[5]), "+v"(a[6]), "+v"(a[7]))
__device__ __forceinline__ void p2_compress_unit(Frame& F, int unit) {
    const int bg = unit >> 2, kv = (unit >> 1) & 1, half = unit & 1, lane = cur_lane(), w = F.wave;
    const bf16* X = wsp<bf16>(F, WS_KV + (size_t)kv * KV_STRIDE) + (size_t)bg * SEQ * 64;
    const bf16* W1t = wsp<bf16>(F, kv ? WS_W1V : WS_W1K); const bf16* W2t = wsp<bf16>(F, kv ? WS_W2V : WS_W2K); const float* PB = wsp<float>(F, kv ? WS_PBV : WS_PBK);
    bf16* OUT = wsp<bf16>(F, kv ? WS_VCMP : WS_KCMP) + (size_t)bg * 128 * 64;
    const int rt = w & 1, ct = (w >> 1) & 1, kh = w >> 2, r = lane & 31, h = lane >> 5;
    const int irow = 64 * half + 32 * rt + r, ild = irow < 126 ? irow : 126;
    const GAS bf16x8* arow = (const GAS bf16x8*)(X + (size_t)ild * 1024 + kh * 1024); const GAS bf16x8* brow = (const GAS bf16x8*)(W1t + (size_t)(32 * ct + r) * 2048 + kh * 1024);
#define P2_KIDX(S) (8 * ((S) >> 2) + 4 * h + ((S) & 3))
    f32x16 acc = {};
    bf16x8 a0[8], b0[8], a1[8], b1[8];
#pragma unroll
    for (int s = 0; s < 8; ++s) { a0[s] = arow[P2_KIDX(s)]; b0[s] = brow[P2_KIDX(s)]; }
#pragma unroll 1
    for (int bt = 0; bt < 8; bt += 2) {
#pragma unroll
        for (int s = 0; s < 8; ++s) { a1[s] = arow[P2_KIDX(8 * (bt + 1) + s)]; b1[s] = brow[P2_KIDX(8 * (bt + 1) + s)]; }
        P2_PIN8(a0); P2_PIN8(b0);
#pragma unroll
        for (int s = 0; s < 8; ++s) acc = __builtin_amdgcn_mfma_f32_32x32x16_bf16(a0[s], b0[s], acc, 0, 0, 0);
        if (bt + 2 < 8) {
#pragma unroll
            for (int s = 0; s < 8; ++s) { a0[s] = arow[P2_KIDX(8 * (bt + 2) + s)]; b0[s] = brow[P2_KIDX(8 * (bt + 2) + s)]; } }
#undef P2_KIDX_DONE
        P2_PIN8(a1); P2_PIN8(b1);
#pragma unroll
        for (int s = 0; s < 8; ++s) acc = __builtin_amdgcn_mfma_f32_32x32x16_bf16(a1[s], b1[s], acc, 0, 0, 0);
    }
    LAS float* red = (LAS float*)(F.lds + RING_OFF);
    LAS bf16* Hs = (LAS bf16*)(F.lds + RING_OFF + 16384);
    if (kh == 1) {
#pragma unroll
        for (int i = 0; i < 16; ++i) red[((w & 3) * 16 + i) * 64 + lane] = acc[i];
    }
    __syncthreads();
    if (kh == 0) { const float pb = PB[32 * ct + r];
#pragma unroll
        for (int i = 0; i < 16; ++i) { float v = acc[i] + red[((w & 3) * 16 + i) * 64 + lane] + pb; v = v / (1.0f + __expf(-v)); Hs[(32 * rt + crow(i, h)) * 72 + 32 * ct + r] = (bf16)f2bf(v); }
    }
    __syncthreads();
    if (kh == 0) { f32x16 o = {};
#pragma unroll
        for (int s = 0; s < 4; ++s) { const bf16x8 a = *(const LAS bf16x8*)(Hs + (32 * rt + r) * 72 + 16 * s + 8 * h), b = *(const GAS bf16x8*)(W2t + (size_t)(32 * ct + r) * 64 + 16 * s + 8 * h);
            o = __builtin_amdgcn_mfma_f32_32x32x16_bf16(a, b, o, 0, 0, 0); }
#pragma unroll
        for (int i = 0; i < 16; ++i) { const int row = 64 * half + 32 * rt + crow(i, h); OUT[(size_t)row * 64 + 32 * ct + r] = (bf16)(row == 127 ? 0u : f2bf(o[i])); }
    }
    __syncthreads();
}
__device__ __forceinline__ void p2_phase(Frame& F) {
    for (int id = F.vcu; id < BATCH * 8; id += F.G) { const int b = id >> 3, h = id & 7, tid = cur_tid(F), lane = cur_lane(), w = F.wave;
        LAS float* wt = (LAS float*)(F.lds + RING_OFF + 32768);
        const float* lf = wsp<float>(F, WS_LF) + ((size_t)b * SEQ + 4 * tid) * 8 + h; float v[4];
#pragma unroll
        for (int i = 0; i < 4; ++i) v[i] = lf[i * 8];
        const float tot = (v[0] + v[1]) + (v[2] + v[3]); float incl = tot;
#pragma unroll
        for (int o = 1; o < 64; o <<= 1) { const float n = __shfl_up(incl, o); if (lane >= o) incl += n; }
        if (lane == 63) wt[w] = incl;
        __syncthreads();
        float run = incl - tot;
        for (int k = 0; k < w; ++k) run += wt[k];
        float* c = wsp<float>(F, WS_C) + (size_t)id * SEQ + 4 * tid; GAS v4u* kx = (GAS v4u*)(wsp<bf16>(F, WS_FKX) + ((size_t)id * SEQ + 4 * tid) * 16);
        float cv[4];
#pragma unroll
        for (int i = 0; i < 4; ++i) { run += v[i]; cv[i] = run;
            const float x = -run * LOG2E; const unsigned h1 = f2bf(x); const float r1 = x - __uint_as_float(h1 << 16); const unsigned h2 = f2bf(r1); const float r2 = r1 - __uint_as_float(h2 << 16); const unsigned h3 = f2bf(r2);
            kx[2 * i] = (v4u){h1 | (h2 << 16), h3, 0u, 0u}; kx[2 * i + 1] = (v4u){0u, 0u, 0u, 0u}; }
        *(GAS f32x4*)c = (f32x4){cv[0], cv[1], cv[2], cv[3]};
        { LAS float* cl = (LAS float*)(F.lds + RING_OFF + 36864); LAS float* wk = cl + 2048; LAS float* wq = wk + 256;
          *(LAS f32x4*)(cl + 4 * tid) = (f32x4){cv[0], cv[1], cv[2], cv[3]};
          const GAS v4u* kr = (const GAS v4u*)(wsp<bf16>(F, WS_FK) + ((size_t)b * SEQ + (tid >> 3)) * 512 + h * 64 + (tid & 7) * 8);
          const GAS v4u* qrw = (const GAS v4u*)(wsp<bf16>(F, WS_FQ) + ((size_t)b * SEQ + (tid >> 3)) * 512 + h * 64 + (tid & 7) * 8);
#pragma unroll 1
          for (int i0 = 0; i0 < 32; i0 += 16) { v4u ka[16], qa[16];
#pragma unroll
              for (int i = 0; i < 16; ++i) { ka[i] = kr[(size_t)(i0 + i) * 64 * 64]; qa[i] = qrw[(size_t)(i0 + i) * 64 * 64]; }
              asm volatile("" : "+v"(ka[0]), "+v"(ka[1]), "+v"(ka[2]), "+v"(ka[3]), "+v"(ka[4]), "+v"(ka[5]), "+v"(ka[6]), "+v"(ka[7]), "+v"(ka[8]), "+v"(ka[9]), "+v"(ka[10]), "+v"(ka[11]), "+v"(ka[12]), "+v"(ka[13]), "+v"(ka[14]), "+v"(ka[15]));
              asm volatile("" : "+v"(qa[0]), "+v"(qa[1]), "+v"(qa[2]), "+v"(qa[3]), "+v"(qa[4]), "+v"(qa[5]), "+v"(qa[6]), "+v"(qa[7]), "+v"(qa[8]), "+v"(qa[9]), "+v"(qa[10]), "+v"(qa[11]), "+v"(qa[12]), "+v"(qa[13]), "+v"(qa[14]), "+v"(qa[15]));
#pragma unroll
              for (int i = 0; i < 16; ++i) { const v4u a = ka[i], e = qa[i];
                  float sk = (bfl(a.x) * bfl(a.x) + bfh(a.x) * bfh(a.x)) + (bfl(a.y) * bfl(a.y) + bfh(a.y) * bfh(a.y)) + (bfl(a.z) * bfl(a.z) + bfh(a.z) * bfh(a.z)) + (bfl(a.w) * bfl(a.w) + bfh(a.w) * bfh(a.w));
                  float sq = (bfl(e.x) * bfl(e.x) + bfh(e.x) * bfh(e.x)) + (bfl(e.y) * bfl(e.y) + bfh(e.y) * bfh(e.y)) + (bfl(e.z) * bfl(e.z) + bfh(e.z) * bfh(e.z)) + (bfl(e.w) * bfl(e.w) + bfh(e.w) * bfh(e.w));
                  sk += __shfl_xor(sk, 1); sq += __shfl_xor(sq, 1); sk += __shfl_xor(sk, 2); sq += __shfl_xor(sq, 2); sk += __shfl_xor(sk, 4); sq += __shfl_xor(sq, 4);
                  sk = fmaxf(sk, __shfl_xor(sk, 8)); sq = fmaxf(sq, __shfl_xor(sq, 8)); sk = fmaxf(sk, __shfl_xor(sk, 16)); sq = fmaxf(sq, __shfl_xor(sq, 16)); sk = fmaxf(sk, __shfl_xor(sk, 32)); sq = fmaxf(sq, __shfl_xor(sq, 32));
                  if (lane == 0) { wk[w * 32 + i0 + i] = sk; wq[w * 32 + i0 + i] = sq; } } }
          __syncthreads();
          if (tid < 8) { const int qb = tid; float Qm = 0.f, Kband = 0.f;
              for (int t4 = 0; t4 < 4; ++t4) for (int ww = 0; ww < 8; ++ww) { Qm = fmaxf(Qm, wq[ww * 32 + 4 * qb + t4]); Kband = fmaxf(Kband, wk[ww * 32 + 4 * qb + t4]); }
              Qm = sqrtf(Qm) * 1.001f; Kband = sqrtf(Kband) * 1.001f;
              const float cq0 = cl[256 * qb]; int kt0 = 4 * qb;
              for (int kt = 4 * qb - 1; kt >= 0; --kt) { float kk = 0.f; for (int ww = 0; ww < 8; ++ww) kk = fmaxf(kk, wk[ww * 32 + kt]); kk = sqrtf(kk) * 1.001f;
                  const float bound = Qm * (kk + Kband) + (cq0 - cl[64 * kt + 63]) * LOG2E; if (bound >= -40.0f) kt0 = kt; }
              wsp<int>(F, WS_KT0)[id * 8 + qb] = kt0; } }
        __syncthreads(); }
    for (int u = F.vcu; u < 256; u += F.G) p2_compress_unit(F, u);
}

template <bool FINAL>
__device__ __forceinline__ void row_pass(Frame& F, const float* xin_f32, const bf16* xin_b16, const bf16* Y, const float* gpost, float* out_f32, bf16* X1B, float* RSTD2) {
#ifndef RP_FINAL
#define RP_FINAL 4
#endif
    constexpr int RP = FINAL ? RP_FINAL : 4;
    const int gw = F.vcu * NWAVES + F.wave, NGW = F.G * NWAVES, lane = cur_lane();
    const GAS f32x4* gp = (const GAS f32x4*)gpost + lane;
    f32x4 gpv[4];
#pragma unroll
    for (int j = 0; j < 4; ++j) gpv[j] = gp[64 * j];
    for (int m0 = gw; m0 < MTOK; m0 += NGW * RP) {
        f32x4 xv[FINAL ? 1 : RP][4]; unsigned long long xw[FINAL ? RP : 1][4]; unsigned long long yw[RP][4];
#pragma unroll
        for (int r = 0; r < RP; ++r) { const size_t m = (size_t)(m0 + r * NGW);
            const GAS unsigned long long* yr = (const GAS unsigned long long*)(Y + m * DMODEL) + lane;
            if (FINAL) { const GAS unsigned long long* xr = (const GAS unsigned long long*)(xin_b16 + m * DMODEL) + lane;
#pragma unroll
                for (int j = 0; j < 4; ++j) { xw[r][j] = __builtin_nontemporal_load(xr + 64 * j); yw[r][j] = __builtin_nontemporal_load(yr + 64 * j); }
            } else { const GAS f32x4* xr = (const GAS f32x4*)(xin_f32 + m * DMODEL) + lane;
#pragma unroll
                for (int j = 0; j < 4; ++j) { xv[r][j] = __builtin_nontemporal_load(xr + 64 * j); yw[r][j] = __builtin_nontemporal_load(yr + 64 * j); } } }
#pragma unroll
        for (int r = 0; r < RP; ++r) { const size_t m = (size_t)(m0 + r * NGW);
            f32x4 yv[4]; float s = 0.f;
#pragma unroll
            for (int j = 0; j < 4; ++j) { const unsigned lo = (unsigned)yw[r][j], hi = (unsigned)(yw[r][j] >> 32);
                yv[j] = (f32x4){bfl(lo), bfh(lo), bfl(hi), bfh(hi)}; s += (yv[j].x * yv[j].x + yv[j].y * yv[j].y) + (yv[j].z * yv[j].z + yv[j].w * yv[j].w); }
            float eps = RMS_EPS;
            if (FINAL) { const float r2 = RSTD2[m]; eps = RMS_EPS / ((r2 * r2) * (r2 * r2)); }
            const float rr = 1.0f / sqrtf(wave_sum(s) * (1.f / DMODEL) + eps); float s2 = 0.f;
            if (FINAL) { GAS f32x4* xo = (GAS f32x4*)(out_f32 + m * DMODEL) + lane;
#pragma unroll
                for (int j = 0; j < 4; ++j) { const unsigned lo = (unsigned)xw[r][j], hi = (unsigned)(xw[r][j] >> 32); const f32x4 xf = (f32x4){bfl(lo), bfh(lo), bfl(hi), bfh(hi)}; __builtin_nontemporal_store(xf + yv[j] * rr * gpv[j], xo + 64 * j); }
            } else { GAS unsigned long long* o8 = (GAS unsigned long long*)(X1B + m * DMODEL) + lane;
#pragma unroll
                for (int j = 0; j < 4; ++j) { const f32x4 v = xv[r][j] + yv[j] * rr * gpv[j]; s2 += (v.x * v.x + v.y * v.y) + (v.z * v.z + v.w * v.w);
                    o8[64 * j] = (unsigned long long)pk2(v.x, v.y) | ((unsigned long long)pk2(v.z, v.w) << 32); }
                const float r2 = 1.0f / sqrtf(wave_sum(s2) * (1.f / DMODEL) + RMS_EPS); if (lane == 0) RSTD2[m] = r2; }
        }
    }
}

namespace at {
constexpr int KSLOT = 10240, VSLOT = 8192, NSLOT = 3;
constexpr int L_K = 0, L_V = NSLOT * KSLOT, L_WS = L_V + NSLOT * VSLOT, L_PARK = L_WS + 8 * 512, L_PSL = L_PARK, L_CMP = L_PARK + 4 * 64 * 33 * 4, L_SELM = L_CMP + 4 * 8192, L_NEXT = L_SELM + 256, L_END = L_NEXT + 16;
static_assert(L_SELM >= L_PARK + 8 * 8192, "park region");
static_assert(L_END <= RING_BYTES, "attention LDS map");
constexpr float THR = 8.0f;
typedef short s16x4 __attribute__((ext_vector_type(4)));
typedef short v4i16_t __attribute__((ext_vector_type(4)));
#define AT_NEG (-INFINITY)
__device__ __forceinline__ void glds16(const void* sbase, unsigned voff, unsigned lds_dst) { unsigned keep;
    asm volatile("s_mov_b32 %0, m0\n\ts_mov_b32 m0, %3\n\ts_nop 2\n\tglobal_load_lds_dwordx4 %1, %2\n\ts_mov_b32 m0, %0" : "=&s"(keep) : "v"(voff), "s"(sbase), "s"(lds_dst) : "memory"); }
__device__ __forceinline__ void glds4(const void* sbase, unsigned voff, unsigned lds_dst) { unsigned keep;
    asm volatile("s_mov_b32 %0, m0\n\ts_mov_b32 m0, %3\n\ts_nop 2\n\tglobal_load_lds_dword %1, %2\n\ts_mov_b32 m0, %0" : "=&s"(keep) : "v"(voff), "s"(sbase), "s"(lds_dst) : "memory"); }
#define AT_WAIT_BAR(N) asm volatile("s_waitcnt vmcnt(" #N ") lgkmcnt(0)\n\ts_barrier" ::: "memory")
#ifndef AT_PRIO_MODE
#define AT_PRIO_MODE 1
#endif
#define AT_PRIO(w) do { if (AT_PRIO_MODE == 1) { if ((w) < 4) __builtin_amdgcn_s_setprio(2); else __builtin_amdgcn_s_setprio(0); } else if (AT_PRIO_MODE == 2) { if (((w) & 1) == 0) __builtin_amdgcn_s_setprio(2); else __builtin_amdgcn_s_setprio(0); } } while (0)
#define AT_BAR() asm volatile("s_waitcnt lgkmcnt(0)\n\ts_barrier" ::: "memory")
__device__ __forceinline__ unsigned cvtpk(float lo, float hi) { typedef float f2 __attribute__((ext_vector_type(2))); typedef __bf16 b2 __attribute__((ext_vector_type(2))); f2 v = {lo, hi}; b2 b = __builtin_convertvector(v, b2); return __builtin_bit_cast(unsigned, b); }
__device__ __forceinline__ float swap_half(float x, int hi) { auto rr = __builtin_amdgcn_permlane32_swap(__float_as_uint(x), __float_as_uint(x), false, false); return hi ? __uint_as_float(rr[0]) : __uint_as_float(rr[1]); }
__device__ __forceinline__ float max_half(float x) { auto rr = __builtin_amdgcn_permlane32_swap(__float_as_uint(x), __float_as_uint(x), false, false); return fmaxf(__uint_as_float(rr[0]), __uint_as_float(rr[1])); }
__device__ __forceinline__ float sum_half(float x) { auto rr = __builtin_amdgcn_permlane32_swap(__float_as_uint(x), __float_as_uint(x), false, false); return __uint_as_float(rr[0]) + __uint_as_float(rr[1]); }
template <int KS>
__device__ __forceinline__ void qk(f32x16& p0, f32x16& p1, const LAS unsigned char* Kslot, const bf16x8 (&qr)[5], const f32x16& cinit, int r32, int hi) {
    const LAS unsigned char* kb = Kslot + hi * 1024 + r32 * 16;
#pragma unroll
    for (int d0 = 0; d0 < KS; ++d0) { const bf16x8 b0 = *(const LAS bf16x8*)(kb + d0 * 2048), b1 = *(const LAS bf16x8*)(kb + d0 * 2048 + 512);
        if (d0 == 0) { p0 = __builtin_amdgcn_mfma_f32_32x32x16_bf16(b0, qr[0], cinit, 0, 0, 0); p1 = __builtin_amdgcn_mfma_f32_32x32x16_bf16(b1, qr[0], cinit, 0, 0, 0); }
        else { p0 = __builtin_amdgcn_mfma_f32_32x32x16_bf16(b0, qr[d0], p0, 0, 0, 0); p1 = __builtin_amdgcn_mfma_f32_32x32x16_bf16(b1, qr[d0], p1, 0, 0, 0); } }
}
__device__ __forceinline__ s16x4 vtr(const LAS unsigned char* p) { return __builtin_bit_cast(s16x4, __builtin_amdgcn_ds_read_tr16_b64_v4i16((LAS v4i16_t*)p)); }
__device__ __forceinline__ void pv(f32x16 (&o)[2], const LAS unsigned char* vb, const f32x16& p0, const f32x16& p1) {
    v4u pw[4];
#pragma unroll
    for (int k = 0; k < 2; ++k) { pw[k] = (v4u){cvtpk(p0[8 * k], p0[8 * k + 1]), cvtpk(p0[8 * k + 2], p0[8 * k + 3]), cvtpk(p0[8 * k + 4], p0[8 * k + 5]), cvtpk(p0[8 * k + 6], p0[8 * k + 7])};
        pw[2 + k] = (v4u){cvtpk(p1[8 * k], p1[8 * k + 1]), cvtpk(p1[8 * k + 2], p1[8 * k + 3]), cvtpk(p1[8 * k + 4], p1[8 * k + 5]), cvtpk(p1[8 * k + 6], p1[8 * k + 7])}; }
#pragma unroll
    for (int d0 = 0; d0 < 2; ++d0)
#pragma unroll
        for (int ks = 0; ks < 4; ++ks) { const s16x4 lo = vtr(vb + d0 * 4096 + ks * 1024), hi = vtr(vb + d0 * 4096 + ks * 1024 + 512);
            const bf16x8 vf = (bf16x8){lo[0], lo[1], lo[2], lo[3], hi[0], hi[1], hi[2], hi[3]};
            o[d0] = __builtin_amdgcn_mfma_f32_32x32x16_bf16(__builtin_bit_cast(bf16x8, pw[ks]), vf, o[d0], 0, 0, 0); }
}
template <int KS>
__device__ __forceinline__ void load_kf(bf16x8 (&kf)[10], const LAS unsigned char* Kslot, int r32, int hi) {
    const LAS unsigned char* kb = Kslot + hi * 1024 + r32 * 16;
#pragma unroll
    for (int d0 = 0; d0 < KS; ++d0) { kf[2 * d0] = *(const LAS bf16x8*)(kb + d0 * 2048); kf[2 * d0 + 1] = *(const LAS bf16x8*)(kb + d0 * 2048 + 512); }
}
__device__ __forceinline__ void v_load(bf16x8 (&vf)[8], const LAS unsigned char* vb) {
#pragma unroll
    for (int d0 = 0; d0 < 2; ++d0)
#pragma unroll
        for (int ks = 0; ks < 4; ++ks) { const s16x4 lo = vtr(vb + d0 * 4096 + ks * 1024), hi = vtr(vb + d0 * 4096 + ks * 1024 + 512);
            vf[d0 * 4 + ks] = (bf16x8){lo[0], lo[1], lo[2], lo[3], hi[0], hi[1], hi[2], hi[3]}; }
}
template <int KS, bool LOADK>
__device__ __forceinline__ void pv_regs(f32x16 (&o)[2], const bf16x8 (&vf)[8], const f32x16& p0, const f32x16& p1, bf16x8 (&kf)[10], const LAS unsigned char* Knext, int r32, int hi) {
    v4u pw[4];
#pragma unroll
    for (int k = 0; k < 2; ++k) { pw[k] = (v4u){cvtpk(p0[8 * k], p0[8 * k + 1]), cvtpk(p0[8 * k + 2], p0[8 * k + 3]), cvtpk(p0[8 * k + 4], p0[8 * k + 5]), cvtpk(p0[8 * k + 6], p0[8 * k + 7])};
        pw[2 + k] = (v4u){cvtpk(p1[8 * k], p1[8 * k + 1]), cvtpk(p1[8 * k + 2], p1[8 * k + 3]), cvtpk(p1[8 * k + 4], p1[8 * k + 5]), cvtpk(p1[8 * k + 6], p1[8 * k + 7])}; }
#pragma unroll
    for (int ks = 0; ks < 2; ++ks)
#pragma unroll
        for (int d0 = 0; d0 < 2; ++d0) o[d0] = __builtin_amdgcn_mfma_f32_32x32x16_bf16(__builtin_bit_cast(bf16x8, pw[ks]), vf[d0 * 4 + ks], o[d0], 0, 0, 0);
    if (LOADK) { __builtin_amdgcn_sched_barrier(0); load_kf<KS>(kf, Knext, r32, hi); __builtin_amdgcn_sched_barrier(0); }
#pragma unroll
    for (int ks = 2; ks < 4; ++ks)
#pragma unroll
        for (int d0 = 0; d0 < 2; ++d0) o[d0] = __builtin_amdgcn_mfma_f32_32x32x16_bf16(__builtin_bit_cast(bf16x8, pw[ks]), vf[d0 * 4 + ks], o[d0], 0, 0, 0);
}
__device__ __forceinline__ float max3f(float a, float b, float c) { float r; asm("v_max3_f32 %0, %1, %2, %3" : "=v"(r) : "v"(a), "v"(b), "v"(c)); return r; }
__device__ __forceinline__ float rowmax32(const f32x16& p0, const f32x16& p1) {
    float a = max3f(p0[0], p0[1], p1[0]), b = max3f(p0[2], p0[3], p1[1]); a = max3f(a, p1[2], p1[3]);
#pragma unroll
    for (int r = 4; r < 16; r += 4) { a = max3f(a, p0[r], p0[r + 1]); b = max3f(b, p0[r + 2], p0[r + 3]); a = max3f(a, p1[r], p1[r + 1]); b = max3f(b, p1[r + 2], p1[r + 3]); }
    return max_half(__builtin_fmaxf(a, b));
}
template <bool FIRST>
__device__ __forceinline__ void softmax_tile(f32x16& p0, f32x16& p1, f32x16& cinit, float& l, f32x16 (&o)[2], LAS float* wsf, int r32, int hi) {
    const float rm = rowmax32(p0, p1);
    bool resc = false;
    if (FIRST) { const float dl = rm;
#pragma unroll
        for (int r = 0; r < 16; ++r) { p0[r] -= dl; p1[r] -= dl; cinit[r] -= dl; } }
    else if (__any(rm > THR)) { const float dl = fmaxf(rm, 0.f);
#pragma unroll
        for (int r = 0; r < 16; ++r) { p0[r] -= dl; p1[r] -= dl; cinit[r] -= dl; }
        const float f = __builtin_amdgcn_exp2f(-dl); l *= f; if (hi == 0) wsf[r32] = f; resc = true; }
    float s = 0.f;
#pragma unroll
    for (int r = 0; r < 16; ++r) { p0[r] = __builtin_amdgcn_exp2f(p0[r]); p1[r] = __builtin_amdgcn_exp2f(p1[r]); s += p0[r] + p1[r]; }
    l += s;
    if (resc) {
#pragma unroll
        for (int i = 0; i < 4; ++i) { const f32x4 f4 = *(const LAS f32x4*)(wsf + 8 * i + 4 * hi);
#pragma unroll
            for (int k = 0; k < 4; ++k) { o[0][4 * i + k] *= f4[k]; o[1][4 * i + k] *= f4[k]; } } }
}
__device__ __forceinline__ void row_bcast(float v, float (&out)[16], LAS float* wsf, int r32, int hi) {
    asm volatile("s_waitcnt lgkmcnt(0)" ::: "memory");
    if (hi == 0) wsf[32 + r32] = v;
#pragma unroll
    for (int i = 0; i < 4; ++i) { const f32x4 f4 = *(const LAS f32x4*)(wsf + 32 + 8 * i + 4 * hi);
#pragma unroll
        for (int k = 0; k < 4; ++k) out[4 * i + k] = f4[k]; }
    asm volatile("s_waitcnt lgkmcnt(0)" ::: "memory");
}
__device__ __forceinline__ void store_rows(const f32x16 (&v)[2], LAS unsigned char* stg_, bf16* Ow, int pitch, int lane, int r32, int hi) {
    LAS bf16* stg = (LAS bf16*)stg_;
#pragma unroll
    for (int r = 0; r < 16; ++r) { const int orow = crow(r, hi);
#pragma unroll
        for (int d0 = 0; d0 < 2; ++d0) stg[orow * 64 + d0 * 32 + r32] = (bf16)f2bf(v[d0][r]); }
    asm volatile("s_waitcnt lgkmcnt(0)" ::: "memory");
#pragma unroll
    for (int i = 0; i < 4; ++i) { const int row = i * 8 + (lane >> 3), ch = lane & 7; const v4u w = *(const LAS v4u*)(stg + row * 64 + ch * 8); *(GAS v4u*)(Ow + (size_t)row * pitch + ch * 8) = w; }
    asm volatile("s_waitcnt lgkmcnt(0)" ::: "memory");
}


template <int KS>
__device__ __forceinline__ void qk_regs(f32x16& p0, f32x16& p1, const bf16x8 (&kf)[10], const bf16x8 (&qr)[5], const f32x16& cinit) {
    p0 = __builtin_amdgcn_mfma_f32_32x32x16_bf16(kf[0], qr[0], cinit, 0, 0, 0); p1 = __builtin_amdgcn_mfma_f32_32x32x16_bf16(kf[1], qr[0], cinit, 0, 0, 0);
#pragma unroll
    for (int d0 = 1; d0 < KS; ++d0) { p0 = __builtin_amdgcn_mfma_f32_32x32x16_bf16(kf[2 * d0], qr[d0], p0, 0, 0, 0); p1 = __builtin_amdgcn_mfma_f32_32x32x16_bf16(kf[2 * d0 + 1], qr[d0], p1, 0, 0, 0); }
}
__device__ __forceinline__ void softmax_first(f32x16& p0, f32x16& p1, f32x16& cinit, float& l) {
    const float dl = rowmax32(p0, p1); float s = 0.f;
#pragma unroll
    for (int r = 0; r < 16; ++r) { cinit[r] -= dl; p0[r] = __builtin_amdgcn_exp2f(p0[r] - dl); p1[r] = __builtin_amdgcn_exp2f(p1[r] - dl); s += p0[r] + p1[r]; }
    l = s;
}
__device__ __forceinline__ void softmax_next(f32x16& p0, f32x16& p1, f32x16& cinit, float& l, f32x16 (&o)[2], LAS float* wsf, int r32, int hi) {
    const float rm = rowmax32(p0, p1);
    if (__builtin_expect(__any(rm > THR), 0)) { const float dl = __builtin_fmaxf(rm, 0.f);
#pragma unroll
        for (int r = 0; r < 16; ++r) { p0[r] -= dl; p1[r] -= dl; cinit[r] -= dl; }
        const float f = __builtin_amdgcn_exp2f(-dl); l *= f; if (hi == 0) wsf[r32] = f;
#pragma unroll
        for (int i = 0; i < 4; ++i) { const f32x4 f4 = *(const LAS f32x4*)(wsf + 8 * i + 4 * hi);
#pragma unroll
            for (int k = 0; k < 4; ++k) { o[0][4 * i + k] *= f4[k]; o[1][4 * i + k] *= f4[k]; } } }
    float s = 0.f;
#pragma unroll
    for (int r = 0; r < 16; ++r) { p0[r] = __builtin_amdgcn_exp2f(p0[r]); p1[r] = __builtin_amdgcn_exp2f(p1[r]); s += p0[r] + p1[r]; }
    l += s;
}

#define AT_CONSUME4(a, b, c, d) asm volatile("" :: "v"(a), "v"(b), "v"(c), "v"(d))

__device__ __forceinline__ void fox_unit(Frame& F, int bh, int qb, int kt0, const int ABL) {
    int tid_ = cur_tid(F); asm volatile("" : "+v"(tid_));
    AT_PRIO(F.wave);
    const int lane = tid_ & 63, r32 = lane & 31, hi = lane >> 5, wid = F.wave; const int b = bh >> 3, h = bh & 7;
    LAS unsigned char* shm = F.lds + RING_OFF; const unsigned lds0 = (unsigned)(uintptr_t)shm;
    LAS float* wsf = (LAS float*)(shm + L_WS + wid * 512);
    const size_t rowbase = (size_t)b * SEQ; const int q0 = qb * 256;
    const bf16* Q = wsp<bf16>(F, WS_FQ); const bf16* K = wsp<bf16>(F, WS_FK) + (rowbase + (size_t)kt0 * 64) * 512 + h * 64; const bf16* V = wsp<bf16>(F, WS_FV) + (rowbase + (size_t)kt0 * 64) * 512 + h * 64;
    const bf16* KX = wsp<bf16>(F, WS_FKX) + ((size_t)bh * SEQ + (size_t)kt0 * 64) * 16;
    const unsigned koff = (unsigned)(lane * 512 + wid * 8) * 2u, voff = (unsigned)((16 * (wid & 3) + (lane >> 2)) * 512 + (wid >> 2) * 32 + (lane & 3) * 8) * 2u;
    const unsigned xoff = (unsigned)((16 * (wid & 3) + (lane >> 2)) * 16 + (wid >> 2) * 8 + (lane & 3) * 2) * 2u;
    const unsigned kdst = lds0 + L_K + wid * 1024, vdst = lds0 + L_V + wid * 1024, xdst = lds0 + L_K + (8 + (wid >> 2)) * 1024 + (wid & 3) * 256;
#define FX_DMA_K(t, slot) do { glds16(K + (size_t)(t) * 64 * 512, koff, (unsigned)__builtin_amdgcn_readfirstlane(kdst + (slot) * KSLOT)); \
        glds4(KX + (size_t)(t) * 64 * 16, xoff, (unsigned)__builtin_amdgcn_readfirstlane(xdst + (slot) * KSLOT)); } while (0)
#define FX_DMA_V(t, slot) glds16(V + (size_t)(t) * 64 * 512, voff, (unsigned)__builtin_amdgcn_readfirstlane(vdst + (slot) * VSLOT))
    const int NT = 4 * qb + 4 - kt0;
    bf16x8 qr[5];
    { const bf16* Qw = Q + (rowbase + q0 + wid * 32 + r32) * 512 + h * 64;
#pragma unroll
      for (int d0 = 0; d0 < 4; ++d0) { if (ABL == 10) { qr[d0] = (bf16x8){(short)lane, 0, 0, 0, 0, 0, 0, 0}; asm volatile("" : "+v"(qr[d0])); } else qr[d0] = *(const GAS bf16x8*)(Qw + d0 * 16 + hi * 8); }
      const short one = (short)0x3F80; qr[4] = hi == 0 ? (bf16x8){one, one, one, 0, 0, 0, 0, 0} : (bf16x8){0, 0, 0, 0, 0, 0, 0, 0}; }
    const float ct = wsp<float>(F, WS_C)[(size_t)bh * SEQ + q0 + wid * 32 + r32] * LOG2E;
    asm volatile("" ::: "memory");
    if (ABL != 9) { FX_DMA_K(0, 0); FX_DMA_V(0, 0); FX_DMA_K(1, 1); FX_DMA_K(2, 2); FX_DMA_V(1, 1); }
    f32x16 cinit;
    f32x16 o[2]; o[0] = f32x16{}; o[1] = f32x16{}; float l = 0.f;
    const int qrel = wid * 32 + r32;
    const LAS unsigned char* vtb = shm + L_V + ((lane >> 4) & 1) * 32 + (lane & 3) * 8 + (4 * hi + ((lane & 15) >> 2)) * 64;
    bf16x8 kf[10], vf[8];
    AT_WAIT_BAR(3);
    AT_CONSUME4(qr[0], qr[1], qr[2], qr[3]); asm volatile("" :: "v"(ct));
#pragma unroll
    for (int r = 0; r < 16; ++r) cinit[r] = ct;
    load_kf<5>(kf, shm + L_K, r32, hi);
    int s0 = 0, s1 = 1, s2 = 2;
#define FX_MASK(n) do { const int jb_ = (n) - (NT - 4); if (jb_ >= 0) { const int kb_ = 64 * jb_ + 4 * hi; \
        _Pragma("unroll") for (int r = 0; r < 16; ++r) { const int kv = kb_ + (r & 3) + 8 * (r >> 2); if (kv > qrel) p0[r] = AT_NEG; if (kv + 32 > qrel) p1[r] = AT_NEG; } } } while (0)
#define FX_ROT() do { const int t_ = s0; s0 = s1; s1 = s2; s2 = t_; } while (0)
    if (ABL < 7) {
    {
      AT_WAIT_BAR(3); FX_DMA_K(3, 0); FX_DMA_V(2, 2);
      f32x16 p0, p1; qk_regs<5>(p0, p1, kf, qr, cinit); v_load(vf, vtb); __builtin_amdgcn_sched_barrier(0);
      FX_MASK(0); softmax_first(p0, p1, cinit, l); pv_regs<5, true>(o, vf, p0, p1, kf, shm + L_K + KSLOT, r32, hi); FX_ROT(); }
    int n = 1;
    for (; n + 3 < NT; ++n) {
        if (ABL == 4) asm volatile("s_waitcnt vmcnt(3) lgkmcnt(0)" ::: "memory"); else AT_WAIT_BAR(3);
        if (ABL != 5) { FX_DMA_K(n + 3, s0); FX_DMA_V(n + 2, s2); }
        f32x16 p0, p1; if (ABL == 3) { p0 = cinit; p1 = cinit; asm volatile("" : "+v"(p0), "+v"(p1)); } else qk_regs<5>(p0, p1, kf, qr, cinit);
        v_load(vf, vtb + s0 * VSLOT); __builtin_amdgcn_sched_barrier(0);
        FX_MASK(n);
        if (ABL == 6) { asm volatile("" : "+v"(p0), "+v"(p1)); }
        else if (ABL == 1) { const float rm = rowmax32(p0, p1); l += rm; asm volatile("" : "+v"(p0), "+v"(p1)); }
        else softmax_next(p0, p1, cinit, l, o, wsf, r32, hi);
        if (ABL == 2) { asm volatile("" :: "v"(p0), "v"(p1), "v"(vf[0]), "v"(vf[1]), "v"(vf[2]), "v"(vf[3]), "v"(vf[4]), "v"(vf[5]), "v"(vf[6]), "v"(vf[7])); load_kf<5>(kf, shm + L_K + s1 * KSLOT, r32, hi); }
        else pv_regs<5, true>(o, vf, p0, p1, kf, shm + L_K + s1 * KSLOT, r32, hi);
        FX_ROT(); }
    {
      AT_WAIT_BAR(3); FX_DMA_V(n + 2, s2);
      f32x16 p0, p1; qk_regs<5>(p0, p1, kf, qr, cinit); v_load(vf, vtb + s0 * VSLOT); __builtin_amdgcn_sched_barrier(0);
      FX_MASK(n); softmax_next(p0, p1, cinit, l, o, wsf, r32, hi); pv_regs<5, true>(o, vf, p0, p1, kf, shm + L_K + s1 * KSLOT, r32, hi); FX_ROT(); ++n; }
    {
      AT_WAIT_BAR(1);
      f32x16 p0, p1; qk_regs<5>(p0, p1, kf, qr, cinit); v_load(vf, vtb + s0 * VSLOT); __builtin_amdgcn_sched_barrier(0);
      FX_MASK(n); softmax_next(p0, p1, cinit, l, o, wsf, r32, hi); pv_regs<5, true>(o, vf, p0, p1, kf, shm + L_K + s1 * KSLOT, r32, hi); FX_ROT(); ++n; }
    {
      AT_WAIT_BAR(0);
      f32x16 p0, p1; qk_regs<5>(p0, p1, kf, qr, cinit); v_load(vf, vtb + s0 * VSLOT); __builtin_amdgcn_sched_barrier(0);
      FX_MASK(n); softmax_next(p0, p1, cinit, l, o, wsf, r32, hi); pv_regs<5, false>(o, vf, p0, p1, kf, shm, r32, hi); }
    } else { asm volatile("s_waitcnt vmcnt(0)" ::: "memory"); l = 1.f; }
#undef FX_DMA_K
#undef FX_DMA_V
#undef FX_MASK
#undef FX_ROT
    l = sum_half(l); float rl[16]; row_bcast(1.0f / l, rl, wsf, r32, hi);
#pragma unroll
    for (int r = 0; r < 16; ++r) { o[0][r] *= rl[r]; o[1][r] *= rl[r]; }
    if (ABL != 8) store_rows(o, shm + L_PARK + wid * 8192, wsp<bf16>(F, ABL ? WS_PROBE_O : WS_ATT) + (rowbase + q0 + wid * 32) * 1024 + 512 + h * 64, 1024, lane, r32, hi);
    AT_BAR();
}

__device__ __forceinline__ void nsa_unit(Frame& F, int bg, int j, const int ABL) {
    int tid_ = cur_tid(F); asm volatile("" : "+v"(tid_));
    AT_PRIO(F.wave);
    const int tid = tid_, lane = tid & 63, r32 = lane & 31, hi = lane >> 5, wid = F.wave; const int b = bg >> 1, g = bg & 1, hh = wid >> 1, head = 4 * g + hh;
    LAS unsigned char* shm = F.lds + RING_OFF; const unsigned lds0 = (unsigned)(uintptr_t)shm;
    LAS float* wsf = (LAS float*)(shm + L_WS + wid * 512);
    LAS float* PSL = (LAS float*)(shm + L_PSL); LAS unsigned* SELM = (LAS unsigned*)(shm + L_SELM);
    const int qrel = 32 * (wid & 1) + r32, t = 64 * j + qrel; const size_t row = (size_t)b * SEQ + t;
    const bf16* KC = wsp<bf16>(F, WS_KCMP) + (size_t)bg * 128 * 64; const bf16* VC = wsp<bf16>(F, WS_VCMP) + (size_t)bg * 128 * 64;
    const bf16* KS = wsp<bf16>(F, WS_KV + 2 * KV_STRIDE) + (size_t)bg * SEQ * 64; const bf16* VS = wsp<bf16>(F, WS_KV + 3 * KV_STRIDE) + (size_t)bg * SEQ * 64;
    const bf16* KW = wsp<bf16>(F, WS_KV + 4 * KV_STRIDE) + (size_t)bg * SEQ * 64; const bf16* VW = wsp<bf16>(F, WS_KV + 5 * KV_STRIDE) + (size_t)bg * SEQ * 64;
    const unsigned koff = (unsigned)(lane * 64 + wid * 8) * 2u, voff = (unsigned)((16 * (wid & 3) + (lane >> 2)) * 64 + (wid >> 2) * 32 + (lane & 3) * 8) * 2u;
    const unsigned kdst = lds0 + L_K + wid * 1024, vdst = lds0 + L_V + wid * 1024, cdst = lds0 + L_CMP + wid * 1024;
    const int nsel = j + 1, nwin = j >= 8 ? 9 : j + 1, NR = nsel + nwin;
#define NS_TILE(m) ({ int m_ = (m); m_ = m_ < NR ? m_ : NR - 1; (m_ < nsel) ? m_ : (j - (m_ - nsel)) + 64; })
#define NS_DMA_K(m, slot) do { const int e_ = NS_TILE(m); const bf16* kp_ = (e_ < 64) ? KS + e_ * 4096 : KW + (e_ - 64) * 4096; glds16(kp_, koff, (unsigned)__builtin_amdgcn_readfirstlane(kdst + (slot) * KSLOT)); } while (0)
#define NS_DMA_V(m, slot) do { const int e_ = NS_TILE(m); const bf16* vp_ = (e_ < 64) ? VS + e_ * 4096 : VW + (e_ - 64) * 4096; glds16(vp_, voff, (unsigned)__builtin_amdgcn_readfirstlane(vdst + (slot) * VSLOT)); } while (0)
    bf16x8 qr[5];
    { const bf16* Qw = wsp<bf16>(F, WS_NQ) + row * 512 + head * 64;
#pragma unroll
      for (int d0 = 0; d0 < 4; ++d0) qr[d0] = *(const GAS bf16x8*)(Qw + d0 * 16 + hi * 8);
      qr[4] = (bf16x8){0, 0, 0, 0, 0, 0, 0, 0}; }
    const float* gt = wsp<float>(F, WS_GATE) + row * 24 + head * 3; const float g0 = gt[0], g1 = gt[1], g2 = gt[2];
    asm volatile("" ::: "memory");
    glds16(KC, koff, (unsigned)__builtin_amdgcn_readfirstlane(cdst)); glds16(KC + 4096, koff, (unsigned)__builtin_amdgcn_readfirstlane(cdst + 8192));
    glds16(VC, voff, (unsigned)__builtin_amdgcn_readfirstlane(cdst + 16384)); glds16(VC + 4096, voff, (unsigned)__builtin_amdgcn_readfirstlane(cdst + 24576));
    NS_DMA_K(0, 0); NS_DMA_V(0, 0); NS_DMA_K(1, 1); NS_DMA_K(2, 2); NS_DMA_V(1, 1);
    const LAS unsigned char* vlane = shm + ((lane >> 4) & 1) * 32 + (lane & 3) * 8 + (4 * hi + ((lane & 15) >> 2)) * 64;
    const LAS unsigned char* vtb = vlane + L_V;
    f32x16 o[2]; float rs[16]; bf16x8 kf[10], vf[8];
    LAS float* park = (LAS float*)(shm + L_PARK + wid * 8192) + lane;
    AT_WAIT_BAR(5);
    AT_CONSUME4(qr[0], qr[1], qr[2], qr[3]); asm volatile("" :: "v"(g0), "v"(g1), "v"(g2));
    { f32x16 zero = f32x16{}; f32x16 a0, a1, b0, b1;
      load_kf<4>(kf, shm + L_CMP, r32, hi); qk_regs<4>(a0, a1, kf, qr, zero); load_kf<4>(kf, shm + L_CMP + 8192, r32, hi); qk_regs<4>(b0, b1, kf, qr, zero);
      const int nmax = (t - 31) >> 4;
#pragma unroll
      for (int r = 0; r < 16; ++r) { const int n = (r & 3) + 8 * (r >> 2) + 4 * hi; if (n > nmax) a0[r] = AT_NEG; if (n + 32 > nmax) a1[r] = AT_NEG; if (n + 64 > nmax) b0[r] = AT_NEG; if (n + 96 > nmax) b1[r] = AT_NEG; }
      float m = __builtin_fmaxf(rowmax32(a0, a1), rowmax32(b0, b1)); m = (m == AT_NEG) ? 0.f : m;
      float s = 0.f;
#pragma unroll
      for (int r = 0; r < 16; ++r) { a0[r] = __builtin_amdgcn_exp2f(a0[r] - m); a1[r] = __builtin_amdgcn_exp2f(a1[r] - m); b0[r] = __builtin_amdgcn_exp2f(b0[r] - m); b1[r] = __builtin_amdgcn_exp2f(b1[r] - m); s += (a0[r] + a1[r]) + (b0[r] + b1[r]); }
      s = sum_half(s); const float inv = 1.0f / fmaxf(s, 1e-30f);
#pragma unroll
      for (int r = 0; r < 16; ++r) { a0[r] *= inv; a1[r] *= inv; b0[r] *= inv; b1[r] *= inv; }
      if (j >= 8) {
          float G[16], Lp[16];
#pragma unroll
          for (int i = 0; i < 4; ++i) { G[i] = (a0[4 * i] + a0[4 * i + 1]) + (a0[4 * i + 2] + a0[4 * i + 3]); G[4 + i] = (a1[4 * i] + a1[4 * i + 1]) + (a1[4 * i + 2] + a1[4 * i + 3]);
              G[8 + i] = (b0[4 * i] + b0[4 * i + 1]) + (b0[4 * i + 2] + b0[4 * i + 3]); G[12 + i] = (b1[4 * i] + b1[4 * i + 1]) + (b1[4 * i + 2] + b1[4 * i + 3]);
              Lp[i] = swap_half(a0[4 * i + 3], hi); Lp[4 + i] = swap_half(a1[4 * i + 3], hi); Lp[8 + i] = swap_half(b0[4 * i + 3], hi); Lp[12 + i] = swap_half(b1[4 * i + 3], hi); }
          LAS float* dst = PSL + (hh * 64 + qrel) * 33 + hi;
#pragma unroll
          for (int I = 0; I < 16; ++I) { const float prev = hi ? Lp[I] : (I > 0 ? Lp[I > 0 ? I - 1 : 0] : 0.f); dst[2 * I] = G[I] + prev; }
      }
      o[0] = f32x16{}; o[1] = f32x16{};
      pv(o, vlane + L_CMP + 16384, a0, a1); pv(o, vlane + L_CMP + 24576, b0, b1);
    }
    AT_BAR();
    if (j >= 8 && ABL != 3) { const int q = tid >> 3, sub = tid & 7;
        float v[4]; unsigned bits = 1u | (1u << j) | (1u << (j - 1));
#pragma unroll
        for (int c4 = 0; c4 < 4; ++c4) { const int k = 4 * sub + c4;
            const float ps = (PSL[(0 * 64 + q) * 33 + k] + PSL[(1 * 64 + q) * 33 + k]) + (PSL[(2 * 64 + q) * 33 + k] + PSL[(3 * 64 + q) * 33 + k]);
            v[c4] = (k > j - 2 || k == 0) ? -1e30f : ps; }
#pragma unroll 1
        for (int rnd = 0; rnd < 5; ++rnd) {
            float bv = v[0]; int bi = 4 * sub;
#pragma unroll
            for (int c4 = 1; c4 < 4; ++c4) if (v[c4] > bv) { bv = v[c4]; bi = 4 * sub + c4; }
#pragma unroll
            for (int o = 1; o < 8; o <<= 1) { const float ov = __shfl_xor(bv, o); const int oi = __shfl_xor(bi, o); if (ov > bv || (ov == bv && oi < bi)) { bv = ov; bi = oi; } }
            bits |= 1u << bi;
#pragma unroll
            for (int c4 = 0; c4 < 4; ++c4) if (bi == 4 * sub + c4) v[c4] = -3.0e38f; }
        if (sub == 0) SELM[q] = bits;
    } else { if (tid < 64) SELM[tid] = (2u << j) - 1u; }
    AT_BAR();
    const unsigned selm = SELM[qrel];
    row_bcast(g0, rs, wsf, r32, hi);
#pragma unroll
    for (int r = 0; r < 16; ++r) { park[r * 64] = o[0][r] * rs[r]; park[(16 + r) * 64] = o[1][r] * rs[r]; }
    f32x16 cinit; float l;
    AT_WAIT_BAR(2);
    load_kf<4>(kf, shm + L_K, r32, hi);
    int s0 = 0, s1 = 1, s2 = 2, m = 0;
#define NS_ROT() do { const int t_ = s0; s0 = s1; s1 = s2; s2 = t_; ++m; } while (0)
#define NS_HEAD() AT_WAIT_BAR(2); NS_DMA_K(m + 3, s0); NS_DMA_V(m + 2, s2); f32x16 p0, p1; qk_regs<4>(p0, p1, kf, qr, cinit); v_load(vf, vtb + s0 * VSLOT); __builtin_amdgcn_sched_barrier(0)
#define NS_MASK_SEL() do { const float keep_ = ((selm >> m) & 1u) ? 0.f : AT_NEG;        \
        if (ABL != 1) { _Pragma("unroll") for (int r = 0; r < 16; ++r) { p0[r] += keep_; p1[r] += keep_; } } \
        if (m == j) {   \
        _Pragma("unroll") for (int r = 0; r < 16; ++r) { const int kk = (r & 3) + 8 * (r >> 2) + 4 * hi; if (kk > qrel) p0[r] = AT_NEG; if (kk + 32 > qrel) p1[r] = AT_NEG; } } } while (0)
#define NS_MASK_WIN() do { const int tt = j - (m - nsel); if (tt == j) { \
        _Pragma("unroll") for (int r = 0; r < 16; ++r) { const int kk = (r & 3) + 8 * (r >> 2) + 4 * hi; if (kk > qrel) p0[r] = AT_NEG; if (kk + 32 > qrel) p1[r] = AT_NEG; } } \
      else if (tt == j - 8) {   \
        _Pragma("unroll") for (int r = 0; r < 16; ++r) { const int kk = (r & 3) + 8 * (r >> 2) + 4 * hi; if (kk <= qrel) p0[r] = AT_NEG; if (kk + 32 <= qrel) p1[r] = AT_NEG; } } } while (0)
    cinit = f32x16{}; o[0] = f32x16{}; o[1] = f32x16{};
    l = 1.f;
    if (ABL != 2) {
    { NS_HEAD(); NS_MASK_SEL(); softmax_first(p0, p1, cinit, l); pv_regs<4, true>(o, vf, p0, p1, kf, shm + L_K + s1 * KSLOT, r32, hi); NS_ROT(); }
    for (; m < nsel;) { NS_HEAD(); NS_MASK_SEL(); softmax_next(p0, p1, cinit, l, o, wsf, r32, hi); pv_regs<4, true>(o, vf, p0, p1, kf, shm + L_K + s1 * KSLOT, r32, hi); NS_ROT(); }
    }
    l = sum_half(l); row_bcast(g1 / l, rs, wsf, r32, hi);
#pragma unroll
    for (int r = 0; r < 16; ++r) { park[r * 64] += o[0][r] * rs[r]; park[(16 + r) * 64] += o[1][r] * rs[r]; }
    cinit = f32x16{}; o[0] = f32x16{}; o[1] = f32x16{};
    l = 1.f;
    if (ABL != 2) {
    { NS_HEAD(); NS_MASK_WIN(); softmax_first(p0, p1, cinit, l); pv_regs<4, true>(o, vf, p0, p1, kf, shm + L_K + s1 * KSLOT, r32, hi); NS_ROT(); }
    for (; m < NR;) { NS_HEAD(); NS_MASK_WIN(); softmax_next(p0, p1, cinit, l, o, wsf, r32, hi); pv_regs<4, true>(o, vf, p0, p1, kf, shm + L_K + s1 * KSLOT, r32, hi); NS_ROT(); }
    }
#undef NS_HEAD
#undef NS_TILE
#undef NS_DMA_K
#undef NS_DMA_V
#undef NS_ROT
#undef NS_MASK_SEL
#undef NS_MASK_WIN
    l = sum_half(l); row_bcast(g2 / l, rs, wsf, r32, hi);
#pragma unroll
    for (int r = 0; r < 16; ++r) { o[0][r] = park[r * 64] + o[0][r] * rs[r]; o[1][r] = park[(16 + r) * 64] + o[1][r] * rs[r]; }
    asm volatile("s_waitcnt vmcnt(0) lgkmcnt(0)" ::: "memory");
    store_rows(o, shm + L_PARK + wid * 8192, wsp<bf16>(F, ABL ? WS_PROBE_O : WS_ATT) + ((size_t)b * SEQ + 64 * j + 32 * (wid & 1)) * 1024 + head * 64, 1024, lane, r32, hi);
    AT_BAR();
}
constexpr int NUNITS = 4096;
__device__ const unsigned short BLK_TAB[64] = {64512, 63489, 62466, 61443, 60420, 59397, 58374, 57351, 56328, 55305, 54282, 53259, 52236, 51213, 50190, 49167, 48144, 47121, 46098, 45075, 44052, 43029, 42006, 40983, 39960, 38937, 37914, 36891, 35868, 2077, 2077, 2077, 2077, 3105, 3105, 3105, 3105, 4133, 4133, 4133, 4133, 5161, 5161, 5161, 5161, 6189, 6189, 6189, 6189, 7217, 7217, 7217, 7217, 34869, 1078, 1078, 1078, 1078, 33850, 32827, 60, 60, 60, 60};
}
#ifndef PROBE_ABL
#define PROBE_ABL 0
#endif
__device__ __forceinline__ void p3_attention(Frame& F, const int MODE) {
    const int G = F.G, c = F.vcu, nrounds = (at::NUNITS + G - 1) / G;
    const gu32* KT0 = (const gu32*)wsp<unsigned>(F, WS_KT0);
#define P3_UNIT(i) ((i) * G + (((i) & 1) ? G - 1 - c : c))
#define P3_KT0_IDX(u) ({ const unsigned tb_ = at::BLK_TAB[(u) >> 6]; const int ix_ = (u) - (int)(tb_ & 1023u) * 64; (tb_ >> 15) ? 0 : ix_ * 8 + (int)((tb_ >> 10) & 31u); })
    unsigned kt_next = 0u;
    { const int u0 = P3_UNIT(0); if (u0 < at::NUNITS) kt_next = __hip_atomic_load(KT0 + P3_KT0_IDX(u0), RLX_AGENT); }
    for (int i = 0; i < nrounds; ++i) {
        const int u = P3_UNIT(i); if (u >= at::NUNITS) continue;
        const int kt0 = __builtin_amdgcn_readfirstlane((int)kt_next);
        { const int un = P3_UNIT(i + 1); if (i + 1 < nrounds && un < at::NUNITS) kt_next = __hip_atomic_load(KT0 + P3_KT0_IDX(un), RLX_AGENT); }
        const unsigned tab = at::BLK_TAB[u >> 6]; const int idx = u - (int)(tab & 1023u) * 64; const int par = (tab >> 10) & 31;
        if (tab >> 15) { if (MODE != 1 && MODE != 5) at::nsa_unit(F, idx, par, MODE == 2 ? PROBE_ABL : 0); } else { if (MODE != 2 && MODE != 5) at::fox_unit(F, idx, par, kt0, MODE == 1 ? PROBE_ABL : 0); }
    }
#undef P3_UNIT
#undef P3_KT0_IDX
    if (AT_PRIO_MODE != 0) __builtin_amdgcn_s_setprio(0);
    asm volatile("s_waitcnt vmcnt(0) lgkmcnt(0)" ::: "memory");
    __syncthreads();
}

struct Args { const float* in[18]; float* out; unsigned char* ws; int ph_lo, ph_hi, li, pad; };
__global__ void __launch_bounds__(NWAVES * 64, 2) fwd_kernel(Args args) {
    extern __shared__ __attribute__((aligned(16))) unsigned char lds[];
    Frame F;
    F.lds = (LAS unsigned char*)lds;
    F.MISC = (volatile LAS unsigned*)(F.lds + MISC_OFF);
    F.wave = __builtin_amdgcn_readfirstlane((int)threadIdx.x >> 6);
    F.G = gridDim.x; { const int bx = blockIdx.x; F.vcu = (F.G % 8 == 0) ? (bx % 8) * (F.G / 8) + bx / 8 : bx; }
    F.ws = args.ws; F.ctl = (gu32*)(args.ws + WS_CTL);
    F.x = args.in[0]; F.g_mix_pre = args.in[1]; F.g_mix_post = args.in[2]; F.g_mlp_pre = args.in[3]; F.g_mlp_post = args.in[4]; F.w_in = args.in[5]; F.b_forget = args.in[6];
    F.pos_k = args.in[7]; F.w1_k = args.in[8]; F.w2_k = args.in[9]; F.pos_v = args.in[10]; F.w1_v = args.in[11]; F.w2_v = args.in[12];
    F.w_fox = args.in[13]; F.w_nsa = args.in[14]; F.w_o = args.in[15]; F.w_up = args.in[16]; F.w_down = args.in[17]; F.out = args.out;
    for (int u = (int)threadIdx.x; u < (LDS_BYTES - LDSCTL_OFF) / 4; u += NWAVES * 64) ((LAS unsigned*)(F.lds + LDSCTL_OFF))[u] = 0u;
    __syncthreads();
    XcdBarrier bar; bar.bar = (unsigned*)(F.ctl + CW_BAR); bar.x = 0; bar.st = nullptr;
    if (N_LAUNCHES == 1) bar = xcd_barrier_post((unsigned*)(F.ctl + CW_BAR), F.MISC + 8);
#define GRID_BAR() do { if (N_LAUNCHES == 1) xcd_barrier(bar); } while (0)
    const int lo = args.ph_lo, hi = args.ph_hi;
#define IN(k) (lo <= (k) && (k) < hi)
#define BOTH(k) (IN(k) && IN((k) + 1))
#ifndef STAGGER_P7
#define STAGGER_P7 0
#endif
#ifndef STAGGER_P1
#define STAGGER_P1 0
#endif
#define XCD_STAGGER(ticks) do { if ((ticks) > 0) { const unsigned long long t0_ = rt(); const unsigned long long d_ = (unsigned long long)(xb_xcc_id() & 7u) * (unsigned)(ticks) / 8u; while (rt() - t0_ < d_) __builtin_amdgcn_s_sleep(8); } } while (0)
#ifndef PROBE_REPEAT
#define PROBE_REPEAT (-1)
#endif
#define REPS(k) for (int rep_ = 0; rep_ < ((PROBE_REPEAT == (k)) ? 2 : 1); ++rep_)
#define REP_BAR(k) do { if (PROBE_REPEAT == (k) && rep_ == 0) { VM_WAIT(); __syncthreads(); GRID_BAR(); } } while (0)

    if (IN(0)) { REPS(0) { p0_prologue(F); REP_BAR(0); } if (BOTH(0)) GRID_BAR(); }

    if (IN(1)) { XCD_STAGGER(STAGGER_P1);
        pg8::Gemm g{wsp<bf16>(F, WS_HB), wsp<bf16>(F, WS_WIN), MTOK, NPROJ, DMODEL}; pg8::StaticOrder S; S.init(MTOK, NPROJ, F.G, (int)blockIdx.x);
        pg8::EpiInProj E{wsp<bf16>(F, WS_FQ), wsp<bf16>(F, WS_NQ), wsp<bf16>(F, WS_KV), wsp<bf16>(F, WS_SGA),
                         wsp<float>(F, WS_LF), wsp<float>(F, WS_GATE), F.b_forget, wsp<float>(F, WS_ROPEC), wsp<float>(F, WS_ROPES), (WS_FK - WS_FQ) / 2, KV_STRIDE / 2, (WS_SGB - WS_SGA) / 2, QSCALE};
        REPS(1) { pg8::gemm_phase<pg8::EpiInProj, pg8::StaticOrder, true, true>(F.lds + RING_OFF, g, S, E, F.wave); REP_BAR(1); }
        if (BOTH(1)) GRID_BAR();
    }
    if (IN(2)) { REPS(2) { p2_phase(F); REP_BAR(2); } if (BOTH(2)) GRID_BAR(); }
#ifndef PROBE_P3_MODE
#define PROBE_P3_MODE 3
#endif
    if (IN(3)) {
#if PROBE_REPEAT == 3
        for (int rep_ = 0; rep_ < 2; ++rep_) { p3_attention(F, rep_ ? PROBE_P3_MODE : 0); if (rep_ == 0) { VM_WAIT(); __syncthreads(); GRID_BAR(); } }
#else
        p3_attention(F, 0);
#endif
        if (BOTH(3)) GRID_BAR(); }
    if (IN(4)) { REPS(4) {
        pg8::Gemm g{wsp<bf16>(F, WS_ATT), wsp<bf16>(F, WS_WF), MTOK, DMODEL, DMODEL}; pg8::StaticOrder S; S.init(MTOK, DMODEL, F.G, (int)blockIdx.x);
        pg8::EpiGateMid E{wsp<bf16>(F, WS_HB), wsp<bf16>(F, WS_SGA), wsp<bf16>(F, WS_SGB), DMODEL};
        pg8::gemm_phase<pg8::EpiGateMid, pg8::StaticOrder, true, true>(F.lds + RING_OFF, g, S, E, F.wave);
        REP_BAR(4); }
        if (BOTH(4)) GRID_BAR();
    }
    if (IN(5)) {
        pg8::Gemm g{wsp<bf16>(F, WS_HB), wsp<bf16>(F, WS_WO), MTOK, DMODEL, DMODEL}; pg8::StaticOrder S; S.init(MTOK, DMODEL, F.G, (int)blockIdx.x);
        pg8::EpiPlain<0> E{wsp<bf16>(F, WS_Y), DMODEL};
        REPS(5) { pg8::gemm_phase<pg8::EpiPlain<0>, pg8::StaticOrder, true, true>(F.lds + RING_OFF, g, S, E, F.wave); REP_BAR(5); }
        if (BOTH(5)) GRID_BAR();
    }
    if (IN(6)) { REPS(6) { row_pass<false>(F, F.x, nullptr, wsp<bf16>(F, WS_Y), F.g_mix_post, nullptr, wsp<bf16>(F, WS_HB), wsp<float>(F, WS_RSTD2)); REP_BAR(6); } if (BOTH(6)) GRID_BAR(); }
#ifndef MLP_CHUNKS
#define MLP_CHUNKS 1
#endif
    if (IN(7) || IN(8)) {
        constexpr int CH = MLP_CHUNKS, MC = MTOK / CH;
#pragma unroll
        for (int ch = 0; ch < CH; ++ch) {
            if (IN(7)) { XCD_STAGGER(STAGGER_P7);
                pg8::Gemm g{wsp<bf16>(F, WS_HB) + (size_t)ch * MC * DMODEL, wsp<bf16>(F, WS_WUP), MC, DFF, DMODEL}; pg8::StaticOrder S; S.init(MC, DFF, F.G, (int)blockIdx.x);
                pg8::EpiRelu2F8 E{wsp<unsigned char>(F, WS_U) + (size_t)ch * MC * DFF, DFF};
                REPS(7) { pg8::gemm_phase<pg8::EpiRelu2F8, pg8::StaticOrder, true, true>(F.lds + RING_OFF, g, S, E, F.wave); REP_BAR(7); }
                if (IN(8)) GRID_BAR(); }
            if (IN(8)) {
                pg8::Gemm g{(const pg8::bf16_t*)(wsp<unsigned char>(F, WS_U) + (size_t)ch * MC * DFF), (const pg8::bf16_t*)wsp<unsigned char>(F, WS_WDN), MC, DMODEL, DFF / 2}; pg8::StaticOrder S; S.init(MC, DMODEL, F.G, (int)blockIdx.x);
                pg8::EpiScaled E{wsp<bf16>(F, WS_Y) + (size_t)ch * MC * DMODEL, DMODEL, 1.f / WDN_SCALE};
                REPS(8) { pg8::gemm_phase<pg8::EpiScaled, pg8::StaticOrder, true, true, true>(F.lds + RING_OFF, g, S, E, F.wave); REP_BAR(8); }
                if (ch + 1 == CH && BOTH(8)) GRID_BAR(); }
        }
    }
    if (IN(9)) { row_pass<true>(F, nullptr, wsp<bf16>(F, WS_HB), wsp<bf16>(F, WS_Y), F.g_mlp_post, F.out, nullptr, wsp<float>(F, WS_RSTD2)); }
#undef IN
#undef BOTH
#undef GRID_BAR
}

extern "C" void kernel_launch(void* const* d_in, const int* in_sizes, int n_in, void* d_out, int out_size, void* d_ws, size_t ws_size, hipStream_t stream) {
    static int grid = 0;
    if (grid == 0) {
        if (n_in != 18 || in_sizes[0] != MTOK * DMODEL || out_size != MTOK * DMODEL || ws_size < WS_END) {
            fprintf(stderr, "kernel_launch: built for 18 inputs, x/out of %d floats, >= %zu bytes of workspace; got n_in %d, in0 %d, out %d, ws %zu; nothing launched\n", MTOK * DMODEL, (size_t)WS_END, n_in, n_in > 0 ? in_sizes[0] : -1, out_size, ws_size); grid = -1; return; }
        int dev = 0, cus = 0, per_cu = 0;
        if (hipGetDevice(&dev) != hipSuccess || hipDeviceGetAttribute(&cus, hipDeviceAttributeMultiprocessorCount, dev) != hipSuccess) { fprintf(stderr, "kernel_launch: device query failed\n"); grid = -1; return; }
        if (hipFuncSetAttribute((const void*)fwd_kernel, hipFuncAttributeMaxDynamicSharedMemorySize, LDS_BYTES) != hipSuccess) { fprintf(stderr, "kernel_launch: hipFuncSetAttribute failed\n"); grid = -1; return; }
        if (hipOccupancyMaxActiveBlocksPerMultiprocessor(&per_cu, (const void*)fwd_kernel, NWAVES * 64, LDS_BYTES) != hipSuccess || per_cu < 1)
            fprintf(stderr, "kernel_launch: note: occupancy query reports %d workgroups per CU\n", per_cu);
        (void)hipGetLastError();
        grid = 256;
        if (cus < grid) fprintf(stderr, "kernel_launch: this device reports %d CUs; the 256-workgroup grid cannot be resident: the grid barrier will time out (bounded) and the output will be wrong\n", cus);
    }
    if (grid < 0) return;
    if (hipMemsetAsync((char*)d_ws + WS_CTL, 0, CTL_ZERO_BYTES, stream) != hipSuccess) { fprintf(stderr, "kernel_launch: hipMemsetAsync failed\n"); return; }
    Args a{};
    for (int i = 0; i < 18; ++i) a.in[i] = (const float*)d_in[i];
    a.out = (float*)d_out; a.ws = (unsigned char*)d_ws;
    for (int li = 0; li < N_LAUNCHES; ++li) {
        a.ph_lo = (N_LAUNCHES == 1) ? 0 : li; a.ph_hi = (N_LAUNCHES == 1) ? N_PHASES : li + 1; a.li = li; a.pad = 0;
        hipLaunchKernelGGL(fwd_kernel, dim3(grid), dim3(NWAVES * 64), LDS_BYTES, stream, a);
        const hipError_t le = hipPeekAtLastError();
        if (le != hipSuccess) { fprintf(stderr, "kernel_launch: launch %d failed: %s\n", li, hipGetErrorName(le)); break; }
    }
}
```

```cpp
#include <hip/hip_runtime.h>
#include <cstdio>
#include <cstdint>
#include <cmath>
namespace pg8 {
#define PG8_LAS __attribute__((address_space(3)))
typedef unsigned short bf16_t;
typedef short bf16x8 __attribute__((ext_vector_type(8)));
typedef float f32x4 __attribute__((ext_vector_type(4)));
typedef unsigned u32x4 __attribute__((ext_vector_type(4)));
constexpr int BM = 256, BK = 64, HALF = 128, HTB = HALF * BK * 2  , STAGE_BYTES = 8 * HTB, NXCD = 8, WGM = 8;

__host__ __device__ __forceinline__ int lds_byte(int r, int c) { const int st = (r >> 4) * 2 + (c >> 5), rr = r & 15, cc = c & 31, ob = rr * 64 + cc * 2; return st * 1024 + (ob ^ (((ob >> 9) & 1) << 5)); }
__host__ __device__ __forceinline__ void stage_rc(int b, int& R, int& C) { const int st = b / 1024, sb = b % 1024, swz = sb ^ (((sb >> 9) & 1) << 5); R = (st >> 1) * 16 + swz / 64; C = (st & 1) * 32 + (swz % 64) / 2; }
__host__ __device__ __forceinline__ int perm32(int rho) { const int n = rho >> 4, i = rho & 15; return 8 * (i >> 2) + 4 * n + (i & 3); }

__host__ __device__ __forceinline__ int perm16(int R) { const int w = R >> 5, n = (R >> 4) & 1, i = R & 15; return 64 * w + 16 * (i >> 2) + 4 * n + (i & 3); }
struct Unit { int pm, pn; };
struct Gemm { const bf16_t* A; const bf16_t* Bt; int M, N, K; };

struct StaticOrder {
    int nM, nN, nwg, G, c;
    __host__ __device__ void init(int M, int N, int G_, int c_) { nM = M / BM; nN = N / BM; nwg = nM * nN; G = G_; c = c_; }
    __host__ __device__ bool next(int i, Unit& u) const {
        const long L = (long)i * G + c; if (L >= nwg) return false;
        int wgid = (int)L; { const int q = nwg / NXCD, r = nwg % NXCD, xcd = wgid % NXCD, off = wgid / NXCD; wgid = (xcd < r ? xcd * (q + 1) : r * (q + 1) + (xcd - r) * q) + off; }
        const int nig = WGM * nN, gid = wgid / nig, fm = gid * WGM, gsz = (nM - fm) < WGM ? (nM - fm) : WGM;
        u.pm = fm + ((wgid % nig) % gsz); u.pn = (wgid % nig) / gsz; return true;
    }
    __device__ __forceinline__ void a_ready(const Unit&) const {}
    __device__ __forceinline__ void done(const Unit&) const {}
};

__device__ __forceinline__ unsigned cvt_pk_bf16(float lo, float hi) { unsigned r; asm volatile("v_cvt_pk_bf16_f32 %0, %1, %2" : "=v"(r) : "v"(lo), "v"(hi)); return r; }
typedef float f32x2 __attribute__((ext_vector_type(2)));
typedef int i32x8 __attribute__((ext_vector_type(8)));
typedef int i32x4 __attribute__((ext_vector_type(4)));
__device__ __forceinline__ i32x8 cat8(const bf16x8& a, const bf16x8& b) { const i32x4 x = __builtin_bit_cast(i32x4, a), y = __builtin_bit_cast(i32x4, b); return __builtin_shufflevector(x, y, 0, 1, 2, 3, 4, 5, 6, 7); }
constexpr float F8_MAX = 448.f;
__device__ __forceinline__ unsigned cvt4_fp8(float a, float b, float c, float d) {
    int r = 0; r = __builtin_amdgcn_cvt_pk_fp8_f32(fminf(a, F8_MAX), fminf(b, F8_MAX), r, false); r = __builtin_amdgcn_cvt_pk_fp8_f32(fminf(c, F8_MAX), fminf(d, F8_MAX), r, true); return (unsigned)r; }
__device__ __forceinline__ void mfma_f8_inplace(f32x4& c, const i32x8 a, const i32x8 b) { asm volatile("v_mfma_f32_16x16x128_f8f6f4 %0, %1, %2, %0" : "+v"(c) : "v"(a), "v"(b)); }
__device__ __forceinline__ float bf_lo(unsigned w) { return __uint_as_float(w << 16); }
__device__ __forceinline__ float bf_hi(unsigned w) { return __uint_as_float(w & 0xffff0000u); }
__device__ __forceinline__ float sigmoid_f(float x) { return __builtin_amdgcn_rcpf(1.0f + __expf(-x)); }
typedef unsigned u32x2 __attribute__((ext_vector_type(2)));
__device__ __forceinline__ u32x4 pack8(const f32x4& a, const f32x4& b) { u32x4 w; w.x = cvt_pk_bf16(a[0], a[1]); w.y = cvt_pk_bf16(a[2], a[3]); w.z = cvt_pk_bf16(b[0], b[1]); w.w = cvt_pk_bf16(b[2], b[3]); return w; }
__device__ __forceinline__ u32x2 pack4(const f32x4& a) { u32x2 w; w.x = cvt_pk_bf16(a[0], a[1]); w.y = cvt_pk_bf16(a[2], a[3]); return w; }

struct EpiInProj {
    static constexpr bool PERM = true, PERM16 = false, AFTER_DRAIN = false, MIDK = false;
    bf16_t *QKV, *NQ, *KVB, *SG;
    float *LF, *GATE; const float* bforget; const float *ROPEC, *ROPES; size_t qkvs, kvs, sgs; float qscale;
    __device__ __forceinline__ void operator()(const f32x4 (&acc)[2][2][4][2], const Unit& u, int wr, int wc, int fr, int fq) const {
        const int pn = u.pn; const bool roped = pn >= 6 && pn < 11; const int i4 = (4 * (wc & 1) + fq) * 4;
#pragma unroll
        for (int ai = 0; ai < 2; ++ai) {
#pragma unroll
          for (int mp = 0; mp < 2; ++mp) {
            f32x4 csv[8];
            if (roped) {
#pragma unroll
                for (int mm = 0; mm < 2; ++mm) { const int t_ = (u.pm * BM + ai * HALF + wr * 64 + (2 * mp + mm) * 16 + fr) & 2047; csv[mm] = *(const f32x4*)(ROPEC + t_ * 32 + i4); csv[4 + mm] = *(const f32x4*)(ROPES + t_ * 32 + i4); }
                asm volatile("" : "+v"(csv[0]), "+v"(csv[1]), "+v"(csv[4]), "+v"(csv[5])); }
#pragma unroll
            for (int mm = 0; mm < 2; ++mm) { const int m = 2 * mp + mm;
                const int row = u.pm * BM + ai * HALF + wr * 64 + m * 16 + fr; const int t = row & 2047, b = row >> 11; (void)t;
#pragma unroll
                for (int bj = 0; bj < 2; ++bj) {
                    const int tc = bj * HALF + wc * 32 + 8 * fq;
                    f32x4 v0 = acc[ai][bj][m][0], v1 = acc[ai][bj][m][1];
                    if (pn < 6) {
                        bf16_t* base = QKV + (size_t)(pn >> 1) * qkvs; const float sc = pn < 2 ? qscale : 1.0f;
                        *(u32x4*)(base + (size_t)row * 512 + (pn & 1) * 256 + tc) = pack8(v0 * sc, v1 * sc);
                    } else if (pn < 8) {
                        const int head = (pn - 6) * 4 + (tc >> 6);
                        const f32x4 cs = csv[mm], sn = csv[4 + mm];
                        const f32x4 lo = (v0 * cs - v1 * sn) * qscale, hi = (v1 * cs + v0 * sn) * qscale;
                        bf16_t* d = NQ + (size_t)row * 512 + head * 64 + i4;
                        *(u32x2*)d = pack4(lo); *(u32x2*)(d + 32) = pack4(hi);
                    } else if (pn < 11) {
                        const int sel = pn - 8;
                        if (bj == 0) {
                            const int g = tc >> 6;
                            const f32x4 cs = csv[mm], sn = csv[4 + mm];
                            const f32x4 lo = v0 * cs - v1 * sn, hi = v1 * cs + v0 * sn;
                            bf16_t* d = KVB + (size_t)(2 * sel) * kvs + ((size_t)((b * 2 + g) * 2048 + t)) * 64 + i4;
                            *(u32x2*)d = pack4(lo); *(u32x2*)(d + 32) = pack4(hi);
                        } else {
                            const int tv = tc - HALF, g = tv >> 6, dd = tv & 63;
                            bf16_t* d = KVB + (size_t)(2 * sel + 1) * kvs + ((size_t)((b * 2 + g) * 2048 + t)) * 64 + dd;
                            *(u32x4*)d = pack8(v0, v1);
                        }
                    } else if (pn < 19) {
                        if (bj == 0) { const int ct = (pn - 11) * 128 + wc * 32 + 8 * fq; const f32x4 w0 = acc[ai][1][m][0], w1 = acc[ai][1][m][1];
                            f32x4 a, c, ra, rc;
#pragma unroll
                            for (int k = 0; k < 4; ++k) { const float ea = __expf(-v0[k]), ec = __expf(-v1[k]), fa = __expf(-w0[k]), fc = __expf(-w1[k]);
                                a[k] = __builtin_amdgcn_rcpf(1.0f + ea); c[k] = __builtin_amdgcn_rcpf(1.0f + ec); ra[k] = (1.0f + ea) * __builtin_amdgcn_rcpf(1.0f + fa); rc[k] = (1.0f + ec) * __builtin_amdgcn_rcpf(1.0f + fc); }
                            __builtin_nontemporal_store(pack8(a, c), (u32x4*)(SG + (size_t)row * 1024 + ct)); __builtin_nontemporal_store(pack8(ra, rc), (u32x4*)(SG + sgs + (size_t)row * 1024 + ct)); }
                    } else {
                        if (bj == 0 && wc == 0) {
                            if (fq == 0) {
                                f32x4 a, c;
#pragma unroll
                                for (int k = 0; k < 4; ++k) { const float x0 = v0[k] + bforget[k], x1 = v1[k] + bforget[4 + k];
                                    a[k] = fminf(x0, 0.f) - log1pf(__expf(-fabsf(x0))); c[k] = fminf(x1, 0.f) - log1pf(__expf(-fabsf(x1))); }
                                *(f32x4*)(LF + (size_t)row * 8) = a; *(f32x4*)(LF + (size_t)row * 8 + 4) = c;
                            } else {
                                f32x4 a, c;
#pragma unroll
                                for (int k = 0; k < 4; ++k) { a[k] = sigmoid_f(v0[k]); c[k] = sigmoid_f(v1[k]); }
                                *(f32x4*)(GATE + (size_t)row * 24 + 8 * (fq - 1)) = a; *(f32x4*)(GATE + (size_t)row * 24 + 8 * (fq - 1) + 4) = c;
                            }
                        }
                    }
                }
            }
          }
        }
    }
};
#define PIN8(a) asm volatile("" : "+v"(a[0]), "+v"(a[1]), "+v"(a[2]), "+v"(a[3]), "+v"(a[4]), "+v"(a[5]), "+v"(a[6]), "+v"(a[7]))
struct EpiGate {
    static constexpr bool PERM = true, PERM16 = false, AFTER_DRAIN = false, MIDK = false;
    bf16_t* O; const bf16_t* gate; const bf16_t* addend; int ldc;
    __device__ __forceinline__ void operator()(const f32x4 (&acc)[2][2][4][2], const Unit& u, int wr, int wc, int fr, int fq) const {
#pragma unroll
        for (int ai = 0; ai < 2; ++ai) {
            const size_t base = (size_t)(u.pm * BM + ai * HALF + wr * 64 + fr) * ldc + u.pn * BM + wc * 32 + 8 * fq;
            u32x4 gw[8], aw[8];
#pragma unroll
            for (int k = 0; k < 8; ++k) gw[k] = *(const u32x4*)(gate + base + (size_t)((k >> 1) * 16) * ldc + (k & 1) * HALF);
            PIN8(gw);
            if (addend) {
#pragma unroll
                for (int k = 0; k < 8; ++k) aw[k] = *(const u32x4*)(addend + base + (size_t)((k >> 1) * 16) * ldc + (k & 1) * HALF);
                PIN8(aw); }
#pragma unroll
            for (int k = 0; k < 8; ++k) { const int m = k >> 1, bj = k & 1; const u32x4 g = gw[k];
                f32x4 v0 = acc[ai][bj][m][0], v1 = acc[ai][bj][m][1];
                v0[0] *= bf_lo(g.x); v0[1] *= bf_hi(g.x); v0[2] *= bf_lo(g.y); v0[3] *= bf_hi(g.y);
                v1[0] *= bf_lo(g.z); v1[1] *= bf_hi(g.z); v1[2] *= bf_lo(g.w); v1[3] *= bf_hi(g.w);
                if (addend) { const u32x4 a = aw[k];
                    v0[0] += bf_lo(a.x); v0[1] += bf_hi(a.x); v0[2] += bf_lo(a.y); v0[3] += bf_hi(a.y);
                    v1[0] += bf_lo(a.z); v1[1] += bf_hi(a.z); v1[2] += bf_lo(a.w); v1[3] += bf_hi(a.w); }
                *(u32x4*)(O + base + (size_t)(m * 16) * ldc + bj * HALF) = pack8(v0, v1); }
        }
    }
};
struct EpiGateMid {
    static constexpr bool PERM = true, PERM16 = false, AFTER_DRAIN = false, MIDK = true;
    bf16_t* O; const bf16_t* sga; const bf16_t* rr; int ldc;
    __device__ __forceinline__ void scale(f32x4 (&acc)[2][2][4][2], const bf16_t* g, const Unit& u, int wr, int wc, int fr, int fq, bf16_t* out) const {
#pragma unroll
        for (int ai = 0; ai < 2; ++ai) {
            const size_t base = (size_t)(u.pm * BM + ai * HALF + wr * 64 + fr) * ldc + u.pn * BM + wc * 32 + 8 * fq;
            u32x4 gw[8];
#pragma unroll
            for (int k = 0; k < 8; ++k) gw[k] = *(const u32x4*)(g + base + (size_t)((k >> 1) * 16) * ldc + (k & 1) * HALF);
            PIN8(gw);
#pragma unroll
            for (int k = 0; k < 8; ++k) { const int m = k >> 1, bj = k & 1; const u32x4 w = gw[k];
                f32x4& v0 = acc[ai][bj][m][0]; f32x4& v1 = acc[ai][bj][m][1];
                v0[0] *= bf_lo(w.x); v0[1] *= bf_hi(w.x); v0[2] *= bf_lo(w.y); v0[3] *= bf_hi(w.y);
                v1[0] *= bf_lo(w.z); v1[1] *= bf_hi(w.z); v1[2] *= bf_lo(w.w); v1[3] *= bf_hi(w.w);
                if (out) *(u32x4*)(out + base + (size_t)(m * 16) * ldc + bj * HALF) = pack8(v0, v1); }
        }
    }
    __device__ __forceinline__ void mid(f32x4 (&acc)[2][2][4][2], const Unit& u, int wr, int wc, int fr, int fq) const { int fr_ = fr; asm volatile("" : "+v"(fr_));
        scale(acc, rr, u, wr, wc, fr_, fq, nullptr); }
    __device__ __forceinline__ void operator()(const f32x4 (&acc)[2][2][4][2], const Unit& u, int wr, int wc, int fr, int fq) const {
#pragma unroll
        for (int ai = 0; ai < 2; ++ai) {
            const size_t base = (size_t)(u.pm * BM + ai * HALF + wr * 64 + fr) * ldc + u.pn * BM + wc * 32 + 8 * fq;
            u32x4 gw[8];
#pragma unroll
            for (int k = 0; k < 8; ++k) gw[k] = *(const u32x4*)(sga + base + (size_t)((k >> 1) * 16) * ldc + (k & 1) * HALF);
            PIN8(gw);
#pragma unroll
            for (int k = 0; k < 8; ++k) { const int m = k >> 1, bj = k & 1; const u32x4 w = gw[k];
                f32x4 v0 = acc[ai][bj][m][0], v1 = acc[ai][bj][m][1];
                v0[0] *= bf_lo(w.x); v0[1] *= bf_hi(w.x); v0[2] *= bf_lo(w.y); v0[3] *= bf_hi(w.y);
                v1[0] *= bf_lo(w.z); v1[1] *= bf_hi(w.z); v1[2] *= bf_lo(w.w); v1[3] *= bf_hi(w.w);
                *(u32x4*)(O + base + (size_t)(m * 16) * ldc + bj * HALF) = pack8(v0, v1); }
        }
    }
};
template <int ACT> struct EpiPlain {
    static constexpr bool PERM = true, PERM16 = false, AFTER_DRAIN = false, MIDK = false;
    bf16_t* O; int ldc;
    __device__ __forceinline__ void operator()(const f32x4 (&acc)[2][2][4][2], const Unit& u, int wr, int wc, int fr, int fq) const {
#pragma unroll
        for (int ai = 0; ai < 2; ++ai)
#pragma unroll
            for (int m = 0; m < 4; ++m) {
                const size_t rowo = (size_t)(u.pm * BM + ai * HALF + wr * 64 + m * 16 + fr) * ldc + u.pn * BM + wc * 32 + 8 * fq;
#pragma unroll
                for (int bj = 0; bj < 2; ++bj) {
                    f32x4 v0 = acc[ai][bj][m][0], v1 = acc[ai][bj][m][1];
                    if (ACT == 1) {
#pragma unroll
                        for (int k = 0; k < 4; ++k) { const float a = fmaxf(v0[k], 0.f), c = fmaxf(v1[k], 0.f); v0[k] = a * a; v1[k] = c * c; }
                    }
                    *(u32x4*)(O + rowo + bj * HALF) = pack8(v0, v1);
                }
            }
    }
};

struct EpiRelu2Rs {
    static constexpr bool PERM = true, PERM16 = false, AFTER_DRAIN = false, MIDK = false;
    bf16_t* O; const float* rs; int ldc;
    __device__ __forceinline__ void operator()(const f32x4 (&acc)[2][2][4][2], const Unit& u, int wr, int wc, int fr, int fq) const {
        float rv[8];
#pragma unroll
        for (int k = 0; k < 8; ++k) rv[k] = rs[u.pm * BM + (k >> 2) * HALF + wr * 64 + (k & 3) * 16 + fr];
        PIN8(rv);
#pragma unroll
        for (int ai = 0; ai < 2; ++ai)
#pragma unroll
            for (int m = 0; m < 4; ++m) { const float r = rv[ai * 4 + m];
                const size_t rowo = (size_t)(u.pm * BM + ai * HALF + wr * 64 + m * 16 + fr) * ldc + u.pn * BM + wc * 32 + 8 * fq;
#pragma unroll
                for (int bj = 0; bj < 2; ++bj) { f32x4 v0 = acc[ai][bj][m][0], v1 = acc[ai][bj][m][1];
#pragma unroll
                    for (int k = 0; k < 4; ++k) { const float a = fmaxf(v0[k] * r, 0.f), c = fmaxf(v1[k] * r, 0.f); v0[k] = a * a; v1[k] = c * c; }
                    __builtin_nontemporal_store(pack8(v0, v1), (u32x4*)(O + rowo + bj * HALF)); } }
    }
};

struct EpiRelu2F8 {
    static constexpr bool PERM = true, PERM16 = true, AFTER_DRAIN = false, MIDK = false;
    unsigned char* O; int ldc;
    __device__ __forceinline__ void operator()(const f32x4 (&acc)[2][2][4][2], const Unit& u, int wr, int wc, int fr, int fq) const {
#pragma unroll
        for (int ai = 0; ai < 2; ++ai)
#pragma unroll
            for (int m = 0; m < 4; ++m) {
                const size_t rowo = (size_t)(u.pm * BM + ai * HALF + wr * 64 + m * 16 + fr) * ldc + u.pn * BM + wc * 64 + 16 * fq;
                u32x4 o;
#pragma unroll
                for (int bj = 0; bj < 2; ++bj) { f32x4 v0 = acc[ai][bj][m][0], v1 = acc[ai][bj][m][1];
#pragma unroll
                    for (int k = 0; k < 4; ++k) { const float a = fmaxf(v0[k], 0.f), c = fmaxf(v1[k], 0.f); v0[k] = a * a; v1[k] = c * c; }
                    o[2 * bj] = cvt4_fp8(v0[0], v0[1], v0[2], v0[3]); o[2 * bj + 1] = cvt4_fp8(v1[0], v1[1], v1[2], v1[3]); }
                __builtin_nontemporal_store(o, (u32x4*)(O + rowo)); }
    }
};
struct EpiScaled {
    static constexpr bool PERM = true, PERM16 = false, AFTER_DRAIN = false, MIDK = false;
    bf16_t* O; int ldc; float sc;
    __device__ __forceinline__ void operator()(const f32x4 (&acc)[2][2][4][2], const Unit& u, int wr, int wc, int fr, int fq) const {
#pragma unroll
        for (int ai = 0; ai < 2; ++ai)
#pragma unroll
            for (int m = 0; m < 4; ++m) {
                const size_t rowo = (size_t)(u.pm * BM + ai * HALF + wr * 64 + m * 16 + fr) * ldc + u.pn * BM + wc * 32 + 8 * fq;
#pragma unroll
                for (int bj = 0; bj < 2; ++bj) *(u32x4*)(O + rowo + bj * HALF) = pack8(acc[ai][bj][m][0] * sc, acc[ai][bj][m][1] * sc);
            }
    }
};
template <class Epi, class Sched, bool ALIGN_EPI = false, bool SP2 = false, bool F8 = false>
__device__ __forceinline__ void gemm_phase(PG8_LAS unsigned char* lds, const Gemm g, const Sched& S, const Epi& E, const int wave_id  ) {
    int tid_ = wave_id * 64 + (int)__builtin_amdgcn_mbcnt_hi(~0u, __builtin_amdgcn_mbcnt_lo(~0u, 0u)); asm volatile("" : "+v"(tid_));
    const int tid = tid_, wid = __builtin_amdgcn_readfirstlane(tid >> 6), lane = tid & 63, wr = wid >> 2, wc = wid & 3, fr = lane & 15, fq = lane >> 4;
    const int K = g.K, nt = K / BK;
    unsigned voffA[2], voffB[2];
#pragma unroll
    for (int i = 0; i < 2; ++i) { int R, C; stage_rc(tid * 16 + i * 8192, R, C); const int Rb = Epi::PERM16 ? perm16(R) : Epi::PERM ? ((R & ~31) + perm32(R & 31)) : R;
        voffA[i] = (unsigned)(R * K + C) * 2u; voffB[i] = (unsigned)(Rb * K + C) * 2u; }
    const size_t kstep = (size_t)(BK * 2);
    const size_t hstep = (size_t)HALF * K * 2;
    const size_t bhstep = Epi::PERM16 ? (size_t)8 * K * 2 : hstep;
    const size_t tstep = 2 * hstep;
    const unsigned ldsw = (unsigned)wid * 1024u;
    const int aoff = lds_byte(wr * 64 + fr, fq * 8), boff = lds_byte(wc * 32 + fr, fq * 8);
#define PG8_SA(b, h) (((b) * 2 + (h)) * HTB)
#define PG8_SB(b, h) ((4 + (b) * 2 + (h)) * HTB)
#define PG8_STAGE(bufoff, gbase, voff) do { _Pragma("unroll") for (int _i = 0; _i < 2; ++_i) \
        __builtin_amdgcn_global_load_lds((const unsigned*)((const char*)(gbase) + (voff)[_i]), (PG8_LAS unsigned*)(lds + (bufoff) + ldsw + _i * 8192), 16, 0, 0); } while (0)
#define PG8_LDA(dst, b, h) do { _Pragma("unroll") for (int m = 0; m < 4; ++m) _Pragma("unroll") for (int k = 0; k < 2; ++k) dst[m][k] = *(const PG8_LAS bf16x8*)(lds + PG8_SA(b, h) + aoff + m * 2048 + k * 1024); } while (0)
#define PG8_LDB(dst, b, h) do { _Pragma("unroll") for (int n = 0; n < 2; ++n) _Pragma("unroll") for (int k = 0; k < 2; ++k) dst[n][k] = *(const PG8_LAS bf16x8*)(lds + PG8_SB(b, h) + boff + n * 2048 + k * 1024); } while (0)
#define PG8_MMA(ai, bj, At, Bt) do { __builtin_amdgcn_s_setprio(1); _Pragma("unroll") for (int m = 0; m < 4; ++m) _Pragma("unroll") for (int n = 0; n < 2; ++n) { \
        if constexpr (F8) mfma_f8_inplace(acc[ai][bj][m][n], cat8(Bt[n][0], Bt[n][1]), cat8(At[m][0], At[m][1])); \
        else { _Pragma("unroll") for (int k = 0; k < 2; ++k) acc[ai][bj][m][n] = __builtin_amdgcn_mfma_f32_16x16x32_bf16(Bt[n][k], At[m][k], acc[ai][bj][m][n], 0, 0, 0); } } __builtin_amdgcn_s_setprio(0); } while (0)
#define PG8_WAIT_V(n) asm volatile("s_waitcnt vmcnt(" #n ")" ::: "memory")
#define PG8_WAIT_L(n) asm volatile("s_waitcnt lgkmcnt(" #n ")" ::: "memory")
#define PG8_BAR __builtin_amdgcn_s_barrier()
#define PG8_SCHED __builtin_amdgcn_sched_barrier(0)
    Unit cur, nxt; int ui = 0;
    if (!S.next(0, cur)) return;
    f32x4 acc[2][2][4][2];
#pragma unroll
    for (int a = 0; a < 2; ++a)
#pragma unroll
        for (int b = 0; b < 2; ++b)
#pragma unroll
            for (int m = 0; m < 4; ++m)
#pragma unroll
                for (int n = 0; n < 2; ++n) acc[a][b][m][n] = (f32x4){0.f, 0.f, 0.f, 0.f};
    bf16x8 At[4][2], B0[2][2], B1[2][2];
    const char* cA = (const char*)g.A + (size_t)cur.pm * tstep; const char* cB = (const char*)g.Bt + (size_t)cur.pn * tstep;
    S.a_ready(cur);
    if constexpr (SP2) {
        PG8_STAGE(PG8_SB(0, 0), cB, voffB); PG8_STAGE(PG8_SB(0, 1), cB + bhstep, voffB); PG8_STAGE(PG8_SA(0, 0), cA, voffA); PG8_STAGE(PG8_SA(0, 1), cA + hstep, voffA);
        if (wr == 1) PG8_BAR;
        PG8_WAIT_V(2); PG8_BAR;
        PG8_STAGE(PG8_SB(1, 0), cB + kstep, voffB); PG8_STAGE(PG8_SA(1, 0), cA + kstep, voffA); PG8_STAGE(PG8_SB(1, 1), cB + bhstep + kstep, voffB);
        PG8_WAIT_V(6); PG8_BAR;
    } else {
        PG8_STAGE(PG8_SB(0, 0), cB, voffB); PG8_STAGE(PG8_SA(0, 0), cA, voffA); PG8_STAGE(PG8_SB(0, 1), cB + bhstep, voffB); PG8_STAGE(PG8_SA(0, 1), cA + hstep, voffA);
        if (wr == 1) PG8_BAR;
        PG8_WAIT_V(4); PG8_BAR;
        PG8_STAGE(PG8_SB(1, 0), cB + kstep, voffB); PG8_STAGE(PG8_SA(1, 0), cA + kstep, voffA); PG8_STAGE(PG8_SB(1, 1), cB + bhstep + kstep, voffB);
        PG8_WAIT_V(6); PG8_BAR;
    }
    for (;;) {
        const bool has_next = S.next(ui + 1, nxt);
        const char* nA = has_next ? (const char*)g.A + (size_t)nxt.pm * tstep : cA; const char* nB = has_next ? (const char*)g.Bt + (size_t)nxt.pn * tstep : cB;
        for (int t = 0; t < nt; t += 2) {
            if constexpr (Epi::MIDK) { if (t == nt / 2) E.mid(acc, cur, wr, wc, fr, fq); }
            const bool last = (t == nt - 2);
            const char* a1 = cA + (size_t)(t + 1) * kstep;
            const char* a2 = last ? nA : cA + (size_t)(t + 2) * kstep; const char* b2 = last ? nB : cB + (size_t)(t + 2) * kstep;
            const char* a3 = a2 + kstep; const char* b3 = b2 + kstep;
            if (last && has_next) S.a_ready(nxt);
            if constexpr (SP2) {
            PG8_LDB(B0, 0, 0); PG8_LDB(B1, 0, 1); PG8_SCHED; PG8_LDA(At, 0, 0); PG8_STAGE(PG8_SA(1, 1), a1 + hstep, voffA);
            PG8_WAIT_V(8); PG8_WAIT_L(0); PG8_BAR; PG8_MMA(0, 0, At, B0); PG8_MMA(0, 1, At, B1); PG8_BAR; PG8_SCHED;
            PG8_LDA(At, 0, 1); PG8_STAGE(PG8_SB(0, 0), b2, voffB); PG8_STAGE(PG8_SB(0, 1), b2 + bhstep, voffB); PG8_STAGE(PG8_SA(0, 0), a2, voffA);
            PG8_WAIT_V(8); PG8_WAIT_L(0); PG8_BAR; PG8_MMA(1, 0, At, B0); PG8_MMA(1, 1, At, B1); PG8_BAR; PG8_SCHED;
            PG8_LDB(B0, 1, 0); PG8_LDB(B1, 1, 1); PG8_SCHED; PG8_LDA(At, 1, 0); PG8_STAGE(PG8_SA(0, 1), a2 + hstep, voffA);
            PG8_WAIT_V(8); PG8_WAIT_L(0); PG8_BAR; PG8_MMA(0, 0, At, B0); PG8_MMA(0, 1, At, B1); PG8_BAR; PG8_SCHED;
            PG8_LDA(At, 1, 1); PG8_STAGE(PG8_SB(1, 0), b3, voffB); PG8_STAGE(PG8_SB(1, 1), b3 + bhstep, voffB); PG8_STAGE(PG8_SA(1, 0), a3, voffA);
            PG8_WAIT_V(8); PG8_WAIT_L(0); PG8_BAR; PG8_MMA(1, 0, At, B0); PG8_MMA(1, 1, At, B1); PG8_BAR; PG8_SCHED;
            } else {
            PG8_LDB(B0, 0, 0); PG8_SCHED; PG8_LDA(At, 0, 0); PG8_STAGE(PG8_SA(1, 1), a1 + hstep, voffA);
            PG8_WAIT_L(8); PG8_BAR; PG8_WAIT_L(0); PG8_MMA(0, 0, At, B0); PG8_BAR; PG8_SCHED;
            PG8_LDB(B1, 0, 1); PG8_STAGE(PG8_SB(0, 0), b2, voffB);
            PG8_BAR; PG8_WAIT_L(0); PG8_MMA(0, 1, At, B1); PG8_BAR;
            PG8_LDA(At, 0, 1); PG8_STAGE(PG8_SA(0, 0), a2, voffA);
            PG8_BAR; PG8_WAIT_L(0); PG8_MMA(1, 0, At, B0); PG8_BAR; PG8_SCHED;
            PG8_STAGE(PG8_SB(0, 1), b2 + bhstep, voffB);
            PG8_WAIT_V(6); PG8_BAR; PG8_MMA(1, 1, At, B1); PG8_BAR;
            PG8_LDB(B0, 1, 0); PG8_SCHED; PG8_LDA(At, 1, 0); PG8_STAGE(PG8_SA(0, 1), a2 + hstep, voffA);
            PG8_WAIT_L(8); PG8_BAR; PG8_WAIT_L(0); PG8_MMA(0, 0, At, B0); PG8_BAR; PG8_SCHED;
            PG8_LDB(B1, 1, 1); PG8_STAGE(PG8_SB(1, 0), b3, voffB);
            PG8_BAR; PG8_WAIT_L(0); PG8_MMA(0, 1, At, B1); PG8_BAR;
            PG8_LDA(At, 1, 1); PG8_STAGE(PG8_SA(1, 0), a3, voffA);
            PG8_BAR; PG8_WAIT_L(0); PG8_MMA(1, 0, At, B0); PG8_BAR; PG8_SCHED;
            PG8_STAGE(PG8_SB(1, 1), b3 + bhstep, voffB);
            PG8_WAIT_V(6); PG8_BAR; PG8_MMA(1, 1, At, B1); PG8_BAR;
            }
        }
        if constexpr (F8) asm volatile("s_nop 15\n\ts_nop 15" ::: "memory");
        if constexpr (ALIGN_EPI) { if (wr == 0) PG8_BAR; }
        if constexpr (!Epi::AFTER_DRAIN) { E(acc, cur, wr, wc, fr, fq); S.done(cur); }
        if (!has_next) break;
#pragma unroll
        for (int a = 0; a < 2; ++a)
#pragma unroll
            for (int b = 0; b < 2; ++b)
#pragma unroll
                for (int m = 0; m < 4; ++m)
#pragma unroll
                    for (int n = 0; n < 2; ++n) acc[a][b][m][n] = (f32x4){0.f, 0.f, 0.f, 0.f};
        cur = nxt; cA = nA; cB = nB; ++ui;
        if constexpr (ALIGN_EPI) { if (wr == 1) PG8_BAR; }
    }
    PG8_WAIT_V(0);
    if constexpr (!ALIGN_EPI) { if (wr == 0) PG8_BAR; }
    PG8_BAR;
    if constexpr (Epi::AFTER_DRAIN) { E.fused(acc, cur, wr, wc, fr, fq, lds, wid, lane); S.done(cur); }
#undef PG8_SA
#undef PG8_SB
#undef PG8_STAGE
#undef PG8_LDA
#undef PG8_LDB
#undef PG8_MMA
#undef PG8_WAIT_V
#undef PG8_WAIT_L
#undef PG8_BAR
#undef PG8_SCHED
}
}
#define GAS __attribute__((address_space(1)))
#define LAS __attribute__((address_space(3)))
typedef unsigned short bf16;
typedef unsigned v4u __attribute__((ext_vector_type(4)));
typedef float f32x4 __attribute__((ext_vector_type(4)));
typedef short bf16x8 __attribute__((ext_vector_type(8)));
typedef GAS unsigned gu32;
typedef GAS unsigned long long gu64;
#define RLX_AGENT __ATOMIC_RELAXED, __HIP_MEMORY_SCOPE_AGENT
#define LDS_WAIT() asm volatile("s_waitcnt lgkmcnt(0)" ::: "memory")
#define VM_WAIT() asm volatile("s_waitcnt vmcnt(0)" ::: "memory")
__device__ __forceinline__ unsigned long long rt() { return __builtin_amdgcn_s_memrealtime(); }
__device__ __forceinline__ unsigned f2bf(float f) { unsigned u = __builtin_bit_cast(unsigned, f); return (u + 0x7fffu + ((u >> 16) & 1u)) >> 16; }
__device__ __forceinline__ unsigned pk2(float lo, float hi) { return f2bf(lo) | (f2bf(hi) << 16); }

#define XB_TMO      128
#define XB_XCNT(j)  (256  + 64 * (j))
#define XB_XSUB(j)  (1280 + 64 * (j))
#define XB_XGEN(j)  (2304 + 64 * (j))
#define XB_TOP      3328
#define XB_TOPGEN   3392
#define XCD_BAR_WORDS 3456
#define XB_SPIN_CAP (1u << 18)

__device__ __forceinline__ unsigned xb_ld(unsigned* p)              { return __hip_atomic_load(p, __ATOMIC_RELAXED, __HIP_MEMORY_SCOPE_AGENT); }
__device__ __forceinline__ unsigned xb_add(unsigned* p, unsigned v) { return __hip_atomic_fetch_add(p, v, __ATOMIC_RELAXED, __HIP_MEMORY_SCOPE_AGENT); }
__device__ __forceinline__ unsigned xb_xcc_id() { return (unsigned)__builtin_amdgcn_s_getreg((3 << 11) | 20) & 0xFu; }
#define XB_SPIN(cond, bar) do { unsigned _sp = 0; while (cond) { __builtin_amdgcn_s_sleep(1); \
    if ((++_sp & 255u) == 0u) { if (xb_ld(&(bar)[XB_TMO])) break; if (_sp > XB_SPIN_CAP) { atomicAdd(&(bar)[XB_TMO], 1u); break; } } } } while (0)

struct XcdBarrier {
    unsigned* bar; unsigned x;
    volatile LAS unsigned* st;
};

__device__ __forceinline__ XcdBarrier xcd_barrier_post(unsigned* bar, volatile LAS unsigned* st) {
    XcdBarrier b; b.bar = bar; b.x = xb_xcc_id(); b.st = st;
    if (threadIdx.x == 0) (void)xb_add(&bar[XB_XCNT(b.x)], 1u);
    return b;
}
__device__ __forceinline__ void xcd_barrier_complete(unsigned* bar, unsigned x, unsigned& nloc, unsigned& nx) {
    const unsigned G = gridDim.x * gridDim.y * gridDim.z;
    unsigned sum, cnt, mine, sp = 0u;
    for (;;) {
        sum = 0u; cnt = 0u; mine = 0u;
#pragma unroll
        for (unsigned j = 0; j < 16; ++j) { const unsigned c = xb_ld(&bar[XB_XCNT(j)]); sum += c; cnt += (c > 0u) ? 1u : 0u; mine = (j == x) ? c : mine; }
        if (sum == G) break;
        __builtin_amdgcn_s_sleep(1);
        if ((++sp & 255u) == 0u) { if (xb_ld(&bar[XB_TMO])) break; if (sp > XB_SPIN_CAP) { atomicAdd(&bar[XB_TMO], 1u); break; } }
    }
    nloc = mine > 0u ? mine : 1u; nx = cnt > 0u ? cnt : 1u;
}

__device__ __forceinline__ void xcd_barrier(const XcdBarrier& b) {
    asm volatile("s_waitcnt vmcnt(0)" ::: "memory");
    __syncthreads();
    if (threadIdx.x == 0) {
        unsigned* bar = b.bar;
        __builtin_amdgcn_s_waitcnt(0);
        unsigned nloc = b.st[0], nx = b.st[1];
        if (nloc == 0u) { xcd_barrier_complete(bar, b.x, nloc, nx); b.st[0] = nloc; b.st[1] = nx; }
        const unsigned old = xb_add(&bar[XB_XSUB(b.x)], 1u);
        const unsigned gen = old / nloc;
        if (old + 1u == (gen + 1u) * nloc) {
            __builtin_amdgcn_fence(__ATOMIC_RELEASE, "agent");
            asm volatile("s_waitcnt vmcnt(0)" ::: "memory");
            const unsigned og = xb_add(&bar[XB_TOP], 1u);
            const unsigned tg = og / nx;
            if (og + 1u == (tg + 1u) * nx) xb_add(&bar[XB_TOPGEN], 1u);
            else XB_SPIN(xb_ld(&bar[XB_TOPGEN]) == tg, bar);
            __builtin_amdgcn_fence(__ATOMIC_ACQUIRE, "agent");
            xb_add(&bar[XB_XGEN(b.x)], 1u);
            asm volatile("s_waitcnt vmcnt(0)" ::: "memory");
        } else {
            XB_SPIN(xb_ld(&bar[XB_XGEN(b.x)]) == gen, bar);
            __builtin_amdgcn_fence(__ATOMIC_ACQUIRE, "agent");
            asm volatile("s_waitcnt vmcnt(0)" ::: "memory");
        }
    }
    __syncthreads();
}

constexpr int NWAVES = 8;
constexpr int BATCH = 32, SEQ = 2048, DMODEL = 1024, MTOK = BATCH * SEQ, DFF = 4096, NPROJ = 5120, INCOLS = 4896;
constexpr float RMS_EPS = 1e-6f;
constexpr float QSCALE = 0.125f * 1.4426950408889634f;
constexpr float LOG2E = 1.4426950408889634f;
constexpr float WDN_SCALE = 256.f;
#ifndef MK_N_LAUNCHES
#define MK_N_LAUNCHES 1
#endif
constexpr int N_PHASES = 10;
constexpr int N_LAUNCHES = MK_N_LAUNCHES;
constexpr size_t MiB = 1u << 20, KiB = 1u << 10;
constexpr size_t WS_CTL = 0, CTL_ZERO_BYTES = 1 * MiB;
constexpr size_t WS_WIN = 2 * MiB, WS_WF = 12 * MiB, WS_WN = 13 * MiB, WS_WO = 14 * MiB, WS_WUP = 16 * MiB, WS_WDN = 24 * MiB;
constexpr size_t WS_W1K = 32 * MiB, WS_W1V = WS_W1K + 256 * KiB, WS_W2K = WS_W1V + 256 * KiB, WS_W2V = WS_W2K + 8 * KiB, WS_PBK = WS_W2V + 8 * KiB, WS_PBV = WS_PBK + 256;
constexpr size_t WS_KT0 = WS_PBV + 256;
constexpr size_t WS_RSTD2 = 46 * MiB;
constexpr size_t WS_ROPEC = 33 * MiB, WS_ROPES = WS_ROPEC + 256 * KiB;
constexpr size_t WS_KCMP = 34 * MiB, WS_VCMP = 35 * MiB, WS_C = 36 * MiB, WS_LF = 38 * MiB, WS_GATE = 40 * MiB;
constexpr size_t WS_HB = 48 * MiB;
constexpr size_t WS_FKX = 48 * MiB;
constexpr size_t WS_PROBE_O = 64 * MiB;
constexpr size_t WS_FQ = 176 * MiB, WS_FK = 240 * MiB, WS_FV = 304 * MiB, WS_NQ = 368 * MiB;
constexpr size_t WS_KV = 432 * MiB, KV_STRIDE = 16 * MiB;
constexpr size_t WS_SGA = 528 * MiB, WS_SGB = 656 * MiB;
#ifndef WS_Y_SKEW
#define WS_Y_SKEW 0
#endif
constexpr size_t WS_Y = 784 * MiB + WS_Y_SKEW;
constexpr size_t WS_ATT = WS_Y;
constexpr size_t WS_FOXO_UNUSED = WS_Y, WS_NSAO_UNUSED = WS_Y + 64 * MiB;
constexpr size_t WS_U = 176 * MiB;
constexpr size_t WS_END = 1024 * MiB;
static_assert(WS_FV - WS_FK == WS_FK - WS_FQ && WS_U + (size_t)MTOK * DFF * 2 <= WS_Y && WS_Y + (size_t)MTOK * 512 * 4 <= WS_END && WS_GATE + (size_t)MTOK * 24 * 4 <= WS_HB, "d_ws map");
constexpr int CW_TMO = 0, CW_CODE = 1, CW_BAR = 4096, CW_QUEUE = 16384;
constexpr int RING_OFF = 0, RING_BYTES = 131072;
constexpr int LDSCTL_OFF = RING_BYTES, MISC_OFF = LDSCTL_OFF + 320;
constexpr int LDS_BYTES = 147456;
static_assert(MISC_OFF + 128 <= LDS_BYTES, "LDS map");


typedef float f32x16 __attribute__((ext_vector_type(16)));
struct Frame {
    LAS unsigned char* lds;
    volatile LAS unsigned* MISC;
    gu32* ctl;
    int wave;
    int vcu, G;
    unsigned char* ws;
    const float* x; float* out;
    const float *g_mix_pre, *g_mix_post, *g_mlp_pre, *g_mlp_post, *w_in, *b_forget, *pos_k, *w1_k, *w2_k, *pos_v, *w1_v, *w2_v, *w_fox, *w_nsa, *w_o, *w_up, *w_down;
};
template <class T> __device__ __forceinline__ T* wsp(const Frame& F, size_t off) { return (T*)(F.ws + off); }
__device__ __forceinline__ int cur_lane() { return (int)__builtin_amdgcn_mbcnt_hi(~0u, __builtin_amdgcn_mbcnt_lo(~0u, 0u)); }
__device__ __forceinline__ int cur_tid(const Frame& F) { return F.wave * 64 + cur_lane(); }

__device__ __forceinline__ float wave_sum(float v) {
#pragma unroll
    for (int o = 1; o < 64; o <<= 1) v += __shfl_xor(v, o);
    return v;
}
__device__ __forceinline__ float bfl(unsigned w) { return __uint_as_float(w << 16); }
__device__ __forceinline__ float bfh(unsigned w) { return __uint_as_float(w & 0xffff0000u); }

__device__ __forceinline__ int rope_d(int w) { const int i = w >> 3, j = w & 7; return j < 4 ? 4 * i + j : 32 + 4 * i + (j - 4); }
__device__ __forceinline__ int in_src_col(int n) {
    if (n < 1536) return n;
    if (n < 2048) { const int l = n - 1536; return 1544 + (l & ~63) + rope_d(l & 63); }
    if (n < 2816) { const int s = (n - 2048) >> 8, l = (n - 2048) & 255; const int kb = 2056 + s * 256;
        return l < 128 ? kb + (l & ~63) + rope_d(l & 63) : kb + 128 + (l - 128); }
    if (n < 4864) { const int q = (n - 2816) >> 8, l = (n - 2816) & 255; return l < 128 ? 2848 + 128 * q + l : 3872 + 128 * q + (l - 128); }
    const int l = n - 4864; if (l < 8) return 1536 + l; if (l < 32) return 2824 + (l - 8); return -1;
}
template <class SrcCol>
__device__ __forceinline__ void p0_transpose_item(const float* W, int K, int Nsrc, bf16* WT, int nblk, LAS float* scr, int item, int lane, SrcCol srccol, const float* kgain = nullptr, int ldk = 0, int koff = 0) {
    const int kb = item / nblk, nb = item % nblk, k0 = 64 * kb, n0 = 32 * nb;
    const int sc = srccol(n0 + (lane & 31));
#pragma unroll 8
    for (int i = 0; i < 32; ++i) { const int kk = 2 * i + (lane >> 5); float w = sc >= 0 ? W[(size_t)(k0 + kk) * Nsrc + sc] : 0.f; if (kgain) w *= kgain[k0 + kk]; scr[kk * 33 + (lane & 31)] = w; }
    LDS_WAIT(); asm volatile("" ::: "memory");
    const int c = lane & 7;
#pragma unroll
    for (int j = 0; j < 4; ++j) { const int n = (lane >> 3) + 8 * j; const LAS float* s = scr + (8 * c) * 33 + n;
        v4u o; o.x = pk2(s[0 * 33], s[1 * 33]); o.y = pk2(s[2 * 33], s[3 * 33]); o.z = pk2(s[4 * 33], s[5 * 33]); o.w = pk2(s[6 * 33], s[7 * 33]);
        *(GAS v4u*)(WT + (size_t)(n0 + n) * (ldk ? ldk : K) + koff + k0 + 8 * c) = o; }
    LDS_WAIT(); asm volatile("" ::: "memory");
}
__device__ __forceinline__ void p0_transpose_item_f8(const float* W, int K, int N, unsigned char* WT, int nblk, LAS float* scr, int item, int lane, float scale) {
    const int kb = item / nblk, nb = item % nblk, k0 = 64 * kb, n0 = 32 * nb;
#pragma unroll 8
    for (int i = 0; i < 32; ++i) { const int kk = 2 * i + (lane >> 5); scr[kk * 33 + (lane & 31)] = W[(size_t)(k0 + kk) * N + n0 + (lane & 31)] * scale; }
    LDS_WAIT(); asm volatile("" ::: "memory");
    const int c = lane & 7;
#pragma unroll
    for (int j = 0; j < 4; ++j) { const int n = (lane >> 3) + 8 * j; const LAS float* s = scr + (8 * c) * 33 + n;
        pg8::f32x2 o; o.x = __builtin_bit_cast(float, pg8::cvt4_fp8(fmaxf(s[0 * 33], -pg8::F8_MAX), fmaxf(s[1 * 33], -pg8::F8_MAX), fmaxf(s[2 * 33], -pg8::F8_MAX), fmaxf(s[3 * 33], -pg8::F8_MAX)));
        o.y = __builtin_bit_cast(float, pg8::cvt4_fp8(fmaxf(s[4 * 33], -pg8::F8_MAX), fmaxf(s[5 * 33], -pg8::F8_MAX), fmaxf(s[6 * 33], -pg8::F8_MAX), fmaxf(s[7 * 33], -pg8::F8_MAX)));
        *(GAS pg8::f32x2*)(WT + (size_t)(n0 + n) * K + k0 + 8 * c) = o; }
    LDS_WAIT(); asm volatile("" ::: "memory");
}
__device__ __forceinline__ void rms_rows_to_bf16(int lane, int gw, int NGW, const float* X, const float* g, bf16* O) {
    constexpr int RP = 4;
    const GAS f32x4* gr = (const GAS f32x4*)g + lane; f32x4 gv[4];
#pragma unroll
    for (int j = 0; j < 4; ++j) gv[j] = gr[64 * j];
    for (int m0 = gw; m0 < MTOK; m0 += NGW * RP) {
        f32x4 v[RP][4];
#pragma unroll
        for (int r = 0; r < RP; ++r) { const GAS f32x4* xr = (const GAS f32x4*)(X + (size_t)(m0 + r * NGW) * DMODEL) + lane;
#pragma unroll
            for (int j = 0; j < 4; ++j) v[r][j] = __builtin_nontemporal_load(xr + 64 * j); }
#pragma unroll
        for (int r = 0; r < RP; ++r) { float s = 0.f;
#pragma unroll
            for (int j = 0; j < 4; ++j) s += (v[r][j].x * v[r][j].x + v[r][j].y * v[r][j].y) + (v[r][j].z * v[r][j].z + v[r][j].w * v[r][j].w);
            const float rr = 1.0f / sqrtf(wave_sum(s) * (1.f / DMODEL) + RMS_EPS);
            GAS unsigned long long* o8 = (GAS unsigned long long*)(O + (size_t)(m0 + r * NGW) * DMODEL) + lane;
#pragma unroll
            for (int j = 0; j < 4; ++j) { const f32x4 a = v[r][j], gg = gv[j];
                o8[64 * j] = (unsigned long long)pk2(a.x * rr * gg.x, a.y * rr * gg.y) | ((unsigned long long)pk2(a.z * rr * gg.z, a.w * rr * gg.w) << 32); } }
    }
}
__device__ __forceinline__ void p0_prologue(Frame& F) {
    LAS float* scr = (LAS float*)(F.lds + RING_OFF + F.wave * 16384);
    const int gw = F.vcu * NWAVES + F.wave, NGW = F.G * NWAVES, lane = cur_lane();
    constexpr int I_IN = 16 * (NPROJ / 32), I_F = 8 * 32, I_O = 16 * 32, I_UP = 16 * 128, I_DN = 64 * 32, I_W1 = 32 * 2, I_W2 = 1 * 2;
    constexpr int NITEMS = I_IN + 2 * I_F + I_O + I_UP + I_DN + 2 * I_W1 + 2 * I_W2;
    auto ident = [](int n) { return n; };
    for (int it = gw; it < NITEMS; it += NGW) {
        int r = it;
        if (r < I_IN) { p0_transpose_item(F.w_in, 1024, INCOLS, wsp<bf16>(F, WS_WIN), NPROJ / 32, scr, r, lane, [](int n) { return in_src_col(n); }); continue; } r -= I_IN;
        if (r < I_F) { p0_transpose_item(F.w_fox, 512, 1024, wsp<bf16>(F, WS_WF), 32, scr, r, lane, ident, nullptr, 1024, 512); continue; } r -= I_F;
        if (r < I_F) { p0_transpose_item(F.w_nsa, 512, 1024, wsp<bf16>(F, WS_WF), 32, scr, r, lane, ident, nullptr, 1024, 0); continue; } r -= I_F;
        if (r < I_O) { p0_transpose_item(F.w_o, 1024, 1024, wsp<bf16>(F, WS_WO), 32, scr, r, lane, ident); continue; } r -= I_O;
        if (r < I_UP) { p0_transpose_item(F.w_up, 1024, 4096, wsp<bf16>(F, WS_WUP), 128, scr, r, lane, ident, F.g_mlp_pre); continue; }     r -= I_UP;
        if (r < I_DN) { p0_transpose_item_f8(F.w_down, 4096, 1024, wsp<unsigned char>(F, WS_WDN), 32, scr, r, lane, WDN_SCALE); continue; } r -= I_DN;
        if (r < I_W1) { p0_transpose_item(F.w1_k, 2048, 64, wsp<bf16>(F, WS_W1K), 2, scr, r, lane, ident); continue; } r -= I_W1;
        if (r < I_W1) { p0_transpose_item(F.w1_v, 2048, 64, wsp<bf16>(F, WS_W1V), 2, scr, r, lane, ident); continue; } r -= I_W1;
        if (r < I_W2) { p0_transpose_item(F.w2_k, 64, 64, wsp<bf16>(F, WS_W2K), 2, scr, r, lane, ident); continue; } r -= I_W2;
        p0_transpose_item(F.w2_v, 64, 64, wsp<bf16>(F, WS_W2V), 2, scr, r, lane, ident);
    }
    { float* RC = wsp<float>(F, WS_ROPEC); float* RS = wsp<float>(F, WS_ROPES);
      for (int e = (F.vcu * NWAVES * 64 + cur_tid(F)); e < SEQ * 32; e += F.G * NWAVES * 64) { const int t = e >> 5, i = e & 31;
          const float inv = powf(10000.0f, -(float)(2 * i) / 64.0f); const float ang = (float)t * inv; RC[e] = cosf(ang); RS[e] = sinf(ang); } }
    if (F.wave == 0) for (int it = F.vcu; it < 128; it += F.G) { const int kv = it >> 6, c = it & 63; const float* pos = kv ? F.pos_v : F.pos_k; const float* w1 = kv ? F.w1_v : F.w1_k; float s = 0.f;
        for (int k = lane; k < 2048; k += 64) s += pos[k] * w1[(size_t)k * 64 + c];
        s = wave_sum(s); if (lane == 0) wsp<float>(F, kv ? WS_PBV : WS_PBK)[c] = s; }
    rms_rows_to_bf16(lane, gw, NGW, F.x, F.g_mix_pre, wsp<bf16>(F, WS_HB));
}

__device__ __forceinline__ int crow(int r, int hi) { return (r & 3) + 8 * (r >> 2) + 4 * hi; }
#define P2_PIN8(a) asm volatile("" : "+v"(a[0]), "+v"(a[1]), "+v"(a[2]), "+v"(a[3]), "+v"(a[4]), "+v"(a[5]), "+v"(a[6]), "+v"(a[7]))
__device__ __forceinline__ void p2_compress_unit(Frame& F, int unit) {
    const int bg = unit >> 2, kv = (unit >> 1) & 1, half = unit & 1, lane = cur_lane(), w = F.wave;
    const bf16* X = wsp<bf16>(F, WS_KV + (size_t)kv * KV_STRIDE) + (size_t)bg * SEQ * 64;
    const bf16* W1t = wsp<bf16>(F, kv ? WS_W1V : WS_W1K); const bf16* W2t = wsp<bf16>(F, kv ? WS_W2V : WS_W2K); const float* PB = wsp<float>(F, kv ? WS_PBV : WS_PBK);
    bf16* OUT = wsp<bf16>(F, kv ? WS_VCMP : WS_KCMP) + (size_t)bg * 128 * 64;
    const int rt = w & 1, ct = (w >> 1) & 1, kh = w >> 2, r = lane & 31, h = lane >> 5;
    const int irow = 64 * half + 32 * rt + r, ild = irow < 126 ? irow : 126;
    const GAS bf16x8* arow = (const GAS bf16x8*)(X + (size_t)ild * 1024 + kh * 1024); const GAS bf16x8* brow = (const GAS bf16x8*)(W1t + (size_t)(32 * ct + r) * 2048 + kh * 1024);
#define P2_KIDX(S) (8 * ((S) >> 2) + 4 * h + ((S) & 3))
    f32x16 acc = {};
    bf16x8 a0[8], b0[8], a1[8], b1[8];
#pragma unroll
    for (int s = 0; s < 8; ++s) { a0[s] = arow[P2_KIDX(s)]; b0[s] = brow[P2_KIDX(s)]; }
#pragma unroll 1
    for (int bt = 0; bt < 8; bt += 2) {
#pragma unroll
        for (int s = 0; s < 8; ++s) { a1[s] = arow[P2_KIDX(8 * (bt + 1) + s)]; b1[s] = brow[P2_KIDX(8 * (bt + 1) + s)]; }
        P2_PIN8(a0); P2_PIN8(b0);
#pragma unroll
        for (int s = 0; s < 8; ++s) acc = __builtin_amdgcn_mfma_f32_32x32x16_bf16(a0[s], b0[s], acc, 0, 0, 0);
        if (bt + 2 < 8) {
#pragma unroll
            for (int s = 0; s < 8; ++s) { a0[s] = arow[P2_KIDX(8 * (bt + 2) + s)]; b0[s] = brow[P2_KIDX(8 * (bt + 2) + s)]; } }
#undef P2_KIDX_DONE
        P2_PIN8(a1); P2_PIN8(b1);
#pragma unroll
        for (int s = 0; s < 8; ++s) acc = __builtin_amdgcn_mfma_f32_32x32x16_bf16(a1[s], b1[s], acc, 0, 0, 0);
    }
    LAS float* red = (LAS float*)(F.lds + RING_OFF);
    LAS bf16* Hs = (LAS bf16*)(F.lds + RING_OFF + 16384);
    if (kh == 1) {
#pragma unroll
        for (int i = 0; i < 16; ++i) red[((w & 3) * 16 + i) * 64 + lane] = acc[i];
    }
    __syncthreads();
    if (kh == 0) { const float pb = PB[32 * ct + r];
#pragma unroll
        for (int i = 0; i < 16; ++i) { float v = acc[i] + red[((w & 3) * 16 + i) * 64 + lane] + pb; v = v / (1.0f + __expf(-v)); Hs[(32 * rt + crow(i, h)) * 72 + 32 * ct + r] = (bf16)f2bf(v); }
    }
    __syncthreads();
    if (kh == 0) { f32x16 o = {};
#pragma unroll
        for (int s = 0; s < 4; ++s) { const bf16x8 a = *(const LAS bf16x8*)(Hs + (32 * rt + r) * 72 + 16 * s + 8 * h), b = *(const GAS bf16x8*)(W2t + (size_t)(32 * ct + r) * 64 + 16 * s + 8 * h);
            o = __builtin_amdgcn_mfma_f32_32x32x16_bf16(a, b, o, 0, 0, 0); }
#pragma unroll
        for (int i = 0; i < 16; ++i) { const int row = 64 * half + 32 * rt + crow(i, h); OUT[(size_t)row * 64 + 32 * ct + r] = (bf16)(row == 127 ? 0u : f2bf(o[i])); }
    }
    __syncthreads();
}
__device__ __forceinline__ void p2_phase(Frame& F) {
    for (int id = F.vcu; id < BATCH * 8; id += F.G) { const int b = id >> 3, h = id & 7, tid = cur_tid(F), lane = cur_lane(), w = F.wave;
        LAS float* wt = (LAS float*)(F.lds + RING_OFF + 32768);
        const float* lf = wsp<float>(F, WS_LF) + ((size_t)b * SEQ + 4 * tid) * 8 + h; float v[4];
#pragma unroll
        for (int i = 0; i < 4; ++i) v[i] = lf[i * 8];
        const float tot = (v[0] + v[1]) + (v[2] + v[3]); float incl = tot;
#pragma unroll
        for (int o = 1; o < 64; o <<= 1) { const float n = __shfl_up(incl, o); if (lane >= o) incl += n; }
        if (lane == 63) wt[w] = incl;
        __syncthreads();
        float run = incl - tot;
        for (int k = 0; k < w; ++k) run += wt[k];
        float* c = wsp<float>(F, WS_C) + (size_t)id * SEQ + 4 * tid; GAS v4u* kx = (GAS v4u*)(wsp<bf16>(F, WS_FKX) + ((size_t)id * SEQ + 4 * tid) * 16);
        float cv[4];
#pragma unroll
        for (int i = 0; i < 4; ++i) { run += v[i]; cv[i] = run;
            const float x = -run * LOG2E; const unsigned h1 = f2bf(x); const float r1 = x - __uint_as_float(h1 << 16); const unsigned h2 = f2bf(r1); const float r2 = r1 - __uint_as_float(h2 << 16); const unsigned h3 = f2bf(r2);
            kx[2 * i] = (v4u){h1 | (h2 << 16), h3, 0u, 0u}; kx[2 * i + 1] = (v4u){0u, 0u, 0u, 0u}; }
        *(GAS f32x4*)c = (f32x4){cv[0], cv[1], cv[2], cv[3]};
        { LAS float* cl = (LAS float*)(F.lds + RING_OFF + 36864); LAS float* wk = cl + 2048; LAS float* wq = wk + 256;
          *(LAS f32x4*)(cl + 4 * tid) = (f32x4){cv[0], cv[1], cv[2], cv[3]};
          const GAS v4u* kr = (const GAS v4u*)(wsp<bf16>(F, WS_FK) + ((size_t)b * SEQ + (tid >> 3)) * 512 + h * 64 + (tid & 7) * 8);
          const GAS v4u* qrw = (const GAS v4u*)(wsp<bf16>(F, WS_FQ) + ((size_t)b * SEQ + (tid >> 3)) * 512 + h * 64 + (tid & 7) * 8);
#pragma unroll 1
          for (int i0 = 0; i0 < 32; i0 += 16) { v4u ka[16], qa[16];
#pragma unroll
              for (int i = 0; i < 16; ++i) { ka[i] = kr[(size_t)(i0 + i) * 64 * 64]; qa[i] = qrw[(size_t)(i0 + i) * 64 * 64]; }
              asm volatile("" : "+v"(ka[0]), "+v"(ka[1]), "+v"(ka[2]), "+v"(ka[3]), "+v"(ka[4]), "+v"(ka[5]), "+v"(ka[6]), "+v"(ka[7]), "+v"(ka[8]), "+v"(ka[9]), "+v"(ka[10]), "+v"(ka[11]), "+v"(ka[12]), "+v"(ka[13]), "+v"(ka[14]), "+v"(ka[15]));
              asm volatile("" : "+v"(qa[0]), "+v"(qa[1]), "+v"(qa[2]), "+v"(qa[3]), "+v"(qa[4]), "+v"(qa[5]), "+v"(qa[6]), "+v"(qa[7]), "+v"(qa[8]), "+v"(qa[9]), "+v"(qa[10]), "+v"(qa[11]), "+v"(qa[12]), "+v"(qa[13]), "+v"(qa[14]), "+v"(qa[15]));
#pragma unroll
              for (int i = 0; i < 16; ++i) { const v4u a = ka[i], e = qa[i];
                  float sk = (bfl(a.x) * bfl(a.x) + bfh(a.x) * bfh(a.x)) + (bfl(a.y) * bfl(a.y) + bfh(a.y) * bfh(a.y)) + (bfl(a.z) * bfl(a.z) + bfh(a.z) * bfh(a.z)) + (bfl(a.w) * bfl(a.w) + bfh(a.w) * bfh(a.w));
                  float sq = (bfl(e.x) * bfl(e.x) + bfh(e.x) * bfh(e.x)) + (bfl(e.y) * bfl(e.y) + bfh(e.y) * bfh(e.y)) + (bfl(e.z) * bfl(e.z) + bfh(e.z) * bfh(e.z)) + (bfl(e.w) * bfl(e.w) + bfh(e.w) * bfh(e.w));
                  sk += __shfl_xor(sk, 1); sq += __shfl_xor(sq, 1); sk += __shfl_xor(sk, 2); sq += __shfl_xor(sq, 2); sk += __shfl_xor(sk, 4); sq += __shfl_xor(sq, 4);
                  sk = fmaxf(sk, __shfl_xor(sk, 8)); sq = fmaxf(sq, __shfl_xor(sq, 8)); sk = fmaxf(sk, __shfl_xor(sk, 16)); sq = fmaxf(sq, __shfl_xor(sq, 16)); sk = fmaxf(sk, __shfl_xor(sk, 32)); sq = fmaxf(sq, __shfl_xor(sq, 32));
                  if (lane == 0) { wk[w * 32 + i0 + i] = sk; wq[w * 32 + i0 + i] = sq; } } }
          __syncthreads();
          if (tid < 8) { const int qb = tid; float Qm = 0.f, Kband = 0.f;
              for (int t4 = 0; t4 < 4; ++t4) for (int ww = 0; ww < 8; ++ww) { Qm = fmaxf(Qm, wq[ww * 32 + 4 * qb + t4]); Kband = fmaxf(Kband, wk[ww * 32 + 4 * qb + t4]); }
              Qm = sqrtf(Qm) * 1.001f; Kband = sqrtf(Kband) * 1.001f;
              const float cq0 = cl[256 * qb]; int kt0 = 4 * qb;
              for (int kt = 4 * qb - 1; kt >= 0; --kt) { float kk = 0.f; for (int ww = 0; ww < 8; ++ww) kk = fmaxf(kk, wk[ww * 32 + kt]); kk = sqrtf(kk) * 1.001f;
                  const float bound = Qm * (kk + Kband) + (cq0 - cl[64 * kt + 63]) * LOG2E; if (bound >= -40.0f) kt0 = kt; }
              wsp<int>(F, WS_KT0)[id * 8 + qb] = kt0; } }
        __syncthreads(); }
    for (int u = F.vcu; u < 256; u += F.G) p2_compress_unit(F, u);
}

template <bool FINAL>
__device__ __forceinline__ void row_pass(Frame& F, const float* xin_f32, const bf16* xin_b16, const bf16* Y, const float* gpost, float* out_f32, bf16* X1B, float* RSTD2) {
#ifndef RP_FINAL
#define RP_FINAL 4
#endif
    constexpr int RP = FINAL ? RP_FINAL : 4;
    const int gw = F.vcu * NWAVES + F.wave, NGW = F.G * NWAVES, lane = cur_lane();
    const GAS f32x4* gp = (const GAS f32x4*)gpost + lane;
    f32x4 gpv[4];
#pragma unroll
    for (int j = 0; j < 4; ++j) gpv[j] = gp[64 * j];
    for (int m0 = gw; m0 < MTOK; m0 += NGW * RP) {
        f32x4 xv[FINAL ? 1 : RP][4]; unsigned long long xw[FINAL ? RP : 1][4]; unsigned long long yw[RP][4];
#pragma unroll
        for (int r = 0; r < RP; ++r) { const size_t m = (size_t)(m0 + r * NGW);
            const GAS unsigned long long* yr = (const GAS unsigned long long*)(Y + m * DMODEL) + lane;
            if (FINAL) { const GAS unsigned long long* xr = (const GAS unsigned long long*)(xin_b16 + m * DMODEL) + lane;
#pragma unroll
                for (int j = 0; j < 4; ++j) { xw[r][j] = __builtin_nontemporal_load(xr + 64 * j); yw[r][j] = __builtin_nontemporal_load(yr + 64 * j); }
            } else { const GAS f32x4* xr = (const GAS f32x4*)(xin_f32 + m * DMODEL) + lane;
#pragma unroll
                for (int j = 0; j < 4; ++j) { xv[r][j] = __builtin_nontemporal_load(xr + 64 * j); yw[r][j] = __builtin_nontemporal_load(yr + 64 * j); } } }
#pragma unroll
        for (int r = 0; r < RP; ++r) { const size_t m = (size_t)(m0 + r * NGW);
            f32x4 yv[4]; float s = 0.f;
#pragma unroll
            for (int j = 0; j < 4; ++j) { const unsigned lo = (unsigned)yw[r][j], hi = (unsigned)(yw[r][j] >> 32);
                yv[j] = (f32x4){bfl(lo), bfh(lo), bfl(hi), bfh(hi)}; s += (yv[j].x * yv[j].x + yv[j].y * yv[j].y) + (yv[j].z * yv[j].z + yv[j].w * yv[j].w); }
            float eps = RMS_EPS;
            if (FINAL) { const float r2 = RSTD2[m]; eps = RMS_EPS / ((r2 * r2) * (r2 * r2)); }
            const float rr = 1.0f / sqrtf(wave_sum(s) * (1.f / DMODEL) + eps); float s2 = 0.f;
            if (FINAL) { GAS f32x4* xo = (GAS f32x4*)(out_f32 + m * DMODEL) + lane;
#pragma unroll
                for (int j = 0; j < 4; ++j) { const unsigned lo = (unsigned)xw[r][j], hi = (unsigned)(xw[r][j] >> 32); const f32x4 xf = (f32x4){bfl(lo), bfh(lo), bfl(hi), bfh(hi)}; __builtin_nontemporal_store(xf + yv[j] * rr * gpv[j], xo + 64 * j); }
            } else { GAS unsigned long long* o8 = (GAS unsigned long long*)(X1B + m * DMODEL) + lane;
#pragma unroll
                for (int j = 0; j < 4; ++j) { const f32x4 v = xv[r][j] + yv[j] * rr * gpv[j]; s2 += (v.x * v.x + v.y * v.y) + (v.z * v.z + v.w * v.w);
                    o8[64 * j] = (unsigned long long)pk2(v.x, v.y) | ((unsigned long long)pk2(v.z, v.w) << 32); }
                const float r2 = 1.0f / sqrtf(wave_sum(s2) * (1.f / DMODEL) + RMS_EPS); if (lane == 0) RSTD2[m] = r2; }
        }
    }
}

namespace at {
constexpr int KSLOT = 10240, VSLOT = 8192, NSLOT = 3;
constexpr int L_K = 0, L_V = NSLOT * KSLOT, L_WS = L_V + NSLOT * VSLOT, L_PARK = L_WS + 8 * 512, L_PSL = L_PARK, L_CMP = L_PARK + 4 * 64 * 33 * 4, L_SELM = L_CMP + 4 * 8192, L_NEXT = L_SELM + 256, L_END = L_NEXT + 16;
static_assert(L_SELM >= L_PARK + 8 * 8192, "park region");
static_assert(L_END <= RING_BYTES, "attention LDS map");
constexpr float THR = 8.0f;
typedef short s16x4 __attribute__((ext_vector_type(4)));
typedef short v4i16_t __attribute__((ext_vector_type(4)));
#define AT_NEG (-INFINITY)
__device__ __forceinline__ void glds16(const void* sbase, unsigned voff, unsigned lds_dst) { unsigned keep;
    asm volatile("s_mov_b32 %0, m0\n\ts_mov_b32 m0, %3\n\ts_nop 2\n\tglobal_load_lds_dwordx4 %1, %2\n\ts_mov_b32 m0, %0" : "=&s"(keep) : "v"(voff), "s"(sbase), "s"(lds_dst) : "memory"); }
__device__ __forceinline__ void glds4(const void* sbase, unsigned voff, unsigned lds_dst) { unsigned keep;
    asm volatile("s_mov_b32 %0, m0\n\ts_mov_b32 m0, %3\n\ts_nop 2\n\tglobal_load_lds_dword %1, %2\n\ts_mov_b32 m0, %0" : "=&s"(keep) : "v"(voff), "s"(sbase), "s"(lds_dst) : "memory"); }
#define AT_WAIT_BAR(N) asm volatile("s_waitcnt vmcnt(" #N ") lgkmcnt(0)\n\ts_barrier" ::: "memory")
#ifndef AT_PRIO_MODE
#define AT_PRIO_MODE 1
#endif
#define AT_PRIO(w) do { if (AT_PRIO_MODE == 1) { if ((w) < 4) __builtin_amdgcn_s_setprio(2); else __builtin_amdgcn_s_setprio(0); } else if (AT_PRIO_MODE == 2) { if (((w) & 1) == 0) __builtin_amdgcn_s_setprio(2); else __builtin_amdgcn_s_setprio(0); } } while (0)
#define AT_BAR() asm volatile("s_waitcnt lgkmcnt(0)\n\ts_barrier" ::: "memory")
__device__ __forceinline__ unsigned cvtpk(float lo, float hi) { typedef float f2 __attribute__((ext_vector_type(2))); typedef __bf16 b2 __attribute__((ext_vector_type(2))); f2 v = {lo, hi}; b2 b = __builtin_convertvector(v, b2); return __builtin_bit_cast(unsigned, b); }
__device__ __forceinline__ float swap_half(float x, int hi) { auto rr = __builtin_amdgcn_permlane32_swap(__float_as_uint(x), __float_as_uint(x), false, false); return hi ? __uint_as_float(rr[0]) : __uint_as_float(rr[1]); }
__device__ __forceinline__ float max_half(float x) { auto rr = __builtin_amdgcn_permlane32_swap(__float_as_uint(x), __float_as_uint(x), false, false); return fmaxf(__uint_as_float(rr[0]), __uint_as_float(rr[1])); }
__device__ __forceinline__ float sum_half(float x) { auto rr = __builtin_amdgcn_permlane32_swap(__float_as_uint(x), __float_as_uint(x), false, false); return __uint_as_float(rr[0]) + __uint_as_float(rr[1]); }
template <int KS>
__device__ __forceinline__ void qk(f32x16& p0, f32x16& p1, const LAS unsigned char* Kslot, const bf16x8 (&qr)[5], const f32x16& cinit, int r32, int hi) {
    const LAS unsigned char* kb = Kslot + hi * 1024 + r32 * 16;
#pragma unroll
    for (int d0 = 0; d0 < KS; ++d0) { const bf16x8 b0 = *(const LAS bf16x8*)(kb + d0 * 2048), b1 = *(const LAS bf16x8*)(kb + d0 * 2048 + 512);
        if (d0 == 0) { p0 = __builtin_amdgcn_mfma_f32_32x32x16_bf16(b0, qr[0], cinit, 0, 0, 0); p1 = __builtin_amdgcn_mfma_f32_32x32x16_bf16(b1, qr[0], cinit, 0, 0, 0); }
        else { p0 = __builtin_amdgcn_mfma_f32_32x32x16_bf16(b0, qr[d0], p0, 0, 0, 0); p1 = __builtin_amdgcn_mfma_f32_32x32x16_bf16(b1, qr[d0], p1, 0, 0, 0); } }
}
__device__ __forceinline__ s16x4 vtr(const LAS unsigned char* p) { return __builtin_bit_cast(s16x4, __builtin_amdgcn_ds_read_tr16_b64_v4i16((LAS v4i16_t*)p)); }
__device__ __forceinline__ void pv(f32x16 (&o)[2], const LAS unsigned char* vb, const f32x16& p0, const f32x16& p1) {
    v4u pw[4];
#pragma unroll
    for (int k = 0; k < 2; ++k) { pw[k] = (v4u){cvtpk(p0[8 * k], p0[8 * k + 1]), cvtpk(p0[8 * k + 2], p0[8 * k + 3]), cvtpk(p0[8 * k + 4], p0[8 * k + 5]), cvtpk(p0[8 * k + 6], p0[8 * k + 7])};
        pw[2 + k] = (v4u){cvtpk(p1[8 * k], p1[8 * k + 1]), cvtpk(p1[8 * k + 2], p1[8 * k + 3]), cvtpk(p1[8 * k + 4], p1[8 * k + 5]), cvtpk(p1[8 * k + 6], p1[8 * k + 7])}; }
#pragma unroll
    for (int d0 = 0; d0 < 2; ++d0)
#pragma unroll
        for (int ks = 0; ks < 4; ++ks) { const s16x4 lo = vtr(vb + d0 * 4096 + ks * 1024), hi = vtr(vb + d0 * 4096 + ks * 1024 + 512);
            const bf16x8 vf = (bf16x8){lo[0], lo[1], lo[2], lo[3], hi[0], hi[1], hi[2], hi[3]};
            o[d0] = __builtin_amdgcn_mfma_f32_32x32x16_bf16(__builtin_bit_cast(bf16x8, pw[ks]), vf, o[d0], 0, 0, 0); }
}
template <int KS>
__device__ __forceinline__ void load_kf(bf16x8 (&kf)[10], const LAS unsigned char* Kslot, int r32, int hi) {
    const LAS unsigned char* kb = Kslot + hi * 1024 + r32 * 16;
#pragma unroll
    for (int d0 = 0; d0 < KS; ++d0) { kf[2 * d0] = *(const LAS bf16x8*)(kb + d0 * 2048); kf[2 * d0 + 1] = *(const LAS bf16x8*)(kb + d0 * 2048 + 512); }
}
__device__ __forceinline__ void v_load(bf16x8 (&vf)[8], const LAS unsigned char* vb) {
#pragma unroll
    for (int d0 = 0; d0 < 2; ++d0)
#pragma unroll
        for (int ks = 0; ks < 4; ++ks) { const s16x4 lo = vtr(vb + d0 * 4096 + ks * 1024), hi = vtr(vb + d0 * 4096 + ks * 1024 + 512);
            vf[d0 * 4 + ks] = (bf16x8){lo[0], lo[1], lo[2], lo[3], hi[0], hi[1], hi[2], hi[3]}; }
}
template <int KS, bool LOADK>
__device__ __forceinline__ void pv_regs(f32x16 (&o)[2], const bf16x8 (&vf)[8], const f32x16& p0, const f32x16& p1, bf16x8 (&kf)[10], const LAS unsigned char* Knext, int r32, int hi) {
    v4u pw[4];
#pragma unroll
    for (int k = 0; k < 2; ++k) { pw[k] = (v4u){cvtpk(p0[8 * k], p0[8 * k + 1]), cvtpk(p0[8 * k + 2], p0[8 * k + 3]), cvtpk(p0[8 * k + 4], p0[8 * k + 5]), cvtpk(p0[8 * k + 6], p0[8 * k + 7])};
        pw[2 + k] = (v4u){cvtpk(p1[8 * k], p1[8 * k + 1]), cvtpk(p1[8 * k + 2], p1[8 * k + 3]), cvtpk(p1[8 * k + 4], p1[8 * k + 5]), cvtpk(p1[8 * k + 6], p1[8 * k + 7])}; }
#pragma unroll
    for (int ks = 0; ks < 2; ++ks)
#pragma unroll
        for (int d0 = 0; d0 < 2; ++d0) o[d0] = __builtin_amdgcn_mfma_f32_32x32x16_bf16(__builtin_bit_cast(bf16x8, pw[ks]), vf[d0 * 4 + ks], o[d0], 0, 0, 0);
    if (LOADK) { __builtin_amdgcn_sched_barrier(0); load_kf<KS>(kf, Knext, r32, hi); __builtin_amdgcn_sched_barrier(0); }
#pragma unroll
    for (int ks = 2; ks < 4; ++ks)
#pragma unroll
        for (int d0 = 0; d0 < 2; ++d0) o[d0] = __builtin_amdgcn_mfma_f32_32x32x16_bf16(__builtin_bit_cast(bf16x8, pw[ks]), vf[d0 * 4 + ks], o[d0], 0, 0, 0);
}
__device__ __forceinline__ float max3f(float a, float b, float c) { float r; asm("v_max3_f32 %0, %1, %2, %3" : "=v"(r) : "v"(a), "v"(b), "v"(c)); return r; }
__device__ __forceinline__ float rowmax32(const f32x16& p0, const f32x16& p1) {
    float a = max3f(p0[0], p0[1], p1[0]), b = max3f(p0[2], p0[3], p1[1]); a = max3f(a, p1[2], p1[3]);
#pragma unroll
    for (int r = 4; r < 16; r += 4) { a = max3f(a, p0[r], p0[r + 1]); b = max3f(b, p0[r + 2], p0[r + 3]); a = max3f(a, p1[r], p1[r + 1]); b = max3f(b, p1[r + 2], p1[r + 3]); }
    return max_half(__builtin_fmaxf(a, b));
}
template <bool FIRST>
__device__ __forceinline__ void softmax_tile(f32x16& p0, f32x16& p1, f32x16& cinit, float& l, f32x16 (&o)[2], LAS float* wsf, int r32, int hi) {
    const float rm = rowmax32(p0, p1);
    bool resc = false;
    if (FIRST) { const float dl = rm;
#pragma unroll
        for (int r = 0; r < 16; ++r) { p0[r] -= dl; p1[r] -= dl; cinit[r] -= dl; } }
    else if (__any(rm > THR)) { const float dl = fmaxf(rm, 0.f);
#pragma unroll
        for (int r = 0; r < 16; ++r) { p0[r] -= dl; p1[r] -= dl; cinit[r] -= dl; }
        const float f = __builtin_amdgcn_exp2f(-dl); l *= f; if (hi == 0) wsf[r32] = f; resc = true; }
    float s = 0.f;
#pragma unroll
    for (int r = 0; r < 16; ++r) { p0[r] = __builtin_amdgcn_exp2f(p0[r]); p1[r] = __builtin_amdgcn_exp2f(p1[r]); s += p0[r] + p1[r]; }
    l += s;
    if (resc) {
#pragma unroll
        for (int i = 0; i < 4; ++i) { const f32x4 f4 = *(const LAS f32x4*)(wsf + 8 * i + 4 * hi);
#pragma unroll
            for (int k = 0; k < 4; ++k) { o[0][4 * i + k] *= f4[k]; o[1][4 * i + k] *= f4[k]; } } }
}
__device__ __forceinline__ void row_bcast(float v, float (&out)[16], LAS float* wsf, int r32, int hi) {
    asm volatile("s_waitcnt lgkmcnt(0)" ::: "memory");
    if (hi == 0) wsf[32 + r32] = v;
#pragma unroll
    for (int i = 0; i < 4; ++i) { const f32x4 f4 = *(const LAS f32x4*)(wsf + 32 + 8 * i + 4 * hi);
#pragma unroll
        for (int k = 0; k < 4; ++k) out[4 * i + k] = f4[k]; }
    asm volatile("s_waitcnt lgkmcnt(0)" ::: "memory");
}
__device__ __forceinline__ void store_rows(const f32x16 (&v)[2], LAS unsigned char* stg_, bf16* Ow, int pitch, int lane, int r32, int hi) {
    LAS bf16* stg = (LAS bf16*)stg_;
#pragma unroll
    for (int r = 0; r < 16; ++r) { const int orow = crow(r, hi);
#pragma unroll
        for (int d0 = 0; d0 < 2; ++d0) stg[orow * 64 + d0 * 32 + r32] = (bf16)f2bf(v[d0][r]); }
    asm volatile("s_waitcnt lgkmcnt(0)" ::: "memory");
#pragma unroll
    for (int i = 0; i < 4; ++i) { const int row = i * 8 + (lane >> 3), ch = lane & 7; const v4u w = *(const LAS v4u*)(stg + row * 64 + ch * 8); *(GAS v4u*)(Ow + (size_t)row * pitch + ch * 8) = w; }
    asm volatile("s_waitcnt lgkmcnt(0)" ::: "memory");
}


template <int KS>
__device__ __forceinline__ void qk_regs(f32x16& p0, f32x16& p1, const bf16x8 (&kf)[10], const bf16x8 (&qr)[5], const f32x16& cinit) {
    p0 = __builtin_amdgcn_mfma_f32_32x32x16_bf16(kf[0], qr[0], cinit, 0, 0, 0); p1 = __builtin_amdgcn_mfma_f32_32x32x16_bf16(kf[1], qr[0], cinit, 0, 0, 0);
#pragma unroll
    for (int d0 = 1; d0 < KS; ++d0) { p0 = __builtin_amdgcn_mfma_f32_32x32x16_bf16(kf[2 * d0], qr[d0], p0, 0, 0, 0); p1 = __builtin_amdgcn_mfma_f32_32x32x16_bf16(kf[2 * d0 + 1], qr[d0], p1, 0, 0, 0); }
}
__device__ __forceinline__ void softmax_first(f32x16& p0, f32x16& p1, f32x16& cinit, float& l) {
    const float dl = rowmax32(p0, p1); float s = 0.f;
#pragma unroll
    for (int r = 0; r < 16; ++r) { cinit[r] -= dl; p0[r] = __builtin_amdgcn_exp2f(p0[r] - dl); p1[r] = __builtin_amdgcn_exp2f(p1[r] - dl); s += p0[r] + p1[r]; }
    l = s;
}
__device__ __forceinline__ void softmax_next(f32x16& p0, f32x16& p1, f32x16& cinit, float& l, f32x16 (&o)[2], LAS float* wsf, int r32, int hi) {
    const float rm = rowmax32(p0, p1);
    if (__builtin_expect(__any(rm > THR), 0)) { const float dl = __builtin_fmaxf(rm, 0.f);
#pragma unroll
        for (int r = 0; r < 16; ++r) { p0[r] -= dl; p1[r] -= dl; cinit[r] -= dl; }
        const float f = __builtin_amdgcn_exp2f(-dl); l *= f; if (hi == 0) wsf[r32] = f;
#pragma unroll
        for (int i = 0; i < 4; ++i) { const f32x4 f4 = *(const LAS f32x4*)(wsf + 8 * i + 4 * hi);
#pragma unroll
            for (int k = 0; k < 4; ++k) { o[0][4 * i + k] *= f4[k]; o[1][4 * i + k] *= f4[k]; } } }
    float s = 0.f;
#pragma unroll
    for (int r = 0; r < 16; ++r) { p0[r] = __builtin_amdgcn_exp2f(p0[r]); p1[r] = __builtin_amdgcn_exp2f(p1[r]); s += p0[r] + p1[r]; }
    l += s;
}

#define AT_CONSUME4(a, b, c, d) asm volatile("" :: "v"(a), "v"(b), "v"(c), "v"(d))

__device__ __forceinline__ void fox_unit(Frame& F, int bh, int qb, int kt0, const int ABL) {
    int tid_ = cur_tid(F); asm volatile("" : "+v"(tid_));
    AT_PRIO(F.wave);
    const int lane = tid_ & 63, r32 = lane & 31, hi = lane >> 5, wid = F.wave; const int b = bh >> 3, h = bh & 7;
    LAS unsigned char* shm = F.lds + RING_OFF; const unsigned lds0 = (unsigned)(uintptr_t)shm;
    LAS float* wsf = (LAS float*)(shm + L_WS + wid * 512);
    const size_t rowbase = (size_t)b * SEQ; const int q0 = qb * 256;
    const bf16* Q = wsp<bf16>(F, WS_FQ); const bf16* K = wsp<bf16>(F, WS_FK) + (rowbase + (size_t)kt0 * 64) * 512 + h * 64; const bf16* V = wsp<bf16>(F, WS_FV) + (rowbase + (size_t)kt0 * 64) * 512 + h * 64;
    const bf16* KX = wsp<bf16>(F, WS_FKX) + ((size_t)bh * SEQ + (size_t)kt0 * 64) * 16;
    const unsigned koff = (unsigned)(lane * 512 + wid * 8) * 2u, voff = (unsigned)((16 * (wid & 3) + (lane >> 2)) * 512 + (wid >> 2) * 32 + (lane & 3) * 8) * 2u;
    const unsigned xoff = (unsigned)((16 * (wid & 3) + (lane >> 2)) * 16 + (wid >> 2) * 8 + (lane & 3) * 2) * 2u;
    const unsigned kdst = lds0 + L_K + wid * 1024, vdst = lds0 + L_V + wid * 1024, xdst = lds0 + L_K + (8 + (wid >> 2)) * 1024 + (wid & 3) * 256;
#define FX_DMA_K(t, slot) do { glds16(K + (size_t)(t) * 64 * 512, koff, (unsigned)__builtin_amdgcn_readfirstlane(kdst + (slot) * KSLOT)); \
        glds4(KX + (size_t)(t) * 64 * 16, xoff, (unsigned)__builtin_amdgcn_readfirstlane(xdst + (slot) * KSLOT)); } while (0)
#define FX_DMA_V(t, slot) glds16(V + (size_t)(t) * 64 * 512, voff, (unsigned)__builtin_amdgcn_readfirstlane(vdst + (slot) * VSLOT))
    const int NT = 4 * qb + 4 - kt0;
    bf16x8 qr[5];
    { const bf16* Qw = Q + (rowbase + q0 + wid * 32 + r32) * 512 + h * 64;
#pragma unroll
      for (int d0 = 0; d0 < 4; ++d0) { if (ABL == 10) { qr[d0] = (bf16x8){(short)lane, 0, 0, 0, 0, 0, 0, 0}; asm volatile("" : "+v"(qr[d0])); } else qr[d0] = *(const GAS bf16x8*)(Qw + d0 * 16 + hi * 8); }
      const short one = (short)0x3F80; qr[4] = hi == 0 ? (bf16x8){one, one, one, 0, 0, 0, 0, 0} : (bf16x8){0, 0, 0, 0, 0, 0, 0, 0}; }
    const float ct = wsp<float>(F, WS_C)[(size_t)bh * SEQ + q0 + wid * 32 + r32] * LOG2E;
    asm volatile("" ::: "memory");
    if (ABL == 11) { FX_DMA_K(0, 0); FX_DMA_K(1, 1); FX_DMA_K(2, 2); } else if (ABL == 12) { FX_DMA_V(0, 0); FX_DMA_V(1, 1); } else if (ABL != 9) { FX_DMA_K(0, 0); FX_DMA_V(0, 0); FX_DMA_K(1, 1); FX_DMA_K(2, 2); FX_DMA_V(1, 1); }
    f32x16 cinit;
    f32x16 o[2]; o[0] = f32x16{}; o[1] = f32x16{}; float l = 0.f;
    const int qrel = wid * 32 + r32;
    const LAS unsigned char* vtb = shm + L_V + ((lane >> 4) & 1) * 32 + (lane & 3) * 8 + (4 * hi + ((lane & 15) >> 2)) * 64;
    bf16x8 kf[10], vf[8];
    AT_WAIT_BAR(3);
    AT_CONSUME4(qr[0], qr[1], qr[2], qr[3]); asm volatile("" :: "v"(ct));
#pragma unroll
    for (int r = 0; r < 16; ++r) cinit[r] = ct;
    load_kf<5>(kf, shm + L_K, r32, hi);
    int s0 = 0, s1 = 1, s2 = 2;
#define FX_MASK(n) do { const int jb_ = (n) - (NT - 4); if (jb_ >= 0) { const int kb_ = 64 * jb_ + 4 * hi; \
        _Pragma("unroll") for (int r = 0; r < 16; ++r) { const int kv = kb_ + (r & 3) + 8 * (r >> 2); if (kv > qrel) p0[r] = AT_NEG; if (kv + 32 > qrel) p1[r] = AT_NEG; } } } while (0)
#define FX_ROT() do { const int t_ = s0; s0 = s1; s1 = s2; s2 = t_; } while (0)
    if (ABL < 7) {
    {
      AT_WAIT_BAR(3); FX_DMA_K(3, 0); FX_DMA_V(2, 2);
      f32x16 p0, p1; qk_regs<5>(p0, p1, kf, qr, cinit); v_load(vf, vtb); __builtin_amdgcn_sched_barrier(0);
      FX_MASK(0); softmax_first(p0, p1, cinit, l); pv_regs<5, true>(o, vf, p0, p1, kf, shm + L_K + KSLOT, r32, hi); FX_ROT(); }
    int n = 1;
    for (; n + 3 < NT; ++n) {
        if (ABL == 4) asm volatile("s_waitcnt vmcnt(3) lgkmcnt(0)" ::: "memory"); else AT_WAIT_BAR(3);
        if (ABL != 5) { FX_DMA_K(n + 3, s0); FX_DMA_V(n + 2, s2); }
        f32x16 p0, p1; if (ABL == 3) { p0 = cinit; p1 = cinit; asm volatile("" : "+v"(p0), "+v"(p1)); } else qk_regs<5>(p0, p1, kf, qr, cinit);
        v_load(vf, vtb + s0 * VSLOT); __builtin_amdgcn_sched_barrier(0);
        FX_MASK(n);
        if (ABL == 6) { asm volatile("" : "+v"(p0), "+v"(p1)); }
        else if (ABL == 1) { const float rm = rowmax32(p0, p1); l += rm; asm volatile("" : "+v"(p0), "+v"(p1)); }
        else softmax_next(p0, p1, cinit, l, o, wsf, r32, hi);
        if (ABL == 2) { asm volatile("" :: "v"(p0), "v"(p1), "v"(vf[0]), "v"(vf[1]), "v"(vf[2]), "v"(vf[3]), "v"(vf[4]), "v"(vf[5]), "v"(vf[6]), "v"(vf[7])); load_kf<5>(kf, shm + L_K + s1 * KSLOT, r32, hi); }
        else pv_regs<5, true>(o, vf, p0, p1, kf, shm + L_K + s1 * KSLOT, r32, hi);
        FX_ROT(); }
    {
      AT_WAIT_BAR(3); FX_DMA_V(n + 2, s2);
      f32x16 p0, p1; qk_regs<5>(p0, p1, kf, qr, cinit); v_load(vf, vtb + s0 * VSLOT); __builtin_amdgcn_sched_barrier(0);
      FX_MASK(n); softmax_next(p0, p1, cinit, l, o, wsf, r32, hi); pv_regs<5, true>(o, vf, p0, p1, kf, shm + L_K + s1 * KSLOT, r32, hi); FX_ROT(); ++n; }
    {
      AT_WAIT_BAR(1);
      f32x16 p0, p1; qk_regs<5>(p0, p1, kf, qr, cinit); v_load(vf, vtb + s0 * VSLOT); __builtin_amdgcn_sched_barrier(0);
      FX_MASK(n); softmax_next(p0, p1, cinit, l, o, wsf, r32, hi); pv_regs<5, true>(o, vf, p0, p1, kf, shm + L_K + s1 * KSLOT, r32, hi); FX_ROT(); ++n; }
    {
      AT_WAIT_BAR(0);
      f32x16 p0, p1; qk_regs<5>(p0, p1, kf, qr, cinit); v_load(vf, vtb + s0 * VSLOT); __builtin_amdgcn_sched_barrier(0);
      FX_MASK(n); softmax_next(p0, p1, cinit, l, o, wsf, r32, hi); pv_regs<5, false>(o, vf, p0, p1, kf, shm, r32, hi); }
    } else { asm volatile("s_waitcnt vmcnt(0)" ::: "memory"); l = 1.f; }
#undef FX_DMA_K
#undef FX_DMA_V
#undef FX_MASK
#undef FX_ROT
    l = sum_half(l); float rl[16]; row_bcast(1.0f / l, rl, wsf, r32, hi);
#pragma unroll
    for (int r = 0; r < 16; ++r) { o[0][r] *= rl[r]; o[1][r] *= rl[r]; }
    if (ABL != 8) store_rows(o, shm + L_PARK + wid * 8192, wsp<bf16>(F, ABL ? WS_PROBE_O : WS_ATT) + (rowbase + q0 + wid * 32) * 1024 + 512 + h * 64, 1024, lane, r32, hi);
    AT_BAR();
}

__device__ __forceinline__ void nsa_unit(Frame& F, int bg, int j, const int ABL) {
    int tid_ = cur_tid(F); asm volatile("" : "+v"(tid_));
    AT_PRIO(F.wave);
    const int tid = tid_, lane = tid & 63, r32 = lane & 31, hi = lane >> 5, wid = F.wave; const int b = bg >> 1, g = bg & 1, hh = wid >> 1, head = 4 * g + hh;
    LAS unsigned char* shm = F.lds + RING_OFF; const unsigned lds0 = (unsigned)(uintptr_t)shm;
    LAS float* wsf = (LAS float*)(shm + L_WS + wid * 512);
    LAS float* PSL = (LAS float*)(shm + L_PSL); LAS unsigned* SELM = (LAS unsigned*)(shm + L_SELM);
    const int qrel = 32 * (wid & 1) + r32, t = 64 * j + qrel; const size_t row = (size_t)b * SEQ + t;
    const bf16* KC = wsp<bf16>(F, WS_KCMP) + (size_t)bg * 128 * 64; const bf16* VC = wsp<bf16>(F, WS_VCMP) + (size_t)bg * 128 * 64;
    const bf16* KS = wsp<bf16>(F, WS_KV + 2 * KV_STRIDE) + (size_t)bg * SEQ * 64; const bf16* VS = wsp<bf16>(F, WS_KV + 3 * KV_STRIDE) + (size_t)bg * SEQ * 64;
    const bf16* KW = wsp<bf16>(F, WS_KV + 4 * KV_STRIDE) + (size_t)bg * SEQ * 64; const bf16* VW = wsp<bf16>(F, WS_KV + 5 * KV_STRIDE) + (size_t)bg * SEQ * 64;
    const unsigned koff = (unsigned)(lane * 64 + wid * 8) * 2u, voff = (unsigned)((16 * (wid & 3) + (lane >> 2)) * 64 + (wid >> 2) * 32 + (lane & 3) * 8) * 2u;
    const unsigned kdst = lds0 + L_K + wid * 1024, vdst = lds0 + L_V + wid * 1024, cdst = lds0 + L_CMP + wid * 1024;
    const int nsel = j + 1, nwin = j >= 8 ? 9 : j + 1, NR = nsel + nwin;
#define NS_TILE(m) ({ int m_ = (m); m_ = m_ < NR ? m_ : NR - 1; (m_ < nsel) ? m_ : (j - (m_ - nsel)) + 64; })
#define NS_DMA_K(m, slot) do { const int e_ = NS_TILE(m); const bf16* kp_ = (e_ < 64) ? KS + e_ * 4096 : KW + (e_ - 64) * 4096; glds16(kp_, koff, (unsigned)__builtin_amdgcn_readfirstlane(kdst + (slot) * KSLOT)); } while (0)
#define NS_DMA_V(m, slot) do { const int e_ = NS_TILE(m); const bf16* vp_ = (e_ < 64) ? VS + e_ * 4096 : VW + (e_ - 64) * 4096; glds16(vp_, voff, (unsigned)__builtin_amdgcn_readfirstlane(vdst + (slot) * VSLOT)); } while (0)
    bf16x8 qr[5];
    { const bf16* Qw = wsp<bf16>(F, WS_NQ) + row * 512 + head * 64;
#pragma unroll
      for (int d0 = 0; d0 < 4; ++d0) qr[d0] = *(const GAS bf16x8*)(Qw + d0 * 16 + hi * 8);
      qr[4] = (bf16x8){0, 0, 0, 0, 0, 0, 0, 0}; }
    const float* gt = wsp<float>(F, WS_GATE) + row * 24 + head * 3; const float g0 = gt[0], g1 = gt[1], g2 = gt[2];
    asm volatile("" ::: "memory");
    if (ABL != 7) {
    glds16(KC, koff, (unsigned)__builtin_amdgcn_readfirstlane(cdst)); glds16(KC + 4096, koff, (unsigned)__builtin_amdgcn_readfirstlane(cdst + 8192));
    glds16(VC, voff, (unsigned)__builtin_amdgcn_readfirstlane(cdst + 16384)); glds16(VC + 4096, voff, (unsigned)__builtin_amdgcn_readfirstlane(cdst + 24576));
    NS_DMA_K(0, 0); NS_DMA_V(0, 0); NS_DMA_K(1, 1); NS_DMA_K(2, 2); NS_DMA_V(1, 1); }
    const LAS unsigned char* vlane = shm + ((lane >> 4) & 1) * 32 + (lane & 3) * 8 + (4 * hi + ((lane & 15) >> 2)) * 64;
    const LAS unsigned char* vtb = vlane + L_V;
    f32x16 o[2]; float rs[16]; bf16x8 kf[10], vf[8];
    LAS float* park = (LAS float*)(shm + L_PARK + wid * 8192) + lane;
    AT_WAIT_BAR(5);
    AT_CONSUME4(qr[0], qr[1], qr[2], qr[3]); asm volatile("" :: "v"(g0), "v"(g1), "v"(g2));
    o[0] = f32x16{}; o[1] = f32x16{};
    if (ABL != 4 && ABL < 5) { f32x16 zero = f32x16{}; f32x16 a0, a1, b0, b1;
      load_kf<4>(kf, shm + L_CMP, r32, hi); qk_regs<4>(a0, a1, kf, qr, zero); load_kf<4>(kf, shm + L_CMP + 8192, r32, hi); qk_regs<4>(b0, b1, kf, qr, zero);
      const int nmax = (t - 31) >> 4;
#pragma unroll
      for (int r = 0; r < 16; ++r) { const int n = (r & 3) + 8 * (r >> 2) + 4 * hi; if (n > nmax) a0[r] = AT_NEG; if (n + 32 > nmax) a1[r] = AT_NEG; if (n + 64 > nmax) b0[r] = AT_NEG; if (n + 96 > nmax) b1[r] = AT_NEG; }
      float m = __builtin_fmaxf(rowmax32(a0, a1), rowmax32(b0, b1)); m = (m == AT_NEG) ? 0.f : m;
      float s = 0.f;
#pragma unroll
      for (int r = 0; r < 16; ++r) { a0[r] = __builtin_amdgcn_exp2f(a0[r] - m); a1[r] = __builtin_amdgcn_exp2f(a1[r] - m); b0[r] = __builtin_amdgcn_exp2f(b0[r] - m); b1[r] = __builtin_amdgcn_exp2f(b1[r] - m); s += (a0[r] + a1[r]) + (b0[r] + b1[r]); }
      s = sum_half(s); const float inv = 1.0f / fmaxf(s, 1e-30f);
#pragma unroll
      for (int r = 0; r < 16; ++r) { a0[r] *= inv; a1[r] *= inv; b0[r] *= inv; b1[r] *= inv; }
      if (j >= 8) {
          float G[16], Lp[16];
#pragma unroll
          for (int i = 0; i < 4; ++i) { G[i] = (a0[4 * i] + a0[4 * i + 1]) + (a0[4 * i + 2] + a0[4 * i + 3]); G[4 + i] = (a1[4 * i] + a1[4 * i + 1]) + (a1[4 * i + 2] + a1[4 * i + 3]);
              G[8 + i] = (b0[4 * i] + b0[4 * i + 1]) + (b0[4 * i + 2] + b0[4 * i + 3]); G[12 + i] = (b1[4 * i] + b1[4 * i + 1]) + (b1[4 * i + 2] + b1[4 * i + 3]);
              Lp[i] = swap_half(a0[4 * i + 3], hi); Lp[4 + i] = swap_half(a1[4 * i + 3], hi); Lp[8 + i] = swap_half(b0[4 * i + 3], hi); Lp[12 + i] = swap_half(b1[4 * i + 3], hi); }
          LAS float* dst = PSL + (hh * 64 + qrel) * 33 + hi;
#pragma unroll
          for (int I = 0; I < 16; ++I) { const float prev = hi ? Lp[I] : (I > 0 ? Lp[I > 0 ? I - 1 : 0] : 0.f); dst[2 * I] = G[I] + prev; }
      }
      o[0] = f32x16{}; o[1] = f32x16{};
      pv(o, vlane + L_CMP + 16384, a0, a1); pv(o, vlane + L_CMP + 24576, b0, b1);
    }
    AT_BAR();
    if (j >= 8 && ABL != 3) { const int q = tid >> 3, sub = tid & 7;
        float v[4]; unsigned bits = 1u | (1u << j) | (1u << (j - 1));
#pragma unroll
        for (int c4 = 0; c4 < 4; ++c4) { const int k = 4 * sub + c4;
            const float ps = (PSL[(0 * 64 + q) * 33 + k] + PSL[(1 * 64 + q) * 33 + k]) + (PSL[(2 * 64 + q) * 33 + k] + PSL[(3 * 64 + q) * 33 + k]);
            v[c4] = (k > j - 2 || k == 0) ? -1e30f : ps; }
#pragma unroll 1
        for (int rnd = 0; rnd < 5; ++rnd) {
            float bv = v[0]; int bi = 4 * sub;
#pragma unroll
            for (int c4 = 1; c4 < 4; ++c4) if (v[c4] > bv) { bv = v[c4]; bi = 4 * sub + c4; }
#pragma unroll
            for (int o = 1; o < 8; o <<= 1) { const float ov = __shfl_xor(bv, o); const int oi = __shfl_xor(bi, o); if (ov > bv || (ov == bv && oi < bi)) { bv = ov; bi = oi; } }
            bits |= 1u << bi;
#pragma unroll
            for (int c4 = 0; c4 < 4; ++c4) if (bi == 4 * sub + c4) v[c4] = -3.0e38f; }
        if (sub == 0) SELM[q] = bits;
    } else { if (tid < 64) SELM[tid] = (2u << j) - 1u; }
    AT_BAR();
    const unsigned selm = SELM[qrel];
    row_bcast(g0, rs, wsf, r32, hi);
#pragma unroll
    for (int r = 0; r < 16; ++r) { park[r * 64] = o[0][r] * rs[r]; park[(16 + r) * 64] = o[1][r] * rs[r]; }
    f32x16 cinit; float l;
    AT_WAIT_BAR(2);
    load_kf<4>(kf, shm + L_K, r32, hi);
    int s0 = 0, s1 = 1, s2 = 2, m = 0;
#define NS_ROT() do { const int t_ = s0; s0 = s1; s1 = s2; s2 = t_; ++m; } while (0)
#define NS_HEAD() AT_WAIT_BAR(2); NS_DMA_K(m + 3, s0); NS_DMA_V(m + 2, s2); f32x16 p0, p1; qk_regs<4>(p0, p1, kf, qr, cinit); v_load(vf, vtb + s0 * VSLOT); __builtin_amdgcn_sched_barrier(0)
#define NS_MASK_SEL() do { const float keep_ = ((selm >> m) & 1u) ? 0.f : AT_NEG;        \
        if (ABL != 1) { _Pragma("unroll") for (int r = 0; r < 16; ++r) { p0[r] += keep_; p1[r] += keep_; } } \
        if (m == j) {   \
        _Pragma("unroll") for (int r = 0; r < 16; ++r) { const int kk = (r & 3) + 8 * (r >> 2) + 4 * hi; if (kk > qrel) p0[r] = AT_NEG; if (kk + 32 > qrel) p1[r] = AT_NEG; } } } while (0)
#define NS_MASK_WIN() do { const int tt = j - (m - nsel); if (tt == j) { \
        _Pragma("unroll") for (int r = 0; r < 16; ++r) { const int kk = (r & 3) + 8 * (r >> 2) + 4 * hi; if (kk > qrel) p0[r] = AT_NEG; if (kk + 32 > qrel) p1[r] = AT_NEG; } } \
      else if (tt == j - 8) {   \
        _Pragma("unroll") for (int r = 0; r < 16; ++r) { const int kk = (r & 3) + 8 * (r >> 2) + 4 * hi; if (kk <= qrel) p0[r] = AT_NEG; if (kk + 32 <= qrel) p1[r] = AT_NEG; } } } while (0)
    cinit = f32x16{}; o[0] = f32x16{}; o[1] = f32x16{};
    l = 1.f;
    if (ABL != 2 && ABL < 5) {
    { NS_HEAD(); NS_MASK_SEL(); softmax_first(p0, p1, cinit, l); pv_regs<4, true>(o, vf, p0, p1, kf, shm + L_K + s1 * KSLOT, r32, hi); NS_ROT(); }
    for (; m < nsel;) { NS_HEAD(); NS_MASK_SEL(); softmax_next(p0, p1, cinit, l, o, wsf, r32, hi); pv_regs<4, true>(o, vf, p0, p1, kf, shm + L_K + s1 * KSLOT, r32, hi); NS_ROT(); }
    }
    l = sum_half(l); row_bcast(g1 / l, rs, wsf, r32, hi);
#pragma unroll
    for (int r = 0; r < 16; ++r) { park[r * 64] += o[0][r] * rs[r]; park[(16 + r) * 64] += o[1][r] * rs[r]; }
    cinit = f32x16{}; o[0] = f32x16{}; o[1] = f32x16{};
    l = 1.f;
    if (ABL != 2 && ABL < 5) {
    { NS_HEAD(); NS_MASK_WIN(); softmax_first(p0, p1, cinit, l); pv_regs<4, true>(o, vf, p0, p1, kf, shm + L_K + s1 * KSLOT, r32, hi); NS_ROT(); }
    for (; m < NR;) { NS_HEAD(); NS_MASK_WIN(); softmax_next(p0, p1, cinit, l, o, wsf, r32, hi); pv_regs<4, true>(o, vf, p0, p1, kf, shm + L_K + s1 * KSLOT, r32, hi); NS_ROT(); }
    }
#undef NS_HEAD
#undef NS_TILE
#undef NS_DMA_K
#undef NS_DMA_V
#undef NS_ROT
#undef NS_MASK_SEL
#undef NS_MASK_WIN
    l = sum_half(l); row_bcast(g2 / l, rs, wsf, r32, hi);
#pragma unroll
    for (int r = 0; r < 16; ++r) { o[0][r] = park[r * 64] + o[0][r] * rs[r]; o[1][r] = park[(16 + r) * 64] + o[1][r] * rs[r]; }
    asm volatile("s_waitcnt vmcnt(0) lgkmcnt(0)" ::: "memory");
    if (ABL != 6) store_rows(o, shm + L_PARK + wid * 8192, wsp<bf16>(F, ABL ? WS_PROBE_O : WS_ATT) + ((size_t)b * SEQ + 64 * j + 32 * (wid & 1)) * 1024 + head * 64, 1024, lane, r32, hi);
    AT_BAR();
}
constexpr int NUNITS = 4096;
__device__ const unsigned short BLK_TAB[64] = {64512, 63489, 62466, 61443, 60420, 59397, 58374, 57351, 56328, 55305, 54282, 53259, 52236, 51213, 50190, 49167, 48144, 47121, 46098, 45075, 44052, 43029, 42006, 40983, 39960, 38937, 37914, 36891, 35868, 2077, 2077, 2077, 2077, 3105, 3105, 3105, 3105, 4133, 4133, 4133, 4133, 5161, 5161, 5161, 5161, 6189, 6189, 6189, 6189, 7217, 7217, 7217, 7217, 34869, 1078, 1078, 1078, 1078, 33850, 32827, 60, 60, 60, 60};
__device__ const unsigned char NSJ[256] = {14, 21, 11, 0, 18, 23, 22, 19, 1, 16, 4, 28, 2, 8, 7, 10, 24, 30, 9, 15, 17, 13, 5, 25, 27, 20, 26, 3, 12, 29, 31, 6, 11, 27, 8, 10, 7, 21, 18, 14, 29, 28, 26, 1, 17, 20, 6, 23, 22, 5, 12, 19, 16, 3, 2, 25, 9, 30, 31, 15, 13, 24, 0, 4, 4, 11, 20, 8, 15, 6, 13, 29, 23, 0, 18, 17, 24, 14, 25, 7, 9, 28, 16, 1, 31, 30, 21, 3, 12, 10, 22, 26, 2, 5, 19, 27, 22, 31, 13, 10, 16, 19, 14, 9, 15, 27, 3, 20, 21, 4, 12, 11, 6, 5, 2, 28, 29, 24, 25, 23, 17, 26, 1, 30, 18, 7, 0, 8, 27, 1, 23, 22, 15, 7, 30, 4, 8, 24, 19, 25, 5, 12, 0, 21, 18, 29, 28, 9, 13, 31, 11, 2, 16, 6, 17, 3, 20, 14, 10, 26, 27, 7, 26, 23, 29, 16, 6, 8, 18, 0, 12, 15, 14, 22, 31, 25, 24, 5, 10, 11, 21, 20, 28, 19, 13, 4, 1, 9, 17, 3, 30, 2, 0, 25, 3, 21, 11, 5, 6, 19, 9, 23, 29, 18, 13, 12, 24, 28, 17, 8, 20, 30, 1, 2, 4, 15, 16, 7, 22, 14, 31, 27, 10, 26, 21, 4, 17, 28, 6, 23, 11, 18, 19, 12, 14, 3, 29, 26, 22, 0, 2, 15, 24, 10, 1, 5, 31, 13, 7, 20, 8, 25, 9, 16, 30, 27};
}
#ifndef PROBE_ABL
#define PROBE_ABL 0
#endif
__device__ __forceinline__ void p3_attention(Frame& F, const int MODE) {
    const int G = F.G, c = F.vcu; const bool xl = (G == 256); const int nrounds = xl ? 16 : (at::NUNITS + G - 1) / G;
    const gu32* KT0 = (const gu32*)wsp<unsigned>(F, WS_KT0);
    const int xq = c >> 5, kq = c & 31;
#define P3_DESC(i, ty_, ix_, pa_) do { if (xl) { const int r_ = (i) & 7; if ((i) < 8) { ty_ = 1; ix_ = 8 * xq + r_; pa_ = (int)at::NSJ[r_ * 32 + kq]; } else if ((i) < 16) { ty_ = 0; ix_ = 32 * xq + 4 * r_ + (kq >> 3); pa_ = (kq + r_) & 7; } else { ty_ = -1; ix_ = 0; pa_ = 0; } } \
        else { const int u_ = (i) * G + (((i) & 1) ? G - 1 - c : c); if ((i) < nrounds && u_ < at::NUNITS) { const unsigned tb_ = at::BLK_TAB[u_ >> 6]; ty_ = (int)(tb_ >> 15); ix_ = u_ - (int)(tb_ & 1023u) * 64; pa_ = (int)((tb_ >> 10) & 31u); } else { ty_ = -1; ix_ = 0; pa_ = 0; } } } while (0)
    unsigned kt_next = 0u;
    { int ty, ix, pa; P3_DESC(0, ty, ix, pa); if (ty == 0) kt_next = __hip_atomic_load(KT0 + ix * 8 + pa, RLX_AGENT); }
    for (int i = 0; i < nrounds; ++i) {
        int ty, ix, pa; P3_DESC(i, ty, ix, pa); if (ty < 0) continue;
        const int kt0 = __builtin_amdgcn_readfirstlane((int)kt_next);
        { int ty2, ix2, pa2; P3_DESC(i + 1, ty2, ix2, pa2); if (ty2 == 0) kt_next = __hip_atomic_load(KT0 + ix2 * 8 + pa2, RLX_AGENT); }
        if (ty) { if (MODE != 1 && MODE != 5) at::nsa_unit(F, ix, pa, MODE == 2 ? PROBE_ABL : 0); } else { if (MODE != 2 && MODE != 5) at::fox_unit(F, ix, pa, kt0, MODE == 1 ? PROBE_ABL : 0); }
    }
#undef P3_DESC
    if (AT_PRIO_MODE != 0) __builtin_amdgcn_s_setprio(0);
    asm volatile("s_waitcnt vmcnt(0) lgkmcnt(0)" ::: "memory");
    __syncthreads();
}

struct Args { const float* in[18]; float* out; unsigned char* ws; int ph_lo, ph_hi, li, pad; };
__global__ void __launch_bounds__(NWAVES * 64, 2) fwd_kernel(Args args) {
    extern __shared__ __attribute__((aligned(16))) unsigned char lds[];
    Frame F;
    F.lds = (LAS unsigned char*)lds;
    F.MISC = (volatile LAS unsigned*)(F.lds + MISC_OFF);
    F.wave = __builtin_amdgcn_readfirstlane((int)threadIdx.x >> 6);
    F.G = gridDim.x; { const int bx = blockIdx.x; F.vcu = (F.G % 8 == 0) ? (bx % 8) * (F.G / 8) + bx / 8 : bx; }
    F.ws = args.ws; F.ctl = (gu32*)(args.ws + WS_CTL);
    F.x = args.in[0]; F.g_mix_pre = args.in[1]; F.g_mix_post = args.in[2]; F.g_mlp_pre = args.in[3]; F.g_mlp_post = args.in[4]; F.w_in = args.in[5]; F.b_forget = args.in[6];
    F.pos_k = args.in[7]; F.w1_k = args.in[8]; F.w2_k = args.in[9]; F.pos_v = args.in[10]; F.w1_v = args.in[11]; F.w2_v = args.in[12];
    F.w_fox = args.in[13]; F.w_nsa = args.in[14]; F.w_o = args.in[15]; F.w_up = args.in[16]; F.w_down = args.in[17]; F.out = args.out;
    for (int u = (int)threadIdx.x; u < (LDS_BYTES - LDSCTL_OFF) / 4; u += NWAVES * 64) ((LAS unsigned*)(F.lds + LDSCTL_OFF))[u] = 0u;
    __syncthreads();
    XcdBarrier bar; bar.bar = (unsigned*)(F.ctl + CW_BAR); bar.x = 0; bar.st = nullptr;
    if (N_LAUNCHES == 1) bar = xcd_barrier_post((unsigned*)(F.ctl + CW_BAR), F.MISC + 8);
#define GRID_BAR() do { if (N_LAUNCHES == 1) xcd_barrier(bar); } while (0)
    const int lo = args.ph_lo, hi = args.ph_hi;
#define IN(k) (lo <= (k) && (k) < hi)
#define BOTH(k) (IN(k) && IN((k) + 1))
#ifndef STAGGER_P7
#define STAGGER_P7 0
#endif
#ifndef STAGGER_P1
#define STAGGER_P1 0
#endif
#define XCD_STAGGER(ticks) do { if ((ticks) > 0) { const unsigned long long t0_ = rt(); const unsigned long long d_ = (unsigned long long)(xb_xcc_id() & 7u) * (unsigned)(ticks) / 8u; while (rt() - t0_ < d_) __builtin_amdgcn_s_sleep(8); } } while (0)
#ifndef PROBE_REPEAT
#define PROBE_REPEAT (-1)
#endif
#define REPS(k) for (int rep_ = 0; rep_ < ((PROBE_REPEAT == (k)) ? 2 : 1); ++rep_)
#define REP_BAR(k) do { if (PROBE_REPEAT == (k) && rep_ == 0) { VM_WAIT(); __syncthreads(); GRID_BAR(); } } while (0)

    if (IN(0)) { REPS(0) { p0_prologue(F); REP_BAR(0); } if (BOTH(0)) GRID_BAR(); }

    if (IN(1)) { XCD_STAGGER(STAGGER_P1);
        pg8::Gemm g{wsp<bf16>(F, WS_HB), wsp<bf16>(F, WS_WIN), MTOK, NPROJ, DMODEL}; pg8::StaticOrder S; S.init(MTOK, NPROJ, F.G, (int)blockIdx.x);
        pg8::EpiInProj E{wsp<bf16>(F, WS_FQ), wsp<bf16>(F, WS_NQ), wsp<bf16>(F, WS_KV), wsp<bf16>(F, WS_SGA),
                         wsp<float>(F, WS_LF), wsp<float>(F, WS_GATE), F.b_forget, wsp<float>(F, WS_ROPEC), wsp<float>(F, WS_ROPES), (WS_FK - WS_FQ) / 2, KV_STRIDE / 2, (WS_SGB - WS_SGA) / 2, QSCALE};
        REPS(1) { pg8::gemm_phase<pg8::EpiInProj, pg8::StaticOrder, true, true>(F.lds + RING_OFF, g, S, E, F.wave); REP_BAR(1); }
        if (BOTH(1)) GRID_BAR();
    }
    if (IN(2)) { REPS(2) { p2_phase(F); REP_BAR(2); } if (BOTH(2)) GRID_BAR(); }
#ifndef PROBE_P3_MODE
#define PROBE_P3_MODE 3
#endif
    if (IN(3)) {
#if PROBE_REPEAT == 3
        for (int rep_ = 0; rep_ < 2; ++rep_) { p3_attention(F, rep_ ? PROBE_P3_MODE : 0); if (rep_ == 0) { VM_WAIT(); __syncthreads(); GRID_BAR(); } }
#else
        p3_attention(F, 0);
#endif
        if (BOTH(3)) GRID_BAR(); }
    if (IN(4)) { REPS(4) {
        pg8::Gemm g{wsp<bf16>(F, WS_ATT), wsp<bf16>(F, WS_WF), MTOK, DMODEL, DMODEL}; pg8::StaticOrder S; S.init(MTOK, DMODEL, F.G, (int)blockIdx.x);
        pg8::EpiGateMid E{wsp<bf16>(F, WS_HB), wsp<bf16>(F, WS_SGA), wsp<bf16>(F, WS_SGB), DMODEL};
        pg8::gemm_phase<pg8::EpiGateMid, pg8::StaticOrder, true, true>(F.lds + RING_OFF, g, S, E, F.wave);
        REP_BAR(4); }
        if (BOTH(4)) GRID_BAR();
    }
    if (IN(5)) {
        pg8::Gemm g{wsp<bf16>(F, WS_HB), wsp<bf16>(F, WS_WO), MTOK, DMODEL, DMODEL}; pg8::StaticOrder S; S.init(MTOK, DMODEL, F.G, (int)blockIdx.x);
        pg8::EpiPlain<0> E{wsp<bf16>(F, WS_Y), DMODEL};
        REPS(5) { pg8::gemm_phase<pg8::EpiPlain<0>, pg8::StaticOrder, true, true>(F.lds + RING_OFF, g, S, E, F.wave); REP_BAR(5); }
        if (BOTH(5)) GRID_BAR();
    }
    if (IN(6)) { REPS(6) { row_pass<false>(F, F.x, nullptr, wsp<bf16>(F, WS_Y), F.g_mix_post, nullptr, wsp<bf16>(F, WS_HB), wsp<float>(F, WS_RSTD2)); REP_BAR(6); } if (BOTH(6)) GRID_BAR(); }
#ifndef MLP_CHUNKS
#define MLP_CHUNKS 1
#endif
    if (IN(7) || IN(8)) {
        constexpr int CH = MLP_CHUNKS, MC = MTOK / CH;
#pragma unroll
        for (int ch = 0; ch < CH; ++ch) {
            if (IN(7)) { XCD_STAGGER(STAGGER_P7);
                pg8::Gemm g{wsp<bf16>(F, WS_HB) + (size_t)ch * MC * DMODEL, wsp<bf16>(F, WS_WUP), MC, DFF, DMODEL}; pg8::StaticOrder S; S.init(MC, DFF, F.G, (int)blockIdx.x);
                pg8::EpiRelu2F8 E{wsp<unsigned char>(F, WS_U) + (size_t)ch * MC * DFF, DFF};
                REPS(7) { pg8::gemm_phase<pg8::EpiRelu2F8, pg8::StaticOrder, true, true>(F.lds + RING_OFF, g, S, E, F.wave); REP_BAR(7); }
                if (IN(8)) GRID_BAR(); }
            if (IN(8)) {
                pg8::Gemm g{(const pg8::bf16_t*)(wsp<unsigned char>(F, WS_U) + (size_t)ch * MC * DFF), (const pg8::bf16_t*)wsp<unsigned char>(F, WS_WDN), MC, DMODEL, DFF / 2}; pg8::StaticOrder S; S.init(MC, DMODEL, F.G, (int)blockIdx.x);
                pg8::EpiScaled E{wsp<bf16>(F, WS_Y) + (size_t)ch * MC * DMODEL, DMODEL, 1.f / WDN_SCALE};
                REPS(8) { pg8::gemm_phase<pg8::EpiScaled, pg8::StaticOrder, true, true, true>(F.lds + RING_OFF, g, S, E, F.wave); REP_BAR(8); }
                if (ch + 1 == CH && BOTH(8)) GRID_BAR(); }
        }
    }
    if (IN(9)) { row_pass<true>(F, nullptr, wsp<bf16>(F, WS_HB), wsp<bf16>(F, WS_Y), F.g_mlp_post, F.out, nullptr, wsp<float>(F, WS_RSTD2)); }
#undef IN
#undef BOTH
#undef GRID_BAR
}

extern "C" void kernel_launch(void* const* d_in, const int* in_sizes, int n_in, void* d_out, int out_size, void* d_ws, size_t ws_size, hipStream_t stream) {
    static int grid = 0;
    if (grid == 0) {
        if (n_in != 18 || in_sizes[0] != MTOK * DMODEL || out_size != MTOK * DMODEL || ws_size < WS_END) {
            fprintf(stderr, "kernel_launch: built for 18 inputs, x/out of %d floats, >= %zu bytes of workspace; got n_in %d, in0 %d, out %d, ws %zu; nothing launched\n", MTOK * DMODEL, (size_t)WS_END, n_in, n_in > 0 ? in_sizes[0] : -1, out_size, ws_size); grid = -1; return; }
        int dev = 0, cus = 0, per_cu = 0;
        if (hipGetDevice(&dev) != hipSuccess || hipDeviceGetAttribute(&cus, hipDeviceAttributeMultiprocessorCount, dev) != hipSuccess) { fprintf(stderr, "kernel_launch: device query failed\n"); grid = -1; return; }
        if (hipFuncSetAttribute((const void*)fwd_kernel, hipFuncAttributeMaxDynamicSharedMemorySize, LDS_BYTES) != hipSuccess) { fprintf(stderr, "kernel_launch: hipFuncSetAttribute failed\n"); grid = -1; return; }
        if (hipOccupancyMaxActiveBlocksPerMultiprocessor(&per_cu, (const void*)fwd_kernel, NWAVES * 64, LDS_BYTES) != hipSuccess || per_cu < 1)
            fprintf(stderr, "kernel_launch: note: occupancy query reports %d workgroups per CU\n", per_cu);
        (void)hipGetLastError();
        grid = 256;
        if (cus < grid) fprintf(stderr, "kernel_launch: this device reports %d CUs; the 256-workgroup grid cannot be resident: the grid barrier will time out (bounded) and the output will be wrong\n", cus);
    }
    if (grid < 0) return;
    if (hipMemsetAsync((char*)d_ws + WS_CTL, 0, CTL_ZERO_BYTES, stream) != hipSuccess) { fprintf(stderr, "kernel_launch: hipMemsetAsync failed\n"); return; }
    Args a{};
    for (int i = 0; i < 18; ++i) a.in[i] = (const float*)d_in[i];
    a.out = (float*)d_out; a.ws = (unsigned char*)d_ws;
    for (int li = 0; li < N_LAUNCHES; ++li) {
        a.ph_lo = (N_LAUNCHES == 1) ? 0 : li; a.ph_hi = (N_LAUNCHES == 1) ? N_PHASES : li + 1; a.li = li; a.pad = 0;
        hipLaunchKernelGGL(fwd_kernel, dim3(grid), dim3(NWAVES * 64), LDS_BYTES, stream, a);
        const hipError_t le = hipPeekAtLastError();
        if (le != hipSuccess) { fprintf(stderr, "kernel_launch: launch %d failed: %s\n", li, hipGetErrorName(le)); break; }
    }
}
```

```cpp
#include <hip/hip_runtime.h>
#include <cstdio>
#include <cstdint>
#include <cmath>
namespace pg8 {
#define PG8_LAS __attribute__((address_space(3)))
typedef unsigned short bf16_t;
typedef short bf16x8 __attribute__((ext_vector_type(8)));
typedef float f32x4 __attribute__((ext_vector_type(4)));
typedef unsigned u32x4 __attribute__((ext_vector_type(4)));
constexpr int BM = 256, BK = 64, HALF = 128, HTB = HALF * BK * 2  , STAGE_BYTES = 8 * HTB, NXCD = 8, WGM = 8;

__host__ __device__ __forceinline__ int lds_byte(int r, int c) { const int st = (r >> 4) * 2 + (c >> 5), rr = r & 15, cc = c & 31, ob = rr * 64 + cc * 2; return st * 1024 + (ob ^ (((ob >> 9) & 1) << 5)); }
__host__ __device__ __forceinline__ void stage_rc(int b, int& R, int& C) { const int st = b / 1024, sb = b % 1024, swz = sb ^ (((sb >> 9) & 1) << 5); R = (st >> 1) * 16 + swz / 64; C = (st & 1) * 32 + (swz % 64) / 2; }
__host__ __device__ __forceinline__ int perm32(int rho) { const int n = rho >> 4, i = rho & 15; return 8 * (i >> 2) + 4 * n + (i & 3); }

__host__ __device__ __forceinline__ int perm16(int R) { const int w = R >> 5, n = (R >> 4) & 1, i = R & 15; return 64 * w + 16 * (i >> 2) + 4 * n + (i & 3); }
struct Unit { int pm, pn; };
struct Gemm { const bf16_t* A; const bf16_t* Bt; int M, N, K; };

struct StaticOrder {
    int nM, nN, nwg, G, c, rot = 0;
    __host__ __device__ void init(int M, int N, int G_, int c_, int rot_ = 0) { nM = M / BM; nN = N / BM; nwg = nM * nN; G = G_; c = c_; rot = rot_; }
    __host__ __device__ bool next(int i, Unit& u) const {
        const long L = (long)i * G + c; if (L >= nwg) return false;
        int wgid = (int)L; { const int q = nwg / NXCD, r = nwg % NXCD, xcd = wgid % NXCD, off = wgid / NXCD; wgid = (xcd < r ? xcd * (q + 1) : r * (q + 1) + (xcd - r) * q) + off; }
        const int nig = WGM * nN, gid = wgid / nig, fm = gid * WGM, gsz = (nM - fm) < WGM ? (nM - fm) : WGM;
        u.pm = fm + ((wgid % nig) % gsz); u.pn = (wgid % nig) / gsz; if (rot >= 100) { const int r5 = ((u.pn >> 2) + (rot - 100)) % 5; u.pn = 5 * (u.pn & 3) + r5; }     \
        else if (rot) { u.pn += rot; if (u.pn >= nN) u.pn -= nN; } return true;
    }
    __device__ __forceinline__ void a_ready(const Unit&) const {}
    __device__ __forceinline__ void done(const Unit&) const {}
};

__device__ __forceinline__ unsigned cvt_pk_bf16(float lo, float hi) { unsigned r; asm volatile("v_cvt_pk_bf16_f32 %0, %1, %2" : "=v"(r) : "v"(lo), "v"(hi)); return r; }
typedef float f32x2 __attribute__((ext_vector_type(2)));
typedef int i32x8 __attribute__((ext_vector_type(8)));
typedef int i32x4 __attribute__((ext_vector_type(4)));
__device__ __forceinline__ i32x8 cat8(const bf16x8& a, const bf16x8& b) { const i32x4 x = __builtin_bit_cast(i32x4, a), y = __builtin_bit_cast(i32x4, b); return __builtin_shufflevector(x, y, 0, 1, 2, 3, 4, 5, 6, 7); }
constexpr float F8_MAX = 448.f;
__device__ __forceinline__ unsigned cvt4_fp8(float a, float b, float c, float d) {
    int r = 0; r = __builtin_amdgcn_cvt_pk_fp8_f32(fminf(a, F8_MAX), fminf(b, F8_MAX), r, false); r = __builtin_amdgcn_cvt_pk_fp8_f32(fminf(c, F8_MAX), fminf(d, F8_MAX), r, true); return (unsigned)r; }
__device__ __forceinline__ void mfma_f8_inplace(f32x4& c, const i32x8 a, const i32x8 b) { asm volatile("v_mfma_f32_16x16x128_f8f6f4 %0, %1, %2, %0" : "+v"(c) : "v"(a), "v"(b)); }
__device__ __forceinline__ float sum_quads(float x) {
    const unsigned xu = __builtin_bit_cast(unsigned, x); auto a = __builtin_amdgcn_permlane32_swap(xu, xu, false, false);
    const float y = __builtin_bit_cast(float, (unsigned)a[0]) + __builtin_bit_cast(float, (unsigned)a[1]);
    const unsigned yu = __builtin_bit_cast(unsigned, y); auto b = __builtin_amdgcn_permlane16_swap(yu, yu, false, false);
    return __builtin_bit_cast(float, (unsigned)b[0]) + __builtin_bit_cast(float, (unsigned)b[1]); }
__device__ __forceinline__ float bf_lo(unsigned w) { return __uint_as_float(w << 16); }
__device__ __forceinline__ float bf_hi(unsigned w) { return __uint_as_float(w & 0xffff0000u); }
__device__ __forceinline__ float sigmoid_f(float x) { return __builtin_amdgcn_rcpf(1.0f + __expf(-x)); }
typedef unsigned u32x2 __attribute__((ext_vector_type(2)));
__device__ __forceinline__ u32x4 pack8(const f32x4& a, const f32x4& b) { u32x4 w; w.x = cvt_pk_bf16(a[0], a[1]); w.y = cvt_pk_bf16(a[2], a[3]); w.z = cvt_pk_bf16(b[0], b[1]); w.w = cvt_pk_bf16(b[2], b[3]); return w; }
__device__ __forceinline__ u32x2 pack4(const f32x4& a) { u32x2 w; w.x = cvt_pk_bf16(a[0], a[1]); w.y = cvt_pk_bf16(a[2], a[3]); return w; }

struct EpiInProj {
    static constexpr bool PERM = true, PERM16 = false, AFTER_DRAIN = false, MIDK = false;
    bf16_t *QKV, *NQ, *KVB, *SG;
    int abl; float *LF, *GATE, *NRM; const float* bforget; const float *ROPEC, *ROPES; size_t qkvs, qgs, kvs, sgs; float qscale;
    __device__ __forceinline__ void operator()(const f32x4 (&acc)[2][2][4][2], const Unit& u, int wr, int wc, int fr, int fq) const {
        const int pn = u.pn; const bool roped = pn >= 6 && pn < 11; const int i4 = (4 * (wc & 1) + fq) * 4;
        if (abl == 1) return; if (abl == 2 && pn >= 11 && pn < 19) return; if (abl == 3 && pn < 11) return; if (abl == 4 && pn >= 6 && pn < 11) return;
#pragma unroll
        for (int ai = 0; ai < 2; ++ai) {
#pragma unroll
          for (int mp = 0; mp < 2; ++mp) {
            f32x4 csv[8];
            if (roped) {
#pragma unroll
                for (int mm = 0; mm < 2; ++mm) { const int t_ = (u.pm * BM + ai * HALF + wr * 64 + (2 * mp + mm) * 16 + fr) & 2047; csv[mm] = *(const f32x4*)(ROPEC + t_ * 32 + i4); csv[4 + mm] = *(const f32x4*)(ROPES + t_ * 32 + i4); }
                asm volatile("" : "+v"(csv[0]), "+v"(csv[1]), "+v"(csv[4]), "+v"(csv[5])); }
#pragma unroll
            for (int mm = 0; mm < 2; ++mm) { const int m = 2 * mp + mm;
                const int row = u.pm * BM + ai * HALF + wr * 64 + m * 16 + fr; const int t = row & 2047, b = row >> 11; (void)t;
#pragma unroll
                for (int bj = 0; bj < 2; ++bj) {
                    const int tc = bj * HALF + wc * 32 + 8 * fq;
                    f32x4 v0 = acc[ai][bj][m][0], v1 = acc[ai][bj][m][1];
                    if (pn < 6) {
                        bf16_t* base = QKV + (size_t)(row >> 13) * qgs + (size_t)(pn >> 1) * qkvs; const float sc = pn < 2 ? qscale : 1.0f;
                        v0 = v0 * sc; v1 = v1 * sc;
                        *(u32x4*)(base + (size_t)(row & 8191) * 512 + (pn & 1) * 256 + tc) = pack8(v0, v1);
                        if (pn < 4) {
                            float ss = ((v0[0] * v0[0] + v0[1] * v0[1]) + (v0[2] * v0[2] + v0[3] * v0[3])) + ((v1[0] * v1[0] + v1[1] * v1[1]) + (v1[2] * v1[2] + v1[3] * v1[3]));
                            ss = sum_quads(ss);
                            if (fq == 0) NRM[(size_t)(((pn >> 1) * 8 + (pn & 1) * 4 + 2 * bj + (wc >> 1)) * 2 + (wc & 1)) * 65536 + row] = ss; }
                    } else if (pn < 8) {
                        const int head = (pn - 6) * 4 + (tc >> 6);
                        const f32x4 cs = csv[mm], sn = csv[4 + mm];
                        const f32x4 lo = (v0 * cs - v1 * sn) * qscale, hi = (v1 * cs + v0 * sn) * qscale;
                        bf16_t* d = NQ + (size_t)(row >> 13) * qgs + (size_t)(row & 8191) * 512 + head * 64 + i4;
                        *(u32x2*)d = pack4(lo); *(u32x2*)(d + 32) = pack4(hi);
                    } else if (pn < 11) {
                        const int sel = pn - 8;
                        if (bj == 0) {
                            const int g = tc >> 6;
                            const f32x4 cs = csv[mm], sn = csv[4 + mm];
                            const f32x4 lo = v0 * cs - v1 * sn, hi = v1 * cs + v0 * sn;
                            bf16_t* d = KVB + (size_t)(2 * sel) * kvs + ((size_t)((b * 2 + g) * 2048 + t)) * 64 + i4;
                            *(u32x2*)d = pack4(lo); *(u32x2*)(d + 32) = pack4(hi);
                        } else {
                            const int tv = tc - HALF, g = tv >> 6, dd = tv & 63;
                            bf16_t* d = KVB + (size_t)(2 * sel + 1) * kvs + ((size_t)((b * 2 + g) * 2048 + t)) * 64 + dd;
                            *(u32x4*)d = pack8(v0, v1);
                        }
                    } else if (pn < 19) {
                        if (bj == 0) { const int ct = (pn - 11) * 128 + wc * 32 + 8 * fq; const f32x4 w0 = acc[ai][1][m][0], w1 = acc[ai][1][m][1];
                            unsigned qa[8], qb[8];
#pragma unroll
                            for (int k = 0; k < 4; ++k) { const float ea = __expf(-v0[k]), ec = __expf(-v1[k]), fa = __expf(-w0[k]), fc = __expf(-w1[k]);
                                qa[k] = (unsigned)fminf(256.0f * __builtin_amdgcn_rcpf(1.0f + ea), 255.0f); qa[4 + k] = (unsigned)fminf(256.0f * __builtin_amdgcn_rcpf(1.0f + ec), 255.0f);
                                qb[k] = (unsigned)fminf(256.0f * __builtin_amdgcn_rcpf(1.0f + fa), 255.0f); qb[4 + k] = (unsigned)fminf(256.0f * __builtin_amdgcn_rcpf(1.0f + fc), 255.0f); }
                            u32x4 o; o.x = qa[0] | (qa[1] << 8) | (qa[2] << 16) | (qa[3] << 24); o.y = qa[4] | (qa[5] << 8) | (qa[6] << 16) | (qa[7] << 24);
                            o.z = qb[0] | (qb[1] << 8) | (qb[2] << 16) | (qb[3] << 24); o.w = qb[4] | (qb[5] << 8) | (qb[6] << 16) | (qb[7] << 24);
                            __builtin_nontemporal_store(o, (u32x4*)((unsigned char*)SG + (size_t)row * 2048 + (ct >> 3) * 16)); }
                    } else {
                        if (bj == 0 && wc == 0) {
                            if (fq == 0) {
                                f32x4 a, c;
#pragma unroll
                                for (int k = 0; k < 4; ++k) { const float x0 = v0[k] + bforget[k], x1 = v1[k] + bforget[4 + k];
                                    a[k] = fminf(x0, 0.f) - log1pf(__expf(-fabsf(x0))); c[k] = fminf(x1, 0.f) - log1pf(__expf(-fabsf(x1))); }
                                *(f32x4*)(LF + (size_t)row * 8) = a; *(f32x4*)(LF + (size_t)row * 8 + 4) = c;
                            } else {
                                f32x4 a, c;
#pragma unroll
                                for (int k = 0; k < 4; ++k) { a[k] = sigmoid_f(v0[k]); c[k] = sigmoid_f(v1[k]); }
                                *(f32x4*)(GATE + (size_t)row * 24 + 8 * (fq - 1)) = a; *(f32x4*)(GATE + (size_t)row * 24 + 8 * (fq - 1) + 4) = c;
                            }
                        }
                    }
                }
            }
          }
        }
    }
};
#define PIN8(a) asm volatile("" : "+v"(a[0]), "+v"(a[1]), "+v"(a[2]), "+v"(a[3]), "+v"(a[4]), "+v"(a[5]), "+v"(a[6]), "+v"(a[7]))
struct EpiGate {
    static constexpr bool PERM = true, PERM16 = false, AFTER_DRAIN = false, MIDK = false;
    bf16_t* O; const bf16_t* gate; const bf16_t* addend; int ldc;
    __device__ __forceinline__ void operator()(const f32x4 (&acc)[2][2][4][2], const Unit& u, int wr, int wc, int fr, int fq) const {
#pragma unroll
        for (int ai = 0; ai < 2; ++ai) {
            const size_t base = (size_t)(u.pm * BM + ai * HALF + wr * 64 + fr) * ldc + u.pn * BM + wc * 32 + 8 * fq;
            u32x4 gw[8], aw[8];
#pragma unroll
            for (int k = 0; k < 8; ++k) gw[k] = *(const u32x4*)(gate + base + (size_t)((k >> 1) * 16) * ldc + (k & 1) * HALF);
            PIN8(gw);
            if (addend) {
#pragma unroll
                for (int k = 0; k < 8; ++k) aw[k] = *(const u32x4*)(addend + base + (size_t)((k >> 1) * 16) * ldc + (k & 1) * HALF);
                PIN8(aw); }
#pragma unroll
            for (int k = 0; k < 8; ++k) { const int m = k >> 1, bj = k & 1; const u32x4 g = gw[k];
                f32x4 v0 = acc[ai][bj][m][0], v1 = acc[ai][bj][m][1];
                v0[0] *= bf_lo(g.x); v0[1] *= bf_hi(g.x); v0[2] *= bf_lo(g.y); v0[3] *= bf_hi(g.y);
                v1[0] *= bf_lo(g.z); v1[1] *= bf_hi(g.z); v1[2] *= bf_lo(g.w); v1[3] *= bf_hi(g.w);
                if (addend) { const u32x4 a = aw[k];
                    v0[0] += bf_lo(a.x); v0[1] += bf_hi(a.x); v0[2] += bf_lo(a.y); v0[3] += bf_hi(a.y);
                    v1[0] += bf_lo(a.z); v1[1] += bf_hi(a.z); v1[2] += bf_lo(a.w); v1[3] += bf_hi(a.w); }
                *(u32x4*)(O + base + (size_t)(m * 16) * ldc + bj * HALF) = pack8(v0, v1); }
        }
    }
};
struct EpiGates8 {
    static constexpr bool PERM = true, PERM16 = false, AFTER_DRAIN = false, MIDK = false;
    unsigned char* SG; float inv;
    __device__ __forceinline__ void operator()(const f32x4 (&acc)[2][2][4][2], const Unit& u, int wr, int wc, int fr, int fq) const {
#pragma unroll
        for (int ai = 0; ai < 2; ++ai)
#pragma unroll
            for (int m = 0; m < 4; ++m) { const size_t row = (size_t)(u.pm * BM + ai * HALF + wr * 64 + m * 16 + fr); const int ct = u.pn * 128 + wc * 32 + 8 * fq;
                const f32x4 v0 = acc[ai][0][m][0], v1 = acc[ai][0][m][1], w0 = acc[ai][1][m][0], w1 = acc[ai][1][m][1];
                const float c2 = -1.4426950408889634f * inv;
                u32x4 o = {0u, 0u, 0u, 0u};
#pragma unroll
                for (int k = 0; k < 4; ++k) { const float ea = __builtin_amdgcn_exp2f(v0[k] * c2), ec = __builtin_amdgcn_exp2f(v1[k] * c2), fa = __builtin_amdgcn_exp2f(w0[k] * c2), fc = __builtin_amdgcn_exp2f(w1[k] * c2);
                    o.x = __builtin_amdgcn_cvt_pk_u8_f32(fmaf(256.0f, __builtin_amdgcn_rcpf(1.0f + ea), -0.25f), k, o.x); o.y = __builtin_amdgcn_cvt_pk_u8_f32(fmaf(256.0f, __builtin_amdgcn_rcpf(1.0f + ec), -0.25f), k, o.y);
                    o.z = __builtin_amdgcn_cvt_pk_u8_f32(fmaf(256.0f, __builtin_amdgcn_rcpf(1.0f + fa), -0.25f), k, o.z); o.w = __builtin_amdgcn_cvt_pk_u8_f32(fmaf(256.0f, __builtin_amdgcn_rcpf(1.0f + fc), -0.25f), k, o.w); }
                __builtin_nontemporal_store(o, (u32x4*)(SG + row * 2048 + (ct >> 3) * 16)); }
    }
};
struct EpiGateMid {
    static constexpr bool PERM = true, PERM16 = false, AFTER_DRAIN = false, MIDK = true; static constexpr int NST = 0;
    bf16_t* O; const unsigned char* sg8; int ldc;
    __device__ __forceinline__ static float ub(unsigned w, int k) { return (float)((w >> (8 * k)) & 255u) + 0.5f; }
    template <bool FINAL>
    __device__ __forceinline__ void scale(f32x4 (&acc)[2][2][4][2], const Unit& u, int wr, int wc, int fr, int fq) const {
#pragma unroll
        for (int ai = 0; ai < 2; ++ai) {
            const size_t row0 = (size_t)(u.pm * BM + ai * HALF + wr * 64 + fr); const int cb0 = u.pn * 32 + wc * 4 + fq;
            u32x4 gw[8];
#pragma unroll
            for (int k = 0; k < 8; ++k) gw[k] = *(const u32x4*)(sg8 + (row0 + (size_t)((k >> 1) * 16)) * 2048 + (size_t)(cb0 + (k & 1) * 16) * 16);
            PIN8(gw);
#pragma unroll
            for (int k = 0; k < 8; ++k) { const int m = k >> 1, bj = k & 1; const u32x4 w = gw[k];
                f32x4& v0 = acc[ai][bj][m][0]; f32x4& v1 = acc[ai][bj][m][1];
#pragma unroll
                for (int j = 0; j < 4; ++j) {
                    if (FINAL) { v0[j] *= ub(w.x, j) * (1.0f / 256.0f); v1[j] *= ub(w.y, j) * (1.0f / 256.0f); }
                    else { v0[j] *= ub(w.z, j) * __builtin_amdgcn_rcpf(ub(w.x, j)); v1[j] *= ub(w.w, j) * __builtin_amdgcn_rcpf(ub(w.y, j)); } }
                if (FINAL) *(u32x4*)(O + (row0 + (size_t)(m * 16)) * ldc + u.pn * BM + bj * HALF + wc * 32 + 8 * fq) = pack8(v0, v1); }
        }
    }
    __device__ __forceinline__ void mid(f32x4 (&acc)[2][2][4][2], const Unit& u, int wr, int wc, int fr, int fq) const { int fr_ = fr; asm volatile("" : "+v"(fr_));
        scale<false>(acc, u, wr, wc, fr_, fq); }
    __device__ __forceinline__ void operator()(f32x4 (&acc)[2][2][4][2], const Unit& u, int wr, int wc, int fr, int fq) const { scale<true>(acc, u, wr, wc, fr, fq); }
};
template <int ACT> struct EpiPlain {
    static constexpr bool PERM = true, PERM16 = false, AFTER_DRAIN = false, MIDK = false;
    bf16_t* O; int ldc;
    __device__ __forceinline__ void operator()(const f32x4 (&acc)[2][2][4][2], const Unit& u, int wr, int wc, int fr, int fq) const {
#pragma unroll
        for (int ai = 0; ai < 2; ++ai)
#pragma unroll
            for (int m = 0; m < 4; ++m) {
                const size_t rowo = (size_t)(u.pm * BM + ai * HALF + wr * 64 + m * 16 + fr) * ldc + u.pn * BM + wc * 32 + 8 * fq;
#pragma unroll
                for (int bj = 0; bj < 2; ++bj) {
                    f32x4 v0 = acc[ai][bj][m][0], v1 = acc[ai][bj][m][1];
                    if (ACT == 1) {
#pragma unroll
                        for (int k = 0; k < 4; ++k) { const float a = fmaxf(v0[k], 0.f), c = fmaxf(v1[k], 0.f); v0[k] = a * a; v1[k] = c * c; }
                    }
                    *(u32x4*)(O + rowo + bj * HALF) = pack8(v0, v1);
                }
            }
    }
};

struct EpiRelu2Rs {
    static constexpr bool PERM = true, PERM16 = false, AFTER_DRAIN = false, MIDK = false;
    bf16_t* O; const float* rs; int ldc;
    __device__ __forceinline__ void operator()(const f32x4 (&acc)[2][2][4][2], const Unit& u, int wr, int wc, int fr, int fq) const {
        float rv[8];
#pragma unroll
        for (int k = 0; k < 8; ++k) rv[k] = rs[u.pm * BM + (k >> 2) * HALF + wr * 64 + (k & 3) * 16 + fr];
        PIN8(rv);
#pragma unroll
        for (int ai = 0; ai < 2; ++ai)
#pragma unroll
            for (int m = 0; m < 4; ++m) { const float r = rv[ai * 4 + m];
                const size_t rowo = (size_t)(u.pm * BM + ai * HALF + wr * 64 + m * 16 + fr) * ldc + u.pn * BM + wc * 32 + 8 * fq;
#pragma unroll
                for (int bj = 0; bj < 2; ++bj) { f32x4 v0 = acc[ai][bj][m][0], v1 = acc[ai][bj][m][1];
#pragma unroll
                    for (int k = 0; k < 4; ++k) { const float a = fmaxf(v0[k] * r, 0.f), c = fmaxf(v1[k] * r, 0.f); v0[k] = a * a; v1[k] = c * c; }
                    __builtin_nontemporal_store(pack8(v0, v1), (u32x4*)(O + rowo + bj * HALF)); } }
    }
};

struct EpiRelu2F8 {
    static constexpr bool PERM = true, PERM16 = true, AFTER_DRAIN = false, MIDK = false;
    unsigned char* O; int ldc;
    __device__ __forceinline__ void operator()(const f32x4 (&acc)[2][2][4][2], const Unit& u, int wr, int wc, int fr, int fq) const {
#pragma unroll
        for (int ai = 0; ai < 2; ++ai)
#pragma unroll
            for (int m = 0; m < 4; ++m) {
                const size_t rowo = (size_t)(u.pm * BM + ai * HALF + wr * 64 + m * 16 + fr) * ldc + u.pn * BM + wc * 64 + 16 * fq;
                u32x4 o;
#pragma unroll
                for (int bj = 0; bj < 2; ++bj) { f32x4 v0 = acc[ai][bj][m][0], v1 = acc[ai][bj][m][1];
#pragma unroll
                    for (int k = 0; k < 4; ++k) { const float a = fmaxf(v0[k], 0.f), c = fmaxf(v1[k], 0.f); v0[k] = a * a; v1[k] = c * c; }
                    o[2 * bj] = cvt4_fp8(v0[0], v0[1], v0[2], v0[3]); o[2 * bj + 1] = cvt4_fp8(v1[0], v1[1], v1[2], v1[3]); }
                __builtin_nontemporal_store(o, (u32x4*)(O + rowo)); }
    }
};
struct EpiScaled {
    static constexpr bool PERM = true, PERM16 = false, AFTER_DRAIN = false, MIDK = false;
    bf16_t* O; int ldc; float sc;
    __device__ __forceinline__ void operator()(const f32x4 (&acc)[2][2][4][2], const Unit& u, int wr, int wc, int fr, int fq) const {
#pragma unroll
        for (int ai = 0; ai < 2; ++ai)
#pragma unroll
            for (int m = 0; m < 4; ++m) {
                const size_t rowo = (size_t)(u.pm * BM + ai * HALF + wr * 64 + m * 16 + fr) * ldc + u.pn * BM + wc * 32 + 8 * fq;
#pragma unroll
                for (int bj = 0; bj < 2; ++bj) *(u32x4*)(O + rowo + bj * HALF) = pack8(acc[ai][bj][m][0] * sc, acc[ai][bj][m][1] * sc);
            }
    }
};
template <class Epi, class Sched, bool ALIGN_EPI = false, bool SP2 = false, bool F8 = false>
__device__ __forceinline__ void gemm_phase(PG8_LAS unsigned char* lds, const Gemm g, const Sched& S, const Epi& E, const int wave_id  ) {
    int tid_ = wave_id * 64 + (int)__builtin_amdgcn_mbcnt_hi(~0u, __builtin_amdgcn_mbcnt_lo(~0u, 0u)); asm volatile("" : "+v"(tid_));
    const int tid = tid_, wid = __builtin_amdgcn_readfirstlane(tid >> 6), lane = tid & 63, wr = wid >> 2, wc = wid & 3, fr = lane & 15, fq = lane >> 4;
    const int K = g.K, nt = K / BK;
    unsigned voffA[2], voffB[2];
#pragma unroll
    for (int i = 0; i < 2; ++i) { int R, C; stage_rc(tid * 16 + i * 8192, R, C); const int Rb = Epi::PERM16 ? perm16(R) : Epi::PERM ? ((R & ~31) + perm32(R & 31)) : R;
        voffA[i] = (unsigned)(R * K + C) * 2u; voffB[i] = (unsigned)(Rb * K + C) * 2u; }
    const size_t kstep = (size_t)(BK * 2);
    const size_t hstep = (size_t)HALF * K * 2;
    const size_t bhstep = Epi::PERM16 ? (size_t)8 * K * 2 : hstep;
    const size_t tstep = 2 * hstep;
    const unsigned ldsw = (unsigned)wid * 1024u;
    const int aoff = lds_byte(wr * 64 + fr, fq * 8), boff = lds_byte(wc * 32 + fr, fq * 8);
#define PG8_SA(b, h) (((b) * 2 + (h)) * HTB)
#define PG8_SB(b, h) ((4 + (b) * 2 + (h)) * HTB)
#define PG8_STAGE(bufoff, gbase, voff) do { _Pragma("unroll") for (int _i = 0; _i < 2; ++_i) \
        __builtin_amdgcn_global_load_lds((const unsigned*)((const char*)(gbase) + (voff)[_i]), (PG8_LAS unsigned*)(lds + (bufoff) + ldsw + _i * 8192), 16, 0, 0); } while (0)
#define PG8_LDA(dst, b, h) do { _Pragma("unroll") for (int m = 0; m < 4; ++m) _Pragma("unroll") for (int k = 0; k < 2; ++k) dst[m][k] = *(const PG8_LAS bf16x8*)(lds + PG8_SA(b, h) + aoff + m * 2048 + k * 1024); } while (0)
#define PG8_LDB(dst, b, h) do { _Pragma("unroll") for (int n = 0; n < 2; ++n) _Pragma("unroll") for (int k = 0; k < 2; ++k) dst[n][k] = *(const PG8_LAS bf16x8*)(lds + PG8_SB(b, h) + boff + n * 2048 + k * 1024); } while (0)
#define PG8_MMA(ai, bj, At, Bt) do { __builtin_amdgcn_s_setprio(1); _Pragma("unroll") for (int m = 0; m < 4; ++m) _Pragma("unroll") for (int n = 0; n < 2; ++n) { \
        if constexpr (F8) mfma_f8_inplace(acc[ai][bj][m][n], cat8(Bt[n][0], Bt[n][1]), cat8(At[m][0], At[m][1])); \
        else { _Pragma("unroll") for (int k = 0; k < 2; ++k) acc[ai][bj][m][n] = __builtin_amdgcn_mfma_f32_16x16x32_bf16(Bt[n][k], At[m][k], acc[ai][bj][m][n], 0, 0, 0); } } __builtin_amdgcn_s_setprio(0); } while (0)
#define PG8_WAIT_V(n) asm volatile("s_waitcnt vmcnt(" #n ")" ::: "memory")
#define PG8_WAIT_L(n) asm volatile("s_waitcnt lgkmcnt(" #n ")" ::: "memory")
#define PG8_BAR __builtin_amdgcn_s_barrier()
#define PG8_SCHED __builtin_amdgcn_sched_barrier(0)
    Unit cur, nxt; int ui = 0;
    if (!S.next(0, cur)) return;
    f32x4 acc[2][2][4][2];
#pragma unroll
    for (int a = 0; a < 2; ++a)
#pragma unroll
        for (int b = 0; b < 2; ++b)
#pragma unroll
            for (int m = 0; m < 4; ++m)
#pragma unroll
                for (int n = 0; n < 2; ++n) acc[a][b][m][n] = (f32x4){0.f, 0.f, 0.f, 0.f};
    bf16x8 At[4][2], B0[2][2], B1[2][2];
    const char* cA = (const char*)g.A + (size_t)cur.pm * tstep; const char* cB = (const char*)g.Bt + (size_t)cur.pn * tstep;
    S.a_ready(cur);
    if constexpr (SP2) {
        PG8_STAGE(PG8_SB(0, 0), cB, voffB); PG8_STAGE(PG8_SB(0, 1), cB + bhstep, voffB); PG8_STAGE(PG8_SA(0, 0), cA, voffA); PG8_STAGE(PG8_SA(0, 1), cA + hstep, voffA);
        if (wr == 1) PG8_BAR;
        PG8_WAIT_V(2); PG8_BAR;
        PG8_STAGE(PG8_SB(1, 0), cB + kstep, voffB); PG8_STAGE(PG8_SA(1, 0), cA + kstep, voffA); PG8_STAGE(PG8_SB(1, 1), cB + bhstep + kstep, voffB);
        PG8_WAIT_V(6); PG8_BAR;
    } else {
        PG8_STAGE(PG8_SB(0, 0), cB, voffB); PG8_STAGE(PG8_SA(0, 0), cA, voffA); PG8_STAGE(PG8_SB(0, 1), cB + bhstep, voffB); PG8_STAGE(PG8_SA(0, 1), cA + hstep, voffA);
        if (wr == 1) PG8_BAR;
        PG8_WAIT_V(4); PG8_BAR;
        PG8_STAGE(PG8_SB(1, 0), cB + kstep, voffB); PG8_STAGE(PG8_SA(1, 0), cA + kstep, voffA); PG8_STAGE(PG8_SB(1, 1), cB + bhstep + kstep, voffB);
        PG8_WAIT_V(6); PG8_BAR;
    }
    for (;;) {
        const bool has_next = S.next(ui + 1, nxt);
        const char* nA = has_next ? (const char*)g.A + (size_t)nxt.pm * tstep : cA; const char* nB = has_next ? (const char*)g.Bt + (size_t)nxt.pn * tstep : cB;
        for (int t = 0; t < nt; t += 2) {
            if constexpr (Epi::MIDK) { if (t == nt / 2) E.mid(acc, cur, wr, wc, fr, fq); }
            const bool last = (t == nt - 2);
            const char* a1 = cA + (size_t)(t + 1) * kstep;
            const char* a2 = last ? nA : cA + (size_t)(t + 2) * kstep; const char* b2 = last ? nB : cB + (size_t)(t + 2) * kstep;
            const char* a3 = a2 + kstep; const char* b3 = b2 + kstep;
            if (last && has_next) S.a_ready(nxt);
            if constexpr (SP2) {
            PG8_LDB(B0, 0, 0); PG8_LDB(B1, 0, 1); PG8_SCHED; PG8_LDA(At, 0, 0); PG8_STAGE(PG8_SA(1, 1), a1 + hstep, voffA);
            PG8_WAIT_V(8); PG8_WAIT_L(0); PG8_BAR; PG8_MMA(0, 0, At, B0); PG8_MMA(0, 1, At, B1); PG8_BAR; PG8_SCHED;
            PG8_LDA(At, 0, 1); PG8_STAGE(PG8_SB(0, 0), b2, voffB); PG8_STAGE(PG8_SB(0, 1), b2 + bhstep, voffB); PG8_STAGE(PG8_SA(0, 0), a2, voffA);
            PG8_WAIT_V(8); PG8_WAIT_L(0); PG8_BAR; PG8_MMA(1, 0, At, B0); PG8_MMA(1, 1, At, B1); PG8_BAR; PG8_SCHED;
            PG8_LDB(B0, 1, 0); PG8_LDB(B1, 1, 1); PG8_SCHED; PG8_LDA(At, 1, 0); PG8_STAGE(PG8_SA(0, 1), a2 + hstep, voffA);
            PG8_WAIT_V(8); PG8_WAIT_L(0); PG8_BAR; PG8_MMA(0, 0, At, B0); PG8_MMA(0, 1, At, B1); PG8_BAR; PG8_SCHED;
            PG8_LDA(At, 1, 1); PG8_STAGE(PG8_SB(1, 0), b3, voffB); PG8_STAGE(PG8_SB(1, 1), b3 + bhstep, voffB); PG8_STAGE(PG8_SA(1, 0), a3, voffA);
            PG8_WAIT_V(8); PG8_WAIT_L(0); PG8_BAR; PG8_MMA(1, 0, At, B0); PG8_MMA(1, 1, At, B1); PG8_BAR; PG8_SCHED;
            } else {
            PG8_LDB(B0, 0, 0); PG8_SCHED; PG8_LDA(At, 0, 0); PG8_STAGE(PG8_SA(1, 1), a1 + hstep, voffA);
            PG8_WAIT_L(8); PG8_BAR; PG8_WAIT_L(0); PG8_MMA(0, 0, At, B0); PG8_BAR; PG8_SCHED;
            PG8_LDB(B1, 0, 1); PG8_STAGE(PG8_SB(0, 0), b2, voffB);
            PG8_BAR; PG8_WAIT_L(0); PG8_MMA(0, 1, At, B1); PG8_BAR;
            PG8_LDA(At, 0, 1); PG8_STAGE(PG8_SA(0, 0), a2, voffA);
            PG8_BAR; PG8_WAIT_L(0); PG8_MMA(1, 0, At, B0); PG8_BAR; PG8_SCHED;
            PG8_STAGE(PG8_SB(0, 1), b2 + bhstep, voffB);
            PG8_WAIT_V(6); PG8_BAR; PG8_MMA(1, 1, At, B1); PG8_BAR;
            PG8_LDB(B0, 1, 0); PG8_SCHED; PG8_LDA(At, 1, 0); PG8_STAGE(PG8_SA(0, 1), a2 + hstep, voffA);
            PG8_WAIT_L(8); PG8_BAR; PG8_WAIT_L(0); PG8_MMA(0, 0, At, B0); PG8_BAR; PG8_SCHED;
            PG8_LDB(B1, 1, 1); PG8_STAGE(PG8_SB(1, 0), b3, voffB);
            PG8_BAR; PG8_WAIT_L(0); PG8_MMA(0, 1, At, B1); PG8_BAR;
            PG8_LDA(At, 1, 1); PG8_STAGE(PG8_SA(1, 0), a3, voffA);
            PG8_BAR; PG8_WAIT_L(0); PG8_MMA(1, 0, At, B0); PG8_BAR; PG8_SCHED;
            PG8_STAGE(PG8_SB(1, 1), b3 + bhstep, voffB);
            PG8_WAIT_V(6); PG8_BAR; PG8_MMA(1, 1, At, B1); PG8_BAR;
            }
        }
        if constexpr (F8) asm volatile("s_nop 15\n\ts_nop 15" ::: "memory");
        if constexpr (ALIGN_EPI) { if (wr == 0) PG8_BAR; }
        if constexpr (!Epi::AFTER_DRAIN) { E(acc, cur, wr, wc, fr, fq); S.done(cur); }
        if (!has_next) break;
#pragma unroll
        for (int a = 0; a < 2; ++a)
#pragma unroll
            for (int b = 0; b < 2; ++b)
#pragma unroll
                for (int m = 0; m < 4; ++m)
#pragma unroll
                    for (int n = 0; n < 2; ++n) acc[a][b][m][n] = (f32x4){0.f, 0.f, 0.f, 0.f};
        cur = nxt; cA = nA; cB = nB; ++ui;
        if constexpr (ALIGN_EPI) { if (wr == 1) PG8_BAR; }
    }
    PG8_WAIT_V(0);
    if constexpr (!ALIGN_EPI) { if (wr == 0) PG8_BAR; }
    PG8_BAR;
    if constexpr (Epi::AFTER_DRAIN) { E.fused(acc, cur, wr, wc, fr, fq, lds, wid, lane); S.done(cur); }
#undef PG8_SA
#undef PG8_SB
#undef PG8_STAGE
#undef PG8_LDA
#undef PG8_LDB
#undef PG8_MMA
#undef PG8_WAIT_V
#undef PG8_WAIT_L
#undef PG8_BAR
#undef PG8_SCHED
}
}
#define GAS __attribute__((address_space(1)))
#define LAS __attribute__((address_space(3)))
typedef unsigned short bf16;
typedef unsigned v4u __attribute__((ext_vector_type(4)));
typedef float f32x4 __attribute__((ext_vector_type(4)));
typedef short bf16x8 __attribute__((ext_vector_type(8)));
typedef GAS unsigned gu32;
typedef GAS unsigned long long gu64;
#define RLX_AGENT __ATOMIC_RELAXED, __HIP_MEMORY_SCOPE_AGENT
#define LDS_WAIT() asm volatile("s_waitcnt lgkmcnt(0)" ::: "memory")
#define VM_WAIT() asm volatile("s_waitcnt vmcnt(0)" ::: "memory")
__device__ __forceinline__ unsigned long long rt() { return __builtin_amdgcn_s_memrealtime(); }
__device__ __forceinline__ unsigned f2bf(float f) { unsigned u = __builtin_bit_cast(unsigned, f); return (u + 0x7fffu + ((u >> 16) & 1u)) >> 16; }
__device__ __forceinline__ unsigned pk2(float lo, float hi) { return f2bf(lo) | (f2bf(hi) << 16); }

#define XB_TMO      128
#define XB_XCNT(j)  (256  + 64 * (j))
#define XB_XSUB(j)  (1280 + 64 * (j))
#define XB_XGEN(j)  (2304 + 64 * (j))
#define XB_TOP      3328
#define XB_TOPGEN   3392
#define XCD_BAR_WORDS 3456
#define XB_SPIN_CAP (1u << 18)

__device__ __forceinline__ unsigned xb_ld(unsigned* p)              { return __hip_atomic_load(p, __ATOMIC_RELAXED, __HIP_MEMORY_SCOPE_AGENT); }
__device__ __forceinline__ unsigned xb_add(unsigned* p, unsigned v) { return __hip_atomic_fetch_add(p, v, __ATOMIC_RELAXED, __HIP_MEMORY_SCOPE_AGENT); }
__device__ __forceinline__ unsigned xb_xcc_id() { return (unsigned)__builtin_amdgcn_s_getreg((3 << 11) | 20) & 0xFu; }
#define XB_SPIN(cond, bar) do { unsigned _sp = 0; while (cond) { __builtin_amdgcn_s_sleep(1); \
    if ((++_sp & 255u) == 0u) { if (xb_ld(&(bar)[XB_TMO])) break; if (_sp > XB_SPIN_CAP) { atomicAdd(&(bar)[XB_TMO], 1u); break; } } } } while (0)

struct XcdBarrier {
    unsigned* bar; unsigned x;
    volatile LAS unsigned* st;
};

__device__ __forceinline__ XcdBarrier xcd_barrier_post(unsigned* bar, volatile LAS unsigned* st) {
    XcdBarrier b; b.bar = bar; b.x = xb_xcc_id(); b.st = st;
    if (threadIdx.x == 0) (void)xb_add(&bar[XB_XCNT(b.x)], 1u);
    return b;
}
__device__ __forceinline__ void xcd_barrier_complete(unsigned* bar, unsigned x, unsigned& nloc, unsigned& nx) {
    const unsigned G = gridDim.x * gridDim.y * gridDim.z;
    unsigned sum, cnt, mine, sp = 0u;
    for (;;) {
        sum = 0u; cnt = 0u; mine = 0u;
#pragma unroll
        for (unsigned j = 0; j < 16; ++j) { const unsigned c = xb_ld(&bar[XB_XCNT(j)]); sum += c; cnt += (c > 0u) ? 1u : 0u; mine = (j == x) ? c : mine; }
        if (sum == G) break;
        __builtin_amdgcn_s_sleep(1);
        if ((++sp & 255u) == 0u) { if (xb_ld(&bar[XB_TMO])) break; if (sp > XB_SPIN_CAP) { atomicAdd(&bar[XB_TMO], 1u); break; } }
    }
    nloc = mine > 0u ? mine : 1u; nx = cnt > 0u ? cnt : 1u;
}

__device__ __forceinline__ void xcd_barrier(const XcdBarrier& b) {
    asm volatile("s_waitcnt vmcnt(0)" ::: "memory");
    __syncthreads();
    if (threadIdx.x == 0) {
        unsigned* bar = b.bar;
        __builtin_amdgcn_s_waitcnt(0);
        unsigned nloc = b.st[0], nx = b.st[1];
        if (nloc == 0u) { xcd_barrier_complete(bar, b.x, nloc, nx); b.st[0] = nloc; b.st[1] = nx; }
        const unsigned old = xb_add(&bar[XB_XSUB(b.x)], 1u);
        const unsigned gen = old / nloc;
        if (old + 1u == (gen + 1u) * nloc) {
            __builtin_amdgcn_fence(__ATOMIC_RELEASE, "agent");
            asm volatile("s_waitcnt vmcnt(0)" ::: "memory");
            const unsigned og = xb_add(&bar[XB_TOP], 1u);
            const unsigned tg = og / nx;
            if (og + 1u == (tg + 1u) * nx) xb_add(&bar[XB_TOPGEN], 1u);
            else XB_SPIN(xb_ld(&bar[XB_TOPGEN]) == tg, bar);
            __builtin_amdgcn_fence(__ATOMIC_ACQUIRE, "agent");
            xb_add(&bar[XB_XGEN(b.x)], 1u);
            asm volatile("s_waitcnt vmcnt(0)" ::: "memory");
        } else {
            XB_SPIN(xb_ld(&bar[XB_XGEN(b.x)]) == gen, bar);
            __builtin_amdgcn_fence(__ATOMIC_ACQUIRE, "agent");
            asm volatile("s_waitcnt vmcnt(0)" ::: "memory");
        }
    }
    __syncthreads();
}

__device__ __forceinline__ void group_barrier(unsigned* bar, unsigned* cnt, unsigned& gen, unsigned nwg, const bool colo) {
    asm volatile("s_waitcnt vmcnt(0)" ::: "memory");
    __syncthreads();
    if (threadIdx.x == 0) {
        __builtin_amdgcn_s_waitcnt(0);
        if (!colo) { __builtin_amdgcn_fence(__ATOMIC_RELEASE, "agent");
            asm volatile("s_waitcnt vmcnt(0)" ::: "memory"); }
        (void)xb_add(cnt, 1u);
        const unsigned target = nwg * (gen + 1u);
        XB_SPIN(xb_ld(cnt) < target, bar);
        __builtin_amdgcn_fence(__ATOMIC_ACQUIRE, "agent");
        asm volatile("s_waitcnt vmcnt(0)" ::: "memory");
    }
    ++gen;
    __syncthreads();
}

constexpr int NWAVES = 8;
constexpr int BATCH = 32, SEQ = 2048, DMODEL = 1024, MTOK = BATCH * SEQ, DFF = 4096, NPROJ = 5120, INCOLS = 4896;
constexpr float RMS_EPS = 1e-6f;
constexpr float QSCALE = 0.125f * 1.4426950408889634f;
constexpr float LOG2E = 1.4426950408889634f;
constexpr float WDN_SCALE = 256.f;
#ifndef MK_N_LAUNCHES
#define MK_N_LAUNCHES 1
#endif
constexpr int N_PHASES = 10;
constexpr int N_LAUNCHES = MK_N_LAUNCHES;
constexpr size_t MiB = 1u << 20, KiB = 1u << 10;
constexpr size_t WS_CTL = 0, CTL_ZERO_BYTES = 1 * MiB;
constexpr size_t WS_WIN8 = 28 * MiB;
constexpr float WIN8_SCALE = 64.f;
constexpr size_t WS_WIN = 2 * MiB, WS_WF = 12 * MiB, WS_WN = 13 * MiB, WS_WO = 14 * MiB, WS_WUP = 16 * MiB, WS_WDN = 24 * MiB;
constexpr size_t WS_W1K = 32 * MiB, WS_W1V = WS_W1K + 256 * KiB, WS_W2K = WS_W1V + 256 * KiB, WS_W2V = WS_W2K + 8 * KiB, WS_PBK = WS_W2V + 8 * KiB, WS_PBV = WS_PBK + 256;
constexpr size_t WS_KT0 = WS_PBV + 256;
constexpr size_t WS_RSTD2 = 46 * MiB;
constexpr size_t WS_ROPEC = 33 * MiB, WS_ROPES = WS_ROPEC + 256 * KiB;
constexpr size_t WS_KCMP = 34 * MiB, WS_VCMP = 35 * MiB, WS_C = 36 * MiB, WS_LF = 38 * MiB, WS_GATE = 40 * MiB;
constexpr size_t WS_HB = 48 * MiB;
constexpr size_t WS_FKX = 48 * MiB;
__host__ __device__ constexpr size_t fkx_off(int bh) { return WS_FKX + (size_t)(bh >> 5) * (16 * MiB) + (size_t)(bh & 31) * (2048 * 32); }
constexpr size_t WS_PROBE_O = 64 * MiB;
constexpr size_t WS_FQ = 176 * MiB, QB_GROUP = 32 * MiB, QB_ARR = 8 * MiB;
__host__ __device__ constexpr size_t qb_off(int arr, size_t row) { return WS_FQ + (row >> 13) * QB_GROUP + (size_t)arr * QB_ARR + (row & 8191) * 1024; }
constexpr size_t WS_KV = 432 * MiB, KV_STRIDE = 16 * MiB;
constexpr size_t WS_SGA = 528 * MiB, WS_SGB = 656 * MiB;
#ifndef WS_Y_SKEW
#define WS_Y_SKEW 0
#endif
constexpr size_t WS_Y = 784 * MiB + WS_Y_SKEW;
constexpr size_t WS_ATT = WS_Y;
constexpr size_t WS_FOXO_UNUSED = WS_Y, WS_NSAO_UNUSED = WS_Y + 64 * MiB;
constexpr size_t WS_U = 176 * MiB;
constexpr size_t WS_NRM = 912 * MiB;
constexpr size_t WS_END = 1024 * MiB;
static_assert(WS_U == WS_FQ && WS_U + (size_t)MTOK * DFF * 2 <= WS_Y && WS_Y + (size_t)MTOK * 512 * 4 <= WS_END && WS_GATE + (size_t)MTOK * 24 * 4 <= WS_HB, "d_ws map");
constexpr int CW_TMO = 0, CW_CODE = 1, CW_BAR = 4096, CW_QUEUE = 16384, CW_GBAR = 32768, CW_XID = 40960;
constexpr int RING_OFF = 0, RING_BYTES = 131072;
constexpr int LDSCTL_OFF = RING_BYTES, MISC_OFF = LDSCTL_OFF + 320;
constexpr int LDS_BYTES = 147456;
static_assert(MISC_OFF + 128 <= LDS_BYTES, "LDS map");

#ifndef RP_LD_NT
#define RP_LD_NT 1
#endif
#ifndef RP_ST_NT
#define RP_ST_NT 1
#endif
#if RP_LD_NT
#define RP_LOAD(p) __builtin_nontemporal_load(p)
#else
#define RP_LOAD(p) (*(p))
#endif
#if RP_ST_NT
#define RP_STORE(v, p) __builtin_nontemporal_store(v, p)
#else
#define RP_STORE(v, p) (*(p) = (v))
#endif
#ifndef RP_Y_NT
#define RP_Y_NT 1
#endif
#if RP_Y_NT
#define RP_LOAD_Y(p) __builtin_nontemporal_load(p)
#else
#define RP_LOAD_Y(p) (*(p))
#endif

typedef float f32x16 __attribute__((ext_vector_type(16)));
struct Frame {
    LAS unsigned char* lds;
    volatile LAS unsigned* MISC;
    gu32* ctl;
    int wave;
    int vcu, G;
    unsigned char* ws;
    const float* x; float* out;
    const float *g_mix_pre, *g_mix_post, *g_mlp_pre, *g_mlp_post, *w_in, *b_forget, *pos_k, *w1_k, *w2_k, *pos_v, *w1_v, *w2_v, *w_fox, *w_nsa, *w_o, *w_up, *w_down;
};
template <class T> __device__ __forceinline__ T* wsp(const Frame& F, size_t off) { return (T*)(F.ws + off); }
__device__ __forceinline__ int cur_lane() { return (int)__builtin_amdgcn_mbcnt_hi(~0u, __builtin_amdgcn_mbcnt_lo(~0u, 0u)); }
__device__ __forceinline__ int cur_tid(const Frame& F) { return F.wave * 64 + cur_lane(); }

__device__ __forceinline__ float wave_sum(float v) {
#pragma unroll
    for (int o = 1; o < 64; o <<= 1) v += __shfl_xor(v, o);
    return v;
}
__device__ __forceinline__ float bfl(unsigned w) { return __uint_as_float(w << 16); }
__device__ __forceinline__ float bfh(unsigned w) { return __uint_as_float(w & 0xffff0000u); }

__device__ __forceinline__ int rope_d(int w) { const int i = w >> 3, j = w & 7; return j < 4 ? 4 * i + j : 32 + 4 * i + (j - 4); }
__device__ __forceinline__ int in_src_col(int n) {
    if (n < 1536) return n;
    if (n < 2048) { const int l = n - 1536; return 1544 + (l & ~63) + rope_d(l & 63); }
    if (n < 2816) { const int s = (n - 2048) >> 8, l = (n - 2048) & 255; const int kb = 2056 + s * 256;
        return l < 128 ? kb + (l & ~63) + rope_d(l & 63) : kb + 128 + (l - 128); }
    if (n < 4864) { const int q = (n - 2816) >> 8, l = (n - 2816) & 255; return l < 128 ? 2848 + 128 * q + l : 3872 + 128 * q + (l - 128); }
    const int l = n - 4864; if (l < 8) return 1536 + l; if (l < 32) return 2824 + (l - 8); return -1;
}
template <class SrcCol>
__device__ __forceinline__ void p0_transpose_item(const float* W, int K, int Nsrc, bf16* WT, int nblk, LAS float* scr, int item, int lane, SrcCol srccol, const float* kgain = nullptr, int ldk = 0, int koff = 0) {
    const int kb = item / nblk, nb = item % nblk, k0 = 64 * kb, n0 = 32 * nb;
    const int sc = srccol(n0 + (lane & 31));
#pragma unroll 8
    for (int i = 0; i < 32; ++i) { const int kk = 2 * i + (lane >> 5); float w = sc >= 0 ? W[(size_t)(k0 + kk) * Nsrc + sc] : 0.f; if (kgain) w *= kgain[k0 + kk]; scr[kk * 33 + (lane & 31)] = w; }
    LDS_WAIT(); asm volatile("" ::: "memory");
    const int c = lane & 7;
#pragma unroll
    for (int j = 0; j < 4; ++j) { const int n = (lane >> 3) + 8 * j; const LAS float* s = scr + (8 * c) * 33 + n;
        v4u o; o.x = pk2(s[0 * 33], s[1 * 33]); o.y = pk2(s[2 * 33], s[3 * 33]); o.z = pk2(s[4 * 33], s[5 * 33]); o.w = pk2(s[6 * 33], s[7 * 33]);
        *(GAS v4u*)(WT + (size_t)(n0 + n) * (ldk ? ldk : K) + koff + k0 + 8 * c) = o; }
    LDS_WAIT(); asm volatile("" ::: "memory");
}
__device__ __forceinline__ void p0_transpose_item_f8(const float* W, int K, int N, unsigned char* WT, int nblk, LAS float* scr, int item, int lane, float scale) {
    const int kb = item / nblk, nb = item % nblk, k0 = 64 * kb, n0 = 32 * nb;
#pragma unroll 8
    for (int i = 0; i < 32; ++i) { const int kk = 2 * i + (lane >> 5); scr[kk * 33 + (lane & 31)] = W[(size_t)(k0 + kk) * N + n0 + (lane & 31)] * scale; }
    LDS_WAIT(); asm volatile("" ::: "memory");
    const int c = lane & 7;
#pragma unroll
    for (int j = 0; j < 4; ++j) { const int n = (lane >> 3) + 8 * j; const LAS float* s = scr + (8 * c) * 33 + n;
        pg8::f32x2 o; o.x = __builtin_bit_cast(float, pg8::cvt4_fp8(fmaxf(s[0 * 33], -pg8::F8_MAX), fmaxf(s[1 * 33], -pg8::F8_MAX), fmaxf(s[2 * 33], -pg8::F8_MAX), fmaxf(s[3 * 33], -pg8::F8_MAX)));
        o.y = __builtin_bit_cast(float, pg8::cvt4_fp8(fmaxf(s[4 * 33], -pg8::F8_MAX), fmaxf(s[5 * 33], -pg8::F8_MAX), fmaxf(s[6 * 33], -pg8::F8_MAX), fmaxf(s[7 * 33], -pg8::F8_MAX)));
        *(GAS pg8::f32x2*)(WT + (size_t)(n0 + n) * K + k0 + 8 * c) = o; }
    LDS_WAIT(); asm volatile("" ::: "memory");
}
template <class SrcCol>
__device__ __forceinline__ void p0_transpose_item_f8s(const float* W, int K, int Nsrc, unsigned char* WT, int nblk, LAS float* scr, int item, int lane, float scale, SrcCol srccol) {
    const int kb = item / nblk, nb = item % nblk, k0 = 64 * kb, n0 = 32 * nb;
    const int sc = srccol(n0 + (lane & 31));
#pragma unroll 8
    for (int i = 0; i < 32; ++i) { const int kk = 2 * i + (lane >> 5); scr[kk * 33 + (lane & 31)] = sc >= 0 ? W[(size_t)(k0 + kk) * Nsrc + sc] * scale : 0.f; }
    LDS_WAIT(); asm volatile("" ::: "memory");
    const int c = lane & 7;
#pragma unroll
    for (int j = 0; j < 4; ++j) { const int n = (lane >> 3) + 8 * j; const LAS float* s = scr + (8 * c) * 33 + n;
        pg8::f32x2 o; o.x = __builtin_bit_cast(float, pg8::cvt4_fp8(fmaxf(s[0 * 33], -pg8::F8_MAX), fmaxf(s[1 * 33], -pg8::F8_MAX), fmaxf(s[2 * 33], -pg8::F8_MAX), fmaxf(s[3 * 33], -pg8::F8_MAX)));
        o.y = __builtin_bit_cast(float, pg8::cvt4_fp8(fmaxf(s[4 * 33], -pg8::F8_MAX), fmaxf(s[5 * 33], -pg8::F8_MAX), fmaxf(s[6 * 33], -pg8::F8_MAX), fmaxf(s[7 * 33], -pg8::F8_MAX)));
        *(GAS pg8::f32x2*)(WT + (size_t)(n0 + n) * K + k0 + 8 * c) = o; }
    LDS_WAIT(); asm volatile("" ::: "memory");
}
__device__ __forceinline__ void rms_rows_to_bf16(int lane, int gw, int NGW, const float* X, const float* g, bf16* O, unsigned char* O8) {
    constexpr int RP = 4;
    const GAS f32x4* gr = (const GAS f32x4*)g + lane; f32x4 gv[4];
#pragma unroll
    for (int j = 0; j < 4; ++j) gv[j] = gr[64 * j];
    for (int m0 = gw; m0 < MTOK; m0 += NGW * RP) {
        f32x4 v[RP][4];
#pragma unroll
        for (int r = 0; r < RP; ++r) { const GAS f32x4* xr = (const GAS f32x4*)(X + (size_t)(m0 + r * NGW) * DMODEL) + lane;
#pragma unroll
            for (int j = 0; j < 4; ++j) v[r][j] = RP_LOAD(xr + 64 * j); }
#pragma unroll
        for (int r = 0; r < RP; ++r) { float s = 0.f;
#pragma unroll
            for (int j = 0; j < 4; ++j) s += (v[r][j].x * v[r][j].x + v[r][j].y * v[r][j].y) + (v[r][j].z * v[r][j].z + v[r][j].w * v[r][j].w);
            const float rr = 1.0f / sqrtf(wave_sum(s) * (1.f / DMODEL) + RMS_EPS);
            GAS unsigned long long* o8 = (GAS unsigned long long*)(O + (size_t)(m0 + r * NGW) * DMODEL) + lane;
#pragma unroll
            for (int j = 0; j < 4; ++j) { const f32x4 a = v[r][j], gg = gv[j];
                const float h0 = a.x * rr * gg.x, h1 = a.y * rr * gg.y, h2 = a.z * rr * gg.z, h3 = a.w * rr * gg.w;
                o8[64 * j] = (unsigned long long)pk2(h0, h1) | ((unsigned long long)pk2(h2, h3) << 32);
                ((GAS unsigned*)(O8 + (size_t)(m0 + r * NGW) * DMODEL))[lane + 64 * j] = pg8::cvt4_fp8(fmaxf(h0, -pg8::F8_MAX), fmaxf(h1, -pg8::F8_MAX), fmaxf(h2, -pg8::F8_MAX), fmaxf(h3, -pg8::F8_MAX)); } }
    }
}
__device__ __forceinline__ void p0_prologue(Frame& F) {
    LAS float* scr = (LAS float*)(F.lds + RING_OFF + F.wave * 16384);
    const int gw = F.vcu * NWAVES + F.wave, NGW = F.G * NWAVES, lane = cur_lane();
    constexpr int I_IN = 16 * (NPROJ / 32), I_F = 8 * 32, I_O = 16 * 32, I_UP = 16 * 128, I_DN = 64 * 32, I_W1 = 32 * 2, I_W2 = 1 * 2;
    constexpr int I_G8 = 16 * 64;
    constexpr int NITEMS = I_IN + 2 * I_F + I_O + I_UP + I_DN + 2 * I_W1 + 2 * I_W2 + I_G8;
    auto ident = [](int n) { return n; };
    for (int it = gw; it < NITEMS; it += NGW) {
        int r = it;
        if (r >= NITEMS - I_G8) { p0_transpose_item_f8s(F.w_in, 1024, INCOLS, wsp<unsigned char>(F, WS_WIN8), 64, scr, r - (NITEMS - I_G8), lane, WIN8_SCALE, [](int n) { return in_src_col(11 * 256 + n); }); continue; }
        if (r < I_IN) { p0_transpose_item(F.w_in, 1024, INCOLS, wsp<bf16>(F, WS_WIN), NPROJ / 32, scr, r, lane, [](int n) { return in_src_col(n); }); continue; } r -= I_IN;
        if (r < I_F) { p0_transpose_item(F.w_fox, 512, 1024, wsp<bf16>(F, WS_WF), 32, scr, r, lane, ident, nullptr, 1024, 512); continue; } r -= I_F;
        if (r < I_F) { p0_transpose_item(F.w_nsa, 512, 1024, wsp<bf16>(F, WS_WF), 32, scr, r, lane, ident, nullptr, 1024, 0); continue; } r -= I_F;
        if (r < I_O) { p0_transpose_item(F.w_o, 1024, 1024, wsp<bf16>(F, WS_WO), 32, scr, r, lane, ident); continue; } r -= I_O;
        if (r < I_UP) { p0_transpose_item(F.w_up, 1024, 4096, wsp<bf16>(F, WS_WUP), 128, scr, r, lane, ident, F.g_mlp_pre); continue; }     r -= I_UP;
        if (r < I_DN) { p0_transpose_item_f8(F.w_down, 4096, 1024, wsp<unsigned char>(F, WS_WDN), 32, scr, r, lane, WDN_SCALE); continue; } r -= I_DN;
        if (r < I_W1) { p0_transpose_item(F.w1_k, 2048, 64, wsp<bf16>(F, WS_W1K), 2, scr, r, lane, ident); continue; } r -= I_W1;
        if (r < I_W1) { p0_transpose_item(F.w1_v, 2048, 64, wsp<bf16>(F, WS_W1V), 2, scr, r, lane, ident); continue; } r -= I_W1;
        if (r < I_W2) { p0_transpose_item(F.w2_k, 64, 64, wsp<bf16>(F, WS_W2K), 2, scr, r, lane, ident); continue; } r -= I_W2;
        p0_transpose_item(F.w2_v, 64, 64, wsp<bf16>(F, WS_W2V), 2, scr, r, lane, ident);
    }
    { float* RC = wsp<float>(F, WS_ROPEC); float* RS = wsp<float>(F, WS_ROPES);
      for (int e = (F.vcu * NWAVES * 64 + cur_tid(F)); e < SEQ * 32; e += F.G * NWAVES * 64) { const int t = e >> 5, i = e & 31;
          const float inv = powf(10000.0f, -(float)(2 * i) / 64.0f); const float ang = (float)t * inv; RC[e] = cosf(ang); RS[e] = sinf(ang); } }
    if (F.wave == 0) for (int it = F.vcu; it < 128; it += F.G) { const int kv = it >> 6, c = it & 63; const float* pos = kv ? F.pos_v : F.pos_k; const float* w1 = kv ? F.w1_v : F.w1_k; float s = 0.f;
        for (int k = lane; k < 2048; k += 64) s += pos[k] * w1[(size_t)k * 64 + c];
        s = wave_sum(s); if (lane == 0) wsp<float>(F, kv ? WS_PBV : WS_PBK)[c] = s; }
    rms_rows_to_bf16(lane, gw, NGW, F.x, F.g_mix_pre, wsp<bf16>(F, WS_HB), wsp<unsigned char>(F, WS_SGB));
}

__device__ __forceinline__ int crow(int r, int hi) { return (r & 3) + 8 * (r >> 2) + 4 * hi; }
__device__ __forceinline__ void p1_tail_unit(Frame& F, int mtile) {
    const int lane = cur_lane(), w = F.wave, r = lane & 31, h = lane >> 5;
    const bf16* A = wsp<bf16>(F, WS_HB) + (size_t)mtile * 256 * DMODEL; const bf16* B = wsp<bf16>(F, WS_WIN) + (size_t)(19 * 256) * DMODEL;
    LAS unsigned char* stg = F.lds + RING_OFF;
    unsigned aoff[4], boff;
#pragma unroll
    for (int j = 0; j < 4; ++j) { const int row = 8 * (4 * w + j) + (lane >> 3); aoff[j] = (unsigned)(row * DMODEL + (((lane & 7) ^ ((row >> 1) & 7)) * 8)) * 2u; }
    { const int row = 8 * (w & 3) + (lane >> 3); boff = (unsigned)(row * DMODEL + (((lane & 7) ^ ((row >> 1) & 7)) * 8)) * 2u; }
#define PT_STAGE(kc, buf) do { _Pragma("unroll") for (int j = 0; j < 4; ++j) \
        __builtin_amdgcn_global_load_lds((const unsigned*)((const char*)A + aoff[j] + (kc) * 128), (LAS unsigned*)(stg + (buf) * 36864 + (4 * w + j) * 1024), 16, 0, 0); \
        __builtin_amdgcn_global_load_lds((const unsigned*)((const char*)B + boff + (kc) * 128), (LAS unsigned*)(stg + (buf) * 36864 + 32768 + (w & 3) * 1024), 16, 0, 0); } while (0)
    f32x16 acc = {};
    const int key = (r >> 1) & 7;
    const LAS unsigned char* fa = stg + (32 * w + r) * 128; const LAS unsigned char* fb = stg + 32768 + r * 128;
    PT_STAGE(0, 0);
#pragma unroll 1
    for (int kc = 0; kc < 16; ++kc) { const int buf = kc & 1;
        if (kc + 1 < 16) { PT_STAGE(kc + 1, buf ^ 1); asm volatile("s_waitcnt vmcnt(5)" ::: "memory"); } else asm volatile("s_waitcnt vmcnt(0)" ::: "memory");
        __builtin_amdgcn_s_barrier();
        bf16x8 af[4], bq[4];
#pragma unroll
        for (int s2 = 0; s2 < 4; ++s2) { const int c = ((2 * s2 + h) ^ key) * 16; af[s2] = *(const LAS bf16x8*)(fa + buf * 36864 + c); bq[s2] = *(const LAS bf16x8*)(fb + buf * 36864 + c); }
#pragma unroll
        for (int s2 = 0; s2 < 4; ++s2) acc = __builtin_amdgcn_mfma_f32_32x32x16_bf16(af[s2], bq[s2], acc, 0, 0, 0);
        asm volatile("s_waitcnt lgkmcnt(0)" ::: "memory"); __builtin_amdgcn_s_barrier();
    }
#undef PT_STAGE
    float* LF = wsp<float>(F, WS_LF); float* GT = wsp<float>(F, WS_GATE);
    const float bf_ = r < 8 ? F.b_forget[r] : 0.f;
#pragma unroll
    for (int i = 0; i < 16; ++i) { const size_t row = (size_t)mtile * 256 + 32 * w + crow(i, h); const float v = acc[i];
        if (r < 8) { const float x0 = v + bf_; LF[row * 8 + r] = fminf(x0, 0.f) - log1pf(__expf(-fabsf(x0))); }
        else GT[row * 24 + (r - 8)] = 1.0f / (1.0f + __expf(-v)); }
    __syncthreads();
}

#define P2_PIN8(a) asm volatile("" : "+v"(a[0]), "+v"(a[1]), "+v"(a[2]), "+v"(a[3]), "+v"(a[4]), "+v"(a[5]), "+v"(a[6]), "+v"(a[7]))
__device__ __forceinline__ void p2_compress_unit(Frame& F, int unit) {
    const int bg = unit >> 2, kv = (unit >> 1) & 1, half = unit & 1, lane = cur_lane(), w = F.wave;
    const bf16* X = wsp<bf16>(F, WS_KV + (size_t)kv * KV_STRIDE) + (size_t)bg * SEQ * 64;
    const bf16* W1t = wsp<bf16>(F, kv ? WS_W1V : WS_W1K); const bf16* W2t = wsp<bf16>(F, kv ? WS_W2V : WS_W2K); const float* PB = wsp<float>(F, kv ? WS_PBV : WS_PBK);
    bf16* OUT = wsp<bf16>(F, kv ? WS_VCMP : WS_KCMP) + (size_t)bg * 128 * 64;
    const int rt = w & 1, ct = (w >> 1) & 1, kh = w >> 2, r = lane & 31, h = lane >> 5;
    LAS unsigned char* stg = F.lds + RING_OFF;
    unsigned aoff[4], boff[4];
#pragma unroll
    for (int j = 0; j < 4; ++j) { const int row = 8 * w + 2 * j + (lane >> 5), ch = (lane & 31) ^ (row & 31); const int irow = 64 * half + row, ild = irow < 126 ? irow : 126;
        aoff[j] = (unsigned)(ild * 1024 + ch * 8) * 2u; boff[j] = (unsigned)(row * 2048 + ch * 8) * 2u; }
#define P2_STAGE(kc, buf) do { _Pragma("unroll") for (int j = 0; j < 4; ++j) { \
        __builtin_amdgcn_global_load_lds((const unsigned*)((const char*)X + aoff[j] + (kc) * 512), (LAS unsigned*)(stg + (buf) * 32768 + (8 * w + 2 * j) * 512), 16, 0, 0); \
        __builtin_amdgcn_global_load_lds((const unsigned*)((const char*)W1t + boff[j] + (kc) * 512), (LAS unsigned*)(stg + 65536 + (buf) * 32768 + (8 * w + 2 * j) * 512), 16, 0, 0); } } while (0)
    f32x16 acc = {};
    const LAS unsigned char* fa = stg + (32 * rt + r) * 512; const LAS unsigned char* fb = stg + 65536 + (32 * ct + r) * 512;
    P2_STAGE(0, 0);
#pragma unroll 1
    for (int kc = 0; kc < 8; ++kc) { const int buf = kc & 1;
        if (kc + 1 < 8) { P2_STAGE(kc + 1, buf ^ 1); asm volatile("s_waitcnt vmcnt(8)" ::: "memory"); } else asm volatile("s_waitcnt vmcnt(0)" ::: "memory");
        __builtin_amdgcn_s_barrier();
        bf16x8 af[8], bfr[8];
#pragma unroll
        for (int s2 = 0; s2 < 8; ++s2) { const int c = (2 * (8 * kh + s2) + h) ^ r; af[s2] = *(const LAS bf16x8*)(fa + buf * 32768 + c * 16); bfr[s2] = *(const LAS bf16x8*)(fb + buf * 32768 + c * 16); }
#pragma unroll
        for (int s2 = 0; s2 < 8; ++s2) acc = __builtin_amdgcn_mfma_f32_32x32x16_bf16(af[s2], bfr[s2], acc, 0, 0, 0);
        asm volatile("s_waitcnt lgkmcnt(0)" ::: "memory"); __builtin_amdgcn_s_barrier();
    }
#undef P2_STAGE
    LAS float* red = (LAS float*)(F.lds + RING_OFF);
    LAS bf16* Hs = (LAS bf16*)(F.lds + RING_OFF + 16384);
    if (kh == 1) {
#pragma unroll
        for (int i = 0; i < 16; ++i) red[((w & 3) * 16 + i) * 64 + lane] = acc[i];
    }
    __syncthreads();
    if (kh == 0) { const float pb = PB[32 * ct + r];
#pragma unroll
        for (int i = 0; i < 16; ++i) { float v = acc[i] + red[((w & 3) * 16 + i) * 64 + lane] + pb; v = v / (1.0f + __expf(-v)); Hs[(32 * rt + crow(i, h)) * 72 + 32 * ct + r] = (bf16)f2bf(v); }
    }
    __syncthreads();
    if (kh == 0) { f32x16 o = {};
#pragma unroll
        for (int s = 0; s < 4; ++s) { const bf16x8 a = *(const LAS bf16x8*)(Hs + (32 * rt + r) * 72 + 16 * s + 8 * h), b = *(const GAS bf16x8*)(W2t + (size_t)(32 * ct + r) * 64 + 16 * s + 8 * h);
            o = __builtin_amdgcn_mfma_f32_32x32x16_bf16(a, b, o, 0, 0, 0); }
#pragma unroll
        for (int i = 0; i < 16; ++i) { const int row = 64 * half + 32 * rt + crow(i, h); OUT[(size_t)row * 64 + 32 * ct + r] = (bf16)(row == 127 ? 0u : f2bf(o[i])); }
    }
    __syncthreads();
}
__device__ __forceinline__ void p2_phase(Frame& F, const bool probe_second = false) {
#ifdef PROBE_P2_NOCUM
    if (!probe_second)
#endif
    for (int id = F.vcu; id < BATCH * 8; id += F.G) { const int b = id >> 3, h = id & 7, tid = cur_tid(F), lane = cur_lane(), w = F.wave;
        LAS float* wt = (LAS float*)(F.lds + RING_OFF + 32768);
        const float* lf = wsp<float>(F, WS_LF) + ((size_t)b * SEQ + 4 * tid) * 8 + h; float v[4];
#pragma unroll
        for (int i = 0; i < 4; ++i) v[i] = lf[i * 8];
        const float tot = (v[0] + v[1]) + (v[2] + v[3]); float incl = tot;
#pragma unroll
        for (int o = 1; o < 64; o <<= 1) { const float n = __shfl_up(incl, o); if (lane >= o) incl += n; }
        if (lane == 63) wt[w] = incl;
        __syncthreads();
        float run = incl - tot;
        for (int k = 0; k < w; ++k) run += wt[k];
        float* c = wsp<float>(F, WS_C) + (size_t)id * SEQ + 4 * tid; GAS v4u* kx = (GAS v4u*)((bf16*)(F.ws + fkx_off(id)) + (size_t)(4 * tid) * 16);
        float cv[4];
#pragma unroll
        for (int i = 0; i < 4; ++i) { run += v[i]; cv[i] = run;
            const float x = -run * LOG2E; const unsigned h1 = f2bf(x); const float r1 = x - __uint_as_float(h1 << 16); const unsigned h2 = f2bf(r1); const float r2 = r1 - __uint_as_float(h2 << 16); const unsigned h3 = f2bf(r2);
            kx[2 * i] = (v4u){h1 | (h2 << 16), h3, 0u, 0u}; kx[2 * i + 1] = (v4u){0u, 0u, 0u, 0u}; }
        *(GAS f32x4*)c = (f32x4){cv[0], cv[1], cv[2], cv[3]};
#ifdef PROBE_P2_NONORM
        if (!probe_second)
#endif
        { LAS float* cl = (LAS float*)(F.lds + RING_OFF + 36864); LAS float* wk = cl + 2048; LAS float* wq = wk + 256;
          *(LAS f32x4*)(cl + 4 * tid) = (f32x4){cv[0], cv[1], cv[2], cv[3]};
          { const GAS f32x4* nq = (const GAS f32x4*)(wsp<float>(F, WS_NRM) + (size_t)(2 * h) * MTOK + (size_t)b * SEQ + 4 * tid);
            const f32x4 q0 = nq[0], q1 = nq[MTOK / 4], k0 = nq[(size_t)16 * MTOK / 4], k1 = nq[(size_t)17 * MTOK / 4];
            const f32x4 qs = q0 + q1, ks = k0 + k1;
            float sq = fmaxf(fmaxf(qs.x, qs.y), fmaxf(qs.z, qs.w)), sk = fmaxf(fmaxf(ks.x, ks.y), fmaxf(ks.z, ks.w));
            sq = fmaxf(sq, __shfl_xor(sq, 1)); sk = fmaxf(sk, __shfl_xor(sk, 1)); sq = fmaxf(sq, __shfl_xor(sq, 2)); sk = fmaxf(sk, __shfl_xor(sk, 2));
            sq = fmaxf(sq, __shfl_xor(sq, 4)); sk = fmaxf(sk, __shfl_xor(sk, 4)); sq = fmaxf(sq, __shfl_xor(sq, 8)); sk = fmaxf(sk, __shfl_xor(sk, 8));
            if ((tid & 15) == 0) { wk[tid >> 4] = sk; wq[tid >> 4] = sq; } }
          __syncthreads();
          if (tid < 8) { const int qb = tid; float Qm = 0.f, Kband = 0.f;
              for (int t4 = 0; t4 < 4; ++t4) { Qm = fmaxf(Qm, wq[4 * qb + t4]); Kband = fmaxf(Kband, wk[4 * qb + t4]); }
              Qm = sqrtf(Qm) * 1.005f; Kband = sqrtf(Kband) * 1.005f;
              const float cq0 = cl[256 * qb]; int kt0 = 4 * qb;
              for (int kt = 4 * qb - 1; kt >= 0; --kt) { const float kk = sqrtf(wk[kt]) * 1.005f;
                  const float bound = Qm * (kk + Kband) + (cq0 - cl[64 * kt + 63]) * LOG2E; if (bound >= -40.0f) kt0 = kt; }
              wsp<int>(F, WS_KT0)[id * 8 + qb] = kt0; } }
        __syncthreads(); }
#ifdef PROBE_P2_NOCMP
    if (!probe_second)
#endif
    for (int u = F.vcu; u < 256; u += F.G) p2_compress_unit(F, u);
}

template <bool FINAL>
__device__ __forceinline__ void row_pass(Frame& F, const float* xin_f32, const bf16* xin_b16, const bf16* Y, const float* gpost, float* out_f32, bf16* X1B, float* RSTD2) {
#ifndef RP_FINAL
#define RP_FINAL 4
#endif
    constexpr int RP = FINAL ? RP_FINAL : 4;
    const bool gl_ = (F.G == 256); const int lane = cur_lane();
    const int NGW = gl_ ? 32 * NWAVES : F.G * NWAVES, gw = gl_ ? (F.vcu >> 5) * (MTOK / 8) + (F.vcu & 31) * NWAVES + F.wave : F.vcu * NWAVES + F.wave, mend = gl_ ? ((F.vcu >> 5) + 1) * (MTOK / 8) : MTOK;
    const GAS f32x4* gp = (const GAS f32x4*)gpost + lane;
    f32x4 gpv[4];
#pragma unroll
    for (int j = 0; j < 4; ++j) gpv[j] = gp[64 * j];
    for (int m0 = gw; m0 < mend; m0 += NGW * RP) {
        f32x4 xv[FINAL ? 1 : RP][4]; unsigned long long xw[FINAL ? RP : 1][4]; unsigned long long yw[RP][4];
#pragma unroll
        for (int r = 0; r < RP; ++r) { const size_t m = (size_t)(m0 + r * NGW);
            const GAS unsigned long long* yr = (const GAS unsigned long long*)(Y + m * DMODEL) + lane;
            if (FINAL) { const GAS unsigned long long* xr = (const GAS unsigned long long*)(xin_b16 + m * DMODEL) + lane;
#pragma unroll
                for (int j = 0; j < 4; ++j) { xw[r][j] = RP_LOAD(xr + 64 * j); yw[r][j] = RP_LOAD_Y(yr + 64 * j); }
            } else { const GAS f32x4* xr = (const GAS f32x4*)(xin_f32 + m * DMODEL) + lane;
#pragma unroll
                for (int j = 0; j < 4; ++j) { xv[r][j] = RP_LOAD(xr + 64 * j); yw[r][j] = RP_LOAD_Y(yr + 64 * j); } } }
#pragma unroll
        for (int r = 0; r < RP; ++r) { const size_t m = (size_t)(m0 + r * NGW);
            f32x4 yv[4]; float s = 0.f;
#pragma unroll
            for (int j = 0; j < 4; ++j) { const unsigned lo = (unsigned)yw[r][j], hi = (unsigned)(yw[r][j] >> 32);
                yv[j] = (f32x4){bfl(lo), bfh(lo), bfl(hi), bfh(hi)}; s += (yv[j].x * yv[j].x + yv[j].y * yv[j].y) + (yv[j].z * yv[j].z + yv[j].w * yv[j].w); }
            float eps = RMS_EPS;
            if (FINAL) { const float r2 = RSTD2[m]; eps = RMS_EPS / ((r2 * r2) * (r2 * r2)); }
            const float rr = 1.0f / sqrtf(wave_sum(s) * (1.f / DMODEL) + eps); float s2 = 0.f;
            if (FINAL) { GAS f32x4* xo = (GAS f32x4*)(out_f32 + m * DMODEL) + lane;
#pragma unroll
                for (int j = 0; j < 4; ++j) { const unsigned lo = (unsigned)xw[r][j], hi = (unsigned)(xw[r][j] >> 32); const f32x4 xf = (f32x4){bfl(lo), bfh(lo), bfl(hi), bfh(hi)}; RP_STORE(xf + yv[j] * rr * gpv[j], xo + 64 * j); }
            } else { GAS unsigned long long* o8 = (GAS unsigned long long*)(X1B + m * DMODEL) + lane;
#pragma unroll
                for (int j = 0; j < 4; ++j) { const f32x4 v = xv[r][j] + yv[j] * rr * gpv[j]; s2 += (v.x * v.x + v.y * v.y) + (v.z * v.z + v.w * v.w);
                    o8[64 * j] = (unsigned long long)pk2(v.x, v.y) | ((unsigned long long)pk2(v.z, v.w) << 32); }
                const float r2 = 1.0f / sqrtf(wave_sum(s2) * (1.f / DMODEL) + RMS_EPS); if (lane == 0) RSTD2[m] = r2; }
        }
    }
}

namespace at {
constexpr int KSLOT = 10240, VSLOT = 8192, NSLOT = 3;
constexpr int L_K = 0, L_V = NSLOT * KSLOT, L_WS = L_V + NSLOT * VSLOT, L_PARK = L_WS + 8 * 512, L_PSL = L_PARK, L_CMP = L_PARK + 4 * 64 * 33 * 4, L_SELM = L_CMP + 4 * 8192, L_NEXT = L_SELM + 256, L_END = L_NEXT + 16;
static_assert(L_SELM >= L_PARK + 8 * 8192, "park region");
static_assert(L_END <= RING_BYTES, "attention LDS map");
constexpr float THR = 8.0f;
typedef short s16x4 __attribute__((ext_vector_type(4)));
typedef short v4i16_t __attribute__((ext_vector_type(4)));
#define AT_NEG (-INFINITY)
__device__ __forceinline__ void glds16(const void* sbase, unsigned voff, unsigned lds_dst) { unsigned keep;
    asm volatile("s_mov_b32 %0, m0\n\ts_mov_b32 m0, %3\n\ts_nop 2\n\tglobal_load_lds_dwordx4 %1, %2\n\ts_mov_b32 m0, %0" : "=&s"(keep) : "v"(voff), "s"(sbase), "s"(lds_dst) : "memory"); }
__device__ __forceinline__ void glds4(const void* sbase, unsigned voff, unsigned lds_dst) { unsigned keep;
    asm volatile("s_mov_b32 %0, m0\n\ts_mov_b32 m0, %3\n\ts_nop 2\n\tglobal_load_lds_dword %1, %2\n\ts_mov_b32 m0, %0" : "=&s"(keep) : "v"(voff), "s"(sbase), "s"(lds_dst) : "memory"); }
#define AT_WAIT_BAR(N) asm volatile("s_waitcnt vmcnt(" #N ") lgkmcnt(0)\n\ts_barrier" ::: "memory")
#ifndef AT_PRIO_MODE
#define AT_PRIO_MODE 1
#endif
#define AT_PRIO(w) do { if (AT_PRIO_MODE == 1) { if ((w) < 4) __builtin_amdgcn_s_setprio(2); else __builtin_amdgcn_s_setprio(0); } else if (AT_PRIO_MODE == 2) { if (((w) & 1) == 0) __builtin_amdgcn_s_setprio(2); else __builtin_amdgcn_s_setprio(0); } } while (0)
#define AT_BAR() asm volatile("s_waitcnt lgkmcnt(0)\n\ts_barrier" ::: "memory")
__device__ __forceinline__ unsigned cvtpk(float lo, float hi) { typedef float f2 __attribute__((ext_vector_type(2))); typedef __bf16 b2 __attribute__((ext_vector_type(2))); f2 v = {lo, hi}; b2 b = __builtin_convertvector(v, b2); return __builtin_bit_cast(unsigned, b); }
__device__ __forceinline__ float swap_half(float x, int hi) { auto rr = __builtin_amdgcn_permlane32_swap(__float_as_uint(x), __float_as_uint(x), false, false); return hi ? __uint_as_float(rr[0]) : __uint_as_float(rr[1]); }
__device__ __forceinline__ float max_half(float x) { auto rr = __builtin_amdgcn_permlane32_swap(__float_as_uint(x), __float_as_uint(x), false, false); return fmaxf(__uint_as_float(rr[0]), __uint_as_float(rr[1])); }
__device__ __forceinline__ float sum_half(float x) { auto rr = __builtin_amdgcn_permlane32_swap(__float_as_uint(x), __float_as_uint(x), false, false); return __uint_as_float(rr[0]) + __uint_as_float(rr[1]); }
template <int KS>
__device__ __forceinline__ void qk(f32x16& p0, f32x16& p1, const LAS unsigned char* Kslot, const bf16x8 (&qr)[5], const f32x16& cinit, int r32, int hi) {
    const LAS unsigned char* kb = Kslot + hi * 1024 + r32 * 16;
#pragma unroll
    for (int d0 = 0; d0 < KS; ++d0) { const bf16x8 b0 = *(const LAS bf16x8*)(kb + d0 * 2048), b1 = *(const LAS bf16x8*)(kb + d0 * 2048 + 512);
        if (d0 == 0) { p0 = __builtin_amdgcn_mfma_f32_32x32x16_bf16(b0, qr[0], cinit, 0, 0, 0); p1 = __builtin_amdgcn_mfma_f32_32x32x16_bf16(b1, qr[0], cinit, 0, 0, 0); }
        else { p0 = __builtin_amdgcn_mfma_f32_32x32x16_bf16(b0, qr[d0], p0, 0, 0, 0); p1 = __builtin_amdgcn_mfma_f32_32x32x16_bf16(b1, qr[d0], p1, 0, 0, 0); } }
}
__device__ __forceinline__ s16x4 vtr(const LAS unsigned char* p) { return __builtin_bit_cast(s16x4, __builtin_amdgcn_ds_read_tr16_b64_v4i16((LAS v4i16_t*)p)); }
__device__ __forceinline__ void pv(f32x16 (&o)[2], const LAS unsigned char* vb, const f32x16& p0, const f32x16& p1) {
    v4u pw[4];
#pragma unroll
    for (int k = 0; k < 2; ++k) { pw[k] = (v4u){cvtpk(p0[8 * k], p0[8 * k + 1]), cvtpk(p0[8 * k + 2], p0[8 * k + 3]), cvtpk(p0[8 * k + 4], p0[8 * k + 5]), cvtpk(p0[8 * k + 6], p0[8 * k + 7])};
        pw[2 + k] = (v4u){cvtpk(p1[8 * k], p1[8 * k + 1]), cvtpk(p1[8 * k + 2], p1[8 * k + 3]), cvtpk(p1[8 * k + 4], p1[8 * k + 5]), cvtpk(p1[8 * k + 6], p1[8 * k + 7])}; }
#pragma unroll
    for (int d0 = 0; d0 < 2; ++d0)
#pragma unroll
        for (int ks = 0; ks < 4; ++ks) { const s16x4 lo = vtr(vb + d0 * 4096 + ks * 1024), hi = vtr(vb + d0 * 4096 + ks * 1024 + 512);
            const bf16x8 vf = (bf16x8){lo[0], lo[1], lo[2], lo[3], hi[0], hi[1], hi[2], hi[3]};
            o[d0] = __builtin_amdgcn_mfma_f32_32x32x16_bf16(__builtin_bit_cast(bf16x8, pw[ks]), vf, o[d0], 0, 0, 0); }
}
template <int KS>
__device__ __forceinline__ void load_kf(bf16x8 (&kf)[10], const LAS unsigned char* Kslot, int r32, int hi) {
    const int key = (r32 >> 1) & 7; const LAS unsigned char* kb = Kslot + r32 * 128;
#pragma unroll
    for (int d0 = 0; d0 < (KS < 4 ? KS : 4); ++d0) { const int c = ((2 * d0 + hi) ^ key) * 16; kf[2 * d0] = *(const LAS bf16x8*)(kb + c); kf[2 * d0 + 1] = *(const LAS bf16x8*)(kb + c + 4096); }
    if (KS == 5) { const LAS unsigned char* xb = Kslot + 8192 + hi * 1024 + r32 * 16; kf[8] = *(const LAS bf16x8*)xb; kf[9] = *(const LAS bf16x8*)(xb + 512); }
}
__device__ __forceinline__ void v_load(bf16x8 (&vf)[8], const LAS unsigned char* vb) {
#pragma unroll
    for (int d0 = 0; d0 < 2; ++d0)
#pragma unroll
        for (int ks = 0; ks < 4; ++ks) { const s16x4 lo = vtr(vb + d0 * 4096 + ks * 1024), hi = vtr(vb + d0 * 4096 + ks * 1024 + 512);
            vf[d0 * 4 + ks] = (bf16x8){lo[0], lo[1], lo[2], lo[3], hi[0], hi[1], hi[2], hi[3]}; }
}
template <int KS, bool LOADK>
__device__ __forceinline__ void pv_regs(f32x16 (&o)[2], const bf16x8 (&vf)[8], const f32x16& p0, const f32x16& p1, bf16x8 (&kf)[10], const LAS unsigned char* Knext, int r32, int hi) {
    v4u pw[4];
#pragma unroll
    for (int k = 0; k < 2; ++k) { pw[k] = (v4u){cvtpk(p0[8 * k], p0[8 * k + 1]), cvtpk(p0[8 * k + 2], p0[8 * k + 3]), cvtpk(p0[8 * k + 4], p0[8 * k + 5]), cvtpk(p0[8 * k + 6], p0[8 * k + 7])};
        pw[2 + k] = (v4u){cvtpk(p1[8 * k], p1[8 * k + 1]), cvtpk(p1[8 * k + 2], p1[8 * k + 3]), cvtpk(p1[8 * k + 4], p1[8 * k + 5]), cvtpk(p1[8 * k + 6], p1[8 * k + 7])}; }
#pragma unroll
    for (int ks = 0; ks < 2; ++ks)
#pragma unroll
        for (int d0 = 0; d0 < 2; ++d0) o[d0] = __builtin_amdgcn_mfma_f32_32x32x16_bf16(__builtin_bit_cast(bf16x8, pw[ks]), vf[d0 * 4 + ks], o[d0], 0, 0, 0);
    if (LOADK) { __builtin_amdgcn_sched_barrier(0); load_kf<KS>(kf, Knext, r32, hi); __builtin_amdgcn_sched_barrier(0); }
#pragma unroll
    for (int ks = 2; ks < 4; ++ks)
#pragma unroll
        for (int d0 = 0; d0 < 2; ++d0) o[d0] = __builtin_amdgcn_mfma_f32_32x32x16_bf16(__builtin_bit_cast(bf16x8, pw[ks]), vf[d0 * 4 + ks], o[d0], 0, 0, 0);
}
__device__ __forceinline__ float max3f(float a, float b, float c) { float r; asm("v_max3_f32 %0, %1, %2, %3" : "=v"(r) : "v"(a), "v"(b), "v"(c)); return r; }
__device__ __forceinline__ float rowmax32(const f32x16& p0, const f32x16& p1) {
    float a = max3f(p0[0], p0[1], p1[0]), b = max3f(p0[2], p0[3], p1[1]); a = max3f(a, p1[2], p1[3]);
#pragma unroll
    for (int r = 4; r < 16; r += 4) { a = max3f(a, p0[r], p0[r + 1]); b = max3f(b, p0[r + 2], p0[r + 3]); a = max3f(a, p1[r], p1[r + 1]); b = max3f(b, p1[r + 2], p1[r + 3]); }
    return max_half(__builtin_fmaxf(a, b));
}
template <bool FIRST>
__device__ __forceinline__ void softmax_tile(f32x16& p0, f32x16& p1, f32x16& cinit, float& l, f32x16 (&o)[2], LAS float* wsf, int r32, int hi) {
    const float rm = rowmax32(p0, p1);
    bool resc = false;
    if (FIRST) { const float dl = rm;
#pragma unroll
        for (int r = 0; r < 16; ++r) { p0[r] -= dl; p1[r] -= dl; cinit[r] -= dl; } }
    else if (__any(rm > THR)) { const float dl = fmaxf(rm, 0.f);
#pragma unroll
        for (int r = 0; r < 16; ++r) { p0[r] -= dl; p1[r] -= dl; cinit[r] -= dl; }
        const float f = __builtin_amdgcn_exp2f(-dl); l *= f; if (hi == 0) wsf[r32] = f; resc = true; }
    float s = 0.f;
#pragma unroll
    for (int r = 0; r < 16; ++r) { p0[r] = __builtin_amdgcn_exp2f(p0[r]); p1[r] = __builtin_amdgcn_exp2f(p1[r]); s += p0[r] + p1[r]; }
    l += s;
    if (resc) {
#pragma unroll
        for (int i = 0; i < 4; ++i) { const f32x4 f4 = *(const LAS f32x4*)(wsf + 8 * i + 4 * hi);
#pragma unroll
            for (int k = 0; k < 4; ++k) { o[0][4 * i + k] *= f4[k]; o[1][4 * i + k] *= f4[k]; } } }
}
__device__ __forceinline__ void row_bcast(float v, float (&out)[16], LAS float* wsf, int r32, int hi) {
    asm volatile("s_waitcnt lgkmcnt(0)" ::: "memory");
    if (hi == 0) wsf[32 + r32] = v;
#pragma unroll
    for (int i = 0; i < 4; ++i) { const f32x4 f4 = *(const LAS f32x4*)(wsf + 32 + 8 * i + 4 * hi);
#pragma unroll
        for (int k = 0; k < 4; ++k) out[4 * i + k] = f4[k]; }
    asm volatile("s_waitcnt lgkmcnt(0)" ::: "memory");
}
__device__ __forceinline__ void store_rows(const f32x16 (&v)[2], LAS unsigned char* stg_, bf16* Ow, int pitch, int lane, int r32, int hi) {
    LAS bf16* stg = (LAS bf16*)stg_;
#pragma unroll
    for (int r = 0; r < 16; ++r) { const int orow = crow(r, hi);
#pragma unroll
        for (int d0 = 0; d0 < 2; ++d0) stg[orow * 64 + d0 * 32 + r32] = (bf16)f2bf(v[d0][r]); }
    asm volatile("s_waitcnt lgkmcnt(0)" ::: "memory");
#pragma unroll
    for (int i = 0; i < 4; ++i) { const int row = i * 8 + (lane >> 3), ch = lane & 7; const v4u w = *(const LAS v4u*)(stg + row * 64 + ch * 8); *(GAS v4u*)(Ow + (size_t)row * pitch + ch * 8) = w; }
    asm volatile("s_waitcnt lgkmcnt(0)" ::: "memory");
}


template <int KS>
__device__ __forceinline__ void qk_regs(f32x16& p0, f32x16& p1, const bf16x8 (&kf)[10], const bf16x8 (&qr)[5], const f32x16& cinit) {
    p0 = __builtin_amdgcn_mfma_f32_32x32x16_bf16(kf[0], qr[0], cinit, 0, 0, 0); p1 = __builtin_amdgcn_mfma_f32_32x32x16_bf16(kf[1], qr[0], cinit, 0, 0, 0);
#pragma unroll
    for (int d0 = 1; d0 < KS; ++d0) { p0 = __builtin_amdgcn_mfma_f32_32x32x16_bf16(kf[2 * d0], qr[d0], p0, 0, 0, 0); p1 = __builtin_amdgcn_mfma_f32_32x32x16_bf16(kf[2 * d0 + 1], qr[d0], p1, 0, 0, 0); }
}
__device__ __forceinline__ void softmax_first(f32x16& p0, f32x16& p1, f32x16& cinit, float& l) {
    const float dl = rowmax32(p0, p1); float s = 0.f;
#pragma unroll
    for (int r = 0; r < 16; ++r) { cinit[r] -= dl; p0[r] = __builtin_amdgcn_exp2f(p0[r] - dl); p1[r] = __builtin_amdgcn_exp2f(p1[r] - dl); s += p0[r] + p1[r]; }
    l = s;
}
__device__ __forceinline__ void softmax_next(f32x16& p0, f32x16& p1, f32x16& cinit, float& l, f32x16 (&o)[2], LAS float* wsf, int r32, int hi) {
    const float rm = rowmax32(p0, p1);
    if (__builtin_expect(__any(rm > THR), 0)) { const float dl = __builtin_fmaxf(rm, 0.f);
#pragma unroll
        for (int r = 0; r < 16; ++r) { p0[r] -= dl; p1[r] -= dl; cinit[r] -= dl; }
        const float f = __builtin_amdgcn_exp2f(-dl); l *= f; if (hi == 0) wsf[r32] = f;
#pragma unroll
        for (int i = 0; i < 4; ++i) { const f32x4 f4 = *(const LAS f32x4*)(wsf + 8 * i + 4 * hi);
#pragma unroll
            for (int k = 0; k < 4; ++k) { o[0][4 * i + k] *= f4[k]; o[1][4 * i + k] *= f4[k]; } } }
    float s = 0.f;
#pragma unroll
    for (int r = 0; r < 16; ++r) { p0[r] = __builtin_amdgcn_exp2f(p0[r]); p1[r] = __builtin_amdgcn_exp2f(p1[r]); s += p0[r] + p1[r]; }
    l += s;
}

#define AT_CONSUME4(a, b, c, d) asm volatile("" :: "v"(a), "v"(b), "v"(c), "v"(d))

__device__ __forceinline__ void fox_unit(Frame& F, int bh, int qb, int kt0, const int ABL) {
    int tid_ = cur_tid(F); asm volatile("" : "+v"(tid_));
    AT_PRIO(F.wave);
    const int lane = tid_ & 63, r32 = lane & 31, hi = lane >> 5, wid = F.wave; const int b = bh >> 3, h = bh & 7;
    LAS unsigned char* shm = F.lds + RING_OFF; const unsigned lds0 = (unsigned)(uintptr_t)shm;
    LAS float* wsf = (LAS float*)(shm + L_WS + wid * 512);
    const size_t rowbase = (size_t)b * SEQ; const int q0 = qb * 256;
    const bf16* Q = (const bf16*)(F.ws + qb_off(0, rowbase)) - rowbase * 512; const bf16* K = (const bf16*)(F.ws + qb_off(1, rowbase + (size_t)kt0 * 64)) + h * 64; const bf16* V = (const bf16*)(F.ws + qb_off(2, rowbase + (size_t)kt0 * 64)) + h * 64;
    const bf16* KX = (const bf16*)(F.ws + fkx_off(bh)) + (size_t)kt0 * 64 * 16;
    const int krow_ = 8 * wid + (lane >> 3);
    const unsigned koff = (unsigned)(krow_ * 512 + (((lane & 7) ^ ((krow_ >> 1) & 7)) * 8)) * 2u, voff = (unsigned)((16 * (wid & 3) + (lane >> 2)) * 512 + (wid >> 2) * 32 + (lane & 3) * 8) * 2u;
    const unsigned xoff = (unsigned)((16 * (wid & 3) + (lane >> 2)) * 16 + (wid >> 2) * 8 + (lane & 3) * 2) * 2u;
    const unsigned kdst = lds0 + L_K + wid * 1024, vdst = lds0 + L_V + wid * 1024, xdst = lds0 + L_K + (8 + (wid >> 2)) * 1024 + (wid & 3) * 256;
#define FX_DMA_K(t, slot) do { glds16(K + (size_t)(t) * 64 * 512, koff, (unsigned)__builtin_amdgcn_readfirstlane(kdst + (slot) * KSLOT)); \
        glds4(KX + (size_t)(t) * 64 * 16, xoff, (unsigned)__builtin_amdgcn_readfirstlane(xdst + (slot) * KSLOT)); } while (0)
#define FX_DMA_V(t, slot) glds16(V + (size_t)(t) * 64 * 512, voff, (unsigned)__builtin_amdgcn_readfirstlane(vdst + (slot) * VSLOT))
    const int NT = 4 * qb + 4 - kt0;
    bf16x8 qr[5];
    { const bf16* Qw = Q + (rowbase + q0 + wid * 32 + r32) * 512 + h * 64;
#pragma unroll
      for (int d0 = 0; d0 < 4; ++d0) { if (ABL == 10) { qr[d0] = (bf16x8){(short)lane, 0, 0, 0, 0, 0, 0, 0}; asm volatile("" : "+v"(qr[d0])); } else qr[d0] = *(const GAS bf16x8*)(Qw + d0 * 16 + hi * 8); }
      const short one = (short)0x3F80; qr[4] = hi == 0 ? (bf16x8){one, one, one, 0, 0, 0, 0, 0} : (bf16x8){0, 0, 0, 0, 0, 0, 0, 0}; }
    const float ct = wsp<float>(F, WS_C)[(size_t)bh * SEQ + q0 + wid * 32 + r32] * LOG2E;
    asm volatile("" ::: "memory");
    if (ABL == 11) { FX_DMA_K(0, 0); FX_DMA_K(1, 1); FX_DMA_K(2, 2); } else if (ABL == 12) { FX_DMA_V(0, 0); FX_DMA_V(1, 1); } else if (ABL != 9) { FX_DMA_K(0, 0); FX_DMA_V(0, 0); FX_DMA_K(1, 1); FX_DMA_K(2, 2); FX_DMA_V(1, 1); }
    f32x16 cinit;
    f32x16 o[2]; o[0] = f32x16{}; o[1] = f32x16{}; float l = 0.f;
    const int qrel = wid * 32 + r32;
    const LAS unsigned char* vtb = shm + L_V + ((lane >> 4) & 1) * 32 + (lane & 3) * 8 + (4 * hi + ((lane & 15) >> 2)) * 64;
    bf16x8 kf[10], vf[8];
    AT_WAIT_BAR(3);
    AT_CONSUME4(qr[0], qr[1], qr[2], qr[3]); asm volatile("" :: "v"(ct));
#pragma unroll
    for (int r = 0; r < 16; ++r) cinit[r] = ct;
    load_kf<5>(kf, shm + L_K, r32, hi);
    int s0 = 0, s1 = 1, s2 = 2;
#define FX_MASK(n) do { const int jb_ = (n) - (NT - 4); if (jb_ >= 0) { const int kb_ = 64 * jb_ + 4 * hi; \
        _Pragma("unroll") for (int r = 0; r < 16; ++r) { const int kv = kb_ + (r & 3) + 8 * (r >> 2); if (kv > qrel) p0[r] = AT_NEG; if (kv + 32 > qrel) p1[r] = AT_NEG; } } } while (0)
#define FX_ROT() do { const int t_ = s0; s0 = s1; s1 = s2; s2 = t_; } while (0)
    if (ABL < 7) {
    {
      AT_WAIT_BAR(3); FX_DMA_K(3, 0); FX_DMA_V(2, 2);
      f32x16 p0, p1; qk_regs<5>(p0, p1, kf, qr, cinit); v_load(vf, vtb); __builtin_amdgcn_sched_barrier(0);
      FX_MASK(0); softmax_first(p0, p1, cinit, l); pv_regs<5, true>(o, vf, p0, p1, kf, shm + L_K + KSLOT, r32, hi); FX_ROT(); }
    int n = 1;
    for (; n + 3 < NT; ++n) {
        if (ABL == 4) asm volatile("s_waitcnt vmcnt(3) lgkmcnt(0)" ::: "memory"); else AT_WAIT_BAR(3);
        if (ABL != 5) { FX_DMA_K(n + 3, s0); FX_DMA_V(n + 2, s2); }
        f32x16 p0, p1; if (ABL == 3) { p0 = cinit; p1 = cinit; asm volatile("" : "+v"(p0), "+v"(p1)); } else qk_regs<5>(p0, p1, kf, qr, cinit);
        v_load(vf, vtb + s0 * VSLOT); __builtin_amdgcn_sched_barrier(0);
        FX_MASK(n);
        if (ABL == 6) { asm volatile("" : "+v"(p0), "+v"(p1)); }
        else if (ABL == 1) { const float rm = rowmax32(p0, p1); l += rm; asm volatile("" : "+v"(p0), "+v"(p1)); }
        else softmax_next(p0, p1, cinit, l, o, wsf, r32, hi);
        if (ABL == 2) { asm volatile("" :: "v"(p0), "v"(p1), "v"(vf[0]), "v"(vf[1]), "v"(vf[2]), "v"(vf[3]), "v"(vf[4]), "v"(vf[5]), "v"(vf[6]), "v"(vf[7])); load_kf<5>(kf, shm + L_K + s1 * KSLOT, r32, hi); }
        else pv_regs<5, true>(o, vf, p0, p1, kf, shm + L_K + s1 * KSLOT, r32, hi);
        FX_ROT(); }
    {
      AT_WAIT_BAR(3); FX_DMA_V(n + 2, s2);
      f32x16 p0, p1; qk_regs<5>(p0, p1, kf, qr, cinit); v_load(vf, vtb + s0 * VSLOT); __builtin_amdgcn_sched_barrier(0);
      FX_MASK(n); softmax_next(p0, p1, cinit, l, o, wsf, r32, hi); pv_regs<5, true>(o, vf, p0, p1, kf, shm + L_K + s1 * KSLOT, r32, hi); FX_ROT(); ++n; }
    {
      AT_WAIT_BAR(1);
      f32x16 p0, p1; qk_regs<5>(p0, p1, kf, qr, cinit); v_load(vf, vtb + s0 * VSLOT); __builtin_amdgcn_sched_barrier(0);
      FX_MASK(n); softmax_next(p0, p1, cinit, l, o, wsf, r32, hi); pv_regs<5, true>(o, vf, p0, p1, kf, shm + L_K + s1 * KSLOT, r32, hi); FX_ROT(); ++n; }
    {
      AT_WAIT_BAR(0);
      f32x16 p0, p1; qk_regs<5>(p0, p1, kf, qr, cinit); v_load(vf, vtb + s0 * VSLOT); __builtin_amdgcn_sched_barrier(0);
      FX_MASK(n); softmax_next(p0, p1, cinit, l, o, wsf, r32, hi); pv_regs<5, false>(o, vf, p0, p1, kf, shm, r32, hi); }
    } else { asm volatile("s_waitcnt vmcnt(0)" ::: "memory"); l = 1.f; }
#undef FX_DMA_K
#undef FX_DMA_V
#undef FX_MASK
#undef FX_ROT
    l = sum_half(l); float rl[16]; row_bcast(1.0f / l, rl, wsf, r32, hi);
#pragma unroll
    for (int r = 0; r < 16; ++r) { o[0][r] *= rl[r]; o[1][r] *= rl[r]; }
    if (ABL != 8) store_rows(o, shm + L_PARK + wid * 8192, wsp<bf16>(F, ABL ? WS_PROBE_O : WS_ATT) + (rowbase + q0 + wid * 32) * 1024 + 512 + h * 64, 1024, lane, r32, hi);
    AT_BAR();
}

__device__ __forceinline__ void nsa_unit(Frame& F, int bg, int j, const int ABL) {
    int tid_ = cur_tid(F); asm volatile("" : "+v"(tid_));
    AT_PRIO(F.wave);
    const int tid = tid_, lane = tid & 63, r32 = lane & 31, hi = lane >> 5, wid = F.wave; const int b = bg >> 1, g = bg & 1, hh = wid >> 1, head = 4 * g + hh;
    LAS unsigned char* shm = F.lds + RING_OFF; const unsigned lds0 = (unsigned)(uintptr_t)shm;
    LAS float* wsf = (LAS float*)(shm + L_WS + wid * 512);
    LAS float* PSL = (LAS float*)(shm + L_PSL); LAS unsigned* SELM = (LAS unsigned*)(shm + L_SELM);
    const int qrel = 32 * (wid & 1) + r32, t = 64 * j + qrel; const size_t row = (size_t)b * SEQ + t;
    const bf16* KC = wsp<bf16>(F, WS_KCMP) + (size_t)bg * 128 * 64; const bf16* VC = wsp<bf16>(F, WS_VCMP) + (size_t)bg * 128 * 64;
    const bf16* KS = wsp<bf16>(F, WS_KV + 2 * KV_STRIDE) + (size_t)bg * SEQ * 64; const bf16* VS = wsp<bf16>(F, WS_KV + 3 * KV_STRIDE) + (size_t)bg * SEQ * 64;
    const bf16* KW = wsp<bf16>(F, WS_KV + 4 * KV_STRIDE) + (size_t)bg * SEQ * 64; const bf16* VW = wsp<bf16>(F, WS_KV + 5 * KV_STRIDE) + (size_t)bg * SEQ * 64;
    const int krow_ = 8 * wid + (lane >> 3);
    const unsigned koff = (unsigned)(krow_ * 64 + (((lane & 7) ^ ((krow_ >> 1) & 7)) * 8)) * 2u, voff = (unsigned)((16 * (wid & 3) + (lane >> 2)) * 64 + (wid >> 2) * 32 + (lane & 3) * 8) * 2u;
    const unsigned kdst = lds0 + L_K + wid * 1024, vdst = lds0 + L_V + wid * 1024, cdst = lds0 + L_CMP + wid * 1024;
    const int nsel = j + 1, nwin = j >= 8 ? 9 : j + 1, NR = nsel + nwin;
#define NS_TILE(m) ({ int m_ = (m); m_ = m_ < NR ? m_ : NR - 1; (m_ < nsel) ? m_ : (j - (m_ - nsel)) + 64; })
#define NS_DMA_K(m, slot) do { const int e_ = NS_TILE(m); const bf16* kp_ = (e_ < 64) ? KS + e_ * 4096 : KW + (e_ - 64) * 4096; glds16(kp_, koff, (unsigned)__builtin_amdgcn_readfirstlane(kdst + (slot) * KSLOT)); } while (0)
#define NS_DMA_V(m, slot) do { const int e_ = NS_TILE(m); const bf16* vp_ = (e_ < 64) ? VS + e_ * 4096 : VW + (e_ - 64) * 4096; glds16(vp_, voff, (unsigned)__builtin_amdgcn_readfirstlane(vdst + (slot) * VSLOT)); } while (0)
    bf16x8 qr[5];
    { const bf16* Qw = (const bf16*)(F.ws + qb_off(3, row)) + head * 64;
#pragma unroll
      for (int d0 = 0; d0 < 4; ++d0) qr[d0] = *(const GAS bf16x8*)(Qw + d0 * 16 + hi * 8);
      qr[4] = (bf16x8){0, 0, 0, 0, 0, 0, 0, 0}; }
    const float* gt = wsp<float>(F, WS_GATE) + row * 24 + head * 3; const float g0 = gt[0], g1 = gt[1], g2 = gt[2];
    asm volatile("" ::: "memory");
    if (ABL != 7) {
    glds16(KC, koff, (unsigned)__builtin_amdgcn_readfirstlane(cdst)); glds16(KC + 4096, koff, (unsigned)__builtin_amdgcn_readfirstlane(cdst + 8192));
    glds16(VC, voff, (unsigned)__builtin_amdgcn_readfirstlane(cdst + 16384)); glds16(VC + 4096, voff, (unsigned)__builtin_amdgcn_readfirstlane(cdst + 24576));
    NS_DMA_K(0, 0); NS_DMA_V(0, 0); NS_DMA_K(1, 1); NS_DMA_K(2, 2); NS_DMA_V(1, 1); }
    const LAS unsigned char* vlane = shm + ((lane >> 4) & 1) * 32 + (lane & 3) * 8 + (4 * hi + ((lane & 15) >> 2)) * 64;
    const LAS unsigned char* vtb = vlane + L_V;
    f32x16 o[2]; float rs[16]; bf16x8 kf[10], vf[8];
    LAS float* park = (LAS float*)(shm + L_PARK + wid * 8192) + lane;
    AT_WAIT_BAR(5);
    AT_CONSUME4(qr[0], qr[1], qr[2], qr[3]); asm volatile("" :: "v"(g0), "v"(g1), "v"(g2));
    o[0] = f32x16{}; o[1] = f32x16{};
    if (ABL != 4 && ABL < 5) { f32x16 zero = f32x16{}; f32x16 a0, a1, b0, b1;
      load_kf<4>(kf, shm + L_CMP, r32, hi); qk_regs<4>(a0, a1, kf, qr, zero); load_kf<4>(kf, shm + L_CMP + 8192, r32, hi); qk_regs<4>(b0, b1, kf, qr, zero);
      const int nmax = (t - 31) >> 4;
#pragma unroll
      for (int r = 0; r < 16; ++r) { const int n = (r & 3) + 8 * (r >> 2) + 4 * hi; if (n > nmax) a0[r] = AT_NEG; if (n + 32 > nmax) a1[r] = AT_NEG; if (n + 64 > nmax) b0[r] = AT_NEG; if (n + 96 > nmax) b1[r] = AT_NEG; }
      float m = __builtin_fmaxf(rowmax32(a0, a1), rowmax32(b0, b1)); m = (m == AT_NEG) ? 0.f : m;
      float s = 0.f;
#pragma unroll
      for (int r = 0; r < 16; ++r) { a0[r] = __builtin_amdgcn_exp2f(a0[r] - m); a1[r] = __builtin_amdgcn_exp2f(a1[r] - m); b0[r] = __builtin_amdgcn_exp2f(b0[r] - m); b1[r] = __builtin_amdgcn_exp2f(b1[r] - m); s += (a0[r] + a1[r]) + (b0[r] + b1[r]); }
      s = sum_half(s); const float inv = 1.0f / fmaxf(s, 1e-30f);
#pragma unroll
      for (int r = 0; r < 16; ++r) { a0[r] *= inv; a1[r] *= inv; b0[r] *= inv; b1[r] *= inv; }
      if (j >= 8) {
          float G[16], Lp[16];
#pragma unroll
          for (int i = 0; i < 4; ++i) { G[i] = (a0[4 * i] + a0[4 * i + 1]) + (a0[4 * i + 2] + a0[4 * i + 3]); G[4 + i] = (a1[4 * i] + a1[4 * i + 1]) + (a1[4 * i + 2] + a1[4 * i + 3]);
              G[8 + i] = (b0[4 * i] + b0[4 * i + 1]) + (b0[4 * i + 2] + b0[4 * i + 3]); G[12 + i] = (b1[4 * i] + b1[4 * i + 1]) + (b1[4 * i + 2] + b1[4 * i + 3]);
              Lp[i] = swap_half(a0[4 * i + 3], hi); Lp[4 + i] = swap_half(a1[4 * i + 3], hi); Lp[8 + i] = swap_half(b0[4 * i + 3], hi); Lp[12 + i] = swap_half(b1[4 * i + 3], hi); }
          LAS float* dst = PSL + (hh * 64 + qrel) * 33 + hi;
#pragma unroll
          for (int I = 0; I < 16; ++I) { const float prev = hi ? Lp[I] : (I > 0 ? Lp[I > 0 ? I - 1 : 0] : 0.f); dst[2 * I] = G[I] + prev; }
      }
      o[0] = f32x16{}; o[1] = f32x16{};
      pv(o, vlane + L_CMP + 16384, a0, a1); pv(o, vlane + L_CMP + 24576, b0, b1);
    }
    AT_BAR();
    if (j >= 8 && ABL != 3) { const int q = tid >> 3, sub = tid & 7;
        float v[4]; unsigned bits = 1u | (1u << j) | (1u << (j - 1));
#pragma unroll
        for (int c4 = 0; c4 < 4; ++c4) { const int k = 4 * sub + c4;
            const float ps = (PSL[(0 * 64 + q) * 33 + k] + PSL[(1 * 64 + q) * 33 + k]) + (PSL[(2 * 64 + q) * 33 + k] + PSL[(3 * 64 + q) * 33 + k]);
            v[c4] = (k > j - 2 || k == 0) ? -1e30f : ps; }
#pragma unroll 1
        for (int rnd = 0; rnd < 5; ++rnd) {
            float bv = v[0]; int bi = 4 * sub;
#pragma unroll
            for (int c4 = 1; c4 < 4; ++c4) if (v[c4] > bv) { bv = v[c4]; bi = 4 * sub + c4; }
#pragma unroll
            for (int o = 1; o < 8; o <<= 1) { const float ov = __shfl_xor(bv, o); const int oi = __shfl_xor(bi, o); if (ov > bv || (ov == bv && oi < bi)) { bv = ov; bi = oi; } }
            bits |= 1u << bi;
#pragma unroll
            for (int c4 = 0; c4 < 4; ++c4) if (bi == 4 * sub + c4) v[c4] = -3.0e38f; }
        if (sub == 0) SELM[q] = bits;
    } else { if (tid < 64) SELM[tid] = (2u << j) - 1u; }
    AT_BAR();
    const unsigned selm = SELM[qrel];
    row_bcast(g0, rs, wsf, r32, hi);
#pragma unroll
    for (int r = 0; r < 16; ++r) { park[r * 64] = o[0][r] * rs[r]; park[(16 + r) * 64] = o[1][r] * rs[r]; }
    f32x16 cinit; float l;
    AT_WAIT_BAR(2);
    load_kf<4>(kf, shm + L_K, r32, hi);
    int s0 = 0, s1 = 1, s2 = 2, m = 0;
#define NS_ROT() do { const int t_ = s0; s0 = s1; s1 = s2; s2 = t_; ++m; } while (0)
#define NS_HEAD() AT_WAIT_BAR(2); NS_DMA_K(m + 3, s0); NS_DMA_V(m + 2, s2); f32x16 p0, p1; qk_regs<4>(p0, p1, kf, qr, cinit); v_load(vf, vtb + s0 * VSLOT); __builtin_amdgcn_sched_barrier(0)
#define NS_MASK_SEL() do { const float keep_ = ((selm >> m) & 1u) ? 0.f : AT_NEG;        \
        if (ABL != 1) { _Pragma("unroll") for (int r = 0; r < 16; ++r) { p0[r] += keep_; p1[r] += keep_; } } \
        if (m == j) {   \
        _Pragma("unroll") for (int r = 0; r < 16; ++r) { const int kk = (r & 3) + 8 * (r >> 2) + 4 * hi; if (kk > qrel) p0[r] = AT_NEG; if (kk + 32 > qrel) p1[r] = AT_NEG; } } } while (0)
#define NS_MASK_WIN() do { const int tt = j - (m - nsel); if (tt == j) { \
        _Pragma("unroll") for (int r = 0; r < 16; ++r) { const int kk = (r & 3) + 8 * (r >> 2) + 4 * hi; if (kk > qrel) p0[r] = AT_NEG; if (kk + 32 > qrel) p1[r] = AT_NEG; } } \
      else if (tt == j - 8) {   \
        _Pragma("unroll") for (int r = 0; r < 16; ++r) { const int kk = (r & 3) + 8 * (r >> 2) + 4 * hi; if (kk <= qrel) p0[r] = AT_NEG; if (kk + 32 <= qrel) p1[r] = AT_NEG; } } } while (0)
    cinit = f32x16{}; o[0] = f32x16{}; o[1] = f32x16{};
    l = 1.f;
    if (ABL != 2 && ABL < 5) {
    { NS_HEAD(); NS_MASK_SEL(); softmax_first(p0, p1, cinit, l); pv_regs<4, true>(o, vf, p0, p1, kf, shm + L_K + s1 * KSLOT, r32, hi); NS_ROT(); }
    for (; m < nsel;) { NS_HEAD(); NS_MASK_SEL(); softmax_next(p0, p1, cinit, l, o, wsf, r32, hi); pv_regs<4, true>(o, vf, p0, p1, kf, shm + L_K + s1 * KSLOT, r32, hi); NS_ROT(); }
    }
    l = sum_half(l); row_bcast(g1 / l, rs, wsf, r32, hi);
#pragma unroll
    for (int r = 0; r < 16; ++r) { park[r * 64] += o[0][r] * rs[r]; park[(16 + r) * 64] += o[1][r] * rs[r]; }
    cinit = f32x16{}; o[0] = f32x16{}; o[1] = f32x16{};
    l = 1.f;
    if (ABL != 2 && ABL < 5) {
    { NS_HEAD(); NS_MASK_WIN(); softmax_first(p0, p1, cinit, l); pv_regs<4, true>(o, vf, p0, p1, kf, shm + L_K + s1 * KSLOT, r32, hi); NS_ROT(); }
    for (; m < NR;) { NS_HEAD(); NS_MASK_WIN(); softmax_next(p0, p1, cinit, l, o, wsf, r32, hi); pv_regs<4, true>(o, vf, p0, p1, kf, shm + L_K + s1 * KSLOT, r32, hi); NS_ROT(); }
    }
#undef NS_HEAD
#undef NS_TILE
#undef NS_DMA_K
#undef NS_DMA_V
#undef NS_ROT
#undef NS_MASK_SEL
#undef NS_MASK_WIN
    l = sum_half(l); row_bcast(g2 / l, rs, wsf, r32, hi);
#pragma unroll
    for (int r = 0; r < 16; ++r) { o[0][r] = park[r * 64] + o[0][r] * rs[r]; o[1][r] = park[(16 + r) * 64] + o[1][r] * rs[r]; }
    asm volatile("s_waitcnt vmcnt(0) lgkmcnt(0)" ::: "memory");
    if (ABL != 6) store_rows(o, shm + L_PARK + wid * 8192, wsp<bf16>(F, ABL ? WS_PROBE_O : WS_ATT) + ((size_t)b * SEQ + 64 * j + 32 * (wid & 1)) * 1024 + head * 64, 1024, lane, r32, hi);
    AT_BAR();
}
constexpr int NUNITS = 4096;
__device__ const unsigned short BLK_TAB[64] = {64512, 63489, 62466, 61443, 60420, 59397, 58374, 57351, 56328, 55305, 54282, 53259, 52236, 51213, 50190, 49167, 48144, 47121, 46098, 45075, 44052, 43029, 42006, 40983, 39960, 38937, 37914, 36891, 35868, 2077, 2077, 2077, 2077, 3105, 3105, 3105, 3105, 4133, 4133, 4133, 4133, 5161, 5161, 5161, 5161, 6189, 6189, 6189, 6189, 7217, 7217, 7217, 7217, 34869, 1078, 1078, 1078, 1078, 33850, 32827, 60, 60, 60, 60};
__device__ const unsigned char NSJ[256] = {14, 21, 11, 0, 18, 23, 22, 19, 1, 16, 4, 28, 2, 8, 7, 10, 24, 30, 9, 15, 17, 13, 5, 25, 27, 20, 26, 3, 12, 29, 31, 6, 11, 27, 8, 10, 7, 21, 18, 14, 29, 28, 26, 1, 17, 20, 6, 23, 22, 5, 12, 19, 16, 3, 2, 25, 9, 30, 31, 15, 13, 24, 0, 4, 4, 11, 20, 8, 15, 6, 13, 29, 23, 0, 18, 17, 24, 14, 25, 7, 9, 28, 16, 1, 31, 30, 21, 3, 12, 10, 22, 26, 2, 5, 19, 27, 22, 31, 13, 10, 16, 19, 14, 9, 15, 27, 3, 20, 21, 4, 12, 11, 6, 5, 2, 28, 29, 24, 25, 23, 17, 26, 1, 30, 18, 7, 0, 8, 27, 1, 23, 22, 15, 7, 30, 4, 8, 24, 19, 25, 5, 12, 0, 21, 18, 29, 28, 9, 13, 31, 11, 2, 16, 6, 17, 3, 20, 14, 10, 26, 27, 7, 26, 23, 29, 16, 6, 8, 18, 0, 12, 15, 14, 22, 31, 25, 24, 5, 10, 11, 21, 20, 28, 19, 13, 4, 1, 9, 17, 3, 30, 2, 0, 25, 3, 21, 11, 5, 6, 19, 9, 23, 29, 18, 13, 12, 24, 28, 17, 8, 20, 30, 1, 2, 4, 15, 16, 7, 22, 14, 31, 27, 10, 26, 21, 4, 17, 28, 6, 23, 11, 18, 19, 12, 14, 3, 29, 26, 22, 0, 2, 15, 24, 10, 1, 5, 31, 13, 7, 20, 8, 25, 9, 16, 30, 27};
}
#ifndef PROBE_ABL
#define PROBE_ABL 0
#endif
__device__ __forceinline__ void p3_attention(Frame& F, const int MODE) {
    const int G = F.G, c = F.vcu; const bool xl = (G == 256); const int nrounds = xl ? 16 : (at::NUNITS + G - 1) / G;
    const gu32* KT0 = (const gu32*)wsp<unsigned>(F, WS_KT0);
    const int xq = c >> 5, kq = c & 31;
#ifndef P3_ORDER
#define P3_ORDER 0
#endif
#define P3_DESC(i, ty_, ix_, pa_) do { if (xl) { const int r_ = P3_ORDER == 1 ? ((i) >> 1) : ((i) & 7); const bool ns_ = P3_ORDER == 1 ? (((i) & 1) == 0) : (P3_ORDER == 2 ? ((i) >= 8) : (P3_ORDER == 3 ? (((i) < 8) != ((xq & 1) != 0)) : ((i) < 8))); if ((i) >= 16) { ty_ = -1; ix_ = 0; pa_ = 0; } else if (ns_) { ty_ = 1; ix_ = 8 * xq + r_; pa_ = (int)at::NSJ[r_ * 32 + kq]; } else { ty_ = 0; ix_ = 32 * xq + 4 * r_ + (kq >> 3); pa_ = (kq + r_) & 7; } } \
        else { const int u_ = (i) * G + (((i) & 1) ? G - 1 - c : c); if ((i) < nrounds && u_ < at::NUNITS) { const unsigned tb_ = at::BLK_TAB[u_ >> 6]; ty_ = (int)(tb_ >> 15); ix_ = u_ - (int)(tb_ & 1023u) * 64; pa_ = (int)((tb_ >> 10) & 31u); } else { ty_ = -1; ix_ = 0; pa_ = 0; } } } while (0)
    unsigned kt_next = 0u;
    { int ty, ix, pa; P3_DESC(0, ty, ix, pa); if (ty == 0) kt_next = __hip_atomic_load(KT0 + ix * 8 + pa, RLX_AGENT); }
    for (int i = 0; i < nrounds; ++i) {
        int ty, ix, pa; P3_DESC(i, ty, ix, pa); if (ty < 0) continue;
        const int kt0 = __builtin_amdgcn_readfirstlane((int)kt_next);
        { int ty2, ix2, pa2; P3_DESC(i + 1, ty2, ix2, pa2); if (ty2 == 0) kt_next = __hip_atomic_load(KT0 + ix2 * 8 + pa2, RLX_AGENT); }
        if (ty) { if (MODE != 1 && MODE != 5) at::nsa_unit(F, ix, pa, MODE == 2 ? PROBE_ABL : 0); } else { if (MODE != 2 && MODE != 5) at::fox_unit(F, ix, pa, kt0, MODE == 1 ? PROBE_ABL : 0); }
    }
#undef P3_DESC
    if (AT_PRIO_MODE != 0) __builtin_amdgcn_s_setprio(0);
    asm volatile("s_waitcnt vmcnt(0) lgkmcnt(0)" ::: "memory");
    __syncthreads();
}

struct Args { const float* in[18]; float* out; unsigned char* ws; int ph_lo, ph_hi, li, pad; };
__global__ void __launch_bounds__(NWAVES * 64, 2) fwd_kernel(Args args) {
    extern __shared__ __attribute__((aligned(16))) unsigned char lds[];
    Frame F;
    F.lds = (LAS unsigned char*)lds;
    F.MISC = (volatile LAS unsigned*)(F.lds + MISC_OFF);
    F.wave = __builtin_amdgcn_readfirstlane((int)threadIdx.x >> 6);
    F.G = gridDim.x; { const int bx = blockIdx.x; F.vcu = (F.G % 8 == 0) ? (bx % 8) * (F.G / 8) + bx / 8 : bx; }
    F.ws = args.ws; F.ctl = (gu32*)(args.ws + WS_CTL);
    F.x = args.in[0]; F.g_mix_pre = args.in[1]; F.g_mix_post = args.in[2]; F.g_mlp_pre = args.in[3]; F.g_mlp_post = args.in[4]; F.w_in = args.in[5]; F.b_forget = args.in[6];
    F.pos_k = args.in[7]; F.w1_k = args.in[8]; F.w2_k = args.in[9]; F.pos_v = args.in[10]; F.w1_v = args.in[11]; F.w2_v = args.in[12];
    F.w_fox = args.in[13]; F.w_nsa = args.in[14]; F.w_o = args.in[15]; F.w_up = args.in[16]; F.w_down = args.in[17]; F.out = args.out;
    for (int u = (int)threadIdx.x; u < (LDS_BYTES - LDSCTL_OFF) / 4; u += NWAVES * 64) ((LAS unsigned*)(F.lds + LDSCTL_OFF))[u] = 0u;
    __syncthreads();
    XcdBarrier bar; bar.bar = (unsigned*)(F.ctl + CW_BAR); bar.x = 0; bar.st = nullptr;
    if (N_LAUNCHES == 1) bar = xcd_barrier_post((unsigned*)(F.ctl + CW_BAR), F.MISC + 8);
#define GRID_BAR() do { if (N_LAUNCHES == 1) xcd_barrier(bar); } while (0)
#ifndef P1_ROT
#define P1_ROT 4
#endif
#ifndef GROUP_SYNC
#define GROUP_SYNC 1
#endif
#ifndef GROUP_STAGGER_TICKS
#define GROUP_STAGGER_TICKS 0
#endif
    const bool grp = GROUP_SYNC && N_LAUNCHES == 1 && F.G == 256;
    unsigned ggen = 0u; unsigned* gcnt = (unsigned*)(F.ctl + CW_GBAR) + 64 * (F.vcu >> 5);
    bool colo = false;
    if (grp && threadIdx.x == 0) __hip_atomic_store((unsigned*)(F.ctl + CW_XID) + 64 * (F.vcu >> 5) + (F.vcu & 31), xb_xcc_id() + 1u, __ATOMIC_RELAXED, __HIP_MEMORY_SCOPE_AGENT);
#define PHASE_BAR() do { if (grp) group_barrier((unsigned*)(F.ctl + CW_BAR), gcnt, ggen, 32u, colo); else GRID_BAR(); } while (0)
    const int lo = args.ph_lo, hi = args.ph_hi;
#define IN(k) (lo <= (k) && (k) < hi)
#define BOTH(k) (IN(k) && IN((k) + 1))
#ifndef STAGGER_P7
#define STAGGER_P7 0
#endif
#ifndef STAGGER_P1
#define STAGGER_P1 0
#endif
#ifndef STAGGER_GROUPS
#define STAGGER_GROUPS 8
#endif
#define XCD_STAGGER(ticks) do { if ((ticks) > 0) { const unsigned long long t0_ = rt(); const unsigned long long d_ = (unsigned long long)(xb_xcc_id() & (STAGGER_GROUPS - 1u)) * (unsigned)(ticks) / STAGGER_GROUPS; while (rt() - t0_ < d_) __builtin_amdgcn_s_sleep(8); } } while (0)
#ifndef PROBE_REPEAT
#define PROBE_REPEAT (-1)
#endif
#define REPS(k) for (int rep_ = 0; rep_ < ((PROBE_REPEAT == (k)) ? 2 : 1); ++rep_)
#define REP_BAR(k) do { if (PROBE_REPEAT == (k) && rep_ == 0) { VM_WAIT(); __syncthreads(); GRID_BAR(); } } while (0)

    if (IN(0)) { REPS(0) { p0_prologue(F); REP_BAR(0); } if (BOTH(0)) GRID_BAR(); }
    if (grp && BOTH(0)) {
        if (threadIdx.x == 0) { const unsigned mine = xb_xcc_id() + 1u; unsigned same = 1u;
            for (int k = 0; k < 32; ++k) same &= (xb_ld((unsigned*)(F.ctl + CW_XID) + 64 * (F.vcu >> 5) + k) == mine) ? 1u : 0u;
            F.MISC[12] = same; }
        __syncthreads(); colo = __builtin_amdgcn_readfirstlane((int)F.MISC[12]) != 0; }
    if (grp && GROUP_STAGGER_TICKS > 0) { const unsigned long long t0_ = rt(); const unsigned long long d_ = (unsigned long long)(F.vcu >> 5) * GROUP_STAGGER_TICKS; while (rt() - t0_ < d_) __builtin_amdgcn_s_sleep(8); }

#ifndef P1_HALF_TICKS
#define P1_HALF_TICKS 0
#endif
    if (IN(1)) { XCD_STAGGER(STAGGER_P1);
        if (P1_HALF_TICKS > 0 && ((F.vcu >> 2) & 1)) { const unsigned long long t0_ = rt(); while (rt() - t0_ < (unsigned long long)P1_HALF_TICKS) __builtin_amdgcn_s_sleep(8); }
        pg8::Gemm g{wsp<bf16>(F, WS_HB), wsp<bf16>(F, WS_WIN), MTOK, 11 * 256, DMODEL}; pg8::StaticOrder S; S.init(MTOK, 11 * 256, F.G, (int)blockIdx.x, (((int)blockIdx.x & 7) * 11) / 8);
        pg8::EpiInProj E{wsp<bf16>(F, WS_FQ), wsp<bf16>(F, WS_FQ + 3 * QB_ARR), wsp<bf16>(F, WS_KV), wsp<bf16>(F, WS_SGA),
                         args.pad, wsp<float>(F, WS_LF), wsp<float>(F, WS_GATE), wsp<float>(F, WS_NRM), F.b_forget, wsp<float>(F, WS_ROPEC), wsp<float>(F, WS_ROPES), QB_ARR / 2, QB_GROUP / 2, KV_STRIDE / 2, (WS_SGB - WS_SGA) / 2, QSCALE};
        REPS(1) { pg8::gemm_phase<pg8::EpiInProj, pg8::StaticOrder, true, true>(F.lds + RING_OFF, g, S, E, F.wave); REP_BAR(1); }
        { pg8::Gemm g8{(const pg8::bf16_t*)wsp<unsigned char>(F, WS_SGB), (const pg8::bf16_t*)wsp<unsigned char>(F, WS_WIN8), MTOK, 8 * 256, DMODEL / 2};
          pg8::StaticOrder S8; S8.init(MTOK, 8 * 256, F.G, (int)blockIdx.x, (int)blockIdx.x & 7); pg8::EpiGates8 E8{wsp<unsigned char>(F, WS_SGA), 1.f / WIN8_SCALE};
          pg8::gemm_phase<pg8::EpiGates8, pg8::StaticOrder, true, true, true>(F.lds + RING_OFF, g8, S8, E8, F.wave); }
        for (int mt = F.vcu; mt < MTOK / 256; mt += F.G) p1_tail_unit(F, F.G == 256 ? 32 * (F.vcu >> 5) + (F.vcu & 31) : mt);
        if (BOTH(1)) PHASE_BAR();
    }
#ifdef PROBE_EXTRA_BARS
    if (IN(2)) { for (int eb_ = 0; eb_ < PROBE_EXTRA_BARS; ++eb_) { __syncthreads(); GRID_BAR(); } }
#endif
    if (IN(2)) { REPS(2) { p2_phase(F, rep_ != 0); REP_BAR(2); } if (BOTH(2)) PHASE_BAR(); }
#ifndef PROBE_P3_MODE
#define PROBE_P3_MODE 3
#endif
    if (IN(3)) {
#if PROBE_REPEAT == 3
        for (int rep_ = 0; rep_ < 2; ++rep_) { p3_attention(F, rep_ ? PROBE_P3_MODE : 0); if (rep_ == 0) { VM_WAIT(); __syncthreads(); GRID_BAR(); } }
#else
        p3_attention(F, 0);
#endif
        if (BOTH(3)) PHASE_BAR(); }
    if (IN(4)) { REPS(4) {
        pg8::Gemm g{wsp<bf16>(F, WS_ATT), wsp<bf16>(F, WS_WF), MTOK, DMODEL, DMODEL}; pg8::StaticOrder S; S.init(MTOK, DMODEL, F.G, (int)blockIdx.x);
        pg8::EpiGateMid E{wsp<bf16>(F, WS_HB), (const unsigned char*)(F.ws + WS_SGA), DMODEL};
        pg8::gemm_phase<pg8::EpiGateMid, pg8::StaticOrder, true, true>(F.lds + RING_OFF, g, S, E, F.wave);
        REP_BAR(4); }
        if (BOTH(4)) PHASE_BAR();
    }
    if (IN(5)) {
        pg8::Gemm g{wsp<bf16>(F, WS_HB), wsp<bf16>(F, WS_WO), MTOK, DMODEL, DMODEL}; pg8::StaticOrder S; S.init(MTOK, DMODEL, F.G, (int)blockIdx.x);
        pg8::EpiPlain<0> E{wsp<bf16>(F, WS_Y), DMODEL};
        REPS(5) { pg8::gemm_phase<pg8::EpiPlain<0>, pg8::StaticOrder, true, true>(F.lds + RING_OFF, g, S, E, F.wave); REP_BAR(5); }
        if (BOTH(5)) PHASE_BAR();
    }
    if (IN(6)) { REPS(6) { row_pass<false>(F, F.x, nullptr, wsp<bf16>(F, WS_Y), F.g_mix_post, nullptr, wsp<bf16>(F, WS_HB), wsp<float>(F, WS_RSTD2)); REP_BAR(6); } if (BOTH(6)) PHASE_BAR(); }
#ifndef MLP_CHUNKS
#define MLP_CHUNKS 1
#endif
    if (IN(7) || IN(8)) {
        constexpr int CH = MLP_CHUNKS, MC = MTOK / CH;
#pragma unroll
        for (int ch = 0; ch < CH; ++ch) {
            if (IN(7)) { XCD_STAGGER(STAGGER_P7);
                pg8::Gemm g{wsp<bf16>(F, WS_HB) + (size_t)ch * MC * DMODEL, wsp<bf16>(F, WS_WUP), MC, DFF, DMODEL}; pg8::StaticOrder S; S.init(MC, DFF, F.G, (int)blockIdx.x);
                pg8::EpiRelu2F8 E{wsp<unsigned char>(F, WS_U) + (size_t)ch * MC * DFF, DFF};
                REPS(7) { pg8::gemm_phase<pg8::EpiRelu2F8, pg8::StaticOrder, true, true>(F.lds + RING_OFF, g, S, E, F.wave); REP_BAR(7); }
                if (IN(8)) PHASE_BAR(); }
            if (IN(8)) {
                pg8::Gemm g{(const pg8::bf16_t*)(wsp<unsigned char>(F, WS_U) + (size_t)ch * MC * DFF), (const pg8::bf16_t*)wsp<unsigned char>(F, WS_WDN), MC, DMODEL, DFF / 2}; pg8::StaticOrder S; S.init(MC, DMODEL, F.G, (int)blockIdx.x);
                pg8::EpiScaled E{wsp<bf16>(F, WS_Y) + (size_t)ch * MC * DMODEL, DMODEL, 1.f / WDN_SCALE};
                REPS(8) { pg8::gemm_phase<pg8::EpiScaled, pg8::StaticOrder, true, true, true>(F.lds + RING_OFF, g, S, E, F.wave); REP_BAR(8); }
                if (ch + 1 == CH && BOTH(8)) PHASE_BAR(); }
        }
    }
    if (IN(9)) { row_pass<true>(F, nullptr, wsp<bf16>(F, WS_HB), wsp<bf16>(F, WS_Y), F.g_mlp_post, F.out, nullptr, wsp<float>(F, WS_RSTD2)); }
#ifdef PROBE_COPY
    if (IN(9)) { VM_WAIT(); __syncthreads(); GRID_BAR();
        const int gw = F.vcu * NWAVES + F.wave, NGW = F.G * NWAVES, lane = cur_lane();
        for (int m0 = gw; m0 < MTOK; m0 += NGW * PROBE_COPY) { f32x4 v[PROBE_COPY][4];
#pragma unroll
            for (int r = 0; r < PROBE_COPY; ++r) { const GAS f32x4* xr = (const GAS f32x4*)(F.x + (size_t)(m0 + r * NGW) * DMODEL) + lane;
#pragma unroll
                for (int j = 0; j < 4; ++j) v[r][j] = PROBE_COPY_NT ? __builtin_nontemporal_load(xr + 64 * j) : xr[64 * j]; }
#pragma unroll
            for (int r = 0; r < PROBE_COPY; ++r) { GAS f32x4* xo = (GAS f32x4*)(wsp<float>(F, WS_U) + (size_t)(m0 + r * NGW) * DMODEL) + lane;
#pragma unroll
                for (int j = 0; j < 4; ++j) { if (PROBE_COPY_NT) __builtin_nontemporal_store(v[r][j], xo + 64 * j); else xo[64 * j] = v[r][j]; } } } }
#endif
#undef IN
#undef BOTH
#undef GRID_BAR
}

extern "C" void kernel_launch(void* const* d_in, const int* in_sizes, int n_in, void* d_out, int out_size, void* d_ws, size_t ws_size, hipStream_t stream) {
    static int grid = 0;
    if (grid == 0) {
        if (n_in != 18 || in_sizes[0] != MTOK * DMODEL || out_size != MTOK * DMODEL || ws_size < WS_END) {
            fprintf(stderr, "kernel_launch: built for 18 inputs, x/out of %d floats, >= %zu bytes of workspace; got n_in %d, in0 %d, out %d, ws %zu; nothing launched\n", MTOK * DMODEL, (size_t)WS_END, n_in, n_in > 0 ? in_sizes[0] : -1, out_size, ws_size); grid = -1; return; }
        int dev = 0, cus = 0, per_cu = 0;
        if (hipGetDevice(&dev) != hipSuccess || hipDeviceGetAttribute(&cus, hipDeviceAttributeMultiprocessorCount, dev) != hipSuccess) { fprintf(stderr, "kernel_launch: device query failed\n"); grid = -1; return; }
        if (hipFuncSetAttribute((const void*)fwd_kernel, hipFuncAttributeMaxDynamicSharedMemorySize, LDS_BYTES) != hipSuccess) { fprintf(stderr, "kernel_launch: hipFuncSetAttribute failed\n"); grid = -1; return; }
        if (hipOccupancyMaxActiveBlocksPerMultiprocessor(&per_cu, (const void*)fwd_kernel, NWAVES * 64, LDS_BYTES) != hipSuccess || per_cu < 1)
            fprintf(stderr, "kernel_launch: note: occupancy query reports %d workgroups per CU\n", per_cu);
        (void)hipGetLastError();
        grid = 256;
        if (cus < grid) fprintf(stderr, "kernel_launch: this device reports %d CUs; the 256-workgroup grid cannot be resident: the grid barrier will time out (bounded) and the output will be wrong\n", cus);
    }
    if (grid < 0) return;
    if (hipMemsetAsync((char*)d_ws + WS_CTL, 0, CTL_ZERO_BYTES, stream) != hipSuccess) { fprintf(stderr, "kernel_launch: hipMemsetAsync failed\n"); return; }
    Args a{};
    for (int i = 0; i < 18; ++i) a.in[i] = (const float*)d_in[i];
    a.out = (float*)d_out; a.ws = (unsigned char*)d_ws;
#ifdef PROBE_PREFIX
#ifndef PROBE_EPI_ABL
#define PROBE_EPI_ABL 0
#endif
    a.ph_lo = 0; a.ph_hi = PROBE_PREFIX; a.li = 0; a.pad = PROBE_EPI_ABL;
    hipLaunchKernelGGL(fwd_kernel, dim3(grid), dim3(NWAVES * 64), LDS_BYTES, stream, a);
    if (hipMemsetAsync((char*)d_ws + WS_CTL, 0, CTL_ZERO_BYTES, stream) != hipSuccess) return;
#endif
    for (int li = 0; li < N_LAUNCHES; ++li) {
        a.ph_lo = (N_LAUNCHES == 1) ? 0 : li; a.ph_hi = (N_LAUNCHES == 1) ? N_PHASES : li + 1; a.li = li; a.pad = 0;
        hipLaunchKernelGGL(fwd_kernel, dim3(grid), dim3(NWAVES * 64), LDS_BYTES, stream, a);
        const hipError_t le = hipPeekAtLastError();
        if (le != hipSuccess) { fprintf(stderr, "kernel_launch: launch %d failed: %s\n", li, hipGetErrorName(le)); break; }
    }
}
```
